# Optimizing an MI355X kernel written in HIP

```python
import math
import jax, jax.numpy as jnp
from jax import lax
import numpy as np

D_MODEL = 1024
BATCH = 8
SEQ = 4096
DEPTH = 4

CTX_LEN = 256
GRID_W = 64
HEAD_DIM = 64
A_HEADS = 8
A_KV_HEADS = 2
A_GROUP = A_HEADS // A_KV_HEADS
A_WINDOW = 128
A_BLOCK = 128
B_HEADS = 4
NA_ROWS = 8
NA_COLS = 16
NA_QCOLS = 16
C_HEADS = 4
C_Q_RANK = 256
C_KV_RANK = 128
C_NOPE = 64
C_ROPE = 32
C_V = 64
C_BLOCK = 128
MIX_WIDTH = A_HEADS * HEAD_DIM + B_HEADS * HEAD_DIM + C_HEADS * C_V
IN_WIDTHS = (A_HEADS * HEAD_DIM, A_KV_HEADS * HEAD_DIM, A_KV_HEADS * HEAD_DIM,
             B_HEADS * HEAD_DIM, B_HEADS * HEAD_DIM, B_HEADS * HEAD_DIM,
             C_Q_RANK, C_KV_RANK, C_ROPE)
IN_WIDTH = (A_HEADS + 2 * A_KV_HEADS + 3 * B_HEADS) * HEAD_DIM + C_Q_RANK + C_KV_RANK + C_ROPE
D_FF = 4 * D_MODEL
N_MOD = 6
ROPE_BASE = 10000.0
EPS = 1e-6
NEG_INF = -1e30

kernel_name = 'hybrid_dit_parallel_head_groups'


def rmsnorm(x, g):
    xf = x.astype(jnp.float32)
    y = xf * lax.rsqrt(jnp.mean(jnp.square(xf), axis=-1, keepdims=True) + EPS)
    return (y * g.astype(jnp.float32)).astype(x.dtype)


def modulate(h, shift, scale):
    return h * (1 + scale) + shift


def split_cols(p):
    outs, off = [], 0
    for w in IN_WIDTHS:
        outs.append(p[..., off:off + w])
        off += w
    return outs


def split_heads(t, h):
    return t.reshape(*t.shape[:-1], h, t.shape[-1] // h)


def rope_1d(x, pos):
    half = x.shape[-1] // 2
    freqs = ROPE_BASE ** (-jnp.arange(half, dtype=jnp.float32) / half)
    ang = pos.astype(jnp.float32)[:, None] * freqs
    cos = jnp.cos(ang)[:, None, :].astype(x.dtype)
    sin = jnp.sin(ang)[:, None, :].astype(x.dtype)
    x1, x2 = x[..., :half], x[..., half:]
    return jnp.concatenate([x1 * cos - x2 * sin, x1 * sin + x2 * cos], axis=-1)


def axial_rope(x, row, col):
    n = x.shape[-1] // 2
    return jnp.concatenate([rope_1d(x[..., :n], row), rope_1d(x[..., n:], col)], axis=-1)


def joint_softmax(parts, sink=None):
    parts = [p.astype(jnp.float32) for p in parts]
    m = parts[0].max(axis=-1, keepdims=True)
    for p in parts[1:]:
        m = jnp.maximum(m, p.max(axis=-1, keepdims=True))
    if sink is not None:
        sink = sink.astype(jnp.float32)
        m = jnp.maximum(m, sink)
    exps = [jnp.exp(p - m) for p in parts]
    denom = exps[0].sum(axis=-1, keepdims=True)
    for e in exps[1:]:
        denom = denom + e.sum(axis=-1, keepdims=True)
    if sink is not None:
        denom = denom + jnp.exp(sink - m)
    return [e / denom for e in exps]


def dense_attention(q, k, v, sink=None):
    scale = q.shape[-1] ** -0.5
    s = jnp.einsum('bqhd,bkhd->bhqk', q, k) * scale
    (p,) = joint_softmax([s], None if sink is None else sink[:, None, None])
    return jnp.einsum('bhqk,bkhd->bqhd', p.astype(v.dtype), v)


def windowed_gqa(q, k, v, k_ctx, v_ctx, sink):
    B, S, _, d = q.shape
    nb = S // A_BLOCK
    qb = q.reshape(B, nb, A_BLOCK, A_KV_HEADS, A_GROUP, d)
    pad = ((0, 0), (A_BLOCK, A_BLOCK), (0, 0), (0, 0))

    def band(t):
        tb = jnp.pad(t, pad).reshape(B, nb + 2, A_BLOCK, A_KV_HEADS, d)
        return jnp.concatenate([tb[:, :-2], tb[:, 1:-1], tb[:, 2:]], axis=2)

    kb, vb = band(k), band(v)
    qi = np.arange(A_BLOCK)[:, None]
    ks = np.arange(3 * A_BLOCK)[None, :]
    rel = ks - A_BLOCK - qi
    kpos = (np.arange(nb)[:, None, None] - 1) * A_BLOCK + ks[None]
    mask = (np.abs(rel)[None] <= A_WINDOW) & (kpos >= 0) & (kpos < S)
    scale = d ** -0.5
    s_loc = jnp.einsum('bnqkgd,bnskd->bnkgqs', qb, kb) * scale
    s_loc = jnp.where(mask[None, :, None, None], s_loc.astype(jnp.float32), NEG_INF)
    s_ctx = jnp.einsum('bnqkgd,bckd->bnkgqc', qb, k_ctx) * scale
    p_loc, p_ctx = joint_softmax([s_loc, s_ctx], sink.reshape(A_KV_HEADS, A_GROUP)[:, :, None, None])
    o = (jnp.einsum('bnkgqs,bnskd->bnqkgd', p_loc.astype(v.dtype), vb)
         + jnp.einsum('bnkgqc,bckd->bnqkgd', p_ctx.astype(v.dtype), v_ctx))
    return o.reshape(B, S, A_HEADS * d)


def na_layout(rows):
    kr, kc = min(NA_ROWS, rows), NA_COLS
    qr, qc = math.gcd(rows, NA_ROWS), NA_QCOLS
    krb, kcb = min(qr - 1 + kr, rows), min(qc - 1 + kc, GRID_W)
    nrb, ncb = rows // qr, GRID_W // qc
    q_r = np.arange(nrb)[:, None] * qr + np.arange(qr)[None, :]
    q_c = np.arange(ncb)[:, None] * qc + np.arange(qc)[None, :]
    w_r = np.clip(q_r - kr // 2, 0, rows - kr)
    w_c = np.clip(q_c - kc // 2, 0, GRID_W - kc)
    k_r = np.minimum(w_r[:, 0], rows - krb)[:, None] + np.arange(krb)[None, :]
    k_c = np.minimum(w_c[:, 0], GRID_W - kcb)[:, None] + np.arange(kcb)[None, :]
    qr6 = q_r[:, None, :, None, None, None]
    qc6 = q_c[None, :, None, :, None, None]
    wr6 = w_r[:, None, :, None, None, None]
    wc6 = w_c[None, :, None, :, None, None]
    kr6 = k_r[:, None, None, None, :, None]
    kc6 = k_c[None, :, None, None, None, :]
    shape6 = (nrb, ncb, qr, qc, krb, kcb)

    def flat(a):
        return np.broadcast_to(a, shape6).reshape(nrb, ncb, qr * qc, krb * kcb)

    mask = flat((kr6 >= wr6) & (kr6 < wr6 + kr) & (kc6 >= wc6) & (kc6 < wc6 + kc))
    d_r = flat(np.clip(kr6 - qr6, 1 - NA_ROWS, NA_ROWS - 1) + NA_ROWS - 1)
    d_c = flat(np.clip(kc6 - qc6, 1 - NA_COLS, NA_COLS - 1) + NA_COLS - 1)
    key_tok = (k_r[:, None, :, None] * GRID_W + k_c[None, :, None, :]).reshape(nrb, ncb, krb * kcb)
    return qr, qc, nrb, ncb, mask, d_r, d_c, key_tok


def neighbourhood_attention(q, k, v, k_ctx, v_ctx, rpb):
    B, S, H, d = q.shape
    rows = S // GRID_W
    qr, qc, nrb, ncb, mask, d_r, d_c, key_tok = na_layout(rows)
    qb = q.reshape(B, nrb, qr, ncb, qc, H, d).transpose(0, 1, 3, 2, 4, 5, 6).reshape(B, nrb, ncb, qr * qc, H, d)
    kg = k[:, key_tok]
    vg = v[:, key_tok]
    scale = d ** -0.5
    bias = rpb[:, d_r, d_c].transpose(1, 2, 0, 3, 4)
    s_loc = jnp.einsum('bijqhd,bijkhd->bijhqk', qb, kg) * scale
    s_loc = jnp.where(mask[:, :, None], s_loc.astype(jnp.float32) + bias.astype(jnp.float32), NEG_INF)
    s_ctx = jnp.einsum('bijqhd,bchd->bijhqc', qb, k_ctx) * scale
    p_loc, p_ctx = joint_softmax([s_loc, s_ctx])
    o = (jnp.einsum('bijhqk,bijkhd->bijqhd', p_loc.astype(v.dtype), vg)
         + jnp.einsum('bijhqc,bchd->bijqhd', p_ctx.astype(v.dtype), v_ctx))
    o = o.reshape(B, nrb, ncb, qr, qc, H, d).transpose(0, 1, 3, 2, 4, 5, 6)
    return o.reshape(B, S, H * d)


def mla_q(cq, g, w_uq):
    q = split_heads(rmsnorm(cq, g) @ w_uq, C_HEADS)
    return q[..., :C_NOPE], q[..., C_NOPE:]


def mla_kv(ckv, g, w_ukv):
    kv = split_heads(rmsnorm(ckv, g) @ w_ukv, C_HEADS)
    return kv[..., :C_NOPE], kv[..., C_NOPE:]


def mla_latent(q_nope, q_rope, k_nope, k_rope, v, kn_ctx, kr_ctx, v_ctx):
    B, S, H, _ = q_nope.shape
    kn_all = jnp.concatenate([k_nope, kn_ctx], axis=1)
    kr_all = jnp.concatenate([k_rope, kr_ctx], axis=1)
    v_all = jnp.concatenate([v, v_ctx], axis=1)
    scale = (C_NOPE + C_ROPE) ** -0.5
    nb = S // C_BLOCK

    def block(args):
        qn, qp = args
        s = jnp.einsum('bqhd,bkhd->bhqk', qn, kn_all) + jnp.einsum('bqhr,bkr->bhqk', qp, kr_all)
        (p,) = joint_softmax([s * scale])
        return jnp.einsum('bhqk,bkhd->bqhd', p.astype(v_all.dtype), v_all)

    def to_blocks(t):
        return jnp.moveaxis(t.reshape(B, nb, C_BLOCK, *t.shape[2:]), 1, 0)

    o = lax.map(block, (to_blocks(q_nope), to_blocks(q_rope)))
    return jnp.moveaxis(o, 0, 1).reshape(B, S, H * C_V)


def sq_relu_mlp(h, w1, w2):
    return jnp.square(jax.nn.relu(h @ w1)) @ w2


def setup_inputs(seed: int = 0) -> dict:
    key = jax.random.key(seed)
    ks = jax.random.split(key, 19)

    def nrm(k, shape, s):
        return jax.random.normal(k, shape, jnp.float32) * s

    def gain(k, shape):
        return 1.0 + 0.1 * jax.random.normal(k, shape, jnp.float32)

    return {
        'x': nrm(ks[0], (BATCH, SEQ, D_MODEL), 1.0),
        'c': nrm(ks[1], (BATCH, D_MODEL), 1.0),
        'ctx': nrm(ks[2], (BATCH, CTX_LEN, D_MODEL), 1.0),
        'c_ctx': nrm(ks[3], (D_MODEL,), 1.0),
        'w_ada': nrm(ks[4], (DEPTH, D_MODEL, N_MOD * D_MODEL), 0.5 * D_MODEL ** -0.5),
        'b_ada': nrm(ks[5], (DEPTH, N_MOD * D_MODEL), 0.02),
        'norm1_g': gain(ks[6], (DEPTH, D_MODEL)),
        'norm2_g': gain(ks[7], (DEPTH, D_MODEL)),
        'w_in': nrm(ks[8], (DEPTH, D_MODEL, IN_WIDTH), D_MODEL ** -0.5),
        'attn_sink': nrm(ks[9], (DEPTH, A_HEADS), 0.5),
        'na_rpb': nrm(ks[10], (DEPTH, B_HEADS, 2 * NA_ROWS - 1, 2 * NA_COLS - 1), 0.2),
        'mla_q_norm_g': gain(ks[11], (DEPTH, C_Q_RANK)),
        'mla_w_uq': nrm(ks[12], (DEPTH, C_Q_RANK, C_HEADS * (C_NOPE + C_ROPE)), C_Q_RANK ** -0.5),
        'mla_kv_norm_g': gain(ks[13], (DEPTH, C_KV_RANK)),
        'mla_w_ukv': nrm(ks[14], (DEPTH, C_KV_RANK, C_HEADS * (C_NOPE + C_V)), C_KV_RANK ** -0.5),
        'w_out': nrm(ks[15], (DEPTH, MIX_WIDTH, D_MODEL), MIX_WIDTH ** -0.5),
        'w_mlp_in': nrm(ks[16], (DEPTH, D_MODEL, D_FF), D_MODEL ** -0.5),
        'w_mlp_out': nrm(ks[17], (DEPTH, D_FF, D_MODEL), D_FF ** -0.5),
        'final_norm_g': gain(ks[18], (D_MODEL,)),
    }


def reference(x, c, ctx, c_ctx, w_ada, b_ada, norm1_g, norm2_g, w_in, attn_sink, na_rpb,
              mla_q_norm_g, mla_w_uq, mla_kv_norm_g, mla_w_ukv, w_out, w_mlp_in, w_mlp_out,
              final_norm_g):
    B, S, _ = x.shape
    C = ctx.shape[1]
    tok = jnp.arange(S)
    row, col = tok // GRID_W, tok % GRID_W
    silu_c = jax.nn.silu(c)
    silu_cc = jax.nn.silu(c_ctx)
    for l in range(DEPTH):
        last = l == DEPTH - 1
        mod_x = jnp.split((silu_c @ w_ada[l] + b_ada[l])[:, None, :], N_MOD, axis=-1)
        mod_c = jnp.split(silu_cc @ w_ada[l] + b_ada[l], N_MOD, axis=-1)

        hx = modulate(rmsnorm(x, norm1_g[l]), mod_x[0], mod_x[1])
        hc = modulate(rmsnorm(ctx, norm1_g[l]), mod_c[0], mod_c[1])
        xa_q, xa_k, xa_v, xb_q, xb_k, xb_v, xc_q, xc_kv, xc_kr = split_cols(hx @ w_in[l])
        ca_q, ca_k, ca_v, cb_q, cb_k, cb_v, cc_q, cc_kv, cc_kr = split_cols(hc @ w_in[l])

        ka_c, va_c = split_heads(ca_k, A_KV_HEADS), split_heads(ca_v, A_KV_HEADS)
        kb_c, vb_c = split_heads(cb_k, B_HEADS), split_heads(cb_v, B_HEADS)
        kn_c, vc_c = mla_kv(cc_kv, mla_kv_norm_g[l], mla_w_ukv[l])

        qa = axial_rope(split_heads(xa_q, A_HEADS), row, col)
        ka = axial_rope(split_heads(xa_k, A_KV_HEADS), row, col)
        out_a = windowed_gqa(qa, ka, split_heads(xa_v, A_KV_HEADS), ka_c, va_c, attn_sink[l])
        out_b = neighbourhood_attention(split_heads(xb_q, B_HEADS), split_heads(xb_k, B_HEADS),
                                        split_heads(xb_v, B_HEADS), kb_c, vb_c, na_rpb[l])
        qn, qp = mla_q(xc_q, mla_q_norm_g[l], mla_w_uq[l])
        kn, vc = mla_kv(xc_kv, mla_kv_norm_g[l], mla_w_ukv[l])
        qp = axial_rope(qp, row, col)
        kp = axial_rope(xc_kr[:, :, None, :], row, col)[:, :, 0]
        out_c = mla_latent(qn, qp, kn, kp, vc, kn_c, cc_kr, vc_c)

        x = x + mod_x[2] * (jnp.concatenate([out_a, out_b, out_c], axis=-1) @ w_out[l])

        if not last:
            oa = dense_attention(split_heads(ca_q, A_HEADS), jnp.repeat(ka_c, A_GROUP, axis=2),
                                 jnp.repeat(va_c, A_GROUP, axis=2), attn_sink[l])
            ob = dense_attention(split_heads(cb_q, B_HEADS), kb_c, vb_c)
            qn_c, qp_c = mla_q(cc_q, mla_q_norm_g[l], mla_w_uq[l])
            kp_c = jnp.broadcast_to(cc_kr[:, :, None, :], (B, C, C_HEADS, C_ROPE))
            oc = dense_attention(jnp.concatenate([qn_c, qp_c], axis=-1),
                                 jnp.concatenate([kn_c, kp_c], axis=-1), vc_c)
            mixed_c = jnp.concatenate([oa.reshape(B, C, -1), ob.reshape(B, C, -1),
                                       oc.reshape(B, C, -1)], axis=-1)
            ctx = ctx + mod_c[2] * (mixed_c @ w_out[l])

        x = x + mod_x[5] * sq_relu_mlp(modulate(rmsnorm(x, norm2_g[l]), mod_x[3], mod_x[4]),
                                       w_mlp_in[l], w_mlp_out[l])
        if not last:
            ctx = ctx + mod_c[5] * sq_relu_mlp(modulate(rmsnorm(ctx, norm2_g[l]), mod_c[3], mod_c[4]),
                                               w_mlp_in[l], w_mlp_out[l])
    return rmsnorm(x, final_norm_g)
```

```cpp
#include <hip/hip_runtime.h>
#include <hip/hip_cooperative_groups.h>
#include <cstdio>
#include <cstdint>
namespace cg = cooperative_groups;
namespace pg8 {
#define PG8_LAS __attribute__((address_space(3)))
typedef unsigned short bf16_t;
typedef short bf16x8 __attribute__((ext_vector_type(8)));
typedef float f32x4 __attribute__((ext_vector_type(4)));
typedef unsigned u32x4 __attribute__((ext_vector_type(4)));
constexpr int BM = 256, BK = 64, HALF = 128, HTB = HALF * BK * 2  , STAGE_BYTES = 8 * HTB, NXCD = 8, WGM = 8;

__host__ __device__ __forceinline__ int lds_byte(int r, int c) { const int st = (r >> 4) * 2 + (c >> 5), rr = r & 15, cc = c & 31, ob = rr * 64 + cc * 2; return st * 1024 + (ob ^ (((ob >> 9) & 1) << 5)); }
__host__ __device__ __forceinline__ void stage_rc(int b, int& R, int& C) { const int st = b / 1024, sb = b % 1024, swz = sb ^ (((sb >> 9) & 1) << 5); R = (st >> 1) * 16 + swz / 64; C = (st & 1) * 32 + (swz % 64) / 2; }
__host__ __device__ __forceinline__ int perm32(int rho) { const int n = rho >> 4, i = rho & 15; return 8 * (i >> 2) + 4 * n + (i & 3); }

struct Unit { int pm, pn; };
struct Gemm { const bf16_t* A; const bf16_t* Bt; int M, N, K; };

struct StaticOrder {
    int nM, nN, nwg, G, c;
    __host__ __device__ void init(int M, int N, int G_, int c_) { nM = M / BM; nN = N / BM; nwg = nM * nN; G = G_; c = c_; }
    __host__ __device__ bool next(int i, Unit& u) const {
        const long L = (long)i * G + c; if (L >= nwg) return false;
        int wgid = (int)L; { const int q = nwg / NXCD, r = nwg % NXCD, xcd = wgid % NXCD, off = wgid / NXCD; wgid = (xcd < r ? xcd * (q + 1) : r * (q + 1) + (xcd - r) * q) + off; }
        const int nig = WGM * nN, gid = wgid / nig, fm = gid * WGM, gsz = (nM - fm) < WGM ? (nM - fm) : WGM;
        u.pm = fm + ((wgid % nig) % gsz); u.pn = (wgid % nig) / gsz; return true;
    }
    __device__ __forceinline__ void a_ready(const Unit&) const {}
    __device__ __forceinline__ void done(const Unit&) const {}
};

__device__ __forceinline__ unsigned cvt_pk_bf16(float lo, float hi) { unsigned r; asm volatile("v_cvt_pk_bf16_f32 %0, %1, %2" : "=v"(r) : "v"(lo), "v"(hi)); return r; }
template <class Epi, class Sched, bool ALIGN_EPI = false, bool SP2 = false>
__device__ __forceinline__ void gemm_phase(PG8_LAS unsigned char* lds, const Gemm g, const Sched& S, const Epi& E, const int tid) {
    const int wid = __builtin_amdgcn_readfirstlane(tid >> 6), lane = tid & 63, wr = wid >> 2, wc = wid & 3, fr = lane & 15, fq = lane >> 4;
    const int K = g.K, nt = K / BK;
    unsigned voffA[2], voffB[2];
#pragma unroll
    for (int i = 0; i < 2; ++i) { int R, C; stage_rc(tid * 16 + i * 8192, R, C); const int Rb = Epi::PERM ? ((R & ~31) + perm32(R & 31)) : R;
        voffA[i] = (unsigned)(R * K + C) * 2u; voffB[i] = (unsigned)(Rb * K + C) * 2u; }
    const size_t kstep = (size_t)(BK * 2);
    const size_t hstep = (size_t)HALF * K * 2;
    const size_t tstep = 2 * hstep;
    const unsigned ldsw = (unsigned)wid * 1024u;
    const int aoff = lds_byte(wr * 64 + fr, fq * 8), boff = lds_byte(wc * 32 + fr, fq * 8);
#define PG8_SA(b, h) (((b) * 2 + (h)) * HTB)
#define PG8_SB(b, h) ((4 + (b) * 2 + (h)) * HTB)
#define PG8_STAGE(bufoff, gbase, voff) do { _Pragma("unroll") for (int _i = 0; _i < 2; ++_i) \
        __builtin_amdgcn_global_load_lds((const unsigned*)((const char*)(gbase) + (voff)[_i]), (PG8_LAS unsigned*)(lds + (bufoff) + ldsw + _i * 8192), 16, 0, 0); } while (0)
#define PG8_LDA(dst, b, h) do { _Pragma("unroll") for (int m = 0; m < 4; ++m) _Pragma("unroll") for (int k = 0; k < 2; ++k) dst[m][k] = *(const PG8_LAS bf16x8*)(lds + PG8_SA(b, h) + aoff + m * 2048 + k * 1024); } while (0)
#define PG8_LDB(dst, b, h) do { _Pragma("unroll") for (int n = 0; n < 2; ++n) _Pragma("unroll") for (int k = 0; k < 2; ++k) dst[n][k] = *(const PG8_LAS bf16x8*)(lds + PG8_SB(b, h) + boff + n * 2048 + k * 1024); } while (0)
#define PG8_MMA(ai, bj, At, Bt) do { __builtin_amdgcn_s_setprio(1); _Pragma("unroll") for (int m = 0; m < 4; ++m) _Pragma("unroll") for (int n = 0; n < 2; ++n) _Pragma("unroll") for (int k = 0; k < 2; ++k) \
        acc[ai][bj][m][n] = __builtin_amdgcn_mfma_f32_16x16x32_bf16(Bt[n][k], At[m][k], acc[ai][bj][m][n], 0, 0, 0); __builtin_amdgcn_s_setprio(0); } while (0)
#define PG8_WAIT_V(n) asm volatile("s_waitcnt vmcnt(" #n ")" ::: "memory")
#define PG8_WAIT_L(n) asm volatile("s_waitcnt lgkmcnt(" #n ")" ::: "memory")
#define PG8_BAR __builtin_amdgcn_s_barrier()
#define PG8_SCHED __builtin_amdgcn_sched_barrier(0)
    Unit cur, nxt; int ui = 0;
    if (!S.next(0, cur)) return;
    f32x4 acc[2][2][4][2];
#pragma unroll
    for (int a = 0; a < 2; ++a)
#pragma unroll
        for (int b = 0; b < 2; ++b)
#pragma unroll
            for (int m = 0; m < 4; ++m)
#pragma unroll
                for (int n = 0; n < 2; ++n) acc[a][b][m][n] = (f32x4){0.f, 0.f, 0.f, 0.f};
    bf16x8 At[4][2], B0[2][2], B1[2][2];
    const char* cA = (const char*)g.A + (size_t)cur.pm * tstep; const char* cB = (const char*)g.Bt + (size_t)cur.pn * tstep;
    S.a_ready(cur);
    if constexpr (SP2) {
        PG8_STAGE(PG8_SB(0, 0), cB, voffB); PG8_STAGE(PG8_SB(0, 1), cB + hstep, voffB); PG8_STAGE(PG8_SA(0, 0), cA, voffA); PG8_STAGE(PG8_SA(0, 1), cA + hstep, voffA);
        if (wr == 1) PG8_BAR;
        PG8_WAIT_V(2); PG8_BAR;
        PG8_STAGE(PG8_SB(1, 0), cB + kstep, voffB); PG8_STAGE(PG8_SA(1, 0), cA + kstep, voffA); PG8_STAGE(PG8_SB(1, 1), cB + hstep + kstep, voffB);
        PG8_WAIT_V(6); PG8_BAR;
    } else {
        PG8_STAGE(PG8_SB(0, 0), cB, voffB); PG8_STAGE(PG8_SA(0, 0), cA, voffA); PG8_STAGE(PG8_SB(0, 1), cB + hstep, voffB); PG8_STAGE(PG8_SA(0, 1), cA + hstep, voffA);
        if (wr == 1) PG8_BAR;
        PG8_WAIT_V(4); PG8_BAR;
        PG8_STAGE(PG8_SB(1, 0), cB + kstep, voffB); PG8_STAGE(PG8_SA(1, 0), cA + kstep, voffA); PG8_STAGE(PG8_SB(1, 1), cB + hstep + kstep, voffB);
        PG8_WAIT_V(6); PG8_BAR;
    }
    for (;;) {
        const bool has_next = S.next(ui + 1, nxt);
        const char* nA = has_next ? (const char*)g.A + (size_t)nxt.pm * tstep : cA; const char* nB = has_next ? (const char*)g.Bt + (size_t)nxt.pn * tstep : cB;
        for (int t = 0; t < nt; t += 2) {
            const bool last = (t == nt - 2);
            const char* a1 = cA + (size_t)(t + 1) * kstep;
            const char* a2 = last ? nA : cA + (size_t)(t + 2) * kstep; const char* b2 = last ? nB : cB + (size_t)(t + 2) * kstep;
            const char* a3 = a2 + kstep; const char* b3 = b2 + kstep;
            if (last && has_next) S.a_ready(nxt);
            if constexpr (SP2) {
            PG8_LDB(B0, 0, 0); PG8_LDB(B1, 0, 1); PG8_SCHED; PG8_LDA(At, 0, 0); PG8_STAGE(PG8_SA(1, 1), a1 + hstep, voffA);
            PG8_WAIT_V(8); PG8_WAIT_L(0); PG8_BAR; PG8_MMA(0, 0, At, B0); PG8_MMA(0, 1, At, B1); PG8_BAR; PG8_SCHED;
            PG8_LDA(At, 0, 1); PG8_STAGE(PG8_SB(0, 0), b2, voffB); PG8_STAGE(PG8_SB(0, 1), b2 + hstep, voffB); PG8_STAGE(PG8_SA(0, 0), a2, voffA);
            PG8_WAIT_V(8); PG8_WAIT_L(0); PG8_BAR; PG8_MMA(1, 0, At, B0); PG8_MMA(1, 1, At, B1); PG8_BAR; PG8_SCHED;
            PG8_LDB(B0, 1, 0); PG8_LDB(B1, 1, 1); PG8_SCHED; PG8_LDA(At, 1, 0); PG8_STAGE(PG8_SA(0, 1), a2 + hstep, voffA);
            PG8_WAIT_V(8); PG8_WAIT_L(0); PG8_BAR; PG8_MMA(0, 0, At, B0); PG8_MMA(0, 1, At, B1); PG8_BAR; PG8_SCHED;
            PG8_LDA(At, 1, 1); PG8_STAGE(PG8_SB(1, 0), b3, voffB); PG8_STAGE(PG8_SB(1, 1), b3 + hstep, voffB); PG8_STAGE(PG8_SA(1, 0), a3, voffA);
            PG8_WAIT_V(8); PG8_WAIT_L(0); PG8_BAR; PG8_MMA(1, 0, At, B0); PG8_MMA(1, 1, At, B1); PG8_BAR; PG8_SCHED;
            } else {
            PG8_LDB(B0, 0, 0); PG8_SCHED; PG8_LDA(At, 0, 0); PG8_STAGE(PG8_SA(1, 1), a1 + hstep, voffA);
            PG8_WAIT_L(8); PG8_BAR; PG8_WAIT_L(0); PG8_MMA(0, 0, At, B0); PG8_BAR; PG8_SCHED;
            PG8_LDB(B1, 0, 1); PG8_STAGE(PG8_SB(0, 0), b2, voffB);
            PG8_BAR; PG8_WAIT_L(0); PG8_MMA(0, 1, At, B1); PG8_BAR;
            PG8_LDA(At, 0, 1); PG8_STAGE(PG8_SA(0, 0), a2, voffA);
            PG8_BAR; PG8_WAIT_L(0); PG8_MMA(1, 0, At, B0); PG8_BAR; PG8_SCHED;
            PG8_STAGE(PG8_SB(0, 1), b2 + hstep, voffB);
            PG8_WAIT_V(6); PG8_BAR; PG8_MMA(1, 1, At, B1); PG8_BAR;
            PG8_LDB(B0, 1, 0); PG8_SCHED; PG8_LDA(At, 1, 0); PG8_STAGE(PG8_SA(0, 1), a2 + hstep, voffA);
            PG8_WAIT_L(8); PG8_BAR; PG8_WAIT_L(0); PG8_MMA(0, 0, At, B0); PG8_BAR; PG8_SCHED;
            PG8_LDB(B1, 1, 1); PG8_STAGE(PG8_SB(1, 0), b3, voffB);
            PG8_BAR; PG8_WAIT_L(0); PG8_MMA(0, 1, At, B1); PG8_BAR;
            PG8_LDA(At, 1, 1); PG8_STAGE(PG8_SA(1, 0), a3, voffA);
            PG8_BAR; PG8_WAIT_L(0); PG8_MMA(1, 0, At, B0); PG8_BAR; PG8_SCHED;
            PG8_STAGE(PG8_SB(1, 1), b3 + hstep, voffB);
            PG8_WAIT_V(6); PG8_BAR; PG8_MMA(1, 1, At, B1); PG8_BAR;
            }
        }
        if constexpr (ALIGN_EPI) { if (wr == 0) PG8_BAR; }
        if constexpr (!Epi::AFTER_DRAIN) { E(acc, cur, wr, wc, fr, fq); S.done(cur); }
        if (!has_next) break;
#pragma unroll
        for (int a = 0; a < 2; ++a)
#pragma unroll
            for (int b = 0; b < 2; ++b)
#pragma unroll
                for (int m = 0; m < 4; ++m)
#pragma unroll
                    for (int n = 0; n < 2; ++n) acc[a][b][m][n] = (f32x4){0.f, 0.f, 0.f, 0.f};
        cur = nxt; cA = nA; cB = nB; ++ui;
        if constexpr (ALIGN_EPI) { if (wr == 1) PG8_BAR; }
    }
    PG8_WAIT_V(0);
    if constexpr (!ALIGN_EPI) { if (wr == 0) PG8_BAR; }
    PG8_BAR;
    if constexpr (Epi::AFTER_DRAIN) { E.fused(acc, cur, wr, wc, fr, fq, lds, wid, lane); S.done(cur); }
#undef PG8_SA
#undef PG8_SB
#undef PG8_STAGE
#undef PG8_LDA
#undef PG8_LDB
#undef PG8_MMA
#undef PG8_WAIT_V
#undef PG8_WAIT_L
#undef PG8_BAR
#undef PG8_SCHED
}
}

#define LAS __attribute__((address_space(3)))
#define DI __device__ __forceinline__
typedef unsigned short bf16;
typedef float f32x4 __attribute__((ext_vector_type(4)));
typedef float f32x16 __attribute__((ext_vector_type(16)));
typedef short bf16x8 __attribute__((ext_vector_type(8)));
typedef short s16x4 __attribute__((ext_vector_type(4)));
typedef unsigned u32x2 __attribute__((ext_vector_type(2)));
typedef unsigned u32x4 __attribute__((ext_vector_type(4)));
typedef float f32x2_t __attribute__((ext_vector_type(2)));
typedef __bf16 bf16x2_t __attribute__((ext_vector_type(2)));

#ifndef MK_MASK
#define MK_MASK 0x1ff
#endif
#define PH_EN(k) (((MK_MASK) >> (k)) & 1)
#ifndef MK_PER_PHASE
#define MK_PER_PHASE 0
#endif

constexpr int DM = 1024, NBATCH = 8, SEQ = 4096, DEPTH = 4, CTXL = 256, DFF = 4096;
constexpr int MX = NBATCH * SEQ, MC = NBATCH * CTXL, MT = MX + MC;
constexpr int INW = 1952, PJS = 1536;
constexpr float LOG2E = 1.4426950408889634f;
constexpr float C2A = 0.125f * LOG2E;
constexpr float C2C = 0.10206207261596575f * LOG2E;
constexpr float EPSN = 1e-6f;
constexpr int NTHR = 512;

constexpr size_t MiB = (size_t)1 << 20;
constexpr size_t WS_TAB = 0;
constexpr size_t WS_MODS = 1 * MiB;
constexpr size_t WS_SSQ = 2 * MiB;
constexpr size_t WS_XC = 4 * MiB;
constexpr size_t WS_W = 12 * MiB;
constexpr size_t WL_IN = 0, WL_OUT = 4 * MiB, WL_W1 = 6 * MiB, WL_W2 = 14 * MiB, WL_UQ = 22 * MiB, WL_UKV = 22 * MiB + 256 * 1024, WL_STRIDE = 22 * MiB + 512 * 1024;
constexpr size_t WS_HN = 102 * MiB;
constexpr size_t WS_H1 = 170 * MiB;
constexpr size_t WS_PROJ = 170 * MiB;
constexpr size_t WS_CQ = 272 * MiB;
constexpr size_t WS_CKV = 289 * MiB;
constexpr size_t WS_QM = 298 * MiB;
constexpr size_t WS_KVM = 324 * MiB;
constexpr size_t WS_KRR = 358 * MiB;
constexpr size_t WS_MIX = 362 * MiB;
constexpr size_t WS_END = 442 * MiB;
constexpr int LDS_BYTES = 131072 + 256;

DI unsigned cvtpk(float lo, float hi) { f32x2_t v = {lo, hi}; bf16x2_t b = __builtin_convertvector(v, bf16x2_t); return __builtin_bit_cast(unsigned, b); }
DI void st4bf(bf16* p, f32x4 v) { u32x2 w; w.x = cvtpk(v[0], v[1]); w.y = cvtpk(v[2], v[3]); *(u32x2*)p = w; }
DI float wave_sum(float v) {
#pragma unroll
    for (int o = 1; o < 64; o <<= 1) v += __shfl_xor(v, o);
    return v;
}
DI float fexp2(float x) { return __builtin_amdgcn_exp2f(x); }
#define LDS_WAIT() asm volatile("s_waitcnt lgkmcnt(0)" ::: "memory")

DI f32x4 rope8(f32x4 v, const float* tab  , int fq) {
    const int i0 = 4 * (fq & 1);
    const f32x4 cs = *(const f32x4*)(tab + i0), sn = *(const f32x4*)(tab + 8 + i0);
    f32x4 o;
#pragma unroll
    for (int j = 0; j < 4; ++j) { const float pr = __shfl_xor(v[j], 32); o[j] = (fq < 2) ? v[j] * cs[j] - pr * sn[j] : pr * sn[j] + v[j] * cs[j]; }
    return o;
}

struct EpiInProj {
    static constexpr bool PERM = false, AFTER_DRAIN = false;
    bf16 *proj, *cqb, *ckvb, *krr; float *ssq_q, *ssq_kv; const float *tabA, *tabC;
    DI void operator()(const f32x4 (&acc)[2][2][4][2], const pg8::Unit& u, int wr, int wc, int fr, int fq) const {
        const int pn = u.pn; const bool isx = u.pm < 128;
#pragma unroll
        for (int ai = 0; ai < 2; ++ai)
#pragma unroll
            for (int m = 0; m < 4; ++m) {
                int row = u.pm * 256 + ai * 128 + wr * 64 + m * 16 + fr;
                asm volatile("" : "+v"(row) :: "memory");
                const int tok = row & 4095, prow = tok >> 6, pcol = tok & 63;
                if (pn < 6) {
                    const bool anyrope = isx && pn <= 2;
                    f32x4 cs = {1.f, 1.f, 1.f, 1.f}, sn = {0.f, 0.f, 0.f, 0.f};
                    if (anyrope) { const int pos = (wc & 1) ? pcol : prow; cs = *(const f32x4*)(tabA + pos * 32 + 4 * fq); sn = *(const f32x4*)(tabA + pos * 32 + 16 + 4 * fq); }
#pragma unroll
                    for (int bj = 0; bj < 2; ++bj) {
                        f32x4 v0 = acc[ai][bj][m][0], v1 = acc[ai][bj][m][1];
                        if (anyrope && (pn < 2 || bj == 0)) { const f32x4 a = v0 * cs - v1 * sn, b = v0 * sn + v1 * cs; v0 = a; v1 = b; }
                        if (pn < 2 || pn == 3) { v0 *= C2A; v1 *= C2A; }
                        bf16* p = proj + (size_t)row * PJS + pn * 256 + bj * 128 + wc * 32 + 4 * fq;
                        st4bf(p, v0); st4bf(p + 16, v1);
                    }
                } else if (pn == 6) {
                    float s = 0.f;
#pragma unroll
                    for (int bj = 0; bj < 2; ++bj) {
                        const f32x4 v0 = acc[ai][bj][m][0], v1 = acc[ai][bj][m][1];
                        s += (v0[0] * v0[0] + v0[1] * v0[1]) + (v0[2] * v0[2] + v0[3] * v0[3]) + (v1[0] * v1[0] + v1[1] * v1[1]) + (v1[2] * v1[2] + v1[3] * v1[3]);
                        bf16* p = cqb + (size_t)row * 256 + bj * 128 + wc * 32 + 4 * fq;
                        st4bf(p, v0); st4bf(p + 16, v1);
                    }
                    s += __shfl_xor(s, 16); s += __shfl_xor(s, 32);
                    if (fq == 0) atomicAdd(ssq_q + row, s);
                } else {
                    {
                        const f32x4 v0 = acc[ai][0][m][0], v1 = acc[ai][0][m][1];
                        float s = (v0[0] * v0[0] + v0[1] * v0[1]) + (v0[2] * v0[2] + v0[3] * v0[3]) + (v1[0] * v1[0] + v1[1] * v1[1]) + (v1[2] * v1[2] + v1[3] * v1[3]);
                        bf16* p = ckvb + (size_t)row * 128 + wc * 32 + 4 * fq;
                        st4bf(p, v0); st4bf(p + 16, v1);
                        s += __shfl_xor(s, 16); s += __shfl_xor(s, 32);
                        if (fq == 0) atomicAdd(ssq_kv + row, s);
                    }
                    if (wc == 0) {
                        f32x4 v0 = acc[ai][1][m][0], v1 = acc[ai][1][m][1];
                        if (isx) { v0 = rope8(v0, tabC + prow * 16, fq); v1 = rope8(v1, tabC + pcol * 16, fq); }
                        bf16* p = krr + (size_t)row * 32 + 4 * fq;
                        st4bf(p, v0); st4bf(p + 16, v1);
                    }
                }
            }
    }
};

struct EpiUQ {
    static constexpr bool PERM = false, AFTER_DRAIN = false;
    bf16* qm; const float* ssq_q; const float* tabC;
    DI void operator()(const f32x4 (&acc)[2][2][4][2], const pg8::Unit& u, int wr, int wc, int fr, int fq) const {
        const int pn = u.pn; const bool isx = u.pm < 128;
#pragma unroll
        for (int ai = 0; ai < 2; ++ai)
#pragma unroll
            for (int m = 0; m < 4; ++m) {
                int row = u.pm * 256 + ai * 128 + wr * 64 + m * 16 + fr;
                asm volatile("" : "+v"(row) :: "memory");
                const int tok = row & 4095, prow = tok >> 6, pcol = tok & 63;
                const float rs = rsqrtf(ssq_q[row] * (1.0f / 256.0f) + EPSN) * C2C;
#pragma unroll
                for (int bj = 0; bj < 2; ++bj)
#pragma unroll
                    for (int n = 0; n < 2; ++n) {
                        const int col0 = pn * 256 + bj * 128 + wc * 32 + n * 16;
                        if (col0 < 384) {
                            f32x4 v = acc[ai][bj][m][n] * rs;
                            const int g6 = (col0 >> 4) % 6;
                            if (isx && g6 >= 4) v = rope8(v, tabC + (g6 == 4 ? prow : pcol) * 16, fq);
                            st4bf(qm + (size_t)row * 384 + col0 + 4 * fq, v);
                        }
                    }
            }
    }
};

struct EpiUKV {
    static constexpr bool PERM = false, AFTER_DRAIN = false;
    bf16* kvm; const float* ssq_kv;
    DI void operator()(const f32x4 (&acc)[2][2][4][2], const pg8::Unit& u, int wr, int wc, int fr, int fq) const {
#pragma unroll
        for (int ai = 0; ai < 2; ++ai)
#pragma unroll
            for (int m = 0; m < 4; ++m) {
                int row = u.pm * 256 + ai * 128 + wr * 64 + m * 16 + fr;
                asm volatile("" : "+v"(row) :: "memory");
                const float rs = rsqrtf(ssq_kv[row] * (1.0f / 128.0f) + EPSN);
#pragma unroll
                for (int bj = 0; bj < 2; ++bj)
#pragma unroll
                    for (int n = 0; n < 2; ++n) {
                        const int col0 = u.pn * 256 + bj * 128 + wc * 32 + n * 16;
                        st4bf(kvm + (size_t)row * 512 + col0 + 4 * fq, acc[ai][bj][m][n] * rs);
                    }
            }
    }
};

struct EpiRelu2 {
    static constexpr bool PERM = true, AFTER_DRAIN = false;
    bf16* H;
    DI void operator()(const f32x4 (&acc)[2][2][4][2], const pg8::Unit& u, int wr, int wc, int fr, int fq) const {
        const int row0 = u.pm * 256 + wr * 64 + fr, col0 = u.pn * 256 + wc * 32 + 8 * fq;
#pragma unroll
        for (int ai = 0; ai < 2; ++ai)
#pragma unroll
            for (int m = 0; m < 4; ++m) {
                bf16* rowp = H + (size_t)(row0 + ai * 128 + m * 16) * DFF + col0;
#pragma unroll
                for (int bj = 0; bj < 2; ++bj) {
                    f32x4 v0 = acc[ai][bj][m][0], v1 = acc[ai][bj][m][1];
#pragma unroll
                    for (int j = 0; j < 4; ++j) { const float a = fmaxf(v0[j], 0.f), b = fmaxf(v1[j], 0.f); v0[j] = a * a; v1[j] = b * b; }
                    u32x4 w; w.x = cvtpk(v0[0], v0[1]); w.y = cvtpk(v0[2], v0[3]); w.z = cvtpk(v1[0], v1[1]); w.w = cvtpk(v1[2], v1[3]);
                    *(u32x4*)(rowp + bj * 128) = w;
                }
            }
    }
};

struct EpiResid {
    static constexpr bool PERM = false, AFTER_DRAIN = false;
    const float *srcx, *srcc; float *dstx, *dstc; const float* gate;
    DI void operator()(const f32x4 (&acc)[2][2][4][2], const pg8::Unit& u, int wr, int wc, int fr, int fq) const {
        const bool isx = u.pm < 128; const int mi = isx ? (u.pm >> 4) : 8;
        const int col0 = u.pn * 256 + wc * 32 + 4 * fq;
        f32x4 gv[2][2];
#pragma unroll
        for (int bj = 0; bj < 2; ++bj)
#pragma unroll
            for (int n = 0; n < 2; ++n) gv[bj][n] = *(const f32x4*)(gate + mi * 6144 + col0 + bj * 128 + n * 16);
#pragma unroll
        for (int ai = 0; ai < 2; ++ai)
#pragma unroll
            for (int m = 0; m < 4; ++m) {
                int row = u.pm * 256 + ai * 128 + wr * 64 + m * 16 + fr;
                asm volatile("" : "+v"(row) :: "memory");
                const float* s = isx ? srcx + (size_t)row * DM : srcc + (size_t)(row - MX) * DM;
                float* d = isx ? dstx + (size_t)row * DM : dstc + (size_t)(row - MX) * DM;
#pragma unroll
                for (int bj = 0; bj < 2; ++bj)
#pragma unroll
                    for (int n = 0; n < 2; ++n) { const int off = col0 + bj * 128 + n * 16; *(f32x4*)(d + off) = *(const f32x4*)(s + off) + gv[bj][n] * acc[ai][bj][m][n]; }
            }
    }
};

DI void transpose_item(const float* W, int K, int N, bf16* WT, const float* kscale, LAS float* scr, int item, int lane) {
    const int nblk = N / 32, kb = item / nblk, nb = item % nblk, k0 = 64 * kb, n0 = 32 * nb;
#pragma unroll 8
    for (int i = 0; i < 32; ++i) { const int kk = 2 * i + (lane >> 5); float w = W[(size_t)(k0 + kk) * N + n0 + (lane & 31)]; if (kscale) w *= kscale[k0 + kk]; scr[kk * 33 + (lane & 31)] = w; }
    LDS_WAIT();
    const int c = lane & 7;
#pragma unroll
    for (int j = 0; j < 4; ++j) { const int n = (lane >> 3) + 8 * j; const LAS float* s = scr + (8 * c) * 33 + n;
        u32x4 o; o.x = cvtpk(s[0 * 33], s[1 * 33]); o.y = cvtpk(s[2 * 33], s[3 * 33]); o.z = cvtpk(s[4 * 33], s[5 * 33]); o.w = cvtpk(s[6 * 33], s[7 * 33]);
        *(u32x4*)(WT + (size_t)(n0 + n) * K + k0 + 8 * c) = o; }
    LDS_WAIT();
}

struct Args { const float* in[19]; float* out; unsigned char* ws; int ph_lo, ph_hi; };

DI void prologue(const Args& a, LAS unsigned char* lds, const int tid) {
    const int lane = tid & 63, wave = __builtin_amdgcn_readfirstlane(tid >> 6);
    const int G = gridDim.x, bx = blockIdx.x;
    unsigned char* ws = a.ws;
    {
        LAS float* sl = (LAS float*)lds;
        LAS float* red = (LAS float*)(lds + 36864);
        const float* c = a.in[1]; const float* cc = a.in[3]; const float* w_ada = a.in[4]; const float* b_ada = a.in[5];
        float* mods = (float*)(ws + WS_MODS);
        for (int idx = tid; idx < 9 * 1024; idx += NTHR) { const int mi = idx >> 10, k = idx & 1023; const float v = mi < 8 ? c[mi * 1024 + k] : cc[k]; sl[idx] = v / (1.0f + expf(-v)); }
        __syncthreads();
        for (int item = bx; item < DEPTH * 96; item += G) {
            const int l = item / 96, n0 = (item % 96) * 64, col = tid & 63, kg = wave;
            float acc[9];
#pragma unroll
            for (int mi = 0; mi < 9; ++mi) acc[mi] = 0.f;
            const float* w = w_ada + ((size_t)l * 1024 + kg * 128) * 6144 + n0 + col;
#pragma unroll 4
            for (int k = 0; k < 128; ++k) { const float wv = w[(size_t)k * 6144];
#pragma unroll
                for (int mi = 0; mi < 9; ++mi) acc[mi] += sl[mi * 1024 + kg * 128 + k] * wv; }
#pragma unroll
            for (int mi = 0; mi < 9; ++mi) red[(kg * 9 + mi) * 64 + col] = acc[mi];
            __syncthreads();
            for (int o = tid; o < 576; o += NTHR) { const int mi = o >> 6, cq = o & 63; float s = b_ada[l * 6144 + n0 + cq];
#pragma unroll
                for (int g = 0; g < 8; ++g) s += red[(g * 9 + mi) * 64 + cq];
                mods[(size_t)(l * 9 + mi) * 6144 + n0 + cq] = s; }
            __syncthreads();
        }
    }
    {
        const int gid = bx * NTHR + tid, NG = G * NTHR;
        float* tabA = (float*)(ws + WS_TAB); float* tabC = tabA + 2048;
        if (gid < 1024) { const int pos = gid >> 4, i = gid & 15; const float fr = exp2f(-(float)i * (1.0f / 16.0f) * 13.287712379549449f); const float rev = ((float)pos * fr) * 0.15915494309189535f;
            tabA[pos * 32 + i] = __builtin_amdgcn_cosf(rev); tabA[pos * 32 + 16 + i] = __builtin_amdgcn_sinf(rev); }
        else if (gid < 1536) { const int g = gid - 1024, pos = g >> 3, i = g & 7; const float fr = exp2f(-(float)i * (1.0f / 8.0f) * 13.287712379549449f); const float rev = ((float)pos * fr) * 0.15915494309189535f;
            tabC[pos * 16 + i] = __builtin_amdgcn_cosf(rev); tabC[pos * 16 + 8 + i] = __builtin_amdgcn_sinf(rev); }
        float* ssq = (float*)(ws + WS_SSQ);
        for (int i = gid; i < DEPTH * 2 * MT; i += NG) ssq[i] = 0.f;
        const u32x4 z = {0u, 0u, 0u, 0u};
        for (int i = gid; i < DEPTH * 12288; i += NG) { const int l = i / 12288, r = i % 12288; ((u32x4*)(ws + WS_W + l * WL_STRIDE + WL_IN + (size_t)INW * 1024 * 2))[r] = z; }
        for (int i = gid; i < DEPTH * 4096; i += NG) { const int l = i / 4096, r = i % 4096; ((u32x4*)(ws + WS_W + l * WL_STRIDE + WL_UQ + (size_t)384 * 256 * 2))[r] = z; }
    }
    {
        LAS float* scr = (LAS float*)(lds + wave * 16384);
        const int gw = bx * 8 + wave, NGW = G * 8;
        constexpr int I_IN = 16 * 61, I_OUT = 16 * 32, I_W1 = 16 * 128, I_W2 = 64 * 32, I_UQ = 4 * 12, I_UKV = 2 * 16, I_L = I_IN + I_OUT + I_W1 + I_W2 + I_UQ + I_UKV;
        for (int it = gw; it < DEPTH * I_L; it += NGW) {
            const int l = it / I_L; int r = it % I_L; unsigned char* wb = ws + WS_W + l * WL_STRIDE;
            if (r < I_IN) { transpose_item(a.in[8] + (size_t)l * 1024 * INW, 1024, INW, (bf16*)(wb + WL_IN), nullptr, scr, r, lane); continue; } r -= I_IN;
            if (r < I_OUT) { transpose_item(a.in[15] + (size_t)l * 1024 * 1024, 1024, 1024, (bf16*)(wb + WL_OUT), nullptr, scr, r, lane); continue; } r -= I_OUT;
            if (r < I_W1) { transpose_item(a.in[16] + (size_t)l * 1024 * 4096, 1024, 4096, (bf16*)(wb + WL_W1), nullptr, scr, r, lane); continue; } r -= I_W1;
            if (r < I_W2) { transpose_item(a.in[17] + (size_t)l * 4096 * 1024, 4096, 1024, (bf16*)(wb + WL_W2), nullptr, scr, r, lane); continue; } r -= I_W2;
            if (r < I_UQ) { transpose_item(a.in[12] + (size_t)l * 256 * 384, 256, 384, (bf16*)(wb + WL_UQ), a.in[11] + l * 256, scr, r, lane); continue; } r -= I_UQ;
            transpose_item(a.in[14] + (size_t)l * 128 * 512, 128, 512, (bf16*)(wb + WL_UKV), a.in[13] + l * 128, scr, r, lane);
        }
    }
}

DI void norm_mod_phase(const float* xs, const float* cs, const float* g, const float* mods_l, int kshift, int kscale, bf16* Hn, int nrows, const int tid) {
    const int lane = tid & 63, gw = blockIdx.x * 8 + (tid >> 6), NGW = gridDim.x * 8;
    for (int row = gw; row < nrows; row += NGW) {
        const float* src = row < MX ? xs + (size_t)row * DM : cs + (size_t)(row - MX) * DM;
        const int mi = row < MX ? (row >> 12) : 8;
        const f32x4* xr = (const f32x4*)src + lane;
        f32x4 v[4]; float s = 0.f;
#pragma unroll
        for (int j = 0; j < 4; ++j) { v[j] = xr[64 * j]; s += (v[j][0] * v[j][0] + v[j][1] * v[j][1]) + (v[j][2] * v[j][2] + v[j][3] * v[j][3]); }
        const float r = rsqrtf(wave_sum(s) * (1.0f / DM) + EPSN);
        const float* mrow = mods_l + (size_t)mi * 6144;
#pragma unroll
        for (int j = 0; j < 4; ++j) { const int col = 256 * j + 4 * lane;
            const f32x4 gg = *(const f32x4*)(g + col), sh = *(const f32x4*)(mrow + kshift * 1024 + col), sc = *(const f32x4*)(mrow + kscale * 1024 + col);
            const f32x4 y = (v[j] * r * gg) * (sc + 1.0f) + sh;
            st4bf(Hn + (size_t)row * DM + col, y); }
    }
}
DI void final_norm_phase(float* x, const float* g, const int tid) {
    const int lane = tid & 63, gw = blockIdx.x * 8 + (tid >> 6), NGW = gridDim.x * 8;
    for (int row = gw; row < MX; row += NGW) {
        f32x4* xr = (f32x4*)(x + (size_t)row * DM) + lane;
        f32x4 v[4]; float s = 0.f;
#pragma unroll
        for (int j = 0; j < 4; ++j) { v[j] = xr[64 * j]; s += (v[j][0] * v[j][0] + v[j][1] * v[j][1]) + (v[j][2] * v[j][2] + v[j][3] * v[j][3]); }
        const float r = rsqrtf(wave_sum(s) * (1.0f / DM) + EPSN);
#pragma unroll
        for (int j = 0; j < 4; ++j) { const f32x4 gg = *(const f32x4*)(g + 256 * j + 4 * lane); xr[64 * j] = v[j] * r * gg; }
    }
}

struct AttnP { const bf16 *proj, *qm, *kvm, *krr; bf16* mix; const float* sink; const float* rpb; };
constexpr int A_VS = 144, L_K = 0, L_V = 64 * 208, L_B = L_V + 64 * A_VS;

template <int TYPE> DI int key_row(int t, int j, int b, int nblk, int kr0, int kc0) {
    if (t < 4) return MX + b * 256 + t * 64 + j;
    const int tt = t - 4;
    if (TYPE == 0) return b * 4096 + (nblk - 1) * 128 + tt * 64 + j;
    if (TYPE == 1) { const int tr = tt / 3, tc = tt - 3 * tr; return b * 4096 + (kr0 + 4 * tr + (j >> 4)) * 64 + kc0 + 16 * tc + (j & 15); }
    return b * 4096 + tt * 64 + j;
}

template <int TYPE> DI void attn_unit(const AttnP& P, int uid, bool isctx, LAS unsigned char* lds, const int tid) {
    constexpr int DQK = TYPE == 2 ? 96 : 64, NKS = DQK / 16, KSTR = DQK * 2 + 16;
    const int lane = tid & 63, w = __builtin_amdgcn_readfirstlane(tid >> 6), r = lane & 31, h = lane >> 5;
    int b, hd, kvh = 0, qrow, nblk = 0, kr0 = 0, kc0 = 0, qr = 0, qc = 0, tb0 = 4, tb1 = 4;
    if (TYPE == 0) {
        int gp;
        if (!isctx) { b = uid >> 7; kvh = (uid >> 6) & 1; nblk = (uid >> 1) & 31; gp = uid & 1; qrow = b * 4096 + nblk * 128 + (w & 3) * 32 + r; tb0 = nblk == 0 ? 6 : 4; tb1 = nblk == 31 ? 8 : 10; }
        else { b = uid >> 3; kvh = (uid >> 2) & 1; gp = (uid >> 1) & 1; nblk = uid & 1; qrow = MX + b * 256 + nblk * 128 + (w & 3) * 32 + r; }
        hd = kvh * 4 + gp * 2 + (w >> 2);
    } else if (TYPE == 1) {
        if (!isctx) { b = uid >> 6; hd = (uid >> 4) & 3; const int ib = (uid >> 1) & 7, cp = uid & 1;
            qr = 8 * ib + 2 * (w & 3) + (r >> 4); qc = 16 * (2 * cp + (w >> 2)) + (r & 15); qrow = b * 4096 + qr * 64 + qc;
            kr0 = min(max(8 * ib - 4, 0), 48); kc0 = 16 * cp; tb1 = 16; }
        else { b = uid >> 2; hd = uid & 3; qrow = MX + b * 256 + w * 32 + r; }
    } else {
        if (!isctx) { b = uid >> 6; hd = (uid >> 4) & 3; qrow = b * 4096 + (uid & 15) * 256 + w * 32 + r; tb1 = 68; }
        else { b = uid >> 2; hd = uid & 3; qrow = MX + b * 256 + w * 32 + r; }
    }
    const int NTA = 4 + (tb1 - tb0);
    const bf16* qp; int ocol;
    if (TYPE == 0) { qp = P.proj + (size_t)qrow * PJS + hd * 64; ocol = hd * 64; }
    else if (TYPE == 1) { qp = P.proj + (size_t)qrow * PJS + 768 + hd * 64; ocol = 512 + hd * 64; }
    else { qp = P.qm + (size_t)qrow * 384 + hd * 96; ocol = 768 + hd * 64; }
    bf16x8 qf[NKS];
#pragma unroll
    for (int ks = 0; ks < NKS; ++ks) qf[ks] = *(const bf16x8*)(qp + 16 * ks + 8 * h);

    __syncthreads();
    LAS float* lbias = (LAS float*)(lds + L_B);
    if (TYPE == 1 && !isctx) { if (tid < 465) lbias[tid] = P.rpb[hd * 465 + tid] * LOG2E; }

    float m_ = -1e30f, l_ = 0.f;
    if (TYPE == 0) { m_ = P.sink[hd] * LOG2E; l_ = (h == 0) ? 1.f : 0.f; }
    f32x16 o0, o1;
#pragma unroll
    for (int i = 0; i < 16; ++i) { o0[i] = 0.f; o1[i] = 0.f; }

    u32x4 kreg, vreg, rreg = {0u, 0u, 0u, 0u};
    const int sj = tid >> 3, sc = tid & 7;
#define AT_LOAD(t) do { const int kr_ = key_row<TYPE>((t), sj, b, nblk, kr0, kc0); \
        if (TYPE == 2) { const bf16* base_ = P.kvm + (size_t)kr_ * 512 + hd * 128 + sc * 8; kreg = *(const u32x4*)base_; vreg = *(const u32x4*)(base_ + 64); \
            if (tid < 256) { const int kr2_ = key_row<TYPE>((t), tid >> 2, b, nblk, kr0, kc0); rreg = *(const u32x4*)(P.krr + (size_t)kr2_ * 32 + (tid & 3) * 8); } } \
        else { const bf16* base_ = P.proj + (size_t)kr_ * PJS + (TYPE == 0 ? 512 + kvh * 64 : 1024 + hd * 64) + sc * 8; kreg = *(const u32x4*)base_; vreg = *(const u32x4*)(base_ + (TYPE == 0 ? 128 : 256)); } } while (0)
    AT_LOAD(0);
    const int q4 = (lane & 15) >> 2, p4 = lane & 3, blk = (lane >> 4) & 1;
    const LAS unsigned char* vb = lds + L_V + (4 * h + q4) * A_VS + (16 * blk + 4 * p4) * 2;
    const LAS unsigned char* kb0 = lds + L_K + r * KSTR + 16 * h;
    const int wr_ = min(max(qr - 4, 0), 56), wc_ = min(max(qc - 8, 0), 48);
    const int qi = (w & 3) * 32 + r;

    for (int it = 0; it < NTA; ++it) {
        const int t = it < 4 ? it : it - 4 + tb0;
        __syncthreads();
        *(LAS u32x4*)(lds + L_K + sj * KSTR + sc * 16) = kreg;
        *(LAS u32x4*)(lds + L_V + sj * A_VS + sc * 16) = vreg;
        if (TYPE == 2) { if (tid < 256) *(LAS u32x4*)(lds + L_K + (tid >> 2) * KSTR + 128 + (tid & 3) * 16) = rreg; }
        __syncthreads();
        if (it + 1 < NTA) { const int tn = (it + 1) < 4 ? (it + 1) : (it + 1) - 4 + tb0; AT_LOAD(tn); }
        f32x16 p0, p1;
#pragma unroll
        for (int i = 0; i < 16; ++i) { p0[i] = 0.f; p1[i] = 0.f; }
#pragma unroll
        for (int ks = 0; ks < NKS; ++ks) {
            const bf16x8 a0 = *(const LAS bf16x8*)(kb0 + ks * 32), a1 = *(const LAS bf16x8*)(kb0 + 32 * KSTR + ks * 32);
            p0 = __builtin_amdgcn_mfma_f32_32x32x16_bf16(a0, qf[ks], p0, 0, 0, 0);
            p1 = __builtin_amdgcn_mfma_f32_32x32x16_bf16(a1, qf[ks], p1, 0, 0, 0);
        }
        if (t >= 4) {
            if (TYPE == 0) {
                const int d0 = 64 * (t - 4) - qi + 4 * h;
#pragma unroll
                for (int i = 0; i < 16; ++i) { const int e = d0 + (i & 3) + 8 * (i >> 2);
                    if ((unsigned)e > 256u) p0[i] = -1e30f;
                    if ((unsigned)(e + 32) > 256u) p1[i] = -1e30f; }
            } else if (TYPE == 1) {
                const int tt = t - 4, tr = tt / 3, tc = tt - 3 * tr;
                const int krb = kr0 + 4 * tr, kcb = kc0 + 16 * tc + 4 * h;
#pragma unroll
                for (int i = 0; i < 16; ++i) {
                    const int kc = kcb + (i & 3) + 8 * ((i >> 2) & 1);
                    const bool cv = (unsigned)(kc - wc_) < 16u;
                    const int ci = kc - qc + 15;
                    { const int kr = krb + (i >> 3); const bool v = cv && ((unsigned)(kr - wr_) < 8u); const int idx = v ? (kr - qr + 7) * 31 + ci : 0; const float bv = lbias[idx]; p0[i] = v ? p0[i] + bv : -1e30f; }
                    { const int kr = krb + 2 + (i >> 3); const bool v = cv && ((unsigned)(kr - wr_) < 8u); const int idx = v ? (kr - qr + 7) * 31 + ci : 0; const float bv = lbias[idx]; p1[i] = v ? p1[i] + bv : -1e30f; }
                }
            }
        }
        float mx = fmaxf(p0[0], p1[0]);
#pragma unroll
        for (int i = 1; i < 16; ++i) mx = fmaxf(mx, fmaxf(p0[i], p1[i]));
        mx = fmaxf(mx, __shfl_xor(mx, 32));
        const float mnew = fmaxf(m_, mx), alpha = fexp2(m_ - mnew);
        m_ = mnew;
        float ls = 0.f;
#pragma unroll
        for (int i = 0; i < 16; ++i) { p0[i] = fexp2(p0[i] - mnew); p1[i] = fexp2(p1[i] - mnew); ls += p0[i] + p1[i]; }
        l_ = l_ * alpha + ls;
#pragma unroll
        for (int i = 0; i < 16; ++i) { o0[i] *= alpha; o1[i] *= alpha; }
        bf16x8 pf[4];
#pragma unroll
        for (int s = 0; s < 4; ++s) {
            u32x4 pw;
            if (s < 2) { pw.x = cvtpk(p0[8 * s + 0], p0[8 * s + 1]); pw.y = cvtpk(p0[8 * s + 2], p0[8 * s + 3]); pw.z = cvtpk(p0[8 * s + 4], p0[8 * s + 5]); pw.w = cvtpk(p0[8 * s + 6], p0[8 * s + 7]); }
            else { const int s2 = s - 2; pw.x = cvtpk(p1[8 * s2 + 0], p1[8 * s2 + 1]); pw.y = cvtpk(p1[8 * s2 + 2], p1[8 * s2 + 3]); pw.z = cvtpk(p1[8 * s2 + 4], p1[8 * s2 + 5]); pw.w = cvtpk(p1[8 * s2 + 6], p1[8 * s2 + 7]); }
            pf[s] = __builtin_bit_cast(bf16x8, pw);
        }
#pragma unroll
        for (int s = 0; s < 4; ++s) {
#pragma unroll
            for (int c = 0; c < 2; ++c) {
                const s16x4 lo = __builtin_bit_cast(s16x4, __builtin_amdgcn_ds_read_tr16_b64_v4i16((LAS s16x4*)(vb + (16 * s) * A_VS + c * 64)));
                const s16x4 hi = __builtin_bit_cast(s16x4, __builtin_amdgcn_ds_read_tr16_b64_v4i16((LAS s16x4*)(vb + (16 * s + 8) * A_VS + c * 64)));
                const bf16x8 vf = __builtin_shufflevector(lo, hi, 0, 1, 2, 3, 4, 5, 6, 7);
                if (c == 0) o0 = __builtin_amdgcn_mfma_f32_32x32x16_bf16(vf, pf[s], o0, 0, 0, 0);
                else o1 = __builtin_amdgcn_mfma_f32_32x32x16_bf16(vf, pf[s], o1, 0, 0, 0);
            }
        }
    }
#undef AT_LOAD
    const float lt = l_ + __shfl_xor(l_, 32), inv = 1.0f / lt;
    bf16* op = P.mix + (size_t)qrow * DM + ocol + 4 * h;
#pragma unroll
    for (int g = 0; g < 4; ++g) {
        const f32x4 v0 = {o0[4 * g] * inv, o0[4 * g + 1] * inv, o0[4 * g + 2] * inv, o0[4 * g + 3] * inv};
        const f32x4 v1 = {o1[4 * g] * inv, o1[4 * g + 1] * inv, o1[4 * g + 2] * inv, o1[4 * g + 3] * inv};
        st4bf(op + 8 * g, v0); st4bf(op + 32 + 8 * g, v1);
    }
}

DI void attn_phase(const AttnP& P, bool last, LAS unsigned char* lds, const int tid) {
    const int G = gridDim.x, bx = blockIdx.x;
    const int vcu = (G % 8 == 0) ? (bx % 8) * (G / 8) + bx / 8 : bx;
    const int NU = 2048 + (last ? 0 : 128);
    for (int u = vcu; u < NU; u += G) {
        if (u < 512) attn_unit<2>(P, u, false, lds, tid);
        else if (u < 1024) attn_unit<1>(P, u - 512, false, lds, tid);
        else if (u < 2048) attn_unit<0>(P, u - 1024, false, lds, tid);
        else if (u < 2080) attn_unit<2>(P, u - 2048, true, lds, tid);
        else if (u < 2112) attn_unit<1>(P, u - 2080, true, lds, tid);
        else attn_unit<0>(P, u - 2112, true, lds, tid);
    }
}

constexpr int NPH = 2 + 8 * DEPTH;
__global__ void __launch_bounds__(NTHR) mk_fwd(Args a) {
    extern __shared__ __attribute__((aligned(16))) unsigned char lds_raw[];
    LAS unsigned char* lds = (LAS unsigned char*)lds_raw;
    const int G = gridDim.x, bx = blockIdx.x;
    const int ph_lo = a.ph_lo, ph_hi = a.ph_hi;

    for (int ph = ph_lo; ph < ph_hi; ++ph) {
        int tid = threadIdx.x; asm volatile("" : "+v"(tid));
        unsigned char* ws = a.ws; asm volatile("" : "+s"(ws));
        float* mods = (float*)(ws + WS_MODS);
        const float* tabA = (const float*)(ws + WS_TAB); const float* tabC = tabA + 2048;
        float* Xc = (float*)(ws + WS_XC);
        bf16* Hn = (bf16*)(ws + WS_HN); bf16* H1 = (bf16*)(ws + WS_H1);
        bf16* proj = (bf16*)(ws + WS_PROJ); bf16* cqb = (bf16*)(ws + WS_CQ); bf16* ckvb = (bf16*)(ws + WS_CKV);
        bf16* qm = (bf16*)(ws + WS_QM); bf16* kvm = (bf16*)(ws + WS_KVM); bf16* krr = (bf16*)(ws + WS_KRR); bf16* mix = (bf16*)(ws + WS_MIX);

        if (ph == 0) { if (PH_EN(0)) prologue(a, lds, tid); }
        else if (ph == NPH - 1) { if (PH_EN(8)) final_norm_phase(a.out, a.in[18], tid); }
        else {
            const int l = (ph - 1) >> 3, s = (ph - 1) & 7; const bool last = (l == DEPTH - 1);
            unsigned char* wb = ws + WS_W + (size_t)l * WL_STRIDE;
            const float* mods_l = mods + (size_t)l * 9 * 6144;
            float* ssq_q = (float*)(ws + WS_SSQ) + (size_t)l * 2 * MT; float* ssq_kv = ssq_q + MT;
            const float* xsrc = (l == 0) ? a.in[0] : a.out;
            const float* csrc = (l == 0) ? a.in[2] : Xc;
            if (s == 0) { if (PH_EN(1)) norm_mod_phase(xsrc, csrc, a.in[6] + l * DM, mods_l, 0, 1, Hn, MT, tid); }
            else if (s == 1) { if (PH_EN(2)) {
                pg8::Gemm g{Hn, (const bf16*)(wb + WL_IN), MT, 2048, DM}; pg8::StaticOrder S; S.init(MT, 2048, G, bx);
                EpiInProj E{proj, cqb, ckvb, krr, ssq_q, ssq_kv, tabA, tabC};
                pg8::gemm_phase<EpiInProj, pg8::StaticOrder, true, true>(lds, g, S, E, tid); }
            } else if (s == 2) { if (PH_EN(3)) {
                { int Kq = 256; asm volatile("" : "+s"(Kq)); pg8::Gemm g{cqb, (const bf16*)(wb + WL_UQ), MT, 512, Kq}; pg8::StaticOrder S; S.init(MT, 512, G, bx);
                  EpiUQ E{qm, ssq_q, tabC}; pg8::gemm_phase<EpiUQ, pg8::StaticOrder, true, true>(lds, g, S, E, tid); }
                { int Kk = 128; asm volatile("" : "+s"(Kk)); pg8::Gemm g{ckvb, (const bf16*)(wb + WL_UKV), MT, 512, Kk}; pg8::StaticOrder S; S.init(MT, 512, G, (bx + G / 2) % G);
                  EpiUKV E{kvm, ssq_kv}; pg8::gemm_phase<EpiUKV, pg8::StaticOrder, true, true>(lds, g, S, E, tid); } }
            } else if (s == 3) { if (PH_EN(4)) {
                AttnP P{proj, qm, kvm, krr, mix, a.in[9] + l * 8, a.in[10] + l * 4 * 465};
                attn_phase(P, last, lds, tid); }
            } else if (s == 4 || s == 7) { if (PH_EN(5)) {
                const int Mr = last ? MX : MT;
                const bool outp = (s == 4);
                pg8::Gemm g{outp ? mix : H1, (const bf16*)(wb + (outp ? WL_OUT : WL_W2)), Mr, DM, outp ? DM : DFF}; pg8::StaticOrder S; S.init(Mr, DM, G, bx);
                EpiResid E{(outp ? xsrc : a.out), (outp ? csrc : Xc), a.out, Xc, mods_l + (outp ? 2 : 5) * 1024};
                pg8::gemm_phase<EpiResid, pg8::StaticOrder, true, true>(lds, g, S, E, tid); }
            } else if (s == 5) { if (PH_EN(6)) norm_mod_phase(a.out, Xc, a.in[7] + l * DM, mods_l, 3, 4, Hn, last ? MX : MT, tid); }
            else if (PH_EN(7)) {
                const int Mr = last ? MX : MT;
                pg8::Gemm g{Hn, (const bf16*)(wb + WL_W1), Mr, DFF, DM}; pg8::StaticOrder S; S.init(Mr, DFF, G, bx);
                EpiRelu2 E{H1}; pg8::gemm_phase<EpiRelu2, pg8::StaticOrder, true, true>(lds, g, S, E, tid);
            }
        }
        if (ph + 1 < ph_hi) cg::this_grid().sync();
    }
}

extern "C" void kernel_launch(void* const* d_in, const int* in_sizes, int n_in, void* d_out, int out_size, void* d_ws, size_t ws_size, hipStream_t stream) {
    static int grid = 0;
    if (grid == 0) {
        if (n_in != 19 || ws_size < WS_END) { fprintf(stderr, "kernel_launch: unexpected inputs (n_in %d, ws %zu)\n", n_in, ws_size); grid = -1; return; }
        int dev = 0, cus = 0, per_cu = 0;
        hipGetDevice(&dev); hipDeviceGetAttribute(&cus, hipDeviceAttributeMultiprocessorCount, dev);
        hipFuncSetAttribute((const void*)mk_fwd, hipFuncAttributeMaxDynamicSharedMemorySize, LDS_BYTES);
        hipOccupancyMaxActiveBlocksPerMultiprocessor(&per_cu, (const void*)mk_fwd, NTHR, LDS_BYTES);
        if (per_cu < 1) { fprintf(stderr, "kernel_launch: occupancy query says %d\n", per_cu); per_cu = 1; }
        (void)hipGetLastError();
        grid = cus * 1;
    }
    if (grid < 0) return;
    Args a{};
    for (int i = 0; i < 19; ++i) a.in[i] = (const float*)d_in[i];
    a.out = (float*)d_out; a.ws = (unsigned char*)d_ws;
#if MK_PER_PHASE
    for (int ph = 0; ph < NPH; ++ph) { a.ph_lo = ph; a.ph_hi = ph + 1; hipLaunchKernelGGL(mk_fwd, dim3(grid), dim3(NTHR), LDS_BYTES, stream, a); }
#else
    a.ph_lo = 0; a.ph_hi = NPH;
    void* args[] = {&a};
    hipError_t e = hipLaunchCooperativeKernel((const void*)mk_fwd, dim3(grid), dim3(NTHR), args, LDS_BYTES, stream);
    if (e != hipSuccess) fprintf(stderr, "cooperative launch failed: %s (grid %d)\n", hipGetErrorString(e), grid);
#endif
}
```

```cpp
#include <hip/hip_runtime.h>
#include <hip/hip_cooperative_groups.h>
#include <cstdio>
#include <cstdint>
namespace cg = cooperative_groups;
namespace pg8 {
#define PG8_LAS __attribute__((address_space(3)))
typedef unsigned short bf16_t;
typedef short bf16x8 __attribute__((ext_vector_type(8)));
typedef float f32x4 __attribute__((ext_vector_type(4)));
typedef unsigned u32x4 __attribute__((ext_vector_type(4)));
constexpr int BM = 256, BK = 64, HALF = 128, HTB = HALF * BK * 2  , STAGE_BYTES = 8 * HTB, NXCD = 8, WGM = 8;

__host__ __device__ __forceinline__ int lds_byte(int r, int c) { const int st = (r >> 4) * 2 + (c >> 5), rr = r & 15, cc = c & 31, ob = rr * 64 + cc * 2; return st * 1024 + (ob ^ (((ob >> 9) & 1) << 5)); }
__host__ __device__ __forceinline__ void stage_rc(int b, int& R, int& C) { const int st = b / 1024, sb = b % 1024, swz = sb ^ (((sb >> 9) & 1) << 5); R = (st >> 1) * 16 + swz / 64; C = (st & 1) * 32 + (swz % 64) / 2; }
__host__ __device__ __forceinline__ int perm32(int rho) { const int n = rho >> 4, i = rho & 15; return 8 * (i >> 2) + 4 * n + (i & 3); }

struct Unit { int pm, pn; };
struct Gemm { const bf16_t* A; const bf16_t* Bt; int M, N, K; };

struct StaticOrder {
    int nM, nN, nwg, G, c;
    __host__ __device__ void init(int M, int N, int G_, int c_) { nM = M / BM; nN = N / BM; nwg = nM * nN; G = G_; c = c_; }
    __host__ __device__ bool next(int i, Unit& u) const {
        const long L = (long)i * G + c; if (L >= nwg) return false;
        int wgid = (int)L; { const int q = nwg / NXCD, r = nwg % NXCD, xcd = wgid % NXCD, off = wgid / NXCD; wgid = (xcd < r ? xcd * (q + 1) : r * (q + 1) + (xcd - r) * q) + off; }
        const int nig = WGM * nN, gid = wgid / nig, fm = gid * WGM, gsz = (nM - fm) < WGM ? (nM - fm) : WGM;
        u.pm = fm + ((wgid % nig) % gsz); u.pn = (wgid % nig) / gsz; return true;
    }
    __device__ __forceinline__ void a_ready(const Unit&) const {}
    __device__ __forceinline__ void done(const Unit&) const {}
};

__device__ __forceinline__ unsigned cvt_pk_bf16(float lo, float hi) { unsigned r; asm volatile("v_cvt_pk_bf16_f32 %0, %1, %2" : "=v"(r) : "v"(lo), "v"(hi)); return r; }
template <class Epi, class Sched, bool ALIGN_EPI = false, bool SP2 = false>
__device__ __forceinline__ void gemm_phase(PG8_LAS unsigned char* lds, const Gemm g, const Sched& S, const Epi& E, const int tid) {
    const int wid = __builtin_amdgcn_readfirstlane(tid >> 6), lane = tid & 63, wr = wid >> 2, wc = wid & 3, fr = lane & 15, fq = lane >> 4;
    const int K = g.K, nt = K / BK;
    unsigned voffA[2], voffB[2];
#pragma unroll
    for (int i = 0; i < 2; ++i) { int R, C; stage_rc(tid * 16 + i * 8192, R, C); const int Rb = Epi::PERM ? ((R & ~31) + perm32(R & 31)) : R;
        voffA[i] = (unsigned)(R * K + C) * 2u; voffB[i] = (unsigned)(Rb * K + C) * 2u; }
    const size_t kstep = (size_t)(BK * 2);
    const size_t hstep = (size_t)HALF * K * 2;
    const size_t tstep = 2 * hstep;
    const unsigned ldsw = (unsigned)wid * 1024u;
    const int aoff = lds_byte(wr * 64 + fr, fq * 8), boff = lds_byte(wc * 32 + fr, fq * 8);
#define PG8_SA(b, h) (((b) * 2 + (h)) * HTB)
#define PG8_SB(b, h) ((4 + (b) * 2 + (h)) * HTB)
#define PG8_STAGE(bufoff, gbase, voff) do { _Pragma("unroll") for (int _i = 0; _i < 2; ++_i) \
        __builtin_amdgcn_global_load_lds((const unsigned*)((const char*)(gbase) + (voff)[_i]), (PG8_LAS unsigned*)(lds + (bufoff) + ldsw + _i * 8192), 16, 0, 0); } while (0)
#define PG8_LDA(dst, b, h) do { _Pragma("unroll") for (int m = 0; m < 4; ++m) _Pragma("unroll") for (int k = 0; k < 2; ++k) dst[m][k] = *(const PG8_LAS bf16x8*)(lds + PG8_SA(b, h) + aoff + m * 2048 + k * 1024); } while (0)
#define PG8_LDB(dst, b, h) do { _Pragma("unroll") for (int n = 0; n < 2; ++n) _Pragma("unroll") for (int k = 0; k < 2; ++k) dst[n][k] = *(const PG8_LAS bf16x8*)(lds + PG8_SB(b, h) + boff + n * 2048 + k * 1024); } while (0)
#define PG8_MMA(ai, bj, At, Bt) do { __builtin_amdgcn_s_setprio(1); _Pragma("unroll") for (int m = 0; m < 4; ++m) _Pragma("unroll") for (int n = 0; n < 2; ++n) _Pragma("unroll") for (int k = 0; k < 2; ++k) \
        acc[ai][bj][m][n] = __builtin_amdgcn_mfma_f32_16x16x32_bf16(Bt[n][k], At[m][k], acc[ai][bj][m][n], 0, 0, 0); __builtin_amdgcn_s_setprio(0); } while (0)
#define PG8_WAIT_V(n) asm volatile("s_waitcnt vmcnt(" #n ")" ::: "memory")
#define PG8_WAIT_L(n) asm volatile("s_waitcnt lgkmcnt(" #n ")" ::: "memory")
#define PG8_BAR __builtin_amdgcn_s_barrier()
#define PG8_SCHED __builtin_amdgcn_sched_barrier(0)
    Unit cur, nxt; int ui = 0;
    if (!S.next(0, cur)) return;
    f32x4 acc[2][2][4][2];
#pragma unroll
    for (int a = 0; a < 2; ++a)
#pragma unroll
        for (int b = 0; b < 2; ++b)
#pragma unroll
            for (int m = 0; m < 4; ++m)
#pragma unroll
                for (int n = 0; n < 2; ++n) acc[a][b][m][n] = (f32x4){0.f, 0.f, 0.f, 0.f};
    bf16x8 At[4][2], B0[2][2], B1[2][2];
    const char* cA = (const char*)g.A + (size_t)cur.pm * tstep; const char* cB = (const char*)g.Bt + (size_t)cur.pn * tstep;
    S.a_ready(cur);
    if constexpr (SP2) {
        PG8_STAGE(PG8_SB(0, 0), cB, voffB); PG8_STAGE(PG8_SB(0, 1), cB + hstep, voffB); PG8_STAGE(PG8_SA(0, 0), cA, voffA); PG8_STAGE(PG8_SA(0, 1), cA + hstep, voffA);
        if (wr == 1) PG8_BAR;
        PG8_WAIT_V(2); PG8_BAR;
        PG8_STAGE(PG8_SB(1, 0), cB + kstep, voffB); PG8_STAGE(PG8_SA(1, 0), cA + kstep, voffA); PG8_STAGE(PG8_SB(1, 1), cB + hstep + kstep, voffB);
        PG8_WAIT_V(6); PG8_BAR;
    } else {
        PG8_STAGE(PG8_SB(0, 0), cB, voffB); PG8_STAGE(PG8_SA(0, 0), cA, voffA); PG8_STAGE(PG8_SB(0, 1), cB + hstep, voffB); PG8_STAGE(PG8_SA(0, 1), cA + hstep, voffA);
        if (wr == 1) PG8_BAR;
        PG8_WAIT_V(4); PG8_BAR;
        PG8_STAGE(PG8_SB(1, 0), cB + kstep, voffB); PG8_STAGE(PG8_SA(1, 0), cA + kstep, voffA); PG8_STAGE(PG8_SB(1, 1), cB + hstep + kstep, voffB);
        PG8_WAIT_V(6); PG8_BAR;
    }
    for (;;) {
        const bool has_next = S.next(ui + 1, nxt);
        const char* nA = has_next ? (const char*)g.A + (size_t)nxt.pm * tstep : cA; const char* nB = has_next ? (const char*)g.Bt + (size_t)nxt.pn * tstep : cB;
        for (int t = 0; t < nt; t += 2) {
            const bool last = (t == nt - 2);
            const char* a1 = cA + (size_t)(t + 1) * kstep;
            const char* a2 = last ? nA : cA + (size_t)(t + 2) * kstep; const char* b2 = last ? nB : cB + (size_t)(t + 2) * kstep;
            const char* a3 = a2 + kstep; const char* b3 = b2 + kstep;
            if (last && has_next) S.a_ready(nxt);
            if constexpr (SP2) {
            PG8_LDB(B0, 0, 0); PG8_LDB(B1, 0, 1); PG8_SCHED; PG8_LDA(At, 0, 0); PG8_STAGE(PG8_SA(1, 1), a1 + hstep, voffA);
            PG8_WAIT_V(8); PG8_WAIT_L(0); PG8_BAR; PG8_MMA(0, 0, At, B0); PG8_MMA(0, 1, At, B1); PG8_BAR; PG8_SCHED;
            PG8_LDA(At, 0, 1); PG8_STAGE(PG8_SB(0, 0), b2, voffB); PG8_STAGE(PG8_SB(0, 1), b2 + hstep, voffB); PG8_STAGE(PG8_SA(0, 0), a2, voffA);
            PG8_WAIT_V(8); PG8_WAIT_L(0); PG8_BAR; PG8_MMA(1, 0, At, B0); PG8_MMA(1, 1, At, B1); PG8_BAR; PG8_SCHED;
            PG8_LDB(B0, 1, 0); PG8_LDB(B1, 1, 1); PG8_SCHED; PG8_LDA(At, 1, 0); PG8_STAGE(PG8_SA(0, 1), a2 + hstep, voffA);
            PG8_WAIT_V(8); PG8_WAIT_L(0); PG8_BAR; PG8_MMA(0, 0, At, B0); PG8_MMA(0, 1, At, B1); PG8_BAR; PG8_SCHED;
            PG8_LDA(At, 1, 1); PG8_STAGE(PG8_SB(1, 0), b3, voffB); PG8_STAGE(PG8_SB(1, 1), b3 + hstep, voffB); PG8_STAGE(PG8_SA(1, 0), a3, voffA);
            PG8_WAIT_V(8); PG8_WAIT_L(0); PG8_BAR; PG8_MMA(1, 0, At, B0); PG8_MMA(1, 1, At, B1); PG8_BAR; PG8_SCHED;
            } else {
            PG8_LDB(B0, 0, 0); PG8_SCHED; PG8_LDA(At, 0, 0); PG8_STAGE(PG8_SA(1, 1), a1 + hstep, voffA);
            PG8_WAIT_L(8); PG8_BAR; PG8_WAIT_L(0); PG8_MMA(0, 0, At, B0); PG8_BAR; PG8_SCHED;
            PG8_LDB(B1, 0, 1); PG8_STAGE(PG8_SB(0, 0), b2, voffB);
            PG8_BAR; PG8_WAIT_L(0); PG8_MMA(0, 1, At, B1); PG8_BAR;
            PG8_LDA(At, 0, 1); PG8_STAGE(PG8_SA(0, 0), a2, voffA);
            PG8_BAR; PG8_WAIT_L(0); PG8_MMA(1, 0, At, B0); PG8_BAR; PG8_SCHED;
            PG8_STAGE(PG8_SB(0, 1), b2 + hstep, voffB);
            PG8_WAIT_V(6); PG8_BAR; PG8_MMA(1, 1, At, B1); PG8_BAR;
            PG8_LDB(B0, 1, 0); PG8_SCHED; PG8_LDA(At, 1, 0); PG8_STAGE(PG8_SA(0, 1), a2 + hstep, voffA);
            PG8_WAIT_L(8); PG8_BAR; PG8_WAIT_L(0); PG8_MMA(0, 0, At, B0); PG8_BAR; PG8_SCHED;
            PG8_LDB(B1, 1, 1); PG8_STAGE(PG8_SB(1, 0), b3, voffB);
            PG8_BAR; PG8_WAIT_L(0); PG8_MMA(0, 1, At, B1); PG8_BAR;
            PG8_LDA(At, 1, 1); PG8_STAGE(PG8_SA(1, 0), a3, voffA);
            PG8_BAR; PG8_WAIT_L(0); PG8_MMA(1, 0, At, B0); PG8_BAR; PG8_SCHED;
            PG8_STAGE(PG8_SB(1, 1), b3 + hstep, voffB);
            PG8_WAIT_V(6); PG8_BAR; PG8_MMA(1, 1, At, B1); PG8_BAR;
            }
        }
        if constexpr (ALIGN_EPI) { if (wr == 0) PG8_BAR; }
        if constexpr (!Epi::AFTER_DRAIN) { E(acc, cur, wr, wc, fr, fq); S.done(cur); }
        if (!has_next) break;
#pragma unroll
        for (int a = 0; a < 2; ++a)
#pragma unroll
            for (int b = 0; b < 2; ++b)
#pragma unroll
                for (int m = 0; m < 4; ++m)
#pragma unroll
                    for (int n = 0; n < 2; ++n) acc[a][b][m][n] = (f32x4){0.f, 0.f, 0.f, 0.f};
        cur = nxt; cA = nA; cB = nB; ++ui;
        if constexpr (ALIGN_EPI) { if (wr == 1) PG8_BAR; }
    }
    PG8_WAIT_V(0);
    if constexpr (!ALIGN_EPI) { if (wr == 0) PG8_BAR; }
    PG8_BAR;
    if constexpr (Epi::AFTER_DRAIN) { E.fused(acc, cur, wr, wc, fr, fq, lds, wid, lane); S.done(cur); }
#undef PG8_SA
#undef PG8_SB
#undef PG8_STAGE
#undef PG8_LDA
#undef PG8_LDB
#undef PG8_MMA
#undef PG8_WAIT_V
#undef PG8_WAIT_L
#undef PG8_BAR
#undef PG8_SCHED
}
}

#define LAS __attribute__((address_space(3)))
#define DI __device__ __forceinline__
typedef unsigned short bf16;
typedef float f32x4 __attribute__((ext_vector_type(4)));
typedef float f32x16 __attribute__((ext_vector_type(16)));
typedef short bf16x8 __attribute__((ext_vector_type(8)));
typedef short s16x4 __attribute__((ext_vector_type(4)));
typedef unsigned u32x2 __attribute__((ext_vector_type(2)));
typedef unsigned u32x4 __attribute__((ext_vector_type(4)));
typedef float f32x2_t __attribute__((ext_vector_type(2)));
typedef __bf16 bf16x2_t __attribute__((ext_vector_type(2)));

#ifndef MK_MASK
#define MK_MASK 0x1ff
#endif
#define PH_EN(k) (((MK_MASK) >> (k)) & 1)
#ifndef MK_PER_PHASE
#define MK_PER_PHASE 0
#endif

constexpr int DM = 1024, NBATCH = 8, SEQ = 4096, DEPTH = 4, CTXL = 256, DFF = 4096;
constexpr int MX = NBATCH * SEQ, MC = NBATCH * CTXL, MT = MX + MC;
constexpr int INW = 1952, PJS = 1536;
constexpr float LOG2E = 1.4426950408889634f;
constexpr float C2A = 0.125f * LOG2E;
constexpr float C2C = 0.10206207261596575f * LOG2E;
constexpr float EPSN = 1e-6f;
constexpr int NTHR = 512;

constexpr size_t MiB = (size_t)1 << 20;
constexpr size_t WS_TAB = 0;
constexpr size_t WS_BAR = 65536;
constexpr size_t WS_MODS = 1 * MiB;
constexpr size_t WS_SSQ = 2 * MiB;
constexpr size_t WS_XC = 4 * MiB;
constexpr size_t WS_W = 12 * MiB;
constexpr size_t WL_IN = 0, WL_OUT = 4 * MiB, WL_W1 = 6 * MiB, WL_W2 = 14 * MiB, WL_UQ = 22 * MiB, WL_UKV = 22 * MiB + 256 * 1024, WL_STRIDE = 22 * MiB + 512 * 1024;
constexpr size_t WS_HN = 102 * MiB;
constexpr size_t WS_H1 = 170 * MiB;
constexpr size_t WS_PROJ = 170 * MiB;
constexpr size_t WS_CQ = 272 * MiB;
constexpr size_t WS_CKV = 289 * MiB;
constexpr size_t WS_QM = 298 * MiB;
constexpr size_t WS_KVM = 324 * MiB;
constexpr size_t WS_KRR = 358 * MiB;
constexpr size_t WS_MIX = 362 * MiB;
constexpr size_t WS_END = 442 * MiB;
constexpr int LDS_BYTES = 131072 + 256;

DI unsigned cvtpk(float lo, float hi) { f32x2_t v = {lo, hi}; bf16x2_t b = __builtin_convertvector(v, bf16x2_t); return __builtin_bit_cast(unsigned, b); }
DI void st4bf(bf16* p, f32x4 v) { u32x2 w; w.x = cvtpk(v[0], v[1]); w.y = cvtpk(v[2], v[3]); *(u32x2*)p = w; }
DI float wave_sum(float v) {
#pragma unroll
    for (int o = 1; o < 64; o <<= 1) v += __shfl_xor(v, o);
    return v;
}
DI float fexp2(float x) { return __builtin_amdgcn_exp2f(x); }
#define LDS_WAIT() asm volatile("s_waitcnt lgkmcnt(0)" ::: "memory")

DI f32x4 rope8(f32x4 v, const float* tab  , int fq) {
    const int i0 = 4 * (fq & 1);
    const f32x4 cs = *(const f32x4*)(tab + i0), sn = *(const f32x4*)(tab + 8 + i0);
    f32x4 o;
#pragma unroll
    for (int j = 0; j < 4; ++j) { const float pr = __shfl_xor(v[j], 32); o[j] = (fq < 2) ? v[j] * cs[j] - pr * sn[j] : pr * sn[j] + v[j] * cs[j]; }
    return o;
}

struct EpiInProj {
    static constexpr bool PERM = false, AFTER_DRAIN = false;
    bf16 *proj, *cqb, *ckvb, *krr; float *ssq_q, *ssq_kv; const float *tabA, *tabC;
    DI void operator()(const f32x4 (&acc)[2][2][4][2], const pg8::Unit& u, int wr, int wc, int fr, int fq) const {
        const int pn = u.pn; const bool isx = u.pm < 128;
#pragma unroll
        for (int ai = 0; ai < 2; ++ai)
#pragma unroll
            for (int m = 0; m < 4; ++m) {
                int row = u.pm * 256 + ai * 128 + wr * 64 + m * 16 + fr;
                asm volatile("" : "+v"(row) :: "memory");
                const int tok = row & 4095, prow = tok >> 6, pcol = tok & 63;
                if (pn < 6) {
                    const bool anyrope = isx && pn <= 2;
                    f32x4 cs = {1.f, 1.f, 1.f, 1.f}, sn = {0.f, 0.f, 0.f, 0.f};
                    if (anyrope) { const int pos = (wc & 1) ? pcol : prow; cs = *(const f32x4*)(tabA + pos * 32 + 4 * fq); sn = *(const f32x4*)(tabA + pos * 32 + 16 + 4 * fq); }
#pragma unroll
                    for (int bj = 0; bj < 2; ++bj) {
                        f32x4 v0 = acc[ai][bj][m][0], v1 = acc[ai][bj][m][1];
                        if (anyrope && (pn < 2 || bj == 0)) { const f32x4 a = v0 * cs - v1 * sn, b = v0 * sn + v1 * cs; v0 = a; v1 = b; }
                        if (pn < 2 || pn == 3) { v0 *= C2A; v1 *= C2A; }
                        bf16* p = proj + (size_t)row * PJS + pn * 256 + bj * 128 + wc * 32 + 4 * fq;
                        st4bf(p, v0); st4bf(p + 16, v1);
                    }
                } else if (pn == 6) {
                    float s = 0.f;
#pragma unroll
                    for (int bj = 0; bj < 2; ++bj) {
                        const f32x4 v0 = acc[ai][bj][m][0], v1 = acc[ai][bj][m][1];
                        s += (v0[0] * v0[0] + v0[1] * v0[1]) + (v0[2] * v0[2] + v0[3] * v0[3]) + (v1[0] * v1[0] + v1[1] * v1[1]) + (v1[2] * v1[2] + v1[3] * v1[3]);
                        bf16* p = cqb + (size_t)row * 256 + bj * 128 + wc * 32 + 4 * fq;
                        st4bf(p, v0); st4bf(p + 16, v1);
                    }
                    s += __shfl_xor(s, 16); s += __shfl_xor(s, 32);
                    if (fq == 0) atomicAdd(ssq_q + row, s);
                } else {
                    {
                        const f32x4 v0 = acc[ai][0][m][0], v1 = acc[ai][0][m][1];
                        float s = (v0[0] * v0[0] + v0[1] * v0[1]) + (v0[2] * v0[2] + v0[3] * v0[3]) + (v1[0] * v1[0] + v1[1] * v1[1]) + (v1[2] * v1[2] + v1[3] * v1[3]);
                        bf16* p = ckvb + (size_t)row * 128 + wc * 32 + 4 * fq;
                        st4bf(p, v0); st4bf(p + 16, v1);
                        s += __shfl_xor(s, 16); s += __shfl_xor(s, 32);
                        if (fq == 0) atomicAdd(ssq_kv + row, s);
                    }
                    if (wc == 0) {
                        f32x4 v0 = acc[ai][1][m][0], v1 = acc[ai][1][m][1];
                        if (isx) { v0 = rope8(v0, tabC + prow * 16, fq); v1 = rope8(v1, tabC + pcol * 16, fq); }
                        bf16* p = krr + (size_t)row * 32 + 4 * fq;
                        st4bf(p, v0); st4bf(p + 16, v1);
                    }
                }
            }
    }
};

struct EpiUQ {
    static constexpr bool PERM = false, AFTER_DRAIN = false;
    bf16* qm; const float* ssq_q; const float* tabC;
    DI void operator()(const f32x4 (&acc)[2][2][4][2], const pg8::Unit& u, int wr, int wc, int fr, int fq) const {
        const int pn = u.pn; const bool isx = u.pm < 128;
#pragma unroll
        for (int ai = 0; ai < 2; ++ai)
#pragma unroll
            for (int m = 0; m < 4; ++m) {
                int row = u.pm * 256 + ai * 128 + wr * 64 + m * 16 + fr;
                asm volatile("" : "+v"(row) :: "memory");
                const int tok = row & 4095, prow = tok >> 6, pcol = tok & 63;
                const float rs = rsqrtf(ssq_q[row] * (1.0f / 256.0f) + EPSN) * C2C;
#pragma unroll
                for (int bj = 0; bj < 2; ++bj)
#pragma unroll
                    for (int n = 0; n < 2; ++n) {
                        const int col0 = pn * 256 + bj * 128 + wc * 32 + n * 16;
                        if (col0 < 384) {
                            f32x4 v = acc[ai][bj][m][n] * rs;
                            const int g6 = (col0 >> 4) % 6;
                            if (isx && g6 >= 4) v = rope8(v, tabC + (g6 == 4 ? prow : pcol) * 16, fq);
                            st4bf(qm + (size_t)row * 384 + col0 + 4 * fq, v);
                        }
                    }
            }
    }
};

struct EpiUKV {
    static constexpr bool PERM = false, AFTER_DRAIN = false;
    bf16* kvm; const float* ssq_kv;
    DI void operator()(const f32x4 (&acc)[2][2][4][2], const pg8::Unit& u, int wr, int wc, int fr, int fq) const {
#pragma unroll
        for (int ai = 0; ai < 2; ++ai)
#pragma unroll
            for (int m = 0; m < 4; ++m) {
                int row = u.pm * 256 + ai * 128 + wr * 64 + m * 16 + fr;
                asm volatile("" : "+v"(row) :: "memory");
                const float rs = rsqrtf(ssq_kv[row] * (1.0f / 128.0f) + EPSN);
#pragma unroll
                for (int bj = 0; bj < 2; ++bj)
#pragma unroll
                    for (int n = 0; n < 2; ++n) {
                        const int col0 = u.pn * 256 + bj * 128 + wc * 32 + n * 16;
                        st4bf(kvm + (size_t)row * 512 + col0 + 4 * fq, acc[ai][bj][m][n] * rs);
                    }
            }
    }
};

struct EpiRelu2 {
    static constexpr bool PERM = true, AFTER_DRAIN = false;
    bf16* H;
    DI void operator()(const f32x4 (&acc)[2][2][4][2], const pg8::Unit& u, int wr, int wc, int fr, int fq) const {
        const int row0 = u.pm * 256 + wr * 64 + fr, col0 = u.pn * 256 + wc * 32 + 8 * fq;
#pragma unroll
        for (int ai = 0; ai < 2; ++ai)
#pragma unroll
            for (int m = 0; m < 4; ++m) {
                bf16* rowp = H + (size_t)(row0 + ai * 128 + m * 16) * DFF + col0;
#pragma unroll
                for (int bj = 0; bj < 2; ++bj) {
                    f32x4 v0 = acc[ai][bj][m][0], v1 = acc[ai][bj][m][1];
#pragma unroll
                    for (int j = 0; j < 4; ++j) { const float a = fmaxf(v0[j], 0.f), b = fmaxf(v1[j], 0.f); v0[j] = a * a; v1[j] = b * b; }
                    u32x4 w; w.x = cvtpk(v0[0], v0[1]); w.y = cvtpk(v0[2], v0[3]); w.z = cvtpk(v1[0], v1[1]); w.w = cvtpk(v1[2], v1[3]);
                    *(u32x4*)(rowp + bj * 128) = w;
                }
            }
    }
};

struct EpiResid {
    static constexpr bool PERM = false, AFTER_DRAIN = false;
    const float *srcx, *srcc; float *dstx, *dstc; const float* gate;
    DI void operator()(const f32x4 (&acc)[2][2][4][2], const pg8::Unit& u, int wr, int wc, int fr, int fq) const {
        const bool isx = u.pm < 128; const int mi = isx ? (u.pm >> 4) : 8;
        const int col0 = u.pn * 256 + wc * 32 + 4 * fq;
        f32x4 gv[2][2];
#pragma unroll
        for (int bj = 0; bj < 2; ++bj)
#pragma unroll
            for (int n = 0; n < 2; ++n) gv[bj][n] = *(const f32x4*)(gate + mi * 6144 + col0 + bj * 128 + n * 16);
#pragma unroll
        for (int ai = 0; ai < 2; ++ai)
#pragma unroll
            for (int m = 0; m < 4; ++m) {
                int row = u.pm * 256 + ai * 128 + wr * 64 + m * 16 + fr;
                asm volatile("" : "+v"(row) :: "memory");
                const float* s = isx ? srcx + (size_t)row * DM : srcc + (size_t)(row - MX) * DM;
                float* d = isx ? dstx + (size_t)row * DM : dstc + (size_t)(row - MX) * DM;
#pragma unroll
                for (int bj = 0; bj < 2; ++bj)
#pragma unroll
                    for (int n = 0; n < 2; ++n) { const int off = col0 + bj * 128 + n * 16; *(f32x4*)(d + off) = *(const f32x4*)(s + off) + gv[bj][n] * acc[ai][bj][m][n]; }
            }
    }
};

DI void transpose_item(const float* W, int K, int N, bf16* WT, const float* kscale, LAS float* scr, int item, int lane) {
    const int nblk = N / 32, kb = item / nblk, nb = item % nblk, k0 = 64 * kb, n0 = 32 * nb;
#pragma unroll 8
    for (int i = 0; i < 32; ++i) { const int kk = 2 * i + (lane >> 5); float w = W[(size_t)(k0 + kk) * N + n0 + (lane & 31)]; if (kscale) w *= kscale[k0 + kk]; scr[kk * 33 + (lane & 31)] = w; }
    LDS_WAIT();
    const int c = lane & 7;
#pragma unroll
    for (int j = 0; j < 4; ++j) { const int n = (lane >> 3) + 8 * j; const LAS float* s = scr + (8 * c) * 33 + n;
        u32x4 o; o.x = cvtpk(s[0 * 33], s[1 * 33]); o.y = cvtpk(s[2 * 33], s[3 * 33]); o.z = cvtpk(s[4 * 33], s[5 * 33]); o.w = cvtpk(s[6 * 33], s[7 * 33]);
        *(u32x4*)(WT + (size_t)(n0 + n) * K + k0 + 8 * c) = o; }
    LDS_WAIT();
}

struct Args { const float* in[19]; float* out; unsigned char* ws; int ph_lo, ph_hi; };

DI void prologue(const Args& a, LAS unsigned char* lds, const int tid) {
    const int lane = tid & 63, wave = __builtin_amdgcn_readfirstlane(tid >> 6);
    const int G = gridDim.x, bx = blockIdx.x;
    unsigned char* ws = a.ws;
    {
        LAS float* sl = (LAS float*)lds;
        LAS float* red = (LAS float*)(lds + 36864);
        const float* c = a.in[1]; const float* cc = a.in[3]; const float* w_ada = a.in[4]; const float* b_ada = a.in[5];
        float* mods = (float*)(ws + WS_MODS);
        for (int idx = tid; idx < 9 * 1024; idx += NTHR) { const int mi = idx >> 10, k = idx & 1023; const float v = mi < 8 ? c[mi * 1024 + k] : cc[k]; sl[idx] = v / (1.0f + expf(-v)); }
        __syncthreads();
        for (int item = bx; item < DEPTH * 96; item += G) {
            const int l = item / 96, n0 = (item % 96) * 64, col = tid & 63, kg = wave;
            float acc[9];
#pragma unroll
            for (int mi = 0; mi < 9; ++mi) acc[mi] = 0.f;
            const float* w = w_ada + ((size_t)l * 1024 + kg * 128) * 6144 + n0 + col;
#pragma unroll 4
            for (int k = 0; k < 128; ++k) { const float wv = w[(size_t)k * 6144];
#pragma unroll
                for (int mi = 0; mi < 9; ++mi) acc[mi] += sl[mi * 1024 + kg * 128 + k] * wv; }
#pragma unroll
            for (int mi = 0; mi < 9; ++mi) red[(kg * 9 + mi) * 64 + col] = acc[mi];
            __syncthreads();
            for (int o = tid; o < 576; o += NTHR) { const int mi = o >> 6, cq = o & 63; float s = b_ada[l * 6144 + n0 + cq];
#pragma unroll
                for (int g = 0; g < 8; ++g) s += red[(g * 9 + mi) * 64 + cq];
                mods[(size_t)(l * 9 + mi) * 6144 + n0 + cq] = s; }
            __syncthreads();
        }
    }
    {
        const int gid = bx * NTHR + tid, NG = G * NTHR;
        float* tabA = (float*)(ws + WS_TAB); float* tabC = tabA + 2048;
        if (gid < 1024) { const int pos = gid >> 4, i = gid & 15; const float fr = exp2f(-(float)i * (1.0f / 16.0f) * 13.287712379549449f); const float rev = ((float)pos * fr) * 0.15915494309189535f;
            tabA[pos * 32 + i] = __builtin_amdgcn_cosf(rev); tabA[pos * 32 + 16 + i] = __builtin_amdgcn_sinf(rev); }
        else if (gid < 1536) { const int g = gid - 1024, pos = g >> 3, i = g & 7; const float fr = exp2f(-(float)i * (1.0f / 8.0f) * 13.287712379549449f); const float rev = ((float)pos * fr) * 0.15915494309189535f;
            tabC[pos * 16 + i] = __builtin_amdgcn_cosf(rev); tabC[pos * 16 + 8 + i] = __builtin_amdgcn_sinf(rev); }
        float* ssq = (float*)(ws + WS_SSQ);
        for (int i = gid; i < DEPTH * 2 * MT; i += NG) ssq[i] = 0.f;
        const u32x4 z = {0u, 0u, 0u, 0u};
        for (int i = gid; i < DEPTH * 12288; i += NG) { const int l = i / 12288, r = i % 12288; ((u32x4*)(ws + WS_W + l * WL_STRIDE + WL_IN + (size_t)INW * 1024 * 2))[r] = z; }
        for (int i = gid; i < DEPTH * 4096; i += NG) { const int l = i / 4096, r = i % 4096; ((u32x4*)(ws + WS_W + l * WL_STRIDE + WL_UQ + (size_t)384 * 256 * 2))[r] = z; }
    }
    {
        LAS float* scr = (LAS float*)(lds + wave * 16384);
        const int gw = bx * 8 + wave, NGW = G * 8;
        constexpr int I_IN = 16 * 61, I_OUT = 16 * 32, I_W1 = 16 * 128, I_W2 = 64 * 32, I_UQ = 4 * 12, I_UKV = 2 * 16, I_L = I_IN + I_OUT + I_W1 + I_W2 + I_UQ + I_UKV;
        for (int it = gw; it < DEPTH * I_L; it += NGW) {
            const int l = it / I_L; int r = it % I_L; unsigned char* wb = ws + WS_W + l * WL_STRIDE;
            if (r < I_IN) { transpose_item(a.in[8] + (size_t)l * 1024 * INW, 1024, INW, (bf16*)(wb + WL_IN), nullptr, scr, r, lane); continue; } r -= I_IN;
            if (r < I_OUT) { transpose_item(a.in[15] + (size_t)l * 1024 * 1024, 1024, 1024, (bf16*)(wb + WL_OUT), nullptr, scr, r, lane); continue; } r -= I_OUT;
            if (r < I_W1) { transpose_item(a.in[16] + (size_t)l * 1024 * 4096, 1024, 4096, (bf16*)(wb + WL_W1), nullptr, scr, r, lane); continue; } r -= I_W1;
            if (r < I_W2) { transpose_item(a.in[17] + (size_t)l * 4096 * 1024, 4096, 1024, (bf16*)(wb + WL_W2), nullptr, scr, r, lane); continue; } r -= I_W2;
            if (r < I_UQ) { transpose_item(a.in[12] + (size_t)l * 256 * 384, 256, 384, (bf16*)(wb + WL_UQ), a.in[11] + l * 256, scr, r, lane); continue; } r -= I_UQ;
            transpose_item(a.in[14] + (size_t)l * 128 * 512, 128, 512, (bf16*)(wb + WL_UKV), a.in[13] + l * 128, scr, r, lane);
        }
    }
}

DI void norm_mod_phase(const float* xs, const float* cs, const float* g, const float* mods_l, int kshift, int kscale, bf16* Hn, int nrows, const int tid) {
    const int lane = tid & 63, gw = blockIdx.x * 8 + (tid >> 6), NGW = gridDim.x * 8;
    for (int row = gw; row < nrows; row += NGW) {
        const float* src = row < MX ? xs + (size_t)row * DM : cs + (size_t)(row - MX) * DM;
        const int mi = row < MX ? (row >> 12) : 8;
        const f32x4* xr = (const f32x4*)src + lane;
        f32x4 v[4]; float s = 0.f;
#pragma unroll
        for (int j = 0; j < 4; ++j) { v[j] = xr[64 * j]; s += (v[j][0] * v[j][0] + v[j][1] * v[j][1]) + (v[j][2] * v[j][2] + v[j][3] * v[j][3]); }
        const float r = rsqrtf(wave_sum(s) * (1.0f / DM) + EPSN);
        const float* mrow = mods_l + (size_t)mi * 6144;
#pragma unroll
        for (int j = 0; j < 4; ++j) { const int col = 256 * j + 4 * lane;
            const f32x4 gg = *(const f32x4*)(g + col), sh = *(const f32x4*)(mrow + kshift * 1024 + col), sc = *(const f32x4*)(mrow + kscale * 1024 + col);
            const f32x4 y = (v[j] * r * gg) * (sc + 1.0f) + sh;
            st4bf(Hn + (size_t)row * DM + col, y); }
    }
}
DI void final_norm_phase(float* x, const float* g, const int tid) {
    const int lane = tid & 63, gw = blockIdx.x * 8 + (tid >> 6), NGW = gridDim.x * 8;
    for (int row = gw; row < MX; row += NGW) {
        f32x4* xr = (f32x4*)(x + (size_t)row * DM) + lane;
        f32x4 v[4]; float s = 0.f;
#pragma unroll
        for (int j = 0; j < 4; ++j) { v[j] = xr[64 * j]; s += (v[j][0] * v[j][0] + v[j][1] * v[j][1]) + (v[j][2] * v[j][2] + v[j][3] * v[j][3]); }
        const float r = rsqrtf(wave_sum(s) * (1.0f / DM) + EPSN);
#pragma unroll
        for (int j = 0; j < 4; ++j) { const f32x4 gg = *(const f32x4*)(g + 256 * j + 4 * lane); xr[64 * j] = v[j] * r * gg; }
    }
}

struct AttnP { const bf16 *proj, *qm, *kvm, *krr; bf16* mix; const float* sink; const float* rpb; };
constexpr int A_VS = 144, L_K = 0, L_V = 64 * 208, L_B = L_V + 64 * A_VS;

template <int TYPE> DI int key_row(int t, int j, int b, int nblk, int kr0, int kc0) {
    if (t < 4) return MX + b * 256 + t * 64 + j;
    const int tt = t - 4;
    if (TYPE == 0) return b * 4096 + (nblk - 1) * 128 + tt * 64 + j;
    if (TYPE == 1) { const int tr = tt / 3, tc = tt - 3 * tr; return b * 4096 + (kr0 + 4 * tr + (j >> 4)) * 64 + kc0 + 16 * tc + (j & 15); }
    return b * 4096 + tt * 64 + j;
}

template <int TYPE> DI void attn_unit(const AttnP& P, int uid, bool isctx, LAS unsigned char* lds, const int tid) {
    constexpr int DQK = TYPE == 2 ? 96 : 64, NKS = DQK / 16, KSTR = DQK * 2 + 16;
    const int lane = tid & 63, w = __builtin_amdgcn_readfirstlane(tid >> 6), r = lane & 31, h = lane >> 5;
    int b, hd, kvh = 0, qrow, nblk = 0, kr0 = 0, kc0 = 0, qr = 0, qc = 0, tb0 = 4, tb1 = 4;
    if (TYPE == 0) {
        int gp;
        if (!isctx) { b = uid >> 7; kvh = (uid >> 6) & 1; nblk = (uid >> 1) & 31; gp = uid & 1; qrow = b * 4096 + nblk * 128 + (w & 3) * 32 + r; tb0 = nblk == 0 ? 6 : 4; tb1 = nblk == 31 ? 8 : 10; }
        else { b = uid >> 3; kvh = (uid >> 2) & 1; gp = (uid >> 1) & 1; nblk = uid & 1; qrow = MX + b * 256 + nblk * 128 + (w & 3) * 32 + r; }
        hd = kvh * 4 + gp * 2 + (w >> 2);
    } else if (TYPE == 1) {
        if (!isctx) { b = uid >> 6; hd = (uid >> 4) & 3; const int ib = (uid >> 1) & 7, cp = uid & 1;
            qr = 8 * ib + 2 * (w & 3) + (r >> 4); qc = 16 * (2 * cp + (w >> 2)) + (r & 15); qrow = b * 4096 + qr * 64 + qc;
            kr0 = min(max(8 * ib - 4, 0), 48); kc0 = 16 * cp; tb1 = 16; }
        else { b = uid >> 2; hd = uid & 3; qrow = MX + b * 256 + w * 32 + r; }
    } else {
        if (!isctx) { b = uid >> 6; hd = (uid >> 4) & 3; qrow = b * 4096 + (uid & 15) * 256 + w * 32 + r; tb1 = 68; }
        else { b = uid >> 2; hd = uid & 3; qrow = MX + b * 256 + w * 32 + r; }
    }
    const int NTA = 4 + (tb1 - tb0);
    const bf16* qp; int ocol;
    if (TYPE == 0) { qp = P.proj + (size_t)qrow * PJS + hd * 64; ocol = hd * 64; }
    else if (TYPE == 1) { qp = P.proj + (size_t)qrow * PJS + 768 + hd * 64; ocol = 512 + hd * 64; }
    else { qp = P.qm + (size_t)qrow * 384 + hd * 96; ocol = 768 + hd * 64; }
    bf16x8 qf[NKS];
#pragma unroll
    for (int ks = 0; ks < NKS; ++ks) qf[ks] = *(const bf16x8*)(qp + 16 * ks + 8 * h);

    __syncthreads();
    LAS float* lbias = (LAS float*)(lds + L_B);
    if (TYPE == 1 && !isctx) { if (tid < 465) lbias[tid] = P.rpb[hd * 465 + tid] * LOG2E; }

    float m_ = -1e30f, l_ = 0.f;
    if (TYPE == 0) { m_ = P.sink[hd] * LOG2E; l_ = (h == 0) ? 1.f : 0.f; }
    f32x16 o0, o1;
#pragma unroll
    for (int i = 0; i < 16; ++i) { o0[i] = 0.f; o1[i] = 0.f; }

    u32x4 kreg, vreg, rreg = {0u, 0u, 0u, 0u};
    const int sj = tid >> 3, sc = tid & 7;
#define AT_LOAD(t) do { const int kr_ = key_row<TYPE>((t), sj, b, nblk, kr0, kc0); \
        if (TYPE == 2) { const bf16* base_ = P.kvm + (size_t)kr_ * 512 + hd * 128 + sc * 8; kreg = *(const u32x4*)base_; vreg = *(const u32x4*)(base_ + 64); \
            if (tid < 256) { const int kr2_ = key_row<TYPE>((t), tid >> 2, b, nblk, kr0, kc0); rreg = *(const u32x4*)(P.krr + (size_t)kr2_ * 32 + (tid & 3) * 8); } } \
        else { const bf16* base_ = P.proj + (size_t)kr_ * PJS + (TYPE == 0 ? 512 + kvh * 64 : 1024 + hd * 64) + sc * 8; kreg = *(const u32x4*)base_; vreg = *(const u32x4*)(base_ + (TYPE == 0 ? 128 : 256)); } } while (0)
    AT_LOAD(0);
    const int q4 = (lane & 15) >> 2, p4 = lane & 3, blk = (lane >> 4) & 1;
    const LAS unsigned char* vb = lds + L_V + (4 * h + q4) * A_VS + (16 * blk + 4 * p4) * 2;
    const LAS unsigned char* kb0 = lds + L_K + r * KSTR + 16 * h;
    const int wr_ = min(max(qr - 4, 0), 56), wc_ = min(max(qc - 8, 0), 48);
    const int qi = (w & 3) * 32 + r;

    for (int it = 0; it < NTA; ++it) {
        const int t = it < 4 ? it : it - 4 + tb0;
        __syncthreads();
        *(LAS u32x4*)(lds + L_K + sj * KSTR + sc * 16) = kreg;
        *(LAS u32x4*)(lds + L_V + sj * A_VS + sc * 16) = vreg;
        if (TYPE == 2) { if (tid < 256) *(LAS u32x4*)(lds + L_K + (tid >> 2) * KSTR + 128 + (tid & 3) * 16) = rreg; }
        __syncthreads();
        if (it + 1 < NTA) { const int tn = (it + 1) < 4 ? (it + 1) : (it + 1) - 4 + tb0; AT_LOAD(tn); }
        f32x16 p0, p1;
#pragma unroll
        for (int i = 0; i < 16; ++i) { p0[i] = 0.f; p1[i] = 0.f; }
#pragma unroll
        for (int ks = 0; ks < NKS; ++ks) {
            const bf16x8 a0 = *(const LAS bf16x8*)(kb0 + ks * 32), a1 = *(const LAS bf16x8*)(kb0 + 32 * KSTR + ks * 32);
            p0 = __builtin_amdgcn_mfma_f32_32x32x16_bf16(a0, qf[ks], p0, 0, 0, 0);
            p1 = __builtin_amdgcn_mfma_f32_32x32x16_bf16(a1, qf[ks], p1, 0, 0, 0);
        }
        if (t >= 4) {
            if (TYPE == 0) {
                const int d0 = 64 * (t - 4) - qi + 4 * h;
#pragma unroll
                for (int i = 0; i < 16; ++i) { const int e = d0 + (i & 3) + 8 * (i >> 2);
                    if ((unsigned)e > 256u) p0[i] = -1e30f;
                    if ((unsigned)(e + 32) > 256u) p1[i] = -1e30f; }
            } else if (TYPE == 1) {
                const int tt = t - 4, tr = tt / 3, tc = tt - 3 * tr;
                const int krb = kr0 + 4 * tr, kcb = kc0 + 16 * tc + 4 * h;
#pragma unroll
                for (int i = 0; i < 16; ++i) {
                    const int kc = kcb + (i & 3) + 8 * ((i >> 2) & 1);
                    const bool cv = (unsigned)(kc - wc_) < 16u;
                    const int ci = kc - qc + 15;
                    { const int kr = krb + (i >> 3); const bool v = cv && ((unsigned)(kr - wr_) < 8u); const int idx = v ? (kr - qr + 7) * 31 + ci : 0; const float bv = lbias[idx]; p0[i] = v ? p0[i] + bv : -1e30f; }
                    { const int kr = krb + 2 + (i >> 3); const bool v = cv && ((unsigned)(kr - wr_) < 8u); const int idx = v ? (kr - qr + 7) * 31 + ci : 0; const float bv = lbias[idx]; p1[i] = v ? p1[i] + bv : -1e30f; }
                }
            }
        }
        float mx = fmaxf(p0[0], p1[0]);
#pragma unroll
        for (int i = 1; i < 16; ++i) mx = fmaxf(mx, fmaxf(p0[i], p1[i]));
        mx = fmaxf(mx, __shfl_xor(mx, 32));
        const float mnew = fmaxf(m_, mx), alpha = fexp2(m_ - mnew);
        m_ = mnew;
        float ls = 0.f;
#pragma unroll
        for (int i = 0; i < 16; ++i) { p0[i] = fexp2(p0[i] - mnew); p1[i] = fexp2(p1[i] - mnew); ls += p0[i] + p1[i]; }
        l_ = l_ * alpha + ls;
#pragma unroll
        for (int i = 0; i < 16; ++i) { o0[i] *= alpha; o1[i] *= alpha; }
        bf16x8 pf[4];
#pragma unroll
        for (int s = 0; s < 4; ++s) {
            u32x4 pw;
            if (s < 2) { pw.x = cvtpk(p0[8 * s + 0], p0[8 * s + 1]); pw.y = cvtpk(p0[8 * s + 2], p0[8 * s + 3]); pw.z = cvtpk(p0[8 * s + 4], p0[8 * s + 5]); pw.w = cvtpk(p0[8 * s + 6], p0[8 * s + 7]); }
            else { const int s2 = s - 2; pw.x = cvtpk(p1[8 * s2 + 0], p1[8 * s2 + 1]); pw.y = cvtpk(p1[8 * s2 + 2], p1[8 * s2 + 3]); pw.z = cvtpk(p1[8 * s2 + 4], p1[8 * s2 + 5]); pw.w = cvtpk(p1[8 * s2 + 6], p1[8 * s2 + 7]); }
            pf[s] = __builtin_bit_cast(bf16x8, pw);
        }
#pragma unroll
        for (int s = 0; s < 4; ++s) {
#pragma unroll
            for (int c = 0; c < 2; ++c) {
                const s16x4 lo = __builtin_bit_cast(s16x4, __builtin_amdgcn_ds_read_tr16_b64_v4i16((LAS s16x4*)(vb + (16 * s) * A_VS + c * 64)));
                const s16x4 hi = __builtin_bit_cast(s16x4, __builtin_amdgcn_ds_read_tr16_b64_v4i16((LAS s16x4*)(vb + (16 * s + 8) * A_VS + c * 64)));
                const bf16x8 vf = __builtin_shufflevector(lo, hi, 0, 1, 2, 3, 4, 5, 6, 7);
                if (c == 0) o0 = __builtin_amdgcn_mfma_f32_32x32x16_bf16(vf, pf[s], o0, 0, 0, 0);
                else o1 = __builtin_amdgcn_mfma_f32_32x32x16_bf16(vf, pf[s], o1, 0, 0, 0);
            }
        }
    }
#undef AT_LOAD
    const float lt = l_ + __shfl_xor(l_, 32), inv = 1.0f / lt;
    bf16* op = P.mix + (size_t)qrow * DM + ocol + 4 * h;
#pragma unroll
    for (int g = 0; g < 4; ++g) {
        const f32x4 v0 = {o0[4 * g] * inv, o0[4 * g + 1] * inv, o0[4 * g + 2] * inv, o0[4 * g + 3] * inv};
        const f32x4 v1 = {o1[4 * g] * inv, o1[4 * g + 1] * inv, o1[4 * g + 2] * inv, o1[4 * g + 3] * inv};
        st4bf(op + 8 * g, v0); st4bf(op + 32 + 8 * g, v1);
    }
}

DI void attn_phase(const AttnP& P, bool last, LAS unsigned char* lds, const int tid) {
    const int G = gridDim.x, bx = blockIdx.x;
    const int vcu = (G % 8 == 0) ? (bx % 8) * (G / 8) + bx / 8 : bx;
    const int NU = 2048 + (last ? 0 : 128);
    for (int u = vcu; u < NU; u += G) {
        if (u < 512) attn_unit<2>(P, u, false, lds, tid);
        else if (u < 1024) attn_unit<1>(P, u - 512, false, lds, tid);
        else if (u < 2048) attn_unit<0>(P, u - 1024, false, lds, tid);
        else if (u < 2080) attn_unit<2>(P, u - 2048, true, lds, tid);
        else if (u < 2112) attn_unit<1>(P, u - 2080, true, lds, tid);
        else attn_unit<0>(P, u - 2112, true, lds, tid);
    }
}

#define XB_TMO      128
#define XB_XCNT(j)  (256  + 64 * (j))
#define XB_XSUB(j)  (1280 + 64 * (j))
#define XB_XGEN(j)  (2304 + 64 * (j))
#define XB_TOP      3328
#define XB_TOPGEN   3392
#define XCD_BAR_WORDS 3456
#define XB_SPIN_CAP (1u << 18)

__device__ __forceinline__ unsigned xb_ld(unsigned* p)              { return __hip_atomic_load(p, __ATOMIC_RELAXED, __HIP_MEMORY_SCOPE_AGENT); }
__device__ __forceinline__ unsigned xb_add(unsigned* p, unsigned v) { return __hip_atomic_fetch_add(p, v, __ATOMIC_RELAXED, __HIP_MEMORY_SCOPE_AGENT); }
__device__ __forceinline__ unsigned xb_xcc_id() { return (unsigned)__builtin_amdgcn_s_getreg((3 << 11) | 20) & 0xFu; }
#define XB_SPIN(cond, bar) do { unsigned _sp = 0; while (cond) { __builtin_amdgcn_s_sleep(1); \
    if ((++_sp & 255u) == 0u) { if (xb_ld(&(bar)[XB_TMO])) break; if (_sp > XB_SPIN_CAP) { atomicAdd(&(bar)[XB_TMO], 1u); break; } } } } while (0)

struct XcdBarrier {
    unsigned* bar; unsigned x;
    volatile LAS unsigned* st;
};

__device__ __forceinline__ XcdBarrier xcd_barrier_post(unsigned* bar, volatile LAS unsigned* st) {
    XcdBarrier b; b.bar = bar; b.x = xb_xcc_id(); b.st = st;
    if (threadIdx.x == 0) (void)xb_add(&bar[XB_XCNT(b.x)], 1u);
    return b;
}
__device__ __forceinline__ void xcd_barrier_complete(unsigned* bar, unsigned x, unsigned& nloc, unsigned& nx) {
    const unsigned G = gridDim.x * gridDim.y * gridDim.z;
    unsigned sum, cnt, mine, sp = 0u;
    for (;;) {
        sum = 0u; cnt = 0u; mine = 0u;
#pragma unroll
        for (unsigned j = 0; j < 16; ++j) { const unsigned c = xb_ld(&bar[XB_XCNT(j)]); sum += c; cnt += (c > 0u) ? 1u : 0u; mine = (j == x) ? c : mine; }
        if (sum == G) break;
        __builtin_amdgcn_s_sleep(1);
        if ((++sp & 255u) == 0u) { if (xb_ld(&bar[XB_TMO])) break; if (sp > XB_SPIN_CAP) { atomicAdd(&bar[XB_TMO], 1u); break; } }
    }
    nloc = mine > 0u ? mine : 1u; nx = cnt > 0u ? cnt : 1u;
}

__device__ __forceinline__ void xcd_barrier(const XcdBarrier& b) {
    asm volatile("s_waitcnt vmcnt(0)" ::: "memory");
    __syncthreads();
    if (threadIdx.x == 0) {
        unsigned* bar = b.bar;
        __builtin_amdgcn_s_waitcnt(0);
        unsigned nloc = b.st[0], nx = b.st[1];
        if (nloc == 0u) { xcd_barrier_complete(bar, b.x, nloc, nx); b.st[0] = nloc; b.st[1] = nx; }
        const unsigned old = xb_add(&bar[XB_XSUB(b.x)], 1u);
        const unsigned gen = old / nloc;
        if (old + 1u == (gen + 1u) * nloc) {
            __builtin_amdgcn_fence(__ATOMIC_RELEASE, "agent");
            asm volatile("s_waitcnt vmcnt(0)" ::: "memory");
            const unsigned og = xb_add(&bar[XB_TOP], 1u);
            const unsigned tg = og / nx;
            if (og + 1u == (tg + 1u) * nx) xb_add(&bar[XB_TOPGEN], 1u);
            else XB_SPIN(xb_ld(&bar[XB_TOPGEN]) == tg, bar);
            __builtin_amdgcn_fence(__ATOMIC_ACQUIRE, "agent");
            xb_add(&bar[XB_XGEN(b.x)], 1u);
            asm volatile("s_waitcnt vmcnt(0)" ::: "memory");
        } else {
            XB_SPIN(xb_ld(&bar[XB_XGEN(b.x)]) == gen, bar);
            __builtin_amdgcn_fence(__ATOMIC_ACQUIRE, "agent");
            asm volatile("s_waitcnt vmcnt(0)" ::: "memory");
        }
    }
    __syncthreads();
}

constexpr int NPH = 2 + 8 * DEPTH;
__global__ void __launch_bounds__(NTHR) mk_fwd(Args a) {
    extern __shared__ __attribute__((aligned(16))) unsigned char lds_raw[];
    LAS unsigned char* lds = (LAS unsigned char*)lds_raw;
    const int G = gridDim.x, bx = blockIdx.x;
    const int ph_lo = a.ph_lo, ph_hi = a.ph_hi;
    volatile LAS unsigned* bst = (volatile LAS unsigned*)(lds + 131072);
    if (threadIdx.x < 2) bst[threadIdx.x] = 0u;
    __syncthreads();
    XcdBarrier xbar; xbar.bar = (unsigned*)(a.ws + WS_BAR); xbar.x = 0; xbar.st = bst;
    if (!MK_PER_PHASE) xbar = xcd_barrier_post((unsigned*)(a.ws + WS_BAR), bst);

#ifndef MK_DUP
#define MK_DUP 0
#endif
    for (int ph = ph_lo, rep_ = 0; ph < ph_hi;) {
        int tid = threadIdx.x; asm volatile("" : "+v"(tid));
        unsigned char* ws = a.ws; asm volatile("" : "+s"(ws));
        float* mods = (float*)(ws + WS_MODS);
        const float* tabA = (const float*)(ws + WS_TAB); const float* tabC = tabA + 2048;
        float* Xc = (float*)(ws + WS_XC);
        bf16* Hn = (bf16*)(ws + WS_HN); bf16* H1 = (bf16*)(ws + WS_H1);
        bf16* proj = (bf16*)(ws + WS_PROJ); bf16* cqb = (bf16*)(ws + WS_CQ); bf16* ckvb = (bf16*)(ws + WS_CKV);
        bf16* qm = (bf16*)(ws + WS_QM); bf16* kvm = (bf16*)(ws + WS_KVM); bf16* krr = (bf16*)(ws + WS_KRR); bf16* mix = (bf16*)(ws + WS_MIX);

        if (ph == 0) { if (PH_EN(0)) prologue(a, lds, tid); }
        else if (ph == NPH - 1) { if (PH_EN(8)) final_norm_phase(a.out, a.in[18], tid); }
        else {
            const int l = (ph - 1) >> 3, s = (ph - 1) & 7; const bool last = (l == DEPTH - 1);
            unsigned char* wb = ws + WS_W + (size_t)l * WL_STRIDE;
            const float* mods_l = mods + (size_t)l * 9 * 6144;
            float* ssq_q = (float*)(ws + WS_SSQ) + (size_t)l * 2 * MT; float* ssq_kv = ssq_q + MT;
            const float* xsrc = (l == 0) ? a.in[0] : a.out;
            const float* csrc = (l == 0) ? a.in[2] : Xc;
            if (s == 0) { if (PH_EN(1)) norm_mod_phase(xsrc, csrc, a.in[6] + l * DM, mods_l, 0, 1, Hn, MT, tid); }
            else if (s == 1) { if (PH_EN(2)) {
                pg8::Gemm g{Hn, (const bf16*)(wb + WL_IN), MT, 2048, DM}; pg8::StaticOrder S; S.init(MT, 2048, G, bx);
                EpiInProj E{proj, cqb, ckvb, krr, ssq_q, ssq_kv, tabA, tabC};
                pg8::gemm_phase<EpiInProj, pg8::StaticOrder, true, true>(lds, g, S, E, tid); }
            } else if (s == 2) { if (PH_EN(3)) {
                { int Kq = 256; asm volatile("" : "+s"(Kq)); pg8::Gemm g{cqb, (const bf16*)(wb + WL_UQ), MT, 512, Kq}; pg8::StaticOrder S; S.init(MT, 512, G, bx);
                  EpiUQ E{qm, ssq_q, tabC}; pg8::gemm_phase<EpiUQ, pg8::StaticOrder, true, true>(lds, g, S, E, tid); }
                { int Kk = 128; asm volatile("" : "+s"(Kk)); pg8::Gemm g{ckvb, (const bf16*)(wb + WL_UKV), MT, 512, Kk}; pg8::StaticOrder S; S.init(MT, 512, G, (bx + G / 2) % G);
                  EpiUKV E{kvm, ssq_kv}; pg8::gemm_phase<EpiUKV, pg8::StaticOrder, true, true>(lds, g, S, E, tid); } }
            } else if (s == 3) { if (PH_EN(4)) {
                AttnP P{proj, qm, kvm, krr, mix, a.in[9] + l * 8, a.in[10] + l * 4 * 465};
                attn_phase(P, last, lds, tid); }
            } else if (s == 4 || s == 7) { if (PH_EN(5)) {
                const int Mr = last ? MX : MT;
                const bool outp = (s == 4);
                pg8::Gemm g{outp ? mix : H1, (const bf16*)(wb + (outp ? WL_OUT : WL_W2)), Mr, DM, outp ? DM : DFF}; pg8::StaticOrder S; S.init(Mr, DM, G, bx);
                EpiResid E{(outp ? xsrc : a.out), (outp ? csrc : Xc), a.out, Xc, mods_l + (outp ? 2 : 5) * 1024};
                pg8::gemm_phase<EpiResid, pg8::StaticOrder, true, true>(lds, g, S, E, tid); }
            } else if (s == 5) { if (PH_EN(6)) norm_mod_phase(a.out, Xc, a.in[7] + l * DM, mods_l, 3, 4, Hn, last ? MX : MT, tid); }
            else if (PH_EN(7)) {
                const int Mr = last ? MX : MT;
                pg8::Gemm g{Hn, (const bf16*)(wb + WL_W1), Mr, DFF, DM}; pg8::StaticOrder S; S.init(Mr, DFF, G, bx);
                EpiRelu2 E{H1}; pg8::gemm_phase<EpiRelu2, pg8::StaticOrder, true, true>(lds, g, S, E, tid);
            }
        }
        if (MK_DUP != 0 && rep_ == 0 && ph > 0 && ph < NPH - 1 && (((MK_DUP) >> ((ph - 1) & 7)) & 1)) { rep_ = 1; __syncthreads(); continue; }
        rep_ = 0; ++ph;
        if (ph < ph_hi) { if (ph == 1) cg::this_grid().sync(); else xcd_barrier(xbar); }
    }
}

extern "C" void kernel_launch(void* const* d_in, const int* in_sizes, int n_in, void* d_out, int out_size, void* d_ws, size_t ws_size, hipStream_t stream) {
    static int grid = 0;
    if (grid == 0) {
        if (n_in != 19 || ws_size < WS_END) { fprintf(stderr, "kernel_launch: unexpected inputs (n_in %d, ws %zu)\n", n_in, ws_size); grid = -1; return; }
        int dev = 0, cus = 0, per_cu = 0;
        hipGetDevice(&dev); hipDeviceGetAttribute(&cus, hipDeviceAttributeMultiprocessorCount, dev);
        hipFuncSetAttribute((const void*)mk_fwd, hipFuncAttributeMaxDynamicSharedMemorySize, LDS_BYTES);
        hipOccupancyMaxActiveBlocksPerMultiprocessor(&per_cu, (const void*)mk_fwd, NTHR, LDS_BYTES);
        if (per_cu < 1) { fprintf(stderr, "kernel_launch: occupancy query says %d\n", per_cu); per_cu = 1; }
        (void)hipGetLastError();
        grid = cus * 1;
    }
    if (grid < 0) return;
    Args a{};
    for (int i = 0; i < 19; ++i) a.in[i] = (const float*)d_in[i];
    a.out = (float*)d_out; a.ws = (unsigned char*)d_ws;
#if MK_PER_PHASE
    for (int ph = 0; ph < NPH; ++ph) { a.ph_lo = ph; a.ph_hi = ph + 1; hipLaunchKernelGGL(mk_fwd, dim3(grid), dim3(NTHR), LDS_BYTES, stream, a); }
#else
    a.ph_lo = 0; a.ph_hi = NPH;
    (void)hipMemsetAsync((unsigned char*)d_ws + WS_BAR, 0, 16384, stream);
    void* args[] = {&a};
    hipError_t e = hipLaunchCooperativeKernel((const void*)mk_fwd, dim3(grid), dim3(NTHR), args, LDS_BYTES, stream);
    if (e != hipSuccess) fprintf(stderr, "cooperative launch failed: %s (grid %d)\n", hipGetErrorString(e), grid);
#endif
}
```

```cpp
#include <hip/hip_runtime.h>
#include <hip/hip_cooperative_groups.h>
#include <cstdio>
#include <cstdint>
namespace cg = cooperative_groups;
namespace pg8 {
#define PG8_LAS __attribute__((address_space(3)))
typedef unsigned short bf16_t;
typedef short bf16x8 __attribute__((ext_vector_type(8)));
typedef float f32x4 __attribute__((ext_vector_type(4)));
typedef unsigned u32x4 __attribute__((ext_vector_type(4)));
constexpr int BM = 256, BK = 64, HALF = 128, HTB = HALF * BK * 2  , STAGE_BYTES = 8 * HTB, NXCD = 8, WGM = 8;

__host__ __device__ __forceinline__ int lds_byte(int r, int c) { const int st = (r >> 4) * 2 + (c >> 5), rr = r & 15, cc = c & 31, ob = rr * 64 + cc * 2; return st * 1024 + (ob ^ (((ob >> 9) & 1) << 5)); }
__host__ __device__ __forceinline__ void stage_rc(int b, int& R, int& C) { const int st = b / 1024, sb = b % 1024, swz = sb ^ (((sb >> 9) & 1) << 5); R = (st >> 1) * 16 + swz / 64; C = (st & 1) * 32 + (swz % 64) / 2; }
__host__ __device__ __forceinline__ int perm32(int rho) { const int n = rho >> 4, i = rho & 15; return 8 * (i >> 2) + 4 * n + (i & 3); }

struct Unit { int pm, pn; };
struct Gemm { const bf16_t* A; const bf16_t* Bt; int M, N, K; };

struct StaticOrder {
    int nM, nN, nwg, G, c;
    __host__ __device__ void init(int M, int N, int G_, int c_) { nM = M / BM; nN = N / BM; nwg = nM * nN; G = G_; c = c_; }
    __host__ __device__ bool next(int i, Unit& u) const {
        const long L = (long)i * G + c; if (L >= nwg) return false;
        int wgid = (int)L; { const int q = nwg / NXCD, r = nwg % NXCD, xcd = wgid % NXCD, off = wgid / NXCD; wgid = (xcd < r ? xcd * (q + 1) : r * (q + 1) + (xcd - r) * q) + off; }
        const int nig = WGM * nN, gid = wgid / nig, fm = gid * WGM, gsz = (nM - fm) < WGM ? (nM - fm) : WGM;
        u.pm = fm + ((wgid % nig) % gsz); u.pn = (wgid % nig) / gsz; return true;
    }
    __device__ __forceinline__ void a_ready(const Unit&) const {}
    __device__ __forceinline__ void done(const Unit&) const {}
};

__device__ __forceinline__ unsigned cvt_pk_bf16(float lo, float hi) { unsigned r; asm volatile("v_cvt_pk_bf16_f32 %0, %1, %2" : "=v"(r) : "v"(lo), "v"(hi)); return r; }
template <class Epi, class Sched, bool ALIGN_EPI = false, bool SP2 = false>
__device__ __forceinline__ void gemm_phase(PG8_LAS unsigned char* lds, const Gemm g, const Sched& S, const Epi& E, const int tid) {
    const int wid = __builtin_amdgcn_readfirstlane(tid >> 6), lane = tid & 63, wr = wid >> 2, wc = wid & 3, fr = lane & 15, fq = lane >> 4;
    const int K = g.K, nt = K / BK;
    unsigned voffA[2], voffB[2];
#pragma unroll
    for (int i = 0; i < 2; ++i) { int R, C; stage_rc(tid * 16 + i * 8192, R, C); const int Rb = Epi::PERM ? ((R & ~31) + perm32(R & 31)) : R;
        voffA[i] = (unsigned)(R * K + C) * 2u; voffB[i] = (unsigned)(Rb * K + C) * 2u; }
    const size_t kstep = (size_t)(BK * 2);
    const size_t hstep = (size_t)HALF * K * 2;
    const size_t tstep = 2 * hstep;
    const unsigned ldsw = (unsigned)wid * 1024u;
    const int aoff = lds_byte(wr * 64 + fr, fq * 8), boff = lds_byte(wc * 32 + fr, fq * 8);
#define PG8_SA(b, h) (((b) * 2 + (h)) * HTB)
#define PG8_SB(b, h) ((4 + (b) * 2 + (h)) * HTB)
#define PG8_STAGE(bufoff, gbase, voff) do { _Pragma("unroll") for (int _i = 0; _i < 2; ++_i) \
        __builtin_amdgcn_global_load_lds((const unsigned*)((const char*)(gbase) + (voff)[_i]), (PG8_LAS unsigned*)(lds + (bufoff) + ldsw + _i * 8192), 16, 0, 0); } while (0)
#define PG8_LDA(dst, b, h) do { _Pragma("unroll") for (int m = 0; m < 4; ++m) _Pragma("unroll") for (int k = 0; k < 2; ++k) dst[m][k] = *(const PG8_LAS bf16x8*)(lds + PG8_SA(b, h) + aoff + m * 2048 + k * 1024); } while (0)
#define PG8_LDB(dst, b, h) do { _Pragma("unroll") for (int n = 0; n < 2; ++n) _Pragma("unroll") for (int k = 0; k < 2; ++k) dst[n][k] = *(const PG8_LAS bf16x8*)(lds + PG8_SB(b, h) + boff + n * 2048 + k * 1024); } while (0)
#define PG8_MMA(ai, bj, At, Bt) do { __builtin_amdgcn_s_setprio(1); _Pragma("unroll") for (int m = 0; m < 4; ++m) _Pragma("unroll") for (int n = 0; n < 2; ++n) _Pragma("unroll") for (int k = 0; k < 2; ++k) \
        acc[ai][bj][m][n] = __builtin_amdgcn_mfma_f32_16x16x32_bf16(Bt[n][k], At[m][k], acc[ai][bj][m][n], 0, 0, 0); __builtin_amdgcn_s_setprio(0); } while (0)
#define PG8_WAIT_V(n) asm volatile("s_waitcnt vmcnt(" #n ")" ::: "memory")
#define PG8_WAIT_L(n) asm volatile("s_waitcnt lgkmcnt(" #n ")" ::: "memory")
#define PG8_BAR __builtin_amdgcn_s_barrier()
#define PG8_SCHED __builtin_amdgcn_sched_barrier(0)
    Unit cur, nxt; int ui = 0;
    if (!S.next(0, cur)) return;
    f32x4 acc[2][2][4][2];
#pragma unroll
    for (int a = 0; a < 2; ++a)
#pragma unroll
        for (int b = 0; b < 2; ++b)
#pragma unroll
            for (int m = 0; m < 4; ++m)
#pragma unroll
                for (int n = 0; n < 2; ++n) acc[a][b][m][n] = (f32x4){0.f, 0.f, 0.f, 0.f};
    bf16x8 At[4][2], B0[2][2], B1[2][2];
    const char* cA = (const char*)g.A + (size_t)cur.pm * tstep; const char* cB = (const char*)g.Bt + (size_t)cur.pn * tstep;
    S.a_ready(cur);
    if constexpr (SP2) {
        PG8_STAGE(PG8_SB(0, 0), cB, voffB); PG8_STAGE(PG8_SB(0, 1), cB + hstep, voffB); PG8_STAGE(PG8_SA(0, 0), cA, voffA); PG8_STAGE(PG8_SA(0, 1), cA + hstep, voffA);
        if (wr == 1) PG8_BAR;
        PG8_WAIT_V(2); PG8_BAR;
        PG8_STAGE(PG8_SB(1, 0), cB + kstep, voffB); PG8_STAGE(PG8_SA(1, 0), cA + kstep, voffA); PG8_STAGE(PG8_SB(1, 1), cB + hstep + kstep, voffB);
        PG8_WAIT_V(6); PG8_BAR;
    } else {
        PG8_STAGE(PG8_SB(0, 0), cB, voffB); PG8_STAGE(PG8_SA(0, 0), cA, voffA); PG8_STAGE(PG8_SB(0, 1), cB + hstep, voffB); PG8_STAGE(PG8_SA(0, 1), cA + hstep, voffA);
        if (wr == 1) PG8_BAR;
        PG8_WAIT_V(4); PG8_BAR;
        PG8_STAGE(PG8_SB(1, 0), cB + kstep, voffB); PG8_STAGE(PG8_SA(1, 0), cA + kstep, voffA); PG8_STAGE(PG8_SB(1, 1), cB + hstep + kstep, voffB);
        PG8_WAIT_V(6); PG8_BAR;
    }
    for (;;) {
        const bool has_next = S.next(ui + 1, nxt);
        const char* nA = has_next ? (const char*)g.A + (size_t)nxt.pm * tstep : cA; const char* nB = has_next ? (const char*)g.Bt + (size_t)nxt.pn * tstep : cB;
        for (int t = 0; t < nt; t += 2) {
            const bool last = (t == nt - 2);
            const char* a1 = cA + (size_t)(t + 1) * kstep;
            const char* a2 = last ? nA : cA + (size_t)(t + 2) * kstep; const char* b2 = last ? nB : cB + (size_t)(t + 2) * kstep;
            const char* a3 = a2 + kstep; const char* b3 = b2 + kstep;
            if (last && has_next) S.a_ready(nxt);
            if constexpr (SP2) {
            PG8_LDB(B0, 0, 0); PG8_LDB(B1, 0, 1); PG8_SCHED; PG8_LDA(At, 0, 0); PG8_STAGE(PG8_SA(1, 1), a1 + hstep, voffA);
            PG8_WAIT_V(8); PG8_WAIT_L(0); PG8_BAR; PG8_MMA(0, 0, At, B0); PG8_MMA(0, 1, At, B1); PG8_BAR; PG8_SCHED;
            PG8_LDA(At, 0, 1); PG8_STAGE(PG8_SB(0, 0), b2, voffB); PG8_STAGE(PG8_SB(0, 1), b2 + hstep, voffB); PG8_STAGE(PG8_SA(0, 0), a2, voffA);
            PG8_WAIT_V(8); PG8_WAIT_L(0); PG8_BAR; PG8_MMA(1, 0, At, B0); PG8_MMA(1, 1, At, B1); PG8_BAR; PG8_SCHED;
            PG8_LDB(B0, 1, 0); PG8_LDB(B1, 1, 1); PG8_SCHED; PG8_LDA(At, 1, 0); PG8_STAGE(PG8_SA(0, 1), a2 + hstep, voffA);
            PG8_WAIT_V(8); PG8_WAIT_L(0); PG8_BAR; PG8_MMA(0, 0, At, B0); PG8_MMA(0, 1, At, B1); PG8_BAR; PG8_SCHED;
            PG8_LDA(At, 1, 1); PG8_STAGE(PG8_SB(1, 0), b3, voffB); PG8_STAGE(PG8_SB(1, 1), b3 + hstep, voffB); PG8_STAGE(PG8_SA(1, 0), a3, voffA);
            PG8_WAIT_V(8); PG8_WAIT_L(0); PG8_BAR; PG8_MMA(1, 0, At, B0); PG8_MMA(1, 1, At, B1); PG8_BAR; PG8_SCHED;
            } else {
            PG8_LDB(B0, 0, 0); PG8_SCHED; PG8_LDA(At, 0, 0); PG8_STAGE(PG8_SA(1, 1), a1 + hstep, voffA);
            PG8_WAIT_L(8); PG8_BAR; PG8_WAIT_L(0); PG8_MMA(0, 0, At, B0); PG8_BAR; PG8_SCHED;
            PG8_LDB(B1, 0, 1); PG8_STAGE(PG8_SB(0, 0), b2, voffB);
            PG8_BAR; PG8_WAIT_L(0); PG8_MMA(0, 1, At, B1); PG8_BAR;
            PG8_LDA(At, 0, 1); PG8_STAGE(PG8_SA(0, 0), a2, voffA);
            PG8_BAR; PG8_WAIT_L(0); PG8_MMA(1, 0, At, B0); PG8_BAR; PG8_SCHED;
            PG8_STAGE(PG8_SB(0, 1), b2 + hstep, voffB);
            PG8_WAIT_V(6); PG8_BAR; PG8_MMA(1, 1, At, B1); PG8_BAR;
            PG8_LDB(B0, 1, 0); PG8_SCHED; PG8_LDA(At, 1, 0); PG8_STAGE(PG8_SA(0, 1), a2 + hstep, voffA);
            PG8_WAIT_L(8); PG8_BAR; PG8_WAIT_L(0); PG8_MMA(0, 0, At, B0); PG8_BAR; PG8_SCHED;
            PG8_LDB(B1, 1, 1); PG8_STAGE(PG8_SB(1, 0), b3, voffB);
            PG8_BAR; PG8_WAIT_L(0); PG8_MMA(0, 1, At, B1); PG8_BAR;
            PG8_LDA(At, 1, 1); PG8_STAGE(PG8_SA(1, 0), a3, voffA);
            PG8_BAR; PG8_WAIT_L(0); PG8_MMA(1, 0, At, B0); PG8_BAR; PG8_SCHED;
            PG8_STAGE(PG8_SB(1, 1), b3 + hstep, voffB);
            PG8_WAIT_V(6); PG8_BAR; PG8_MMA(1, 1, At, B1); PG8_BAR;
            }
        }
        if constexpr (ALIGN_EPI) { if (wr == 0) PG8_BAR; }
        if constexpr (!Epi::AFTER_DRAIN) { E(acc, cur, wr, wc, fr, fq); S.done(cur); }
        if (!has_next) break;
#pragma unroll
        for (int a = 0; a < 2; ++a)
#pragma unroll
            for (int b = 0; b < 2; ++b)
#pragma unroll
                for (int m = 0; m < 4; ++m)
#pragma unroll
                    for (int n = 0; n < 2; ++n) acc[a][b][m][n] = (f32x4){0.f, 0.f, 0.f, 0.f};
        cur = nxt; cA = nA; cB = nB; ++ui;
        if constexpr (ALIGN_EPI) { if (wr == 1) PG8_BAR; }
    }
    PG8_WAIT_V(0);
    if constexpr (!ALIGN_EPI) { if (wr == 0) PG8_BAR; }
    PG8_BAR;
    if constexpr (Epi::AFTER_DRAIN) { E.fused(acc, cur, wr, wc, fr, fq, lds, wid, lane); S.done(cur); }
#undef PG8_SA
#undef PG8_SB
#undef PG8_STAGE
#undef PG8_LDA
#undef PG8_LDB
#undef PG8_MMA
#undef PG8_WAIT_V
#undef PG8_WAIT_L
#undef PG8_BAR
#undef PG8_SCHED
}
}

#define LAS __attribute__((address_space(3)))
#define DI __device__ __forceinline__
typedef unsigned short bf16;
typedef float f32x4 __attribute__((ext_vector_type(4)));
typedef float f32x16 __attribute__((ext_vector_type(16)));
typedef short bf16x8 __attribute__((ext_vector_type(8)));
typedef short s16x4 __attribute__((ext_vector_type(4)));
typedef unsigned u32x2 __attribute__((ext_vector_type(2)));
typedef unsigned u32x4 __attribute__((ext_vector_type(4)));
typedef float f32x2_t __attribute__((ext_vector_type(2)));
typedef __bf16 bf16x2_t __attribute__((ext_vector_type(2)));

#ifndef MK_MASK
#define MK_MASK 0x1ff
#endif
#define PH_EN(k) (((MK_MASK) >> (k)) & 1)
#ifndef MK_PER_PHASE
#define MK_PER_PHASE 0
#endif

constexpr int DM = 1024, NBATCH = 8, SEQ = 4096, DEPTH = 4, CTXL = 256, DFF = 4096;
constexpr int MX = NBATCH * SEQ, MC = NBATCH * CTXL, MT = MX + MC;
constexpr int INW = 1952, PJS = 1536;
constexpr float LOG2E = 1.4426950408889634f;
constexpr float C2A = 0.125f * LOG2E;
constexpr float C2C = 0.10206207261596575f * LOG2E;
constexpr float EPSN = 1e-6f;
constexpr int NTHR = 512;

constexpr size_t MiB = (size_t)1 << 20;
constexpr size_t WS_TAB = 0;
constexpr size_t WS_BAR = 65536;
constexpr size_t WS_MODS = 1 * MiB;
constexpr size_t WS_SSQ = 2 * MiB;
constexpr size_t WS_XC = 4 * MiB;
constexpr size_t WS_W = 12 * MiB;
constexpr size_t WL_IN = 0, WL_OUT = 4 * MiB, WL_W1 = 6 * MiB, WL_W2 = 14 * MiB, WL_UQ = 22 * MiB, WL_UKV = 22 * MiB + 256 * 1024, WL_STRIDE = 22 * MiB + 512 * 1024;
constexpr size_t WS_HN = 102 * MiB;
constexpr size_t WS_H1 = 170 * MiB;
constexpr size_t WS_PROJ = 170 * MiB;
constexpr size_t WS_CQ = 272 * MiB;
constexpr size_t WS_CKV = 289 * MiB;
constexpr size_t WS_QM = 298 * MiB;
constexpr size_t WS_KVM = 324 * MiB;
constexpr size_t WS_KRR = 358 * MiB;
constexpr size_t WS_MIX = 362 * MiB;
constexpr size_t WS_SSQX = 442 * MiB;
constexpr size_t WS_BIAS1 = 444 * MiB;
constexpr size_t WS_BIAS4 = 445 * MiB;
constexpr size_t WS_END = 446 * MiB;
constexpr int LDS_BYTES = 131072 + 256;

DI unsigned cvtpk(float lo, float hi) { f32x2_t v = {lo, hi}; bf16x2_t b = __builtin_convertvector(v, bf16x2_t); return __builtin_bit_cast(unsigned, b); }
DI void st4bf(bf16* p, f32x4 v) { u32x2 w; w.x = cvtpk(v[0], v[1]); w.y = cvtpk(v[2], v[3]); *(u32x2*)p = w; }
DI float wave_sum(float v) {
#pragma unroll
    for (int o = 1; o < 64; o <<= 1) v += __shfl_xor(v, o);
    return v;
}
DI float fexp2(float x) { return __builtin_amdgcn_exp2f(x); }
#define LDS_WAIT() asm volatile("s_waitcnt lgkmcnt(0)" ::: "memory")

DI f32x4 rope8(f32x4 v, const float* tab  , int fq) {
    const int i0 = 4 * (fq & 1);
    const f32x4 cs = *(const f32x4*)(tab + i0), sn = *(const f32x4*)(tab + 8 + i0);
    f32x4 o;
#pragma unroll
    for (int j = 0; j < 4; ++j) { const float pr = __shfl_xor(v[j], 32); o[j] = (fq < 2) ? v[j] * cs[j] - pr * sn[j] : pr * sn[j] + v[j] * cs[j]; }
    return o;
}

struct EpiInProj {
    static constexpr bool PERM = false, AFTER_DRAIN = false;
    bf16 *proj, *cqb, *ckvb, *krr; float *ssq_q, *ssq_kv; const float *tabA, *tabC; const float *ssqx, *bias;
    DI void operator()(const f32x4 (&acc0)[2][2][4][2], const pg8::Unit& u, int wr, int wc, int fr, int fq) const {
        const int pn = u.pn; const bool isx = u.pm < 128; const int mi = isx ? (u.pm >> 4) : 8;
        f32x4 bv[2][2];
#pragma unroll
        for (int bj = 0; bj < 2; ++bj)
#pragma unroll
            for (int n = 0; n < 2; ++n) bv[bj][n] = *(const f32x4*)(bias + mi * 2048 + pn * 256 + bj * 128 + wc * 32 + n * 16 + 4 * fq);
#pragma unroll
        for (int ai = 0; ai < 2; ++ai)
#pragma unroll
            for (int m = 0; m < 4; ++m) {
                int row = u.pm * 256 + ai * 128 + wr * 64 + m * 16 + fr;
                asm volatile("" : "+v"(row) :: "memory");
                const int tok = row & 4095, prow = tok >> 6, pcol = tok & 63;
                const float rsx = rsqrtf(ssqx[row] * (1.0f / 1024.0f) + EPSN);
                f32x4 acc[2][2];
#pragma unroll
                for (int bj = 0; bj < 2; ++bj)
#pragma unroll
                    for (int n = 0; n < 2; ++n) acc[bj][n] = acc0[ai][bj][m][n] * rsx + bv[bj][n];
                if (pn < 6) {
                    const bool anyrope = isx && pn <= 2;
                    f32x4 cs = {1.f, 1.f, 1.f, 1.f}, sn = {0.f, 0.f, 0.f, 0.f};
                    if (anyrope) { const int pos = (wc & 1) ? pcol : prow; cs = *(const f32x4*)(tabA + pos * 32 + 4 * fq); sn = *(const f32x4*)(tabA + pos * 32 + 16 + 4 * fq); }
#pragma unroll
                    for (int bj = 0; bj < 2; ++bj) {
                        f32x4 v0 = acc[bj][0], v1 = acc[bj][1];
                        if (anyrope && (pn < 2 || bj == 0)) { const f32x4 a = v0 * cs - v1 * sn, b = v0 * sn + v1 * cs; v0 = a; v1 = b; }
                        if (pn < 2 || pn == 3) { v0 *= C2A; v1 *= C2A; }
                        bf16* p = proj + (size_t)row * PJS + pn * 256 + bj * 128 + wc * 32 + 4 * fq;
                        st4bf(p, v0); st4bf(p + 16, v1);
                    }
                } else if (pn == 6) {
                    float s = 0.f;
#pragma unroll
                    for (int bj = 0; bj < 2; ++bj) {
                        const f32x4 v0 = acc[bj][0], v1 = acc[bj][1];
                        s += (v0[0] * v0[0] + v0[1] * v0[1]) + (v0[2] * v0[2] + v0[3] * v0[3]) + (v1[0] * v1[0] + v1[1] * v1[1]) + (v1[2] * v1[2] + v1[3] * v1[3]);
                        bf16* p = cqb + (size_t)row * 256 + bj * 128 + wc * 32 + 4 * fq;
                        st4bf(p, v0); st4bf(p + 16, v1);
                    }
                    s += __shfl_xor(s, 16); s += __shfl_xor(s, 32);
                    if (fq == 0) atomicAdd(ssq_q + row, s);
                } else {
                    {
                        const f32x4 v0 = acc[0][0], v1 = acc[0][1];
                        float s = (v0[0] * v0[0] + v0[1] * v0[1]) + (v0[2] * v0[2] + v0[3] * v0[3]) + (v1[0] * v1[0] + v1[1] * v1[1]) + (v1[2] * v1[2] + v1[3] * v1[3]);
                        bf16* p = ckvb + (size_t)row * 128 + wc * 32 + 4 * fq;
                        st4bf(p, v0); st4bf(p + 16, v1);
                        s += __shfl_xor(s, 16); s += __shfl_xor(s, 32);
                        if (fq == 0) atomicAdd(ssq_kv + row, s);
                    }
                    if (wc == 0) {
                        f32x4 v0 = acc[1][0], v1 = acc[1][1];
                        if (isx) { v0 = rope8(v0, tabC + prow * 16, fq); v1 = rope8(v1, tabC + pcol * 16, fq); }
                        bf16* p = krr + (size_t)row * 32 + 4 * fq;
                        st4bf(p, v0); st4bf(p + 16, v1);
                    }
                }
            }
    }
};

struct EpiUQ {
    static constexpr bool PERM = false, AFTER_DRAIN = false;
    bf16* qm; const float* ssq_q; const float* tabC;
    DI void operator()(const f32x4 (&acc)[2][2][4][2], const pg8::Unit& u, int wr, int wc, int fr, int fq) const {
        const int pn = u.pn; const bool isx = u.pm < 128;
#pragma unroll
        for (int ai = 0; ai < 2; ++ai)
#pragma unroll
            for (int m = 0; m < 4; ++m) {
                int row = u.pm * 256 + ai * 128 + wr * 64 + m * 16 + fr;
                asm volatile("" : "+v"(row) :: "memory");
                const int tok = row & 4095, prow = tok >> 6, pcol = tok & 63;
                const float rs = rsqrtf(ssq_q[row] * (1.0f / 256.0f) + EPSN) * C2C;
#pragma unroll
                for (int bj = 0; bj < 2; ++bj)
#pragma unroll
                    for (int n = 0; n < 2; ++n) {
                        const int col0 = pn * 256 + bj * 128 + wc * 32 + n * 16;
                        if (col0 < 384) {
                            f32x4 v = acc[ai][bj][m][n] * rs;
                            const int g6 = (col0 >> 4) % 6;
                            if (isx && g6 >= 4) v = rope8(v, tabC + (g6 == 4 ? prow : pcol) * 16, fq);
                            st4bf(qm + (size_t)row * 384 + col0 + 4 * fq, v);
                        }
                    }
            }
    }
};

struct EpiUKV {
    static constexpr bool PERM = false, AFTER_DRAIN = false;
    bf16* kvm; const float* ssq_kv;
    DI void operator()(const f32x4 (&acc)[2][2][4][2], const pg8::Unit& u, int wr, int wc, int fr, int fq) const {
#pragma unroll
        for (int ai = 0; ai < 2; ++ai)
#pragma unroll
            for (int m = 0; m < 4; ++m) {
                int row = u.pm * 256 + ai * 128 + wr * 64 + m * 16 + fr;
                asm volatile("" : "+v"(row) :: "memory");
                const float rs = rsqrtf(ssq_kv[row] * (1.0f / 128.0f) + EPSN);
#pragma unroll
                for (int bj = 0; bj < 2; ++bj)
#pragma unroll
                    for (int n = 0; n < 2; ++n) {
                        const int col0 = u.pn * 256 + bj * 128 + wc * 32 + n * 16;
                        st4bf(kvm + (size_t)row * 512 + col0 + 4 * fq, acc[ai][bj][m][n] * rs);
                    }
            }
    }
};

struct EpiRelu2 {
    static constexpr bool PERM = true, AFTER_DRAIN = false;
    bf16* H; const float *ssqx, *bias;
    DI void operator()(const f32x4 (&acc)[2][2][4][2], const pg8::Unit& u, int wr, int wc, int fr, int fq) const {
        const int col0 = u.pn * 256 + wc * 32 + 8 * fq; const int mi = (u.pm < 128) ? (u.pm >> 4) : 8;
        f32x4 bv[2][2];
#pragma unroll
        for (int bj = 0; bj < 2; ++bj)
#pragma unroll
            for (int n = 0; n < 2; ++n) bv[bj][n] = *(const f32x4*)(bias + mi * 4096 + col0 + bj * 128 + 4 * n);
#pragma unroll
        for (int ai = 0; ai < 2; ++ai)
#pragma unroll
            for (int m = 0; m < 4; ++m) {
                int row = u.pm * 256 + ai * 128 + wr * 64 + m * 16 + fr;
                asm volatile("" : "+v"(row) :: "memory");
                const float rsx = rsqrtf(ssqx[row] * (1.0f / 1024.0f) + EPSN);
                bf16* rowp = H + (size_t)row * DFF + col0;
#pragma unroll
                for (int bj = 0; bj < 2; ++bj) {
                    f32x4 v0 = acc[ai][bj][m][0] * rsx + bv[bj][0], v1 = acc[ai][bj][m][1] * rsx + bv[bj][1];
#pragma unroll
                    for (int j = 0; j < 4; ++j) { const float a = fmaxf(v0[j], 0.f), b = fmaxf(v1[j], 0.f); v0[j] = a * a; v1[j] = b * b; }
                    u32x4 w; w.x = cvtpk(v0[0], v0[1]); w.y = cvtpk(v0[2], v0[3]); w.z = cvtpk(v1[0], v1[1]); w.w = cvtpk(v1[2], v1[3]);
                    *(u32x4*)(rowp + bj * 128) = w;
                }
            }
    }
};

struct EpiResid {
    static constexpr bool PERM = false, AFTER_DRAIN = false;
    const float *srcx, *srcc; float *dstx, *dstc; const float* gate; bf16* xg; float* ssq_out; const float *gn, *scn; int donorm;
    DI void operator()(const f32x4 (&acc)[2][2][4][2], const pg8::Unit& u, int wr, int wc, int fr, int fq) const {
        const bool isx = u.pm < 128; const int mi = isx ? (u.pm >> 4) : 8;
        const int col0 = u.pn * 256 + wc * 32 + 4 * fq;
        f32x4 gv[2][2], gp[2][2];
#pragma unroll
        for (int bj = 0; bj < 2; ++bj)
#pragma unroll
            for (int n = 0; n < 2; ++n) { const int c = col0 + bj * 128 + n * 16; gv[bj][n] = *(const f32x4*)(gate + mi * 6144 + c);
                gp[bj][n] = donorm ? *(const f32x4*)(gn + c) * (*(const f32x4*)(scn + mi * 6144 + c) + 1.0f) : (f32x4){0.f, 0.f, 0.f, 0.f}; }
#pragma unroll
        for (int ai = 0; ai < 2; ++ai)
#pragma unroll
            for (int m = 0; m < 4; ++m) {
                int row = u.pm * 256 + ai * 128 + wr * 64 + m * 16 + fr;
                asm volatile("" : "+v"(row) :: "memory");
                const float* s = isx ? srcx + (size_t)row * DM : srcc + (size_t)(row - MX) * DM;
                float* d = isx ? dstx + (size_t)row * DM : dstc + (size_t)(row - MX) * DM;
                float ss = 0.f;
#pragma unroll
                for (int bj = 0; bj < 2; ++bj)
#pragma unroll
                    for (int n = 0; n < 2; ++n) { const int off = col0 + bj * 128 + n * 16;
                        const f32x4 xn = *(const f32x4*)(s + off) + gv[bj][n] * acc[ai][bj][m][n];
                        *(f32x4*)(d + off) = xn;
                        if (donorm) { ss += (xn[0] * xn[0] + xn[1] * xn[1]) + (xn[2] * xn[2] + xn[3] * xn[3]); st4bf(xg + (size_t)row * DM + off, xn * gp[bj][n]); } }
                if (donorm) { ss += __shfl_xor(ss, 16); ss += __shfl_xor(ss, 32); if (fq == 0) atomicAdd(ssq_out + row, ss); }
            }
    }
};

DI void transpose_item(const float* W, int K, int N, bf16* WT, const float* kscale, LAS float* scr, int item, int lane) {
    const int nblk = N / 32, kb = item / nblk, nb = item % nblk, k0 = 64 * kb, n0 = 32 * nb;
#pragma unroll 8
    for (int i = 0; i < 32; ++i) { const int kk = 2 * i + (lane >> 5); float w = W[(size_t)(k0 + kk) * N + n0 + (lane & 31)]; if (kscale) w *= kscale[k0 + kk]; scr[kk * 33 + (lane & 31)] = w; }
    LDS_WAIT();
    const int c = lane & 7;
#pragma unroll
    for (int j = 0; j < 4; ++j) { const int n = (lane >> 3) + 8 * j; const LAS float* s = scr + (8 * c) * 33 + n;
        u32x4 o; o.x = cvtpk(s[0 * 33], s[1 * 33]); o.y = cvtpk(s[2 * 33], s[3 * 33]); o.z = cvtpk(s[4 * 33], s[5 * 33]); o.w = cvtpk(s[6 * 33], s[7 * 33]);
        *(u32x4*)(WT + (size_t)(n0 + n) * K + k0 + 8 * c) = o; }
    LDS_WAIT();
}

DI void gemv9_item(const float* W, int ldw, int nvalid, int n0, const LAS float* sl, LAS float* red, const float* addb, float* out, int ldo, const int tid) {
    const int col = tid & 63, kg = tid >> 6, n = n0 + col;
    float acc[9];
#pragma unroll
    for (int mi = 0; mi < 9; ++mi) acc[mi] = 0.f;
    if (n < nvalid) {
        const float* w = W + (size_t)(kg * 128) * ldw + n;
#pragma unroll 4
        for (int k = 0; k < 128; ++k) { const float wv = w[(size_t)k * ldw];
#pragma unroll
            for (int mi = 0; mi < 9; ++mi) acc[mi] += sl[mi * 1024 + kg * 128 + k] * wv; }
    }
#pragma unroll
    for (int mi = 0; mi < 9; ++mi) red[(kg * 9 + mi) * 64 + col] = acc[mi];
    __syncthreads();
    for (int o = tid; o < 576; o += NTHR) { const int mi = o >> 6, cq = o & 63; float sacc = (addb && n0 + cq < nvalid) ? addb[n0 + cq] : 0.f;
#pragma unroll
        for (int g = 0; g < 8; ++g) sacc += red[(g * 9 + mi) * 64 + cq];
        out[(size_t)mi * ldo + n0 + cq] = sacc; }
    __syncthreads();
}

struct Args { const float* in[19]; float* out; unsigned char* ws; int ph_lo, ph_hi; };

DI void prologue(const Args& a, LAS unsigned char* lds, const int tid) {
    const int lane = tid & 63, wave = __builtin_amdgcn_readfirstlane(tid >> 6);
    const int G = gridDim.x, bx = blockIdx.x;
    unsigned char* ws = a.ws;
    {
        LAS float* sl = (LAS float*)lds;
        LAS float* red = (LAS float*)(lds + 36864);
        const float* c = a.in[1]; const float* cc = a.in[3]; const float* w_ada = a.in[4]; const float* b_ada = a.in[5];
        float* mods = (float*)(ws + WS_MODS);
        for (int idx = tid; idx < 9 * 1024; idx += NTHR) { const int mi = idx >> 10, k = idx & 1023; const float v = mi < 8 ? c[mi * 1024 + k] : cc[k]; sl[idx] = v / (1.0f + expf(-v)); }
        __syncthreads();
        for (int item = bx; item < DEPTH * 96; item += G) {
            const int l = item / 96, n0 = (item % 96) * 64;
            gemv9_item(w_ada + (size_t)l * 1024 * 6144, 6144, 6144, n0, sl, red, b_ada + l * 6144, mods + (size_t)l * 9 * 6144, 6144, tid);
        }
    }
    {
        const int gid = bx * NTHR + tid, NG = G * NTHR;
        float* tabA = (float*)(ws + WS_TAB); float* tabC = tabA + 2048;
        if (gid < 1024) { const int pos = gid >> 4, i = gid & 15; const float fr = exp2f(-(float)i * (1.0f / 16.0f) * 13.287712379549449f); const float rev = ((float)pos * fr) * 0.15915494309189535f;
            tabA[pos * 32 + i] = __builtin_amdgcn_cosf(rev); tabA[pos * 32 + 16 + i] = __builtin_amdgcn_sinf(rev); }
        else if (gid < 1536) { const int g = gid - 1024, pos = g >> 3, i = g & 7; const float fr = exp2f(-(float)i * (1.0f / 8.0f) * 13.287712379549449f); const float rev = ((float)pos * fr) * 0.15915494309189535f;
            tabC[pos * 16 + i] = __builtin_amdgcn_cosf(rev); tabC[pos * 16 + 8 + i] = __builtin_amdgcn_sinf(rev); }
        float* ssq = (float*)(ws + WS_SSQ);
        for (int i = gid; i < DEPTH * 2 * MT; i += NG) ssq[i] = 0.f;
        float* ssqx = (float*)(ws + WS_SSQX);
        for (int i = gid; i < DEPTH * 2 * MT; i += NG) ssqx[i] = 0.f;
        const u32x4 z = {0u, 0u, 0u, 0u};
        for (int i = gid; i < DEPTH * 12288; i += NG) { const int l = i / 12288, r = i % 12288; ((u32x4*)(ws + WS_W + l * WL_STRIDE + WL_IN + (size_t)INW * 1024 * 2))[r] = z; }
        for (int i = gid; i < DEPTH * 4096; i += NG) { const int l = i / 4096, r = i % 4096; ((u32x4*)(ws + WS_W + l * WL_STRIDE + WL_UQ + (size_t)384 * 256 * 2))[r] = z; }
    }
    {
        LAS float* scr = (LAS float*)(lds + wave * 16384);
        const int gw = bx * 8 + wave, NGW = G * 8;
        constexpr int I_IN = 16 * 61, I_OUT = 16 * 32, I_W1 = 16 * 128, I_W2 = 64 * 32, I_UQ = 4 * 12, I_UKV = 2 * 16, I_L = I_IN + I_OUT + I_W1 + I_W2 + I_UQ + I_UKV;
        for (int it = gw; it < DEPTH * I_L; it += NGW) {
            const int l = it / I_L; int r = it % I_L; unsigned char* wb = ws + WS_W + l * WL_STRIDE;
            if (r < I_IN) { transpose_item(a.in[8] + (size_t)l * 1024 * INW, 1024, INW, (bf16*)(wb + WL_IN), nullptr, scr, r, lane); continue; } r -= I_IN;
            if (r < I_OUT) { transpose_item(a.in[15] + (size_t)l * 1024 * 1024, 1024, 1024, (bf16*)(wb + WL_OUT), nullptr, scr, r, lane); continue; } r -= I_OUT;
            if (r < I_W1) { transpose_item(a.in[16] + (size_t)l * 1024 * 4096, 1024, 4096, (bf16*)(wb + WL_W1), nullptr, scr, r, lane); continue; } r -= I_W1;
            if (r < I_W2) { transpose_item(a.in[17] + (size_t)l * 4096 * 1024, 4096, 1024, (bf16*)(wb + WL_W2), nullptr, scr, r, lane); continue; } r -= I_W2;
            if (r < I_UQ) { transpose_item(a.in[12] + (size_t)l * 256 * 384, 256, 384, (bf16*)(wb + WL_UQ), a.in[11] + l * 256, scr, r, lane); continue; } r -= I_UQ;
            transpose_item(a.in[14] + (size_t)l * 128 * 512, 128, 512, (bf16*)(wb + WL_UKV), a.in[13] + l * 128, scr, r, lane);
        }
    }
}

DI void phase1(const Args& a, LAS unsigned char* lds, const int tid) {
    unsigned char* ws = a.ws;
    const int G = gridDim.x, bx = blockIdx.x;
    const float* mods = (const float*)(ws + WS_MODS);
    {
        LAS float* sl = (LAS float*)lds; LAS float* red = (LAS float*)(lds + 36864);
        float* bias1 = (float*)(ws + WS_BIAS1); float* bias4 = (float*)(ws + WS_BIAS4);
        for (int item = bx; item < DEPTH * 96; item += G) {
            const int l = item / 96, r = item % 96, which = r < 32 ? 0 : 1, tile = which ? r - 32 : r;
            const float* mv = mods + (size_t)l * 9 * 6144 + (which ? 3 : 0) * 1024;
            for (int idx = tid; idx < 9 * 1024; idx += NTHR) sl[idx] = mv[(size_t)(idx >> 10) * 6144 + (idx & 1023)];
            __syncthreads();
            if (!which) gemv9_item(a.in[8] + (size_t)l * 1024 * INW, INW, INW, tile * 64, sl, red, nullptr, bias1 + (size_t)l * 9 * 2048, 2048, tid);
            else gemv9_item(a.in[16] + (size_t)l * 1024 * DFF, DFF, DFF, tile * 64, sl, red, nullptr, bias4 + (size_t)l * 9 * 4096, 4096, tid);
        }
    }
    {
        const int lane = tid & 63, gw = bx * 8 + (tid >> 6), NGW = G * 8;
        bf16* Hn = (bf16*)(ws + WS_HN); float* ssqx = (float*)(ws + WS_SSQX); const float* g = a.in[6];
        for (int row = gw; row < MT; row += NGW) {
            const float* src = row < MX ? a.in[0] + (size_t)row * DM : a.in[2] + (size_t)(row - MX) * DM;
            const int mi = row < MX ? (row >> 12) : 8;
            const f32x4* xr = (const f32x4*)src + lane;
            f32x4 v[4]; float s = 0.f;
#pragma unroll
            for (int j = 0; j < 4; ++j) { v[j] = xr[64 * j]; s += (v[j][0] * v[j][0] + v[j][1] * v[j][1]) + (v[j][2] * v[j][2] + v[j][3] * v[j][3]); }
            s = wave_sum(s);
            if (lane == 0) ssqx[row] = s;
            const float* mrow = mods + (size_t)mi * 6144 + 1024;
#pragma unroll
            for (int j = 0; j < 4; ++j) { const int col = 256 * j + 4 * lane;
                const f32x4 gg = *(const f32x4*)(g + col), sc = *(const f32x4*)(mrow + col);
                st4bf(Hn + (size_t)row * DM + col, v[j] * (gg * (sc + 1.0f))); }
        }
    }
}
DI void final_norm_phase(float* x, const float* g, const int tid) {
    const int lane = tid & 63, gw = blockIdx.x * 8 + (tid >> 6), NGW = gridDim.x * 8;
    for (int row = gw; row < MX; row += NGW) {
        f32x4* xr = (f32x4*)(x + (size_t)row * DM) + lane;
        f32x4 v[4]; float s = 0.f;
#pragma unroll
        for (int j = 0; j < 4; ++j) { v[j] = xr[64 * j]; s += (v[j][0] * v[j][0] + v[j][1] * v[j][1]) + (v[j][2] * v[j][2] + v[j][3] * v[j][3]); }
        const float r = rsqrtf(wave_sum(s) * (1.0f / DM) + EPSN);
#pragma unroll
        for (int j = 0; j < 4; ++j) { const f32x4 gg = *(const f32x4*)(g + 256 * j + 4 * lane); xr[64 * j] = v[j] * r * gg; }
    }
}

struct AttnP { const bf16 *proj, *qm, *kvm, *krr; bf16* mix; const float* sink; const float* rpb; };
constexpr int A_VS = 144, L_K = 0, L_V = 64 * 208, L_B = L_V + 64 * A_VS;

template <int TYPE> DI int key_row(int t, int j, int b, int nblk, int kr0, int kc0) {
    if (t < 4) return MX + b * 256 + t * 64 + j;
    const int tt = t - 4;
    if (TYPE == 0) return b * 4096 + (nblk - 1) * 128 + tt * 64 + j;
    if (TYPE == 1) { const int tr = tt / 3, tc = tt - 3 * tr; return b * 4096 + (kr0 + 4 * tr + (j >> 4)) * 64 + kc0 + 16 * tc + (j & 15); }
    return b * 4096 + tt * 64 + j;
}

template <int TYPE> DI void attn_unit(const AttnP& P, int uid, bool isctx, LAS unsigned char* lds, const int tid) {
    constexpr int DQK = TYPE == 2 ? 96 : 64, NKS = DQK / 16, KSTR = DQK * 2 + 16;
    const int lane = tid & 63, w = __builtin_amdgcn_readfirstlane(tid >> 6), r = lane & 31, h = lane >> 5;
    int b, hd, kvh = 0, qrow, nblk = 0, kr0 = 0, kc0 = 0, qr = 0, qc = 0, tb0 = 4, tb1 = 4;
    if (TYPE == 0) {
        int gp;
        if (!isctx) { b = uid >> 7; kvh = (uid >> 6) & 1; nblk = (uid >> 1) & 31; gp = uid & 1; qrow = b * 4096 + nblk * 128 + (w & 3) * 32 + r; tb0 = nblk == 0 ? 6 : 4; tb1 = nblk == 31 ? 8 : 10; }
        else { b = uid >> 3; kvh = (uid >> 2) & 1; gp = (uid >> 1) & 1; nblk = uid & 1; qrow = MX + b * 256 + nblk * 128 + (w & 3) * 32 + r; }
        hd = kvh * 4 + gp * 2 + (w >> 2);
    } else if (TYPE == 1) {
        if (!isctx) { b = uid >> 6; hd = (uid >> 4) & 3; const int ib = (uid >> 1) & 7, cp = uid & 1;
            qr = 8 * ib + 2 * (w & 3) + (r >> 4); qc = 16 * (2 * cp + (w >> 2)) + (r & 15); qrow = b * 4096 + qr * 64 + qc;
            kr0 = min(max(8 * ib - 4, 0), 48); kc0 = 16 * cp; tb1 = 16; }
        else { b = uid >> 2; hd = uid & 3; qrow = MX + b * 256 + w * 32 + r; }
    } else {
        if (!isctx) { b = uid >> 6; hd = (uid >> 4) & 3; qrow = b * 4096 + (uid & 15) * 256 + w * 32 + r; tb1 = 68; }
        else { b = uid >> 2; hd = uid & 3; qrow = MX + b * 256 + w * 32 + r; }
    }
    const int NTA = 4 + (tb1 - tb0);
    const bf16* qp; int ocol;
    if (TYPE == 0) { qp = P.proj + (size_t)qrow * PJS + hd * 64; ocol = hd * 64; }
    else if (TYPE == 1) { qp = P.proj + (size_t)qrow * PJS + 768 + hd * 64; ocol = 512 + hd * 64; }
    else { qp = P.qm + (size_t)qrow * 384 + hd * 96; ocol = 768 + hd * 64; }
    bf16x8 qf[NKS];
#pragma unroll
    for (int ks = 0; ks < NKS; ++ks) qf[ks] = *(const bf16x8*)(qp + 16 * ks + 8 * h);

    __syncthreads();
    LAS float* lbias = (LAS float*)(lds + L_B);
    if (TYPE == 1 && !isctx) { if (tid < 465) lbias[tid] = P.rpb[hd * 465 + tid] * LOG2E; }

    float m_ = -1e30f, l_ = 0.f;
    if (TYPE == 0) { m_ = P.sink[hd] * LOG2E; l_ = (h == 0) ? 1.f : 0.f; }
    f32x16 o0, o1;
#pragma unroll
    for (int i = 0; i < 16; ++i) { o0[i] = 0.f; o1[i] = 0.f; }

    u32x4 kreg, vreg, rreg = {0u, 0u, 0u, 0u};
    const int sj = tid >> 3, sc = tid & 7;
#define AT_LOAD(t) do { const int kr_ = key_row<TYPE>((t), sj, b, nblk, kr0, kc0); \
        if (TYPE == 2) { const bf16* base_ = P.kvm + (size_t)kr_ * 512 + hd * 128 + sc * 8; kreg = *(const u32x4*)base_; vreg = *(const u32x4*)(base_ + 64); \
            if (tid < 256) { const int kr2_ = key_row<TYPE>((t), tid >> 2, b, nblk, kr0, kc0); rreg = *(const u32x4*)(P.krr + (size_t)kr2_ * 32 + (tid & 3) * 8); } } \
        else { const bf16* base_ = P.proj + (size_t)kr_ * PJS + (TYPE == 0 ? 512 + kvh * 64 : 1024 + hd * 64) + sc * 8; kreg = *(const u32x4*)base_; vreg = *(const u32x4*)(base_ + (TYPE == 0 ? 128 : 256)); } } while (0)
    AT_LOAD(0);
    const int q4 = (lane & 15) >> 2, p4 = lane & 3, blk = (lane >> 4) & 1;
    const LAS unsigned char* vb = lds + L_V + (4 * h + q4) * A_VS + (16 * blk + 4 * p4) * 2;
    const LAS unsigned char* kb0 = lds + L_K + r * KSTR + 16 * h;
    const int wr_ = min(max(qr - 4, 0), 56), wc_ = min(max(qc - 8, 0), 48);
    const int qi = (w & 3) * 32 + r;

    for (int it = 0; it < NTA; ++it) {
        const int t = it < 4 ? it : it - 4 + tb0;
        __syncthreads();
        *(LAS u32x4*)(lds + L_K + sj * KSTR + sc * 16) = kreg;
        *(LAS u32x4*)(lds + L_V + sj * A_VS + sc * 16) = vreg;
        if (TYPE == 2) { if (tid < 256) *(LAS u32x4*)(lds + L_K + (tid >> 2) * KSTR + 128 + (tid & 3) * 16) = rreg; }
        __syncthreads();
        if (it + 1 < NTA) { const int tn = (it + 1) < 4 ? (it + 1) : (it + 1) - 4 + tb0; AT_LOAD(tn); }
        f32x16 p0, p1;
#pragma unroll
        for (int i = 0; i < 16; ++i) { p0[i] = 0.f; p1[i] = 0.f; }
#pragma unroll
        for (int ks = 0; ks < NKS; ++ks) {
            const bf16x8 a0 = *(const LAS bf16x8*)(kb0 + ks * 32), a1 = *(const LAS bf16x8*)(kb0 + 32 * KSTR + ks * 32);
            p0 = __builtin_amdgcn_mfma_f32_32x32x16_bf16(a0, qf[ks], p0, 0, 0, 0);
            p1 = __builtin_amdgcn_mfma_f32_32x32x16_bf16(a1, qf[ks], p1, 0, 0, 0);
        }
        if (t >= 4) {
            if (TYPE == 0) {
                const int d0 = 64 * (t - 4) - qi + 4 * h;
#pragma unroll
                for (int i = 0; i < 16; ++i) { const int e = d0 + (i & 3) + 8 * (i >> 2);
                    if ((unsigned)e > 256u) p0[i] = -1e30f;
                    if ((unsigned)(e + 32) > 256u) p1[i] = -1e30f; }
            } else if (TYPE == 1) {
                const int tt = t - 4, tr = tt / 3, tc = tt - 3 * tr;
                const int krb = kr0 + 4 * tr, kcb = kc0 + 16 * tc + 4 * h;
#pragma unroll
                for (int i = 0; i < 16; ++i) {
                    const int kc = kcb + (i & 3) + 8 * ((i >> 2) & 1);
                    const bool cv = (unsigned)(kc - wc_) < 16u;
                    const int ci = kc - qc + 15;
                    { const int kr = krb + (i >> 3); const bool v = cv && ((unsigned)(kr - wr_) < 8u); const int idx = v ? (kr - qr + 7) * 31 + ci : 0; const float bv = lbias[idx]; p0[i] = v ? p0[i] + bv : -1e30f; }
                    { const int kr = krb + 2 + (i >> 3); const bool v = cv && ((unsigned)(kr - wr_) < 8u); const int idx = v ? (kr - qr + 7) * 31 + ci : 0; const float bv = lbias[idx]; p1[i] = v ? p1[i] + bv : -1e30f; }
                }
            }
        }
        float mx = fmaxf(p0[0], p1[0]);
#pragma unroll
        for (int i = 1; i < 16; ++i) mx = fmaxf(mx, fmaxf(p0[i], p1[i]));
        mx = fmaxf(mx, __shfl_xor(mx, 32));
        const float mnew = fmaxf(m_, mx), alpha = fexp2(m_ - mnew);
        m_ = mnew;
        float ls = 0.f;
#pragma unroll
        for (int i = 0; i < 16; ++i) { p0[i] = fexp2(p0[i] - mnew); p1[i] = fexp2(p1[i] - mnew); ls += p0[i] + p1[i]; }
        l_ = l_ * alpha + ls;
#pragma unroll
        for (int i = 0; i < 16; ++i) { o0[i] *= alpha; o1[i] *= alpha; }
        bf16x8 pf[4];
#pragma unroll
        for (int s = 0; s < 4; ++s) {
            u32x4 pw;
            if (s < 2) { pw.x = cvtpk(p0[8 * s + 0], p0[8 * s + 1]); pw.y = cvtpk(p0[8 * s + 2], p0[8 * s + 3]); pw.z = cvtpk(p0[8 * s + 4], p0[8 * s + 5]); pw.w = cvtpk(p0[8 * s + 6], p0[8 * s + 7]); }
            else { const int s2 = s - 2; pw.x = cvtpk(p1[8 * s2 + 0], p1[8 * s2 + 1]); pw.y = cvtpk(p1[8 * s2 + 2], p1[8 * s2 + 3]); pw.z = cvtpk(p1[8 * s2 + 4], p1[8 * s2 + 5]); pw.w = cvtpk(p1[8 * s2 + 6], p1[8 * s2 + 7]); }
            pf[s] = __builtin_bit_cast(bf16x8, pw);
        }
#pragma unroll
        for (int s = 0; s < 4; ++s) {
#pragma unroll
            for (int c = 0; c < 2; ++c) {
                const s16x4 lo = __builtin_bit_cast(s16x4, __builtin_amdgcn_ds_read_tr16_b64_v4i16((LAS s16x4*)(vb + (16 * s) * A_VS + c * 64)));
                const s16x4 hi = __builtin_bit_cast(s16x4, __builtin_amdgcn_ds_read_tr16_b64_v4i16((LAS s16x4*)(vb + (16 * s + 8) * A_VS + c * 64)));
                const bf16x8 vf = __builtin_shufflevector(lo, hi, 0, 1, 2, 3, 4, 5, 6, 7);
                if (c == 0) o0 = __builtin_amdgcn_mfma_f32_32x32x16_bf16(vf, pf[s], o0, 0, 0, 0);
                else o1 = __builtin_amdgcn_mfma_f32_32x32x16_bf16(vf, pf[s], o1, 0, 0, 0);
            }
        }
    }
#undef AT_LOAD
    const float lt = l_ + __shfl_xor(l_, 32), inv = 1.0f / lt;
    bf16* op = P.mix + (size_t)qrow * DM + ocol + 4 * h;
#pragma unroll
    for (int g = 0; g < 4; ++g) {
        const f32x4 v0 = {o0[4 * g] * inv, o0[4 * g + 1] * inv, o0[4 * g + 2] * inv, o0[4 * g + 3] * inv};
        const f32x4 v1 = {o1[4 * g] * inv, o1[4 * g + 1] * inv, o1[4 * g + 2] * inv, o1[4 * g + 3] * inv};
        st4bf(op + 8 * g, v0); st4bf(op + 32 + 8 * g, v1);
    }
}

DI void attn_phase(const AttnP& P, bool last, LAS unsigned char* lds, const int tid) {
    const int G = gridDim.x, bx = blockIdx.x;
    const int vcu = (G % 8 == 0) ? (bx % 8) * (G / 8) + bx / 8 : bx;
    const int NU = 2048 + (last ? 0 : 128);
    for (int u = vcu; u < NU; u += G) {
        if (u < 512) attn_unit<2>(P, u, false, lds, tid);
        else if (u < 1024) attn_unit<1>(P, u - 512, false, lds, tid);
        else if (u < 2048) attn_unit<0>(P, u - 1024, false, lds, tid);
        else if (u < 2080) attn_unit<2>(P, u - 2048, true, lds, tid);
        else if (u < 2112) attn_unit<1>(P, u - 2080, true, lds, tid);
        else attn_unit<0>(P, u - 2112, true, lds, tid);
    }
}

#define XB_TMO      128
#define XB_XCNT(j)  (256  + 64 * (j))
#define XB_XSUB(j)  (1280 + 64 * (j))
#define XB_XGEN(j)  (2304 + 64 * (j))
#define XB_TOP      3328
#define XB_TOPGEN   3392
#define XCD_BAR_WORDS 3456
#define XB_SPIN_CAP (1u << 18)

__device__ __forceinline__ unsigned xb_ld(unsigned* p)              { return __hip_atomic_load(p, __ATOMIC_RELAXED, __HIP_MEMORY_SCOPE_AGENT); }
__device__ __forceinline__ unsigned xb_add(unsigned* p, unsigned v) { return __hip_atomic_fetch_add(p, v, __ATOMIC_RELAXED, __HIP_MEMORY_SCOPE_AGENT); }
__device__ __forceinline__ unsigned xb_xcc_id() { return (unsigned)__builtin_amdgcn_s_getreg((3 << 11) | 20) & 0xFu; }
#define XB_SPIN(cond, bar) do { unsigned _sp = 0; while (cond) { __builtin_amdgcn_s_sleep(1); \
    if ((++_sp & 255u) == 0u) { if (xb_ld(&(bar)[XB_TMO])) break; if (_sp > XB_SPIN_CAP) { atomicAdd(&(bar)[XB_TMO], 1u); break; } } } } while (0)

struct XcdBarrier {
    unsigned* bar; unsigned x;
    volatile LAS unsigned* st;
};

__device__ __forceinline__ XcdBarrier xcd_barrier_post(unsigned* bar, volatile LAS unsigned* st) {
    XcdBarrier b; b.bar = bar; b.x = xb_xcc_id(); b.st = st;
    if (threadIdx.x == 0) (void)xb_add(&bar[XB_XCNT(b.x)], 1u);
    return b;
}
__device__ __forceinline__ void xcd_barrier_complete(unsigned* bar, unsigned x, unsigned& nloc, unsigned& nx) {
    const unsigned G = gridDim.x * gridDim.y * gridDim.z;
    unsigned sum, cnt, mine, sp = 0u;
    for (;;) {
        sum = 0u; cnt = 0u; mine = 0u;
#pragma unroll
        for (unsigned j = 0; j < 16; ++j) { const unsigned c = xb_ld(&bar[XB_XCNT(j)]); sum += c; cnt += (c > 0u) ? 1u : 0u; mine = (j == x) ? c : mine; }
        if (sum == G) break;
        __builtin_amdgcn_s_sleep(1);
        if ((++sp & 255u) == 0u) { if (xb_ld(&bar[XB_TMO])) break; if (sp > XB_SPIN_CAP) { atomicAdd(&bar[XB_TMO], 1u); break; } }
    }
    nloc = mine > 0u ? mine : 1u; nx = cnt > 0u ? cnt : 1u;
}

__device__ __forceinline__ void xcd_barrier(const XcdBarrier& b) {
    asm volatile("s_waitcnt vmcnt(0)" ::: "memory");
    __syncthreads();
    if (threadIdx.x == 0) {
        unsigned* bar = b.bar;
        __builtin_amdgcn_s_waitcnt(0);
        unsigned nloc = b.st[0], nx = b.st[1];
        if (nloc == 0u) { xcd_barrier_complete(bar, b.x, nloc, nx); b.st[0] = nloc; b.st[1] = nx; }
        const unsigned old = xb_add(&bar[XB_XSUB(b.x)], 1u);
        const unsigned gen = old / nloc;
        if (old + 1u == (gen + 1u) * nloc) {
            __builtin_amdgcn_fence(__ATOMIC_RELEASE, "agent");
            asm volatile("s_waitcnt vmcnt(0)" ::: "memory");
            const unsigned og = xb_add(&bar[XB_TOP], 1u);
            const unsigned tg = og / nx;
            if (og + 1u == (tg + 1u) * nx) xb_add(&bar[XB_TOPGEN], 1u);
            else XB_SPIN(xb_ld(&bar[XB_TOPGEN]) == tg, bar);
            __builtin_amdgcn_fence(__ATOMIC_ACQUIRE, "agent");
            xb_add(&bar[XB_XGEN(b.x)], 1u);
            asm volatile("s_waitcnt vmcnt(0)" ::: "memory");
        } else {
            XB_SPIN(xb_ld(&bar[XB_XGEN(b.x)]) == gen, bar);
            __builtin_amdgcn_fence(__ATOMIC_ACQUIRE, "agent");
            asm volatile("s_waitcnt vmcnt(0)" ::: "memory");
        }
    }
    __syncthreads();
}

constexpr int NPH = 3 + 6 * DEPTH;
__global__ void __launch_bounds__(NTHR) mk_fwd(Args a) {
    extern __shared__ __attribute__((aligned(16))) unsigned char lds_raw[];
    LAS unsigned char* lds = (LAS unsigned char*)lds_raw;
    const int G = gridDim.x, bx = blockIdx.x;
    const int ph_lo = a.ph_lo, ph_hi = a.ph_hi;
    volatile LAS unsigned* bst = (volatile LAS unsigned*)(lds + 131072);
    if (threadIdx.x < 2) bst[threadIdx.x] = 0u;
    __syncthreads();
    XcdBarrier xbar; xbar.bar = (unsigned*)(a.ws + WS_BAR); xbar.x = 0; xbar.st = bst;
    if (!MK_PER_PHASE) xbar = xcd_barrier_post((unsigned*)(a.ws + WS_BAR), bst);

    for (int ph = ph_lo; ph < ph_hi;) {
        int tid = threadIdx.x; asm volatile("" : "+v"(tid));
        unsigned char* ws = a.ws; asm volatile("" : "+s"(ws));
        float* mods = (float*)(ws + WS_MODS);
        const float* tabA = (const float*)(ws + WS_TAB); const float* tabC = tabA + 2048;
        float* Xc = (float*)(ws + WS_XC);
        bf16* Hn = (bf16*)(ws + WS_HN); bf16* H1 = (bf16*)(ws + WS_H1);
        bf16* proj = (bf16*)(ws + WS_PROJ); bf16* cqb = (bf16*)(ws + WS_CQ); bf16* ckvb = (bf16*)(ws + WS_CKV);
        bf16* qm = (bf16*)(ws + WS_QM); bf16* kvm = (bf16*)(ws + WS_KVM); bf16* krr = (bf16*)(ws + WS_KRR); bf16* mix = (bf16*)(ws + WS_MIX);

        if (ph == 0) prologue(a, lds, tid);
        else if (ph == 1) phase1(a, lds, tid);
        else if (ph == NPH - 1) final_norm_phase(a.out, a.in[18], tid);
        else {
            const int l = (ph - 2) / 6, s = (ph - 2) - 6 * l; const bool last = (l == DEPTH - 1);
            unsigned char* wb = ws + WS_W + (size_t)l * WL_STRIDE;
            const float* mods_l = mods + (size_t)l * 9 * 6144;
            float* ssq_q = (float*)(ws + WS_SSQ) + (size_t)l * 2 * MT; float* ssq_kv = ssq_q + MT;
            float* ssqx1 = (float*)(ws + WS_SSQX) + (size_t)l * 2 * MT; float* ssqx2 = ssqx1 + MT;
            const float* xsrc = (l == 0) ? a.in[0] : a.out;
            const float* csrc = (l == 0) ? a.in[2] : Xc;
            if (s == 0) {
                pg8::Gemm g{Hn, (const bf16*)(wb + WL_IN), MT, 2048, DM}; pg8::StaticOrder S; S.init(MT, 2048, G, bx);
                EpiInProj E{proj, cqb, ckvb, krr, ssq_q, ssq_kv, tabA, tabC, ssqx1, (const float*)(ws + WS_BIAS1) + (size_t)l * 9 * 2048};
                pg8::gemm_phase<EpiInProj, pg8::StaticOrder, true, true>(lds, g, S, E, tid);
            } else if (s == 1) {
                { int Kq = 256; asm volatile("" : "+s"(Kq)); pg8::Gemm g{cqb, (const bf16*)(wb + WL_UQ), MT, 512, Kq}; pg8::StaticOrder S; S.init(MT, 512, G, bx);
                  EpiUQ E{qm, ssq_q, tabC}; pg8::gemm_phase<EpiUQ, pg8::StaticOrder, true, true>(lds, g, S, E, tid); }
                { int Kk = 128; asm volatile("" : "+s"(Kk)); pg8::Gemm g{ckvb, (const bf16*)(wb + WL_UKV), MT, 512, Kk}; pg8::StaticOrder S; S.init(MT, 512, G, (bx + G / 2) % G);
                  EpiUKV E{kvm, ssq_kv}; pg8::gemm_phase<EpiUKV, pg8::StaticOrder, true, true>(lds, g, S, E, tid); }
            } else if (s == 2) {
                AttnP P{proj, qm, kvm, krr, mix, a.in[9] + l * 8, a.in[10] + l * 4 * 465};
                attn_phase(P, last, lds, tid);
            } else if (s == 3 || s == 5) {
                const int Mr = last ? MX : MT;
                const bool outp = (s == 3);
                pg8::Gemm g{outp ? mix : H1, (const bf16*)(wb + (outp ? WL_OUT : WL_W2)), Mr, DM, outp ? DM : DFF}; pg8::StaticOrder S; S.init(Mr, DM, G, bx);
                const int ln = outp ? l : l + 1;
                const float* mods_n = mods + (size_t)(ln < DEPTH ? ln : 0) * 9 * 6144;
                EpiResid E{(outp ? xsrc : a.out), (outp ? csrc : Xc), a.out, Xc, mods_l + (outp ? 2 : 5) * 1024, Hn,
                           outp ? ssqx2 : ssqx1 + (size_t)2 * MT, (outp ? a.in[7] : a.in[6]) + (ln < DEPTH ? ln : 0) * DM, mods_n + (outp ? 4 : 1) * 1024, (outp || !last) ? 1 : 0};
                pg8::gemm_phase<EpiResid, pg8::StaticOrder, true, true>(lds, g, S, E, tid);
            } else {
                const int Mr = last ? MX : MT;
                pg8::Gemm g{Hn, (const bf16*)(wb + WL_W1), Mr, DFF, DM}; pg8::StaticOrder S; S.init(Mr, DFF, G, bx);
                EpiRelu2 E{H1, ssqx2, (const float*)(ws + WS_BIAS4) + (size_t)l * 9 * 4096}; pg8::gemm_phase<EpiRelu2, pg8::StaticOrder, true, true>(lds, g, S, E, tid);
            }
        }
        ++ph;
        if (ph < ph_hi) { if (ph == 1) cg::this_grid().sync(); else xcd_barrier(xbar); }
    }
}

extern "C" void kernel_launch(void* const* d_in, const int* in_sizes, int n_in, void* d_out, int out_size, void* d_ws, size_t ws_size, hipStream_t stream) {
    static int grid = 0;
    if (grid == 0) {
        if (n_in != 19 || ws_size < WS_END) { fprintf(stderr, "kernel_launch: unexpected inputs (n_in %d, ws %zu)\n", n_in, ws_size); grid = -1; return; }
        int dev = 0, cus = 0, per_cu = 0;
        hipGetDevice(&dev); hipDeviceGetAttribute(&cus, hipDeviceAttributeMultiprocessorCount, dev);
        hipFuncSetAttribute((const void*)mk_fwd, hipFuncAttributeMaxDynamicSharedMemorySize, LDS_BYTES);
        hipOccupancyMaxActiveBlocksPerMultiprocessor(&per_cu, (const void*)mk_fwd, NTHR, LDS_BYTES);
        if (per_cu < 1) { fprintf(stderr, "kernel_launch: occupancy query says %d\n", per_cu); per_cu = 1; }
        (void)hipGetLastError();
        grid = cus * 1;
    }
    if (grid < 0) return;
    Args a{};
    for (int i = 0; i < 19; ++i) a.in[i] = (const float*)d_in[i];
    a.out = (float*)d_out; a.ws = (unsigned char*)d_ws;
#if MK_PER_PHASE
    for (int ph = 0; ph < NPH; ++ph) { a.ph_lo = ph; a.ph_hi = ph + 1; hipLaunchKernelGGL(mk_fwd, dim3(grid), dim3(NTHR), LDS_BYTES, stream, a); }
#else
    a.ph_lo = 0; a.ph_hi = NPH;
    (void)hipMemsetAsync((unsigned char*)d_ws + WS_BAR, 0, 16384, stream);
    void* args[] = {&a};
    hipError_t e = hipLaunchCooperativeKernel((const void*)mk_fwd, dim3(grid), dim3(NTHR), args, LDS_BYTES, stream);
    if (e != hipSuccess) fprintf(stderr, "cooperative launch failed: %s (grid %d)\n", hipGetErrorString(e), grid);
#endif
}
```

```cpp
#include <hip/hip_runtime.h>
#include <hip/hip_cooperative_groups.h>
#include <cstdio>
#include <cstdint>
namespace cg = cooperative_groups;
namespace pg8 {
#define PG8_LAS __attribute__((address_space(3)))
typedef unsigned short bf16_t;
typedef short bf16x8 __attribute__((ext_vector_type(8)));
typedef float f32x4 __attribute__((ext_vector_type(4)));
typedef unsigned u32x4 __attribute__((ext_vector_type(4)));
constexpr int BM = 256, BK = 64, HALF = 128, HTB = HALF * BK * 2  , STAGE_BYTES = 8 * HTB, NXCD = 8, WGM = 8;

__host__ __device__ __forceinline__ int lds_byte(int r, int c) { const int st = (r >> 4) * 2 + (c >> 5), rr = r & 15, cc = c & 31, ob = rr * 64 + cc * 2; return st * 1024 + (ob ^ (((ob >> 9) & 1) << 5)); }
__host__ __device__ __forceinline__ void stage_rc(int b, int& R, int& C) { const int st = b / 1024, sb = b % 1024, swz = sb ^ (((sb >> 9) & 1) << 5); R = (st >> 1) * 16 + swz / 64; C = (st & 1) * 32 + (swz % 64) / 2; }
__host__ __device__ __forceinline__ int perm32(int rho) { const int n = rho >> 4, i = rho & 15; return 8 * (i >> 2) + 4 * n + (i & 3); }

struct Unit { int pm, pn; };
struct Gemm { const bf16_t* A; const bf16_t* Bt; int M, N, K; };

struct StaticOrder {
    int nM, nN, nwg, G, c;
    __host__ __device__ void init(int M, int N, int G_, int c_) { nM = M / BM; nN = N / BM; nwg = nM * nN; G = G_; c = c_; }
    __host__ __device__ bool next(int i, Unit& u) const {
        const long L = (long)i * G + c; if (L >= nwg) return false;
        int wgid = (int)L; { const int q = nwg / NXCD, r = nwg % NXCD, xcd = wgid % NXCD, off = wgid / NXCD; wgid = (xcd < r ? xcd * (q + 1) : r * (q + 1) + (xcd - r) * q) + off; }
        const int nig = WGM * nN, gid = wgid / nig, fm = gid * WGM, gsz = (nM - fm) < WGM ? (nM - fm) : WGM;
        u.pm = fm + ((wgid % nig) % gsz); u.pn = (wgid % nig) / gsz; return true;
    }
    __device__ __forceinline__ void a_ready(const Unit&) const {}
    __device__ __forceinline__ void done(const Unit&) const {}
};

__device__ __forceinline__ unsigned cvt_pk_bf16(float lo, float hi) { unsigned r; asm volatile("v_cvt_pk_bf16_f32 %0, %1, %2" : "=v"(r) : "v"(lo), "v"(hi)); return r; }
template <class Epi, class Sched, bool ALIGN_EPI = false, bool SP2 = false>
__device__ __forceinline__ void gemm_phase(PG8_LAS unsigned char* lds, const Gemm g, const Sched& S, const Epi& E, const int tid) {
    const int wid = __builtin_amdgcn_readfirstlane(tid >> 6), lane = tid & 63, wr = wid >> 2, wc = wid & 3, fr = lane & 15, fq = lane >> 4;
    const int K = g.K, nt = K / BK;
    unsigned voffA[2], voffB[2];
#pragma unroll
    for (int i = 0; i < 2; ++i) { int R, C; stage_rc(tid * 16 + i * 8192, R, C); const int Rb = Epi::PERM ? ((R & ~31) + perm32(R & 31)) : R;
        voffA[i] = (unsigned)(R * K + C) * 2u; voffB[i] = (unsigned)(Rb * K + C) * 2u; }
    const size_t kstep = (size_t)(BK * 2);
    const size_t hstep = (size_t)HALF * K * 2;
    const size_t tstep = 2 * hstep;
    const unsigned ldsw = (unsigned)wid * 1024u;
    const int aoff = lds_byte(wr * 64 + fr, fq * 8), boff = lds_byte(wc * 32 + fr, fq * 8);
#define PG8_SA(b, h) (((b) * 2 + (h)) * HTB)
#define PG8_SB(b, h) ((4 + (b) * 2 + (h)) * HTB)
#define PG8_STAGE(bufoff, gbase, voff) do { _Pragma("unroll") for (int _i = 0; _i < 2; ++_i) \
        __builtin_amdgcn_global_load_lds((const unsigned*)((const char*)(gbase) + (voff)[_i]), (PG8_LAS unsigned*)(lds + (bufoff) + ldsw + _i * 8192), 16, 0, 0); } while (0)
#define PG8_LDA(dst, b, h) do { _Pragma("unroll") for (int m = 0; m < 4; ++m) _Pragma("unroll") for (int k = 0; k < 2; ++k) dst[m][k] = *(const PG8_LAS bf16x8*)(lds + PG8_SA(b, h) + aoff + m * 2048 + k * 1024); } while (0)
#define PG8_LDB(dst, b, h) do { _Pragma("unroll") for (int n = 0; n < 2; ++n) _Pragma("unroll") for (int k = 0; k < 2; ++k) dst[n][k] = *(const PG8_LAS bf16x8*)(lds + PG8_SB(b, h) + boff + n * 2048 + k * 1024); } while (0)
#define PG8_MMA(ai, bj, At, Bt) do { __builtin_amdgcn_s_setprio(1); _Pragma("unroll") for (int m = 0; m < 4; ++m) _Pragma("unroll") for (int n = 0; n < 2; ++n) _Pragma("unroll") for (int k = 0; k < 2; ++k) \
        acc[ai][bj][m][n] = __builtin_amdgcn_mfma_f32_16x16x32_bf16(Bt[n][k], At[m][k], acc[ai][bj][m][n], 0, 0, 0); __builtin_amdgcn_s_setprio(0); } while (0)
#define PG8_WAIT_V(n) asm volatile("s_waitcnt vmcnt(" #n ")" ::: "memory")
#define PG8_WAIT_L(n) asm volatile("s_waitcnt lgkmcnt(" #n ")" ::: "memory")
#define PG8_BAR __builtin_amdgcn_s_barrier()
#define PG8_SCHED __builtin_amdgcn_sched_barrier(0)
    Unit cur, nxt; int ui = 0;
    if (!S.next(0, cur)) return;
    f32x4 acc[2][2][4][2];
#pragma unroll
    for (int a = 0; a < 2; ++a)
#pragma unroll
        for (int b = 0; b < 2; ++b)
#pragma unroll
            for (int m = 0; m < 4; ++m)
#pragma unroll
                for (int n = 0; n < 2; ++n) acc[a][b][m][n] = (f32x4){0.f, 0.f, 0.f, 0.f};
    bf16x8 At[4][2], B0[2][2], B1[2][2];
    const char* cA = (const char*)g.A + (size_t)cur.pm * tstep; const char* cB = (const char*)g.Bt + (size_t)cur.pn * tstep;
    S.a_ready(cur);
    if constexpr (SP2) {
        PG8_STAGE(PG8_SB(0, 0), cB, voffB); PG8_STAGE(PG8_SB(0, 1), cB + hstep, voffB); PG8_STAGE(PG8_SA(0, 0), cA, voffA); PG8_STAGE(PG8_SA(0, 1), cA + hstep, voffA);
        if (wr == 1) PG8_BAR;
        PG8_WAIT_V(2); PG8_BAR;
        PG8_STAGE(PG8_SB(1, 0), cB + kstep, voffB); PG8_STAGE(PG8_SA(1, 0), cA + kstep, voffA); PG8_STAGE(PG8_SB(1, 1), cB + hstep + kstep, voffB);
        PG8_WAIT_V(6); PG8_BAR;
    } else {
        PG8_STAGE(PG8_SB(0, 0), cB, voffB); PG8_STAGE(PG8_SA(0, 0), cA, voffA); PG8_STAGE(PG8_SB(0, 1), cB + hstep, voffB); PG8_STAGE(PG8_SA(0, 1), cA + hstep, voffA);
        if (wr == 1) PG8_BAR;
        PG8_WAIT_V(4); PG8_BAR;
        PG8_STAGE(PG8_SB(1, 0), cB + kstep, voffB); PG8_STAGE(PG8_SA(1, 0), cA + kstep, voffA); PG8_STAGE(PG8_SB(1, 1), cB + hstep + kstep, voffB);
        PG8_WAIT_V(6); PG8_BAR;
    }
    for (;;) {
        const bool has_next = S.next(ui + 1, nxt);
        const char* nA = has_next ? (const char*)g.A + (size_t)nxt.pm * tstep : cA; const char* nB = has_next ? (const char*)g.Bt + (size_t)nxt.pn * tstep : cB;
        for (int t = 0; t < nt; t += 2) {
            const bool last = (t == nt - 2);
            const char* a1 = cA + (size_t)(t + 1) * kstep;
            const char* a2 = last ? nA : cA + (size_t)(t + 2) * kstep; const char* b2 = last ? nB : cB + (size_t)(t + 2) * kstep;
            const char* a3 = a2 + kstep; const char* b3 = b2 + kstep;
            if (last && has_next) S.a_ready(nxt);
            if constexpr (SP2) {
            PG8_LDB(B0, 0, 0); PG8_LDB(B1, 0, 1); PG8_SCHED; PG8_LDA(At, 0, 0); PG8_STAGE(PG8_SA(1, 1), a1 + hstep, voffA);
            PG8_WAIT_V(8); PG8_WAIT_L(0); PG8_BAR; PG8_MMA(0, 0, At, B0); PG8_MMA(0, 1, At, B1); PG8_BAR; PG8_SCHED;
            PG8_LDA(At, 0, 1); PG8_STAGE(PG8_SB(0, 0), b2, voffB); PG8_STAGE(PG8_SB(0, 1), b2 + hstep, voffB); PG8_STAGE(PG8_SA(0, 0), a2, voffA);
            PG8_WAIT_V(8); PG8_WAIT_L(0); PG8_BAR; PG8_MMA(1, 0, At, B0); PG8_MMA(1, 1, At, B1); PG8_BAR; PG8_SCHED;
            PG8_LDB(B0, 1, 0); PG8_LDB(B1, 1, 1); PG8_SCHED; PG8_LDA(At, 1, 0); PG8_STAGE(PG8_SA(0, 1), a2 + hstep, voffA);
            PG8_WAIT_V(8); PG8_WAIT_L(0); PG8_BAR; PG8_MMA(0, 0, At, B0); PG8_MMA(0, 1, At, B1); PG8_BAR; PG8_SCHED;
            PG8_LDA(At, 1, 1); PG8_STAGE(PG8_SB(1, 0), b3, voffB); PG8_STAGE(PG8_SB(1, 1), b3 + hstep, voffB); PG8_STAGE(PG8_SA(1, 0), a3, voffA);
            PG8_WAIT_V(8); PG8_WAIT_L(0); PG8_BAR; PG8_MMA(1, 0, At, B0); PG8_MMA(1, 1, At, B1); PG8_BAR; PG8_SCHED;
            } else {
            PG8_LDB(B0, 0, 0); PG8_SCHED; PG8_LDA(At, 0, 0); PG8_STAGE(PG8_SA(1, 1), a1 + hstep, voffA);
            PG8_WAIT_L(8); PG8_BAR; PG8_WAIT_L(0); PG8_MMA(0, 0, At, B0); PG8_BAR; PG8_SCHED;
            PG8_LDB(B1, 0, 1); PG8_STAGE(PG8_SB(0, 0), b2, voffB);
            PG8_BAR; PG8_WAIT_L(0); PG8_MMA(0, 1, At, B1); PG8_BAR;
            PG8_LDA(At, 0, 1); PG8_STAGE(PG8_SA(0, 0), a2, voffA);
            PG8_BAR; PG8_WAIT_L(0); PG8_MMA(1, 0, At, B0); PG8_BAR; PG8_SCHED;
            PG8_STAGE(PG8_SB(0, 1), b2 + hstep, voffB);
            PG8_WAIT_V(6); PG8_BAR; PG8_MMA(1, 1, At, B1); PG8_BAR;
            PG8_LDB(B0, 1, 0); PG8_SCHED; PG8_LDA(At, 1, 0); PG8_STAGE(PG8_SA(0, 1), a2 + hstep, voffA);
            PG8_WAIT_L(8); PG8_BAR; PG8_WAIT_L(0); PG8_MMA(0, 0, At, B0); PG8_BAR; PG8_SCHED;
            PG8_LDB(B1, 1, 1); PG8_STAGE(PG8_SB(1, 0), b3, voffB);
            PG8_BAR; PG8_WAIT_L(0); PG8_MMA(0, 1, At, B1); PG8_BAR;
            PG8_LDA(At, 1, 1); PG8_STAGE(PG8_SA(1, 0), a3, voffA);
            PG8_BAR; PG8_WAIT_L(0); PG8_MMA(1, 0, At, B0); PG8_BAR; PG8_SCHED;
            PG8_STAGE(PG8_SB(1, 1), b3 + hstep, voffB);
            PG8_WAIT_V(6); PG8_BAR; PG8_MMA(1, 1, At, B1); PG8_BAR;
            }
        }
        if constexpr (ALIGN_EPI) { if (wr == 0) PG8_BAR; }
        if constexpr (!Epi::AFTER_DRAIN) { E(acc, cur, wr, wc, fr, fq); S.done(cur); }
        if (!has_next) break;
#pragma unroll
        for (int a = 0; a < 2; ++a)
#pragma unroll
            for (int b = 0; b < 2; ++b)
#pragma unroll
                for (int m = 0; m < 4; ++m)
#pragma unroll
                    for (int n = 0; n < 2; ++n) acc[a][b][m][n] = (f32x4){0.f, 0.f, 0.f, 0.f};
        cur = nxt; cA = nA; cB = nB; ++ui;
        if constexpr (ALIGN_EPI) { if (wr == 1) PG8_BAR; }
    }
    PG8_WAIT_V(0);
    if constexpr (!ALIGN_EPI) { if (wr == 0) PG8_BAR; }
    PG8_BAR;
    if constexpr (Epi::AFTER_DRAIN) { E.fused(acc, cur, wr, wc, fr, fq, lds, wid, lane); S.done(cur); }
#undef PG8_SA
#undef PG8_SB
#undef PG8_STAGE
#undef PG8_LDA
#undef PG8_LDB
#undef PG8_MMA
#undef PG8_WAIT_V
#undef PG8_WAIT_L
#undef PG8_BAR
#undef PG8_SCHED
}
}

#define LAS __attribute__((address_space(3)))
#define DI __device__ __forceinline__
#define GAS __attribute__((address_space(1)))
typedef unsigned short bf16;
typedef float f32x4 __attribute__((ext_vector_type(4)));
typedef float f32x16 __attribute__((ext_vector_type(16)));
typedef short bf16x8 __attribute__((ext_vector_type(8)));
typedef short s16x4 __attribute__((ext_vector_type(4)));
typedef unsigned u32x2 __attribute__((ext_vector_type(2)));
typedef unsigned u32x4 __attribute__((ext_vector_type(4)));
typedef float f32x2_t __attribute__((ext_vector_type(2)));
typedef __bf16 bf16x2_t __attribute__((ext_vector_type(2)));

#ifndef MK_MASK
#define MK_MASK 0x1ff
#endif
#define PH_EN(k) (((MK_MASK) >> (k)) & 1)
#ifndef MK_PER_PHASE
#define MK_PER_PHASE 0
#endif

constexpr int DM = 1024, NBATCH = 8, SEQ = 4096, DEPTH = 4, CTXL = 256, DFF = 4096;
constexpr int MX = NBATCH * SEQ, MC = NBATCH * CTXL, MT = MX + MC;
constexpr int INW = 1952, PJS = 1536;
constexpr float LOG2E = 1.4426950408889634f;
constexpr float C2A = 0.125f * LOG2E;
constexpr float C2C = 0.10206207261596575f * LOG2E;
constexpr float EPSN = 1e-6f;
constexpr int NTHR = 512;

constexpr size_t MiB = (size_t)1 << 20;
constexpr size_t WS_TAB = 0;
constexpr size_t WS_BAR = 65536;
constexpr size_t WS_MODS = 1 * MiB;
constexpr size_t WS_SSQ = 2 * MiB;
constexpr size_t WS_XC = 4 * MiB;
constexpr size_t WS_W = 12 * MiB;
constexpr size_t WL_IN = 0, WL_OUT = 4 * MiB, WL_W1 = 6 * MiB, WL_W2 = 14 * MiB, WL_UQ = 22 * MiB, WL_UKV = 22 * MiB + 256 * 1024, WL_STRIDE = 22 * MiB + 512 * 1024;
constexpr size_t WS_HN = 102 * MiB;
constexpr size_t WS_H1 = 170 * MiB;
constexpr size_t WS_PROJ = 170 * MiB;
constexpr size_t WS_CQ = 272 * MiB;
constexpr size_t WS_CKV = 289 * MiB;
constexpr size_t WS_QM = 298 * MiB;
constexpr size_t WS_KVM = 324 * MiB;
constexpr size_t WS_KRR = 358 * MiB;
constexpr size_t WS_MIX = 362 * MiB;
constexpr size_t WS_SSQX = 442 * MiB;
constexpr size_t WS_BIAS1 = 444 * MiB;
constexpr size_t WS_BIAS4 = 445 * MiB;
constexpr size_t WS_END = 446 * MiB;
constexpr int LDS_BYTES = 131072 + 256;

DI unsigned cvtpk(float lo, float hi) { f32x2_t v = {lo, hi}; bf16x2_t b = __builtin_convertvector(v, bf16x2_t); return __builtin_bit_cast(unsigned, b); }
DI void st4bf(bf16* p, f32x4 v) { u32x2 w; w.x = cvtpk(v[0], v[1]); w.y = cvtpk(v[2], v[3]); *(GAS u32x2*)p = w; }
DI float wave_sum(float v) {
#pragma unroll
    for (int o = 1; o < 64; o <<= 1) v += __shfl_xor(v, o);
    return v;
}
DI float fexp2(float x) { return __builtin_amdgcn_exp2f(x); }
DI float max3f(float a, float b, float c) { float r; asm("v_max3_f32 %0, %1, %2, %3" : "=v"(r) : "v"(a), "v"(b), "v"(c)); return r; }
#define LDS_WAIT() asm volatile("s_waitcnt lgkmcnt(0)" ::: "memory")

DI f32x4 rope8(f32x4 v, const float* tab  , int fq) {
    const int i0 = 4 * (fq & 1);
    const f32x4 cs = *(const f32x4*)(tab + i0), sn = *(const f32x4*)(tab + 8 + i0);
    f32x4 o;
#pragma unroll
    for (int j = 0; j < 4; ++j) { const float pr = __shfl_xor(v[j], 32); o[j] = (fq < 2) ? v[j] * cs[j] - pr * sn[j] : pr * sn[j] + v[j] * cs[j]; }
    return o;
}

struct EpiInProj {
    static constexpr bool PERM = false, AFTER_DRAIN = false;
    bf16 *proj, *cqb, *ckvb, *krr; float *ssq_q, *ssq_kv; const float *tabA, *tabC; const float *ssqx, *bias;
    DI void operator()(const f32x4 (&acc0)[2][2][4][2], const pg8::Unit& u, int wr, int wc, int fr, int fq) const {
        const int pn = u.pn; const bool isx = u.pm < 128; const int mi = isx ? (u.pm >> 4) : 8;
        f32x4 bv[2][2];
#pragma unroll
        for (int bj = 0; bj < 2; ++bj)
#pragma unroll
            for (int n = 0; n < 2; ++n) bv[bj][n] = *(const f32x4*)(bias + mi * 2048 + pn * 256 + bj * 128 + wc * 32 + n * 16 + 4 * fq);
#pragma unroll
        for (int ai = 0; ai < 2; ++ai)
#pragma unroll
            for (int m = 0; m < 4; ++m) {
                int row = u.pm * 256 + ai * 128 + wr * 64 + m * 16 + fr;
                asm volatile("" : "+v"(row) :: "memory");
                const int tok = row & 4095, prow = tok >> 6, pcol = tok & 63;
                const float rsx = rsqrtf(ssqx[row] * (1.0f / 1024.0f) + EPSN);
                f32x4 acc[2][2];
#pragma unroll
                for (int bj = 0; bj < 2; ++bj)
#pragma unroll
                    for (int n = 0; n < 2; ++n) acc[bj][n] = acc0[ai][bj][m][n] * rsx + bv[bj][n];
                if (pn < 6) {
                    const bool anyrope = isx && pn <= 2;
                    f32x4 cs = {1.f, 1.f, 1.f, 1.f}, sn = {0.f, 0.f, 0.f, 0.f};
                    if (anyrope) { const int pos = (wc & 1) ? pcol : prow; cs = *(const f32x4*)(tabA + pos * 32 + 4 * fq); sn = *(const f32x4*)(tabA + pos * 32 + 16 + 4 * fq); }
#pragma unroll
                    for (int bj = 0; bj < 2; ++bj) {
                        f32x4 v0 = acc[bj][0], v1 = acc[bj][1];
                        if (anyrope && (pn < 2 || bj == 0)) { const f32x4 a = v0 * cs - v1 * sn, b = v0 * sn + v1 * cs; v0 = a; v1 = b; }
                        if (pn < 2 || pn == 3) { v0 *= C2A; v1 *= C2A; }
                        bf16* p = proj + (size_t)row * PJS + pn * 256 + bj * 128 + wc * 32 + 4 * fq;
                        st4bf(p, v0); st4bf(p + 16, v1);
                    }
                } else if (pn == 6) {
                    float s = 0.f;
#pragma unroll
                    for (int bj = 0; bj < 2; ++bj) {
                        const f32x4 v0 = acc[bj][0], v1 = acc[bj][1];
                        s += (v0[0] * v0[0] + v0[1] * v0[1]) + (v0[2] * v0[2] + v0[3] * v0[3]) + (v1[0] * v1[0] + v1[1] * v1[1]) + (v1[2] * v1[2] + v1[3] * v1[3]);
                        bf16* p = cqb + (size_t)row * 256 + bj * 128 + wc * 32 + 4 * fq;
                        st4bf(p, v0); st4bf(p + 16, v1);
                    }
                    s += __shfl_xor(s, 16); s += __shfl_xor(s, 32);
                    if (fq == 0) atomicAdd(ssq_q + row, s);
                } else {
                    {
                        const f32x4 v0 = acc[0][0], v1 = acc[0][1];
                        float s = (v0[0] * v0[0] + v0[1] * v0[1]) + (v0[2] * v0[2] + v0[3] * v0[3]) + (v1[0] * v1[0] + v1[1] * v1[1]) + (v1[2] * v1[2] + v1[3] * v1[3]);
                        bf16* p = ckvb + (size_t)row * 128 + wc * 32 + 4 * fq;
                        st4bf(p, v0); st4bf(p + 16, v1);
                        s += __shfl_xor(s, 16); s += __shfl_xor(s, 32);
                        if (fq == 0) atomicAdd(ssq_kv + row, s);
                    }
                    if (wc == 0) {
                        f32x4 v0 = acc[1][0], v1 = acc[1][1];
                        if (isx) { v0 = rope8(v0, tabC + prow * 16, fq); v1 = rope8(v1, tabC + pcol * 16, fq); }
                        bf16* p = krr + (size_t)row * 32 + 4 * fq;
                        st4bf(p, v0); st4bf(p + 16, v1);
                    }
                }
            }
    }
};

struct EpiUQ {
    static constexpr bool PERM = false, AFTER_DRAIN = false;
    bf16* qm; const float* ssq_q; const float* tabC;
    DI void operator()(const f32x4 (&acc)[2][2][4][2], const pg8::Unit& u, int wr, int wc, int fr, int fq) const {
        const int pn = u.pn; const bool isx = u.pm < 128;
#pragma unroll
        for (int ai = 0; ai < 2; ++ai)
#pragma unroll
            for (int m = 0; m < 4; ++m) {
                int row = u.pm * 256 + ai * 128 + wr * 64 + m * 16 + fr;
                asm volatile("" : "+v"(row) :: "memory");
                const int tok = row & 4095, prow = tok >> 6, pcol = tok & 63;
                const float rs = rsqrtf(ssq_q[row] * (1.0f / 256.0f) + EPSN) * C2C;
#pragma unroll
                for (int bj = 0; bj < 2; ++bj)
#pragma unroll
                    for (int n = 0; n < 2; ++n) {
                        const int col0 = pn * 256 + bj * 128 + wc * 32 + n * 16;
                        if (col0 < 384) {
                            f32x4 v = acc[ai][bj][m][n] * rs;
                            const int g6 = (col0 >> 4) % 6;
                            if (isx && g6 >= 4) v = rope8(v, tabC + (g6 == 4 ? prow : pcol) * 16, fq);
                            st4bf(qm + (size_t)row * 384 + col0 + 4 * fq, v);
                        }
                    }
            }
    }
};

struct EpiUKV {
    static constexpr bool PERM = false, AFTER_DRAIN = false;
    bf16* kvm; const float* ssq_kv;
    DI void operator()(const f32x4 (&acc)[2][2][4][2], const pg8::Unit& u, int wr, int wc, int fr, int fq) const {
#pragma unroll
        for (int ai = 0; ai < 2; ++ai)
#pragma unroll
            for (int m = 0; m < 4; ++m) {
                int row = u.pm * 256 + ai * 128 + wr * 64 + m * 16 + fr;
                asm volatile("" : "+v"(row) :: "memory");
                const float rs = rsqrtf(ssq_kv[row] * (1.0f / 128.0f) + EPSN);
#pragma unroll
                for (int bj = 0; bj < 2; ++bj)
#pragma unroll
                    for (int n = 0; n < 2; ++n) {
                        const int col0 = u.pn * 256 + bj * 128 + wc * 32 + n * 16;
                        st4bf(kvm + (size_t)row * 512 + col0 + 4 * fq, acc[ai][bj][m][n] * rs);
                    }
            }
    }
};

struct EpiRelu2 {
    static constexpr bool PERM = true, AFTER_DRAIN = false;
    bf16* H; const float *ssqx, *bias;
    DI void operator()(const f32x4 (&acc)[2][2][4][2], const pg8::Unit& u, int wr, int wc, int fr, int fq) const {
        const int col0 = u.pn * 256 + wc * 32 + 8 * fq; const int mi = (u.pm < 128) ? (u.pm >> 4) : 8;
        f32x4 bv[2][2];
#pragma unroll
        for (int bj = 0; bj < 2; ++bj)
#pragma unroll
            for (int n = 0; n < 2; ++n) bv[bj][n] = *(const f32x4*)(bias + mi * 4096 + col0 + bj * 128 + 4 * n);
#pragma unroll
        for (int ai = 0; ai < 2; ++ai)
#pragma unroll
            for (int m = 0; m < 4; ++m) {
                int row = u.pm * 256 + ai * 128 + wr * 64 + m * 16 + fr;
                asm volatile("" : "+v"(row) :: "memory");
                const float rsx = rsqrtf(ssqx[row] * (1.0f / 1024.0f) + EPSN);
                bf16* rowp = H + (size_t)row * DFF + col0;
#pragma unroll
                for (int bj = 0; bj < 2; ++bj) {
                    f32x4 v0 = acc[ai][bj][m][0] * rsx + bv[bj][0], v1 = acc[ai][bj][m][1] * rsx + bv[bj][1];
#pragma unroll
                    for (int j = 0; j < 4; ++j) { const float a = fmaxf(v0[j], 0.f), b = fmaxf(v1[j], 0.f); v0[j] = a * a; v1[j] = b * b; }
                    u32x4 w; w.x = cvtpk(v0[0], v0[1]); w.y = cvtpk(v0[2], v0[3]); w.z = cvtpk(v1[0], v1[1]); w.w = cvtpk(v1[2], v1[3]);
                    *(GAS u32x4*)(rowp + bj * 128) = w;
                }
            }
    }
};

struct EpiResid {
    static constexpr bool PERM = false, AFTER_DRAIN = false;
    const float *srcx, *srcc; float *dstx, *dstc; const float* gate; bf16* xg; float* ssq_out; const float *gn, *scn; int donorm;
    DI void operator()(const f32x4 (&acc)[2][2][4][2], const pg8::Unit& u, int wr, int wc, int fr, int fq) const {
        const bool isx = u.pm < 128; const int mi = isx ? (u.pm >> 4) : 8;
        const int col0 = u.pn * 256 + wc * 32 + 4 * fq;
        f32x4 gv[2][2], gp[2][2];
#pragma unroll
        for (int bj = 0; bj < 2; ++bj)
#pragma unroll
            for (int n = 0; n < 2; ++n) { const int c = col0 + bj * 128 + n * 16; gv[bj][n] = *(const f32x4*)(gate + mi * 6144 + c);
                gp[bj][n] = donorm ? *(const f32x4*)(gn + c) * (*(const f32x4*)(scn + mi * 6144 + c) + 1.0f) : (f32x4){0.f, 0.f, 0.f, 0.f}; }
#pragma unroll
        for (int ai = 0; ai < 2; ++ai)
#pragma unroll
            for (int m = 0; m < 4; ++m) {
                int row = u.pm * 256 + ai * 128 + wr * 64 + m * 16 + fr;
                asm volatile("" : "+v"(row) :: "memory");
                const float* s = isx ? srcx + (size_t)row * DM : srcc + (size_t)(row - MX) * DM;
                float* d = isx ? dstx + (size_t)row * DM : dstc + (size_t)(row - MX) * DM;
                float ss = 0.f;
#pragma unroll
                for (int bj = 0; bj < 2; ++bj)
#pragma unroll
                    for (int n = 0; n < 2; ++n) { const int off = col0 + bj * 128 + n * 16;
                        const f32x4 xn = *(const GAS f32x4*)(s + off) + gv[bj][n] * acc[ai][bj][m][n];
                        *(GAS f32x4*)(d + off) = xn;
                        if (donorm) { ss += (xn[0] * xn[0] + xn[1] * xn[1]) + (xn[2] * xn[2] + xn[3] * xn[3]); st4bf(xg + (size_t)row * DM + off, xn * gp[bj][n]); } }
                if (donorm) { ss += __shfl_xor(ss, 16); ss += __shfl_xor(ss, 32); if (fq == 0) atomicAdd(ssq_out + row, ss); }
            }
    }
};

DI void transpose_item(const float* W, int K, int N, bf16* WT, const float* kscale, LAS float* scr, int item, int lane) {
    const int nblk = N / 32, kb = item / nblk, nb = item % nblk, k0 = 64 * kb, n0 = 32 * nb;
#pragma unroll 16
    for (int i = 0; i < 32; ++i) { const int kk = 2 * i + (lane >> 5); float w = W[(size_t)(k0 + kk) * N + n0 + (lane & 31)]; if (kscale) w *= kscale[k0 + kk]; scr[kk * 33 + (lane & 31)] = w; }
    LDS_WAIT();
    const int c = lane & 7;
#pragma unroll
    for (int j = 0; j < 4; ++j) { const int n = (lane >> 3) + 8 * j; const LAS float* s = scr + (8 * c) * 33 + n;
        u32x4 o; o.x = cvtpk(s[0 * 33], s[1 * 33]); o.y = cvtpk(s[2 * 33], s[3 * 33]); o.z = cvtpk(s[4 * 33], s[5 * 33]); o.w = cvtpk(s[6 * 33], s[7 * 33]);
        *(u32x4*)(WT + (size_t)(n0 + n) * K + k0 + 8 * c) = o; }
    LDS_WAIT();
}

DI void gemv9_item(const float* W, int ldw, int nvalid, int n0, const LAS float* sl, LAS float* red, const float* addb, float* out, int ldo, const int tid) {
    const int col = tid & 63, kg = tid >> 6, n = n0 + col;
    float acc[9];
#pragma unroll
    for (int mi = 0; mi < 9; ++mi) acc[mi] = 0.f;
    if (n < nvalid) {
        const float* w = W + (size_t)(kg * 128) * ldw + n;
#pragma unroll 16
        for (int k = 0; k < 128; ++k) { const float wv = w[(size_t)k * ldw];
#pragma unroll
            for (int mi = 0; mi < 9; ++mi) acc[mi] += sl[mi * 1024 + kg * 128 + k] * wv; }
    }
#pragma unroll
    for (int mi = 0; mi < 9; ++mi) red[(kg * 9 + mi) * 64 + col] = acc[mi];
    __syncthreads();
    for (int o = tid; o < 576; o += NTHR) { const int mi = o >> 6, cq = o & 63; float sacc = (addb && n0 + cq < nvalid) ? addb[n0 + cq] : 0.f;
#pragma unroll
        for (int g = 0; g < 8; ++g) sacc += red[(g * 9 + mi) * 64 + cq];
        out[(size_t)mi * ldo + n0 + cq] = sacc; }
    __syncthreads();
}

struct Args { const float* in[19]; float* out; unsigned char* ws; int ph_lo, ph_hi; };

DI void prologue(const Args& a, LAS unsigned char* lds, const int tid) {
    const int lane = tid & 63, wave = __builtin_amdgcn_readfirstlane(tid >> 6);
    int G = gridDim.x; asm volatile("" : "+s"(G));
    const int bx = blockIdx.x;
    unsigned char* ws = a.ws;
    {
        LAS float* sl = (LAS float*)lds;
        LAS float* red = (LAS float*)(lds + 36864);
        const float* c = a.in[1]; const float* cc = a.in[3]; const float* w_ada = a.in[4]; const float* b_ada = a.in[5];
        float* mods = (float*)(ws + WS_MODS);
        for (int idx = tid; idx < 9 * 1024; idx += NTHR) { const int mi = idx >> 10, k = idx & 1023; const float v = mi < 8 ? c[mi * 1024 + k] : cc[k]; sl[idx] = v / (1.0f + expf(-v)); }
        __syncthreads();
        for (int item = bx; item < DEPTH * 96; item += G) {
            const int l = item / 96, n0 = (item % 96) * 64;
            gemv9_item(w_ada + (size_t)l * 1024 * 6144, 6144, 6144, n0, sl, red, b_ada + l * 6144, mods + (size_t)l * 9 * 6144, 6144, tid);
        }
    }
    {
        const int gid = bx * NTHR + tid, NG = G * NTHR;
        float* tabA = (float*)(ws + WS_TAB); float* tabC = tabA + 2048;
        if (gid < 1024) { const int pos = gid >> 4, i = gid & 15; const float fr = exp2f(-(float)i * (1.0f / 16.0f) * 13.287712379549449f); const float rev = ((float)pos * fr) * 0.15915494309189535f;
            tabA[pos * 32 + i] = __builtin_amdgcn_cosf(rev); tabA[pos * 32 + 16 + i] = __builtin_amdgcn_sinf(rev); }
        else if (gid < 1536) { const int g = gid - 1024, pos = g >> 3, i = g & 7; const float fr = exp2f(-(float)i * (1.0f / 8.0f) * 13.287712379549449f); const float rev = ((float)pos * fr) * 0.15915494309189535f;
            tabC[pos * 16 + i] = __builtin_amdgcn_cosf(rev); tabC[pos * 16 + 8 + i] = __builtin_amdgcn_sinf(rev); }
        float* ssq = (float*)(ws + WS_SSQ);
        for (int i = gid; i < DEPTH * 2 * MT; i += NG) ssq[i] = 0.f;
        float* ssqx = (float*)(ws + WS_SSQX);
        for (int i = gid; i < DEPTH * 2 * MT; i += NG) ssqx[i] = 0.f;
        const u32x4 z = {0u, 0u, 0u, 0u};
        for (int i = gid; i < DEPTH * 12288; i += NG) { const int l = i / 12288, r = i % 12288; ((u32x4*)(ws + WS_W + l * WL_STRIDE + WL_IN + (size_t)INW * 1024 * 2))[r] = z; }
        for (int i = gid; i < DEPTH * 4096; i += NG) { const int l = i / 4096, r = i % 4096; ((u32x4*)(ws + WS_W + l * WL_STRIDE + WL_UQ + (size_t)384 * 256 * 2))[r] = z; }
    }
    {
        LAS float* scr = (LAS float*)(lds + wave * 16384);
        const int gw = bx * 8 + wave, NGW = G * 8;
        constexpr int I_IN = 16 * 61, I_OUT = 16 * 32, I_W1 = 16 * 128, I_W2 = 64 * 32, I_UQ = 4 * 12, I_UKV = 2 * 16, I_L = I_IN + I_OUT + I_W1 + I_W2 + I_UQ + I_UKV;
        for (int it = gw; it < DEPTH * I_L; it += NGW) {
            const int l = it / I_L; int r = it % I_L; unsigned char* wb = ws + WS_W + l * WL_STRIDE;
            if (r < I_IN) { transpose_item(a.in[8] + (size_t)l * 1024 * INW, 1024, INW, (bf16*)(wb + WL_IN), nullptr, scr, r, lane); continue; } r -= I_IN;
            if (r < I_OUT) { transpose_item(a.in[15] + (size_t)l * 1024 * 1024, 1024, 1024, (bf16*)(wb + WL_OUT), nullptr, scr, r, lane); continue; } r -= I_OUT;
            if (r < I_W1) { transpose_item(a.in[16] + (size_t)l * 1024 * 4096, 1024, 4096, (bf16*)(wb + WL_W1), nullptr, scr, r, lane); continue; } r -= I_W1;
            if (r < I_W2) { transpose_item(a.in[17] + (size_t)l * 4096 * 1024, 4096, 1024, (bf16*)(wb + WL_W2), nullptr, scr, r, lane); continue; } r -= I_W2;
            if (r < I_UQ) { transpose_item(a.in[12] + (size_t)l * 256 * 384, 256, 384, (bf16*)(wb + WL_UQ), a.in[11] + l * 256, scr, r, lane); continue; } r -= I_UQ;
            transpose_item(a.in[14] + (size_t)l * 128 * 512, 128, 512, (bf16*)(wb + WL_UKV), a.in[13] + l * 128, scr, r, lane);
        }
    }
}

DI void phase1(const Args& a, LAS unsigned char* lds, const int tid) {
    unsigned char* ws = a.ws;
    int G = gridDim.x; asm volatile("" : "+s"(G));
    const int bx = blockIdx.x;
    const float* mods = (const float*)(ws + WS_MODS);
    {
        LAS float* sl = (LAS float*)lds; LAS float* red = (LAS float*)(lds + 36864);
        float* bias1 = (float*)(ws + WS_BIAS1); float* bias4 = (float*)(ws + WS_BIAS4);
        for (int item = bx; item < DEPTH * 96; item += G) {
            const int l = item / 96, r = item % 96, which = r < 32 ? 0 : 1, tile = which ? r - 32 : r;
            const float* mv = mods + (size_t)l * 9 * 6144 + (which ? 3 : 0) * 1024;
            for (int idx = tid; idx < 9 * 1024; idx += NTHR) sl[idx] = mv[(size_t)(idx >> 10) * 6144 + (idx & 1023)];
            __syncthreads();
            if (!which) gemv9_item(a.in[8] + (size_t)l * 1024 * INW, INW, INW, tile * 64, sl, red, nullptr, bias1 + (size_t)l * 9 * 2048, 2048, tid);
            else gemv9_item(a.in[16] + (size_t)l * 1024 * DFF, DFF, DFF, tile * 64, sl, red, nullptr, bias4 + (size_t)l * 9 * 4096, 4096, tid);
        }
    }
    {
        const int lane = tid & 63, gw = bx * 8 + (tid >> 6), NGW = G * 8;
        bf16* Hn = (bf16*)(ws + WS_HN); float* ssqx = (float*)(ws + WS_SSQX); const float* g = a.in[6];
        for (int row = gw; row < MT; row += NGW) {
            const float* src = row < MX ? a.in[0] + (size_t)row * DM : a.in[2] + (size_t)(row - MX) * DM;
            const int mi = row < MX ? (row >> 12) : 8;
            const f32x4* xr = (const f32x4*)src + lane;
            f32x4 v[4]; float s = 0.f;
#pragma unroll
            for (int j = 0; j < 4; ++j) { v[j] = xr[64 * j]; s += (v[j][0] * v[j][0] + v[j][1] * v[j][1]) + (v[j][2] * v[j][2] + v[j][3] * v[j][3]); }
            s = wave_sum(s);
            if (lane == 0) ssqx[row] = s;
            const float* mrow = mods + (size_t)mi * 6144 + 1024;
#pragma unroll
            for (int j = 0; j < 4; ++j) { const int col = 256 * j + 4 * lane;
                const f32x4 gg = *(const f32x4*)(g + col), sc = *(const f32x4*)(mrow + col);
                st4bf(Hn + (size_t)row * DM + col, v[j] * (gg * (sc + 1.0f))); }
        }
    }
}
DI void final_norm_phase(float* x, const float* g, const int tid) {
    const int lane = tid & 63, gw = blockIdx.x * 8 + (tid >> 6), NGW = gridDim.x * 8;
    for (int row = gw; row < MX; row += NGW) {
        f32x4* xr = (f32x4*)(x + (size_t)row * DM) + lane;
        f32x4 v[4]; float s = 0.f;
#pragma unroll
        for (int j = 0; j < 4; ++j) { v[j] = xr[64 * j]; s += (v[j][0] * v[j][0] + v[j][1] * v[j][1]) + (v[j][2] * v[j][2] + v[j][3] * v[j][3]); }
        const float r = rsqrtf(wave_sum(s) * (1.0f / DM) + EPSN);
#pragma unroll
        for (int j = 0; j < 4; ++j) { const f32x4 gg = *(const f32x4*)(g + 256 * j + 4 * lane); xr[64 * j] = v[j] * r * gg; }
    }
}

struct AttnP { const bf16 *proj, *qm, *kvm, *krr; bf16* mix; const float* sink; const float* rpb; };
constexpr int A_VS = 144, A_KB = 64 * 208, A_VB = 64 * A_VS, L_K = 0, L_V = 2 * A_KB, L_B = L_V + 2 * A_VB;

template <int TYPE> DI int key_row(int t, int j, int b, int nblk, int kr0, int kc0) {
    if (t < 4) return MX + b * 256 + t * 64 + j;
    const int tt = t - 4;
    if (TYPE == 0) return b * 4096 + (nblk - 1) * 128 + tt * 64 + j;
    if (TYPE == 1) { const int tr = tt / 3, tc = tt - 3 * tr; return b * 4096 + (kr0 + 4 * tr + (j >> 4)) * 64 + kc0 + 16 * tc + (j & 15); }
    return b * 4096 + tt * 64 + j;
}

constexpr float ATHR = 6.0f;
template <int TYPE> struct AttnCtx { int t_qi, t_h, kr0, kc0, qr, qc, wr_, wc_; };

template <int TYPE, int NKS, int KSTR> DI void at_mfma_block(f32x16& p0, f32x16& p1, f32x16& o0, f32x16& o1, const bf16x8 (&qf)[NKS], const bf16x8 (&pf)[4], float m_,
                                                             const LAS unsigned char* kb0, const LAS unsigned char* vb, bool do_s, bool do_pv) {
    if (do_s) {
        const float nm = -m_;
#pragma unroll
        for (int i = 0; i < 16; ++i) { p0[i] = nm; p1[i] = nm; }
#pragma unroll
        for (int ks = 0; ks < NKS; ++ks) {
            const bf16x8 a0 = *(const LAS bf16x8*)(kb0 + ks * 32), a1 = *(const LAS bf16x8*)(kb0 + 32 * KSTR + ks * 32);
            p0 = __builtin_amdgcn_mfma_f32_32x32x16_bf16(a0, qf[ks], p0, 0, 0, 0);
            p1 = __builtin_amdgcn_mfma_f32_32x32x16_bf16(a1, qf[ks], p1, 0, 0, 0);
            if (ks & 1) asm volatile("" ::: "memory");
        }
    }
    if (do_pv) {
#pragma unroll
        for (int s = 0; s < 4; ++s) {
#pragma unroll
            for (int c = 0; c < 2; ++c) {
                const s16x4 lo = __builtin_bit_cast(s16x4, __builtin_amdgcn_ds_read_tr16_b64_v4i16((LAS s16x4*)(vb + (16 * s) * A_VS + c * 64)));
                const s16x4 hi = __builtin_bit_cast(s16x4, __builtin_amdgcn_ds_read_tr16_b64_v4i16((LAS s16x4*)(vb + (16 * s + 8) * A_VS + c * 64)));
                const bf16x8 vf = __builtin_shufflevector(lo, hi, 0, 1, 2, 3, 4, 5, 6, 7);
                if (c == 0) o0 = __builtin_amdgcn_mfma_f32_32x32x16_bf16(vf, pf[s], o0, 0, 0, 0);
                else o1 = __builtin_amdgcn_mfma_f32_32x32x16_bf16(vf, pf[s], o1, 0, 0, 0);
            }
            asm volatile("" ::: "memory");
        }
    }
}

template <int TYPE> DI void at_valu_block(f32x16& p0, f32x16& p1, f32x16& o0, f32x16& o1, bf16x8 (&pf)[4], float& m_, float& l_, int t, bool first,
                                          int qi, int h, int kr0, int kc0, int qr, int qc, int wr_, int wc_, const LAS float* lbias) {
    if (t >= 4) {
        if (TYPE == 0) {
            const int d0 = 64 * (t - 4) - qi + 4 * h;
#pragma unroll
            for (int i = 0; i < 16; ++i) { const int e = d0 + (i & 3) + 8 * (i >> 2);
                if ((unsigned)e > 256u) p0[i] = -1e30f;
                if ((unsigned)(e + 32) > 256u) p1[i] = -1e30f; }
        } else if (TYPE == 1) {
            const int tt = t - 4, tr = tt / 3, tc = tt - 3 * tr;
            const int krb = kr0 + 4 * tr, kcb = kc0 + 16 * tc + 4 * h;
#pragma unroll
            for (int i = 0; i < 16; ++i) {
                const int kc = kcb + (i & 3) + 8 * ((i >> 2) & 1);
                const bool cv = (unsigned)(kc - wc_) < 16u;
                const int ci = kc - qc + 15;
                { const int kr = krb + (i >> 3); const bool v = cv && ((unsigned)(kr - wr_) < 8u); const int idx = v ? (kr - qr + 7) * 31 + ci : 0; const float bv = lbias[idx]; p0[i] = v ? p0[i] + bv : -1e30f; }
                { const int kr = krb + 2 + (i >> 3); const bool v = cv && ((unsigned)(kr - wr_) < 8u); const int idx = v ? (kr - qr + 7) * 31 + ci : 0; const float bv = lbias[idx]; p1[i] = v ? p1[i] + bv : -1e30f; }
            }
        }
    }
    asm volatile("s_nop 15\n\ts_nop 7" : "+v"(p0), "+v"(p1));
    float mxa = max3f(p0[0], p0[1], p1[0]), mxb = max3f(p0[2], p0[3], p1[1]); mxa = max3f(mxa, p1[2], p1[3]);
#pragma unroll
    for (int i = 4; i < 16; i += 4) { mxa = max3f(mxa, p0[i], p0[i + 1]); mxb = max3f(mxb, p0[i + 2], p0[i + 3]); mxa = max3f(mxa, p1[i], p1[i + 1]); mxb = max3f(mxb, p1[i + 2], p1[i + 3]); }
    float mx = max3f(mxa, mxb, mxb);
    mx = max3f(mx, __shfl_xor(mx, 32), mx);
    if (first || __any(mx > ATHR)) {
        const float dl = (TYPE != 0 && first) ? mx : fmaxf(mx, 0.f);
        const float alpha = fexp2(-dl);
        m_ += dl; l_ *= alpha;
#pragma unroll
        for (int i = 0; i < 16; ++i) { p0[i] -= dl; p1[i] -= dl; o0[i] *= alpha; o1[i] *= alpha; }
    }
    float ls = 0.f;
#pragma unroll
    for (int i = 0; i < 16; ++i) { p0[i] = fexp2(p0[i]); p1[i] = fexp2(p1[i]); ls += p0[i] + p1[i]; }
    l_ += ls;
#pragma unroll
    for (int s = 0; s < 4; ++s) {
        u32x4 pw;
        if (s < 2) { pw.x = cvtpk(p0[8 * s + 0], p0[8 * s + 1]); pw.y = cvtpk(p0[8 * s + 2], p0[8 * s + 3]); pw.z = cvtpk(p0[8 * s + 4], p0[8 * s + 5]); pw.w = cvtpk(p0[8 * s + 6], p0[8 * s + 7]); }
        else { const int s2 = s - 2; pw.x = cvtpk(p1[8 * s2 + 0], p1[8 * s2 + 1]); pw.y = cvtpk(p1[8 * s2 + 2], p1[8 * s2 + 3]); pw.z = cvtpk(p1[8 * s2 + 4], p1[8 * s2 + 5]); pw.w = cvtpk(p1[8 * s2 + 6], p1[8 * s2 + 7]); }
        pf[s] = __builtin_bit_cast(bf16x8, pw);
    }
}

template <int TYPE> DI void attn_unit(const AttnP& P, int uid, bool isctx, LAS unsigned char* lds, const int tid) {
    constexpr int DQK = TYPE == 2 ? 96 : 64, NKS = DQK / 16, KSTR = DQK * 2 + 16;
    const int lane = tid & 63, w = __builtin_amdgcn_readfirstlane(tid >> 6), r = lane & 31, h = lane >> 5;
    int b, hd, kvh = 0, qrow, nblk = 0, kr0 = 0, kc0 = 0, qr = 0, qc = 0, tb0 = 4, tb1 = 4;
    if (TYPE == 0) {
        int gp;
        if (!isctx) { b = uid >> 7; kvh = (uid >> 6) & 1; nblk = (uid >> 1) & 31; gp = uid & 1; qrow = b * 4096 + nblk * 128 + (w & 3) * 32 + r; tb0 = nblk == 0 ? 6 : 4; tb1 = nblk == 31 ? 8 : 10; }
        else { b = uid >> 3; kvh = (uid >> 2) & 1; gp = (uid >> 1) & 1; nblk = uid & 1; qrow = MX + b * 256 + nblk * 128 + (w & 3) * 32 + r; }
        hd = kvh * 4 + gp * 2 + (w >> 2);
    } else if (TYPE == 1) {
        if (!isctx) { b = uid >> 6; hd = (uid >> 4) & 3; const int ib = (uid >> 1) & 7, cp = uid & 1;
            qr = 8 * ib + 2 * (w & 3) + (r >> 4); qc = 16 * (2 * cp + (w >> 2)) + (r & 15); qrow = b * 4096 + qr * 64 + qc;
            kr0 = min(max(8 * ib - 4, 0), 48); kc0 = 16 * cp; tb1 = 16; }
        else { b = uid >> 2; hd = uid & 3; qrow = MX + b * 256 + w * 32 + r; }
    } else {
        if (!isctx) { b = uid >> 6; hd = (uid >> 4) & 3; qrow = b * 4096 + (uid & 15) * 256 + w * 32 + r; tb1 = 68; }
        else { b = uid >> 2; hd = uid & 3; qrow = MX + b * 256 + w * 32 + r; }
    }
    const int NTA = 4 + (tb1 - tb0);
    const bf16* qp; int ocol;
    if (TYPE == 0) { qp = P.proj + (size_t)qrow * PJS + hd * 64; ocol = hd * 64; }
    else if (TYPE == 1) { qp = P.proj + (size_t)qrow * PJS + 768 + hd * 64; ocol = 512 + hd * 64; }
    else { qp = P.qm + (size_t)qrow * 384 + hd * 96; ocol = 768 + hd * 64; }
    bf16x8 qf[NKS];
#pragma unroll
    for (int ks = 0; ks < NKS; ++ks) qf[ks] = *(const GAS bf16x8*)(qp + 16 * ks + 8 * h);

    float m_ = 0.f, l_ = 0.f;
    if (TYPE == 0) { m_ = P.sink[hd] * LOG2E; l_ = (h == 0) ? 1.f : 0.f; }
    f32x16 o0, o1, p0, p1;
#pragma unroll
    for (int i = 0; i < 16; ++i) { o0[i] = 0.f; o1[i] = 0.f; p0[i] = 0.f; p1[i] = 0.f; }
    bf16x8 pf[4];
#pragma unroll
    for (int s = 0; s < 4; ++s) pf[s] = (bf16x8){0, 0, 0, 0, 0, 0, 0, 0};

    u32x4 kreg, vreg, rreg = {0u, 0u, 0u, 0u};
    const int sj = tid >> 3, sc = tid & 7;
#define AT_TILE(it_) ((it_) < 4 ? (it_) : (it_) - 4 + tb0)
#define AT_LOADK(t) do { const int kr_ = key_row<TYPE>((t), sj, b, nblk, kr0, kc0); \
        if (TYPE == 2) { kreg = *(const GAS u32x4*)(P.kvm + (size_t)kr_ * 512 + hd * 128 + sc * 8); \
            if (tid < 256) { const int kr2_ = key_row<TYPE>((t), tid >> 2, b, nblk, kr0, kc0); rreg = *(const GAS u32x4*)(P.krr + (size_t)kr2_ * 32 + (tid & 3) * 8); } } \
        else kreg = *(const GAS u32x4*)(P.proj + (size_t)kr_ * PJS + (TYPE == 0 ? 512 + kvh * 64 : 1024 + hd * 64) + sc * 8); } while (0)
#define AT_LOADV(t) do { const int kr_ = key_row<TYPE>((t), sj, b, nblk, kr0, kc0); \
        if (TYPE == 2) vreg = *(const GAS u32x4*)(P.kvm + (size_t)kr_ * 512 + hd * 128 + 64 + sc * 8); \
        else vreg = *(const GAS u32x4*)(P.proj + (size_t)kr_ * PJS + (TYPE == 0 ? 640 + kvh * 64 : 1280 + hd * 64) + sc * 8); } while (0)
#define AT_STOREK(bi) do { *(LAS u32x4*)(lds + L_K + (bi) * A_KB + sj * KSTR + sc * 16) = kreg; \
        if (TYPE == 2) { if (tid < 256) *(LAS u32x4*)(lds + L_K + (bi) * A_KB + (tid >> 2) * KSTR + 128 + (tid & 3) * 16) = rreg; } } while (0)
#define AT_STOREV(bi) do { *(LAS u32x4*)(lds + L_V + (bi) * A_VB + sj * A_VS + sc * 16) = vreg; } while (0)
    AT_LOADK(0);
    __syncthreads();
    LAS float* lbias = (LAS float*)(lds + L_B);
    if (TYPE == 1 && !isctx) { if (tid < 465) lbias[tid] = ((const GAS float*)P.rpb)[hd * 465 + tid] * LOG2E; }
    AT_STOREK(0);
    AT_LOADK(AT_TILE(1)); AT_LOADV(0);
    __syncthreads();
    const int q4 = (lane & 15) >> 2, p4 = lane & 3, blk = (lane >> 4) & 1;
    const int voff = L_V + (4 * h + q4) * A_VS + (16 * blk + 4 * p4) * 2;
    const int koff = L_K + r * KSTR + 16 * h;
    const int wr_ = min(max(qr - 4, 0), 56), wc_ = min(max(qc - 8, 0), 48);
    const int qi = (w & 3) * 32 + r;
    const bool grp1 = (w >> 2) != 0;

#define AT_STAGE(it) do { if ((it) + 1 < NTA) AT_STOREK(((it) + 1) & 1); AT_STOREV((it) & 1); \
        if ((it) + 2 < NTA) AT_LOADK(AT_TILE((it) + 2)); if ((it) + 1 < NTA) AT_LOADV(AT_TILE((it) + 1)); __syncthreads(); } while (0)
    if (!grp1) {
        for (int it = 0; it < NTA; ++it) {
            const int t = AT_TILE(it);
            const LAS unsigned char* kb0 = lds + (it & 1) * A_KB + koff;
            const LAS unsigned char* vb = lds + ((it + 1) & 1) * A_VB + voff;
            at_mfma_block<TYPE, NKS, KSTR>(p0, p1, o0, o1, qf, pf, m_, kb0, vb, true, it > 0);
            at_valu_block<TYPE>(p0, p1, o0, o1, pf, m_, l_, t, it == 0, qi, h, kr0, kc0, qr, qc, wr_, wc_, lbias);
            AT_STAGE(it);
        }
        const LAS unsigned char* vb = lds + ((NTA - 1) & 1) * A_VB + voff;
        at_mfma_block<TYPE, NKS, KSTR>(p0, p1, o0, o1, qf, pf, m_, vb, vb, false, true);
    } else {
        for (int it = 0; it < NTA; ++it) {
            const int tp = AT_TILE(it - 1);
            const LAS unsigned char* kb0 = lds + (it & 1) * A_KB + koff;
            const LAS unsigned char* vb = lds + ((it + 1) & 1) * A_VB + voff;
            if (it > 0) at_valu_block<TYPE>(p0, p1, o0, o1, pf, m_, l_, tp, it == 1, qi, h, kr0, kc0, qr, qc, wr_, wc_, lbias);
            at_mfma_block<TYPE, NKS, KSTR>(p0, p1, o0, o1, qf, pf, m_, kb0, vb, true, it > 0);
            AT_STAGE(it);
        }
        const LAS unsigned char* vb = lds + ((NTA - 1) & 1) * A_VB + voff;
        at_valu_block<TYPE>(p0, p1, o0, o1, pf, m_, l_, AT_TILE(NTA - 1), false, qi, h, kr0, kc0, qr, qc, wr_, wc_, lbias);
        at_mfma_block<TYPE, NKS, KSTR>(p0, p1, o0, o1, qf, pf, m_, vb, vb, false, true);
    }
#undef AT_STAGE
#undef AT_LOADK
#undef AT_LOADV
#undef AT_STOREK
#undef AT_STOREV
#undef AT_TILE
    const float lt = l_ + __shfl_xor(l_, 32), inv = 1.0f / lt;
    bf16* op = P.mix + (size_t)qrow * DM + ocol + 4 * h;
#pragma unroll
    for (int g = 0; g < 4; ++g) {
        const f32x4 v0 = {o0[4 * g] * inv, o0[4 * g + 1] * inv, o0[4 * g + 2] * inv, o0[4 * g + 3] * inv};
        const f32x4 v1 = {o1[4 * g] * inv, o1[4 * g + 1] * inv, o1[4 * g + 2] * inv, o1[4 * g + 3] * inv};
        st4bf(op + 8 * g, v0); st4bf(op + 32 + 8 * g, v1);
    }
}

DI void attn_phase(const AttnP& P, bool last, LAS unsigned char* lds, const int tid_in) {
    const int G = gridDim.x, bx = blockIdx.x;
    const int vcu = (G % 8 == 0) ? (bx % 8) * (G / 8) + bx / 8 : bx;
    const int NU = 2048 + (last ? 0 : 128);
    for (int u = vcu; u < NU; u += G) {
        int tid = tid_in; asm volatile("" : "+v"(tid));
        if (u < 512) attn_unit<2>(P, u, false, lds, tid);
        else if (u < 1024) attn_unit<1>(P, u - 512, false, lds, tid);
        else if (u < 2048) attn_unit<0>(P, u - 1024, false, lds, tid);
        else if (u < 2080) attn_unit<2>(P, u - 2048, true, lds, tid);
        else if (u < 2112) attn_unit<1>(P, u - 2080, true, lds, tid);
        else attn_unit<0>(P, u - 2112, true, lds, tid);
    }
}

#define XB_TMO      128
#define XB_XCNT(j)  (256  + 64 * (j))
#define XB_XSUB(j)  (1280 + 64 * (j))
#define XB_XGEN(j)  (2304 + 64 * (j))
#define XB_TOP      3328
#define XB_TOPGEN   3392
#define XCD_BAR_WORDS 3456
#define XB_SPIN_CAP (1u << 18)

__device__ __forceinline__ unsigned xb_ld(unsigned* p)              { return __hip_atomic_load(p, __ATOMIC_RELAXED, __HIP_MEMORY_SCOPE_AGENT); }
__device__ __forceinline__ unsigned xb_add(unsigned* p, unsigned v) { return __hip_atomic_fetch_add(p, v, __ATOMIC_RELAXED, __HIP_MEMORY_SCOPE_AGENT); }
__device__ __forceinline__ unsigned xb_xcc_id() { return (unsigned)__builtin_amdgcn_s_getreg((3 << 11) | 20) & 0xFu; }
#define XB_SPIN(cond, bar) do { unsigned _sp = 0; while (cond) { __builtin_amdgcn_s_sleep(1); \
    if ((++_sp & 255u) == 0u) { if (xb_ld(&(bar)[XB_TMO])) break; if (_sp > XB_SPIN_CAP) { atomicAdd(&(bar)[XB_TMO], 1u); break; } } } } while (0)

struct XcdBarrier {
    unsigned* bar; unsigned x;
    volatile LAS unsigned* st;
};

__device__ __forceinline__ XcdBarrier xcd_barrier_post(unsigned* bar, volatile LAS unsigned* st) {
    XcdBarrier b; b.bar = bar; b.x = xb_xcc_id(); b.st = st;
    if (threadIdx.x == 0) (void)xb_add(&bar[XB_XCNT(b.x)], 1u);
    return b;
}
__device__ __forceinline__ void xcd_barrier_complete(unsigned* bar, unsigned x, unsigned& nloc, unsigned& nx) {
    const unsigned G = gridDim.x * gridDim.y * gridDim.z;
    unsigned sum, cnt, mine, sp = 0u;
    for (;;) {
        sum = 0u; cnt = 0u; mine = 0u;
#pragma unroll
        for (unsigned j = 0; j < 16; ++j) { const unsigned c = xb_ld(&bar[XB_XCNT(j)]); sum += c; cnt += (c > 0u) ? 1u : 0u; mine = (j == x) ? c : mine; }
        if (sum == G) break;
        __builtin_amdgcn_s_sleep(1);
        if ((++sp & 255u) == 0u) { if (xb_ld(&bar[XB_TMO])) break; if (sp > XB_SPIN_CAP) { atomicAdd(&bar[XB_TMO], 1u); break; } }
    }
    nloc = mine > 0u ? mine : 1u; nx = cnt > 0u ? cnt : 1u;
}

__device__ __forceinline__ void xcd_barrier(const XcdBarrier& b) {
    asm volatile("s_waitcnt vmcnt(0)" ::: "memory");
    __syncthreads();
    if (threadIdx.x == 0) {
        unsigned* bar = b.bar;
        __builtin_amdgcn_s_waitcnt(0);
        unsigned nloc = b.st[0], nx = b.st[1];
        if (nloc == 0u) { xcd_barrier_complete(bar, b.x, nloc, nx); b.st[0] = nloc; b.st[1] = nx; }
        const unsigned old = xb_add(&bar[XB_XSUB(b.x)], 1u);
        const unsigned gen = old / nloc;
        if (old + 1u == (gen + 1u) * nloc) {
            __builtin_amdgcn_fence(__ATOMIC_RELEASE, "agent");
            asm volatile("s_waitcnt vmcnt(0)" ::: "memory");
            const unsigned og = xb_add(&bar[XB_TOP], 1u);
            const unsigned tg = og / nx;
            if (og + 1u == (tg + 1u) * nx) xb_add(&bar[XB_TOPGEN], 1u);
            else XB_SPIN(xb_ld(&bar[XB_TOPGEN]) == tg, bar);
            __builtin_amdgcn_fence(__ATOMIC_ACQUIRE, "agent");
            xb_add(&bar[XB_XGEN(b.x)], 1u);
            asm volatile("s_waitcnt vmcnt(0)" ::: "memory");
        } else {
            XB_SPIN(xb_ld(&bar[XB_XGEN(b.x)]) == gen, bar);
            __builtin_amdgcn_fence(__ATOMIC_ACQUIRE, "agent");
            asm volatile("s_waitcnt vmcnt(0)" ::: "memory");
        }
    }
    __syncthreads();
}

constexpr int NPH = 3 + 6 * DEPTH;
__global__ void __launch_bounds__(NTHR) mk_fwd(Args a) {
    extern __shared__ __attribute__((aligned(16))) unsigned char lds_raw[];
    LAS unsigned char* lds = (LAS unsigned char*)lds_raw;
    const int G = gridDim.x, bx = blockIdx.x;
    const int ph_lo = a.ph_lo, ph_hi = a.ph_hi;
    volatile LAS unsigned* bst = (volatile LAS unsigned*)(lds + 131072);
    if (threadIdx.x < 2) bst[threadIdx.x] = 0u;
    __syncthreads();
    XcdBarrier xbar; xbar.bar = (unsigned*)(a.ws + WS_BAR); xbar.x = 0; xbar.st = bst;
    if (!MK_PER_PHASE) xbar = xcd_barrier_post((unsigned*)(a.ws + WS_BAR), bst);

    for (int ph = ph_lo; ph < ph_hi;) {
        int tid = threadIdx.x; asm volatile("" : "+v"(tid));
        unsigned char* ws = a.ws; asm volatile("" : "+s"(ws));
        float* mods = (float*)(ws + WS_MODS);
        const float* tabA = (const float*)(ws + WS_TAB); const float* tabC = tabA + 2048;
        float* Xc = (float*)(ws + WS_XC);
        bf16* Hn = (bf16*)(ws + WS_HN); bf16* H1 = (bf16*)(ws + WS_H1);
        bf16* proj = (bf16*)(ws + WS_PROJ); bf16* cqb = (bf16*)(ws + WS_CQ); bf16* ckvb = (bf16*)(ws + WS_CKV);
        bf16* qm = (bf16*)(ws + WS_QM); bf16* kvm = (bf16*)(ws + WS_KVM); bf16* krr = (bf16*)(ws + WS_KRR); bf16* mix = (bf16*)(ws + WS_MIX);

        if (ph == 0) prologue(a, lds, tid);
        else if (ph == 1) phase1(a, lds, tid);
        else if (ph == NPH - 1) final_norm_phase(a.out, a.in[18], tid);
        else {
            const int l = (ph - 2) / 6, s = (ph - 2) - 6 * l; const bool last = (l == DEPTH - 1);
            unsigned char* wb = ws + WS_W + (size_t)l * WL_STRIDE;
            const float* mods_l = mods + (size_t)l * 9 * 6144;
            float* ssq_q = (float*)(ws + WS_SSQ) + (size_t)l * 2 * MT; float* ssq_kv = ssq_q + MT;
            float* ssqx1 = (float*)(ws + WS_SSQX) + (size_t)l * 2 * MT; float* ssqx2 = ssqx1 + MT;
            const float* xsrc = (l == 0) ? a.in[0] : a.out;
            const float* csrc = (l == 0) ? a.in[2] : Xc;
            if (s == 0) {
                pg8::Gemm g{Hn, (const bf16*)(wb + WL_IN), MT, 2048, DM}; pg8::StaticOrder S; S.init(MT, 2048, G, bx);
                EpiInProj E{proj, cqb, ckvb, krr, ssq_q, ssq_kv, tabA, tabC, ssqx1, (const float*)(ws + WS_BIAS1) + (size_t)l * 9 * 2048};
                pg8::gemm_phase<EpiInProj, pg8::StaticOrder, true, true>(lds, g, S, E, tid);
            } else if (s == 1) {
                { int Kq = 256; asm volatile("" : "+s"(Kq)); pg8::Gemm g{cqb, (const bf16*)(wb + WL_UQ), MT, 512, Kq}; pg8::StaticOrder S; S.init(MT, 512, G, bx);
                  EpiUQ E{qm, ssq_q, tabC}; pg8::gemm_phase<EpiUQ, pg8::StaticOrder, true, true>(lds, g, S, E, tid); }
                { int Kk = 128; asm volatile("" : "+s"(Kk)); pg8::Gemm g{ckvb, (const bf16*)(wb + WL_UKV), MT, 512, Kk}; pg8::StaticOrder S; S.init(MT, 512, G, (bx + G / 2) % G);
                  EpiUKV E{kvm, ssq_kv}; pg8::gemm_phase<EpiUKV, pg8::StaticOrder, true, true>(lds, g, S, E, tid); }
            } else if (s == 2) {
                AttnP P{proj, qm, kvm, krr, mix, a.in[9] + l * 8, a.in[10] + l * 4 * 465};
                attn_phase(P, last, lds, tid);
            } else if (s == 3 || s == 5) {
                const int Mr = last ? MX : MT;
                const bool outp = (s == 3);
                pg8::Gemm g{outp ? mix : H1, (const bf16*)(wb + (outp ? WL_OUT : WL_W2)), Mr, DM, outp ? DM : DFF}; pg8::StaticOrder S; S.init(Mr, DM, G, bx);
                const int ln = outp ? l : l + 1;
                const float* mods_n = mods + (size_t)(ln < DEPTH ? ln : 0) * 9 * 6144;
                EpiResid E{(outp ? xsrc : a.out), (outp ? csrc : Xc), a.out, Xc, mods_l + (outp ? 2 : 5) * 1024, Hn,
                           outp ? ssqx2 : ssqx1 + (size_t)2 * MT, (outp ? a.in[7] : a.in[6]) + (ln < DEPTH ? ln : 0) * DM, mods_n + (outp ? 4 : 1) * 1024, (outp || !last) ? 1 : 0};
                pg8::gemm_phase<EpiResid, pg8::StaticOrder, true, true>(lds, g, S, E, tid);
            } else {
                const int Mr = last ? MX : MT;
                pg8::Gemm g{Hn, (const bf16*)(wb + WL_W1), Mr, DFF, DM}; pg8::StaticOrder S; S.init(Mr, DFF, G, bx);
                EpiRelu2 E{H1, ssqx2, (const float*)(ws + WS_BIAS4) + (size_t)l * 9 * 4096}; pg8::gemm_phase<EpiRelu2, pg8::StaticOrder, true, true>(lds, g, S, E, tid);
            }
        }
        ++ph;
        if (ph < ph_hi) { if (ph == 1) cg::this_grid().sync(); else xcd_barrier(xbar); }
    }
}

extern "C" void kernel_launch(void* const* d_in, const int* in_sizes, int n_in, void* d_out, int out_size, void* d_ws, size_t ws_size, hipStream_t stream) {
    static int grid = 0;
    if (grid == 0) {
        if (n_in != 19 || ws_size < WS_END) { fprintf(stderr, "kernel_launch: unexpected inputs (n_in %d, ws %zu)\n", n_in, ws_size); grid = -1; return; }
        int dev = 0, cus = 0, per_cu = 0;
        hipGetDevice(&dev); hipDeviceGetAttribute(&cus, hipDeviceAttributeMultiprocessorCount, dev);
        hipFuncSetAttribute((const void*)mk_fwd, hipFuncAttributeMaxDynamicSharedMemorySize, LDS_BYTES);
        hipOccupancyMaxActiveBlocksPerMultiprocessor(&per_cu, (const void*)mk_fwd, NTHR, LDS_BYTES);
        if (per_cu < 1) { fprintf(stderr, "kernel_launch: occupancy query says %d\n", per_cu); per_cu = 1; }
        (void)hipGetLastError();
        grid = cus * 1;
    }
    if (grid < 0) return;
    Args a{};
    for (int i = 0; i < 19; ++i) a.in[i] = (const float*)d_in[i];
    a.out = (float*)d_out; a.ws = (unsigned char*)d_ws;
#if MK_PER_PHASE
    for (int ph = 0; ph < NPH; ++ph) { a.ph_lo = ph; a.ph_hi = ph + 1; hipLaunchKernelGGL(mk_fwd, dim3(grid), dim3(NTHR), LDS_BYTES, stream, a); }
#else
    a.ph_lo = 0; a.ph_hi = NPH;
    (void)hipMemsetAsync((unsigned char*)d_ws + WS_BAR, 0, 16384, stream);
    void* args[] = {&a};
    hipError_t e = hipLaunchCooperativeKernel((const void*)mk_fwd, dim3(grid), dim3(NTHR), args, LDS_BYTES, stream);
    if (e != hipSuccess) fprintf(stderr, "cooperative launch failed: %s (grid %d)\n", hipGetErrorString(e), grid);
#endif
}
```

```cpp
#include <hip/hip_runtime.h>
#include <hip/hip_cooperative_groups.h>
#include <cstdio>
#include <cstdint>
namespace cg = cooperative_groups;
namespace pg8 {
#define PG8_LAS __attribute__((address_space(3)))
typedef unsigned short bf16_t;
typedef short bf16x8 __attribute__((ext_vector_type(8)));
typedef float f32x4 __attribute__((ext_vector_type(4)));
typedef unsigned u32x4 __attribute__((ext_vector_type(4)));
constexpr int BM = 256, BK = 64, HALF = 128, HTB = HALF * BK * 2  , STAGE_BYTES = 8 * HTB, NXCD = 8, WGM = 8;

__host__ __device__ __forceinline__ int lds_byte(int r, int c) { const int st = (r >> 4) * 2 + (c >> 5), rr = r & 15, cc = c & 31, ob = rr * 64 + cc * 2; return st * 1024 + (ob ^ (((ob >> 9) & 1) << 5)); }
__host__ __device__ __forceinline__ void stage_rc(int b, int& R, int& C) { const int st = b / 1024, sb = b % 1024, swz = sb ^ (((sb >> 9) & 1) << 5); R = (st >> 1) * 16 + swz / 64; C = (st & 1) * 32 + (swz % 64) / 2; }
__host__ __device__ __forceinline__ int perm32(int rho) { const int n = rho >> 4, i = rho & 15; return 8 * (i >> 2) + 4 * n + (i & 3); }

struct Unit { int pm, pn, kb; };
struct Gemm { const bf16_t* A; const bf16_t* Bt; int M, N, K, ld; };

struct StaticOrder {
    int nM, nN, nwg, G, c;
    __host__ __device__ void init(int M, int N, int G_, int c_) { nM = M / BM; nN = N / BM; nwg = nM * nN; G = G_; c = c_; }
    __host__ __device__ bool next(int i, Unit& u) const {
        const long L = (long)i * G + c; if (L >= nwg) return false;
        int wgid = (int)L; { const int q = nwg / NXCD, r = nwg % NXCD, xcd = wgid % NXCD, off = wgid / NXCD; wgid = (xcd < r ? xcd * (q + 1) : r * (q + 1) + (xcd - r) * q) + off; }
        const int nig = WGM * nN, gid = wgid / nig, fm = gid * WGM, gsz = (nM - fm) < WGM ? (nM - fm) : WGM;
        u.pm = fm + ((wgid % nig) % gsz); u.pn = (wgid % nig) / gsz; u.kb = 0; return true;
    }
    __device__ __forceinline__ void a_ready(const Unit&) const {}
    __device__ __forceinline__ void done(const Unit&) const {}
};

__device__ __forceinline__ unsigned cvt_pk_bf16(float lo, float hi) { unsigned r; asm volatile("v_cvt_pk_bf16_f32 %0, %1, %2" : "=v"(r) : "v"(lo), "v"(hi)); return r; }
template <class Epi, class Sched, bool ALIGN_EPI = false, bool SP2 = false>
__device__ __forceinline__ void gemm_phase(PG8_LAS unsigned char* lds, const Gemm g, const Sched& S, const Epi& E, const int tid) {
    const int wid = __builtin_amdgcn_readfirstlane(tid >> 6), lane = tid & 63, wr = wid >> 2, wc = wid & 3, fr = lane & 15, fq = lane >> 4;
    const int K = g.ld, nt = g.K / BK;
    unsigned voffA[2], voffB[2];
#pragma unroll
    for (int i = 0; i < 2; ++i) { int R, C; stage_rc(tid * 16 + i * 8192, R, C); const int Rb = Epi::PERM ? ((R & ~31) + perm32(R & 31)) : R;
        voffA[i] = (unsigned)(R * K + C) * 2u; voffB[i] = (unsigned)(Rb * K + C) * 2u; }
    const size_t kstep = (size_t)(BK * 2);
    const size_t hstep = (size_t)HALF * K * 2;
    const size_t tstep = 2 * hstep;
    const unsigned ldsw = (unsigned)wid * 1024u;
    const int aoff = lds_byte(wr * 64 + fr, fq * 8), boff = lds_byte(wc * 32 + fr, fq * 8);
#define PG8_SA(b, h) (((b) * 2 + (h)) * HTB)
#define PG8_SB(b, h) ((4 + (b) * 2 + (h)) * HTB)
#define PG8_STAGE(bufoff, gbase, voff) do { _Pragma("unroll") for (int _i = 0; _i < 2; ++_i) \
        __builtin_amdgcn_global_load_lds((const unsigned*)((const char*)(gbase) + (voff)[_i]), (PG8_LAS unsigned*)(lds + (bufoff) + ldsw + _i * 8192), 16, 0, 0); } while (0)
#define PG8_LDA(dst, b, h) do { _Pragma("unroll") for (int m = 0; m < 4; ++m) _Pragma("unroll") for (int k = 0; k < 2; ++k) dst[m][k] = *(const PG8_LAS bf16x8*)(lds + PG8_SA(b, h) + aoff + m * 2048 + k * 1024); } while (0)
#define PG8_LDB(dst, b, h) do { _Pragma("unroll") for (int n = 0; n < 2; ++n) _Pragma("unroll") for (int k = 0; k < 2; ++k) dst[n][k] = *(const PG8_LAS bf16x8*)(lds + PG8_SB(b, h) + boff + n * 2048 + k * 1024); } while (0)
#define PG8_MMA(ai, bj, At, Bt) do { __builtin_amdgcn_s_setprio(1); _Pragma("unroll") for (int m = 0; m < 4; ++m) _Pragma("unroll") for (int n = 0; n < 2; ++n) _Pragma("unroll") for (int k = 0; k < 2; ++k) \
        acc[ai][bj][m][n] = __builtin_amdgcn_mfma_f32_16x16x32_bf16(Bt[n][k], At[m][k], acc[ai][bj][m][n], 0, 0, 0); __builtin_amdgcn_s_setprio(0); } while (0)
#define PG8_WAIT_V(n) asm volatile("s_waitcnt vmcnt(" #n ")" ::: "memory")
#define PG8_WAIT_L(n) asm volatile("s_waitcnt lgkmcnt(" #n ")" ::: "memory")
#define PG8_BAR __builtin_amdgcn_s_barrier()
#define PG8_SCHED __builtin_amdgcn_sched_barrier(0)
    Unit cur, nxt; int ui = 0;
    if (!S.next(0, cur)) return;
    f32x4 acc[2][2][4][2];
#pragma unroll
    for (int a = 0; a < 2; ++a)
#pragma unroll
        for (int b = 0; b < 2; ++b)
#pragma unroll
            for (int m = 0; m < 4; ++m)
#pragma unroll
                for (int n = 0; n < 2; ++n) acc[a][b][m][n] = (f32x4){0.f, 0.f, 0.f, 0.f};
    bf16x8 At[4][2], B0[2][2], B1[2][2];
    const char* cA = (const char*)g.A + (size_t)cur.pm * tstep + cur.kb; const char* cB = (const char*)g.Bt + (size_t)cur.pn * tstep + cur.kb;
    S.a_ready(cur);
    if constexpr (SP2) {
        PG8_STAGE(PG8_SB(0, 0), cB, voffB); PG8_STAGE(PG8_SB(0, 1), cB + hstep, voffB); PG8_STAGE(PG8_SA(0, 0), cA, voffA); PG8_STAGE(PG8_SA(0, 1), cA + hstep, voffA);
        if (wr == 1) PG8_BAR;
        PG8_WAIT_V(2); PG8_BAR;
        PG8_STAGE(PG8_SB(1, 0), cB + kstep, voffB); PG8_STAGE(PG8_SA(1, 0), cA + kstep, voffA); PG8_STAGE(PG8_SB(1, 1), cB + hstep + kstep, voffB);
        PG8_WAIT_V(6); PG8_BAR;
    } else {
        PG8_STAGE(PG8_SB(0, 0), cB, voffB); PG8_STAGE(PG8_SA(0, 0), cA, voffA); PG8_STAGE(PG8_SB(0, 1), cB + hstep, voffB); PG8_STAGE(PG8_SA(0, 1), cA + hstep, voffA);
        if (wr == 1) PG8_BAR;
        PG8_WAIT_V(4); PG8_BAR;
        PG8_STAGE(PG8_SB(1, 0), cB + kstep, voffB); PG8_STAGE(PG8_SA(1, 0), cA + kstep, voffA); PG8_STAGE(PG8_SB(1, 1), cB + hstep + kstep, voffB);
        PG8_WAIT_V(6); PG8_BAR;
    }
    for (;;) {
        const bool has_next = S.next(ui + 1, nxt);
        const char* nA = has_next ? (const char*)g.A + (size_t)nxt.pm * tstep + nxt.kb : cA; const char* nB = has_next ? (const char*)g.Bt + (size_t)nxt.pn * tstep + nxt.kb : cB;
        for (int t = 0; t < nt; t += 2) {
            const bool last = (t == nt - 2);
            const char* a1 = cA + (size_t)(t + 1) * kstep;
            const char* a2 = last ? nA : cA + (size_t)(t + 2) * kstep; const char* b2 = last ? nB : cB + (size_t)(t + 2) * kstep;
            const char* a3 = a2 + kstep; const char* b3 = b2 + kstep;
            if (last && has_next) S.a_ready(nxt);
            if constexpr (SP2) {
            PG8_LDB(B0, 0, 0); PG8_LDB(B1, 0, 1); PG8_SCHED; PG8_LDA(At, 0, 0); PG8_STAGE(PG8_SA(1, 1), a1 + hstep, voffA);
            PG8_WAIT_V(8); PG8_WAIT_L(0); PG8_BAR; PG8_MMA(0, 0, At, B0); PG8_MMA(0, 1, At, B1); PG8_BAR; PG8_SCHED;
            PG8_LDA(At, 0, 1); PG8_STAGE(PG8_SB(0, 0), b2, voffB); PG8_STAGE(PG8_SB(0, 1), b2 + hstep, voffB); PG8_STAGE(PG8_SA(0, 0), a2, voffA);
            PG8_WAIT_V(8); PG8_WAIT_L(0); PG8_BAR; PG8_MMA(1, 0, At, B0); PG8_MMA(1, 1, At, B1); PG8_BAR; PG8_SCHED;
            PG8_LDB(B0, 1, 0); PG8_LDB(B1, 1, 1); PG8_SCHED; PG8_LDA(At, 1, 0); PG8_STAGE(PG8_SA(0, 1), a2 + hstep, voffA);
            PG8_WAIT_V(8); PG8_WAIT_L(0); PG8_BAR; PG8_MMA(0, 0, At, B0); PG8_MMA(0, 1, At, B1); PG8_BAR; PG8_SCHED;
            PG8_LDA(At, 1, 1); PG8_STAGE(PG8_SB(1, 0), b3, voffB); PG8_STAGE(PG8_SB(1, 1), b3 + hstep, voffB); PG8_STAGE(PG8_SA(1, 0), a3, voffA);
            PG8_WAIT_V(8); PG8_WAIT_L(0); PG8_BAR; PG8_MMA(1, 0, At, B0); PG8_MMA(1, 1, At, B1); PG8_BAR; PG8_SCHED;
            } else {
            PG8_LDB(B0, 0, 0); PG8_SCHED; PG8_LDA(At, 0, 0); PG8_STAGE(PG8_SA(1, 1), a1 + hstep, voffA);
            PG8_WAIT_L(8); PG8_BAR; PG8_WAIT_L(0); PG8_MMA(0, 0, At, B0); PG8_BAR; PG8_SCHED;
            PG8_LDB(B1, 0, 1); PG8_STAGE(PG8_SB(0, 0), b2, voffB);
            PG8_BAR; PG8_WAIT_L(0); PG8_MMA(0, 1, At, B1); PG8_BAR;
            PG8_LDA(At, 0, 1); PG8_STAGE(PG8_SA(0, 0), a2, voffA);
            PG8_BAR; PG8_WAIT_L(0); PG8_MMA(1, 0, At, B0); PG8_BAR; PG8_SCHED;
            PG8_STAGE(PG8_SB(0, 1), b2 + hstep, voffB);
            PG8_WAIT_V(6); PG8_BAR; PG8_MMA(1, 1, At, B1); PG8_BAR;
            PG8_LDB(B0, 1, 0); PG8_SCHED; PG8_LDA(At, 1, 0); PG8_STAGE(PG8_SA(0, 1), a2 + hstep, voffA);
            PG8_WAIT_L(8); PG8_BAR; PG8_WAIT_L(0); PG8_MMA(0, 0, At, B0); PG8_BAR; PG8_SCHED;
            PG8_LDB(B1, 1, 1); PG8_STAGE(PG8_SB(1, 0), b3, voffB);
            PG8_BAR; PG8_WAIT_L(0); PG8_MMA(0, 1, At, B1); PG8_BAR;
            PG8_LDA(At, 1, 1); PG8_STAGE(PG8_SA(1, 0), a3, voffA);
            PG8_BAR; PG8_WAIT_L(0); PG8_MMA(1, 0, At, B0); PG8_BAR; PG8_SCHED;
            PG8_STAGE(PG8_SB(1, 1), b3 + hstep, voffB);
            PG8_WAIT_V(6); PG8_BAR; PG8_MMA(1, 1, At, B1); PG8_BAR;
            }
        }
        if constexpr (ALIGN_EPI) { if (wr == 0) PG8_BAR; }
        if constexpr (!Epi::AFTER_DRAIN) { E(acc, cur, wr, wc, fr, fq); S.done(cur); }
        if (!has_next) break;
#pragma unroll
        for (int a = 0; a < 2; ++a)
#pragma unroll
            for (int b = 0; b < 2; ++b)
#pragma unroll
                for (int m = 0; m < 4; ++m)
#pragma unroll
                    for (int n = 0; n < 2; ++n) acc[a][b][m][n] = (f32x4){0.f, 0.f, 0.f, 0.f};
        cur = nxt; cA = nA; cB = nB; ++ui;
        if constexpr (ALIGN_EPI) { if (wr == 1) PG8_BAR; }
    }
    PG8_WAIT_V(0);
    if constexpr (!ALIGN_EPI) { if (wr == 0) PG8_BAR; }
    PG8_BAR;
    if constexpr (Epi::AFTER_DRAIN) { E.fused(acc, cur, wr, wc, fr, fq, lds, wid, lane); S.done(cur); }
#undef PG8_SA
#undef PG8_SB
#undef PG8_STAGE
#undef PG8_LDA
#undef PG8_LDB
#undef PG8_MMA
#undef PG8_WAIT_V
#undef PG8_WAIT_L
#undef PG8_BAR
#undef PG8_SCHED
}
}

#define LAS __attribute__((address_space(3)))
#define DI __device__ __forceinline__
#define GAS __attribute__((address_space(1)))
typedef unsigned short bf16;
typedef float f32x4 __attribute__((ext_vector_type(4)));
typedef float f32x16 __attribute__((ext_vector_type(16)));
typedef short bf16x8 __attribute__((ext_vector_type(8)));
typedef short s16x4 __attribute__((ext_vector_type(4)));
typedef unsigned u32x2 __attribute__((ext_vector_type(2)));
typedef unsigned u32x4 __attribute__((ext_vector_type(4)));
typedef float f32x2_t __attribute__((ext_vector_type(2)));
typedef __bf16 bf16x2_t __attribute__((ext_vector_type(2)));

#ifndef MK_MASK
#define MK_MASK 0x1ff
#endif
#define PH_EN(k) (((MK_MASK) >> (k)) & 1)
#ifndef MK_PER_PHASE
#define MK_PER_PHASE 0
#endif

constexpr int DM = 1024, NBATCH = 8, SEQ = 4096, DEPTH = 4, CTXL = 256, DFF = 4096;
constexpr int MX = NBATCH * SEQ, MC = NBATCH * CTXL, MT = MX + MC;
constexpr int INW = 1952, PJS = 1536;
constexpr float LOG2E = 1.4426950408889634f;
constexpr float C2A = 0.125f * LOG2E;
constexpr float C2C = 0.10206207261596575f * LOG2E;
constexpr float EPSN = 1e-6f;
constexpr int NTHR = 512;

constexpr size_t MiB = (size_t)1 << 20;
constexpr size_t WS_TAB = 0;
constexpr size_t WS_BAR = 65536;
constexpr size_t WS_MODS = 1 * MiB;
constexpr size_t WS_SSQ = 2 * MiB;
constexpr size_t WS_XC = 4 * MiB;
constexpr size_t WS_W = 12 * MiB;
constexpr size_t WL_IN = 0, WL_OUT = 4 * MiB, WL_W1 = 6 * MiB, WL_W2 = 14 * MiB, WL_UQ = 22 * MiB, WL_UKV = 22 * MiB + 256 * 1024, WL_STRIDE = 22 * MiB + 512 * 1024;
constexpr size_t WS_HN = 102 * MiB;
constexpr size_t WS_H1 = 170 * MiB;
constexpr size_t WS_PROJ = 170 * MiB;
constexpr size_t WS_CQ = 272 * MiB;
constexpr size_t WS_CKV = 289 * MiB;
constexpr size_t WS_QM = 298 * MiB;
constexpr size_t WS_KVM = 324 * MiB;
constexpr size_t WS_KRR = 358 * MiB;
constexpr size_t WS_MIX = 362 * MiB;
constexpr size_t WS_SSQX = 442 * MiB;
constexpr size_t WS_BIAS1 = 444 * MiB;
constexpr size_t WS_BIAS4 = 445 * MiB;
constexpr size_t WS_PART = 446 * MiB;
constexpr size_t WS_END = 510 * MiB;
constexpr int LDS_BYTES = 131072 + 256;

DI unsigned cvtpk(float lo, float hi) { f32x2_t v = {lo, hi}; bf16x2_t b = __builtin_convertvector(v, bf16x2_t); return __builtin_bit_cast(unsigned, b); }
DI void st4bf(bf16* p, f32x4 v) { u32x2 w; w.x = cvtpk(v[0], v[1]); w.y = cvtpk(v[2], v[3]); *(GAS u32x2*)p = w; }
DI float wave_sum(float v) {
#pragma unroll
    for (int o = 1; o < 64; o <<= 1) v += __shfl_xor(v, o);
    return v;
}
DI float fexp2(float x) { return __builtin_amdgcn_exp2f(x); }
DI float max3f(float a, float b, float c) { float r; asm("v_max3_f32 %0, %1, %2, %3" : "=v"(r) : "v"(a), "v"(b), "v"(c)); return r; }
#define LDS_WAIT() asm volatile("s_waitcnt lgkmcnt(0)" ::: "memory")

DI f32x4 rope8(f32x4 v, const float* tab  , int fq) {
    const int i0 = 4 * (fq & 1);
    const f32x4 cs = *(const f32x4*)(tab + i0), sn = *(const f32x4*)(tab + 8 + i0);
    f32x4 o;
#pragma unroll
    for (int j = 0; j < 4; ++j) { const float pr = __shfl_xor(v[j], 32); o[j] = (fq < 2) ? v[j] * cs[j] - pr * sn[j] : pr * sn[j] + v[j] * cs[j]; }
    return o;
}

struct EpiInProj {
    static constexpr bool PERM = false, AFTER_DRAIN = false;
    bf16 *proj, *cqb, *ckvb, *krr; float *ssq_q, *ssq_kv; const float *tabA, *tabC; const float *ssqx, *bias;
    DI void operator()(const f32x4 (&acc0)[2][2][4][2], const pg8::Unit& u, int wr, int wc, int fr, int fq) const {
        const int pn = u.pn; const bool isx = u.pm < 128; const int mi = isx ? (u.pm >> 4) : 8;
        f32x4 bv[2][2];
#pragma unroll
        for (int bj = 0; bj < 2; ++bj)
#pragma unroll
            for (int n = 0; n < 2; ++n) bv[bj][n] = *(const f32x4*)(bias + mi * 2048 + pn * 256 + bj * 128 + wc * 32 + n * 16 + 4 * fq);
#pragma unroll
        for (int ai = 0; ai < 2; ++ai)
#pragma unroll
            for (int m = 0; m < 4; ++m) {
                int row = u.pm * 256 + ai * 128 + wr * 64 + m * 16 + fr;
                asm volatile("" : "+v"(row) :: "memory");
                const int tok = row & 4095, prow = tok >> 6, pcol = tok & 63;
                const float rsx = rsqrtf(ssqx[row] * (1.0f / 1024.0f) + EPSN);
                f32x4 acc[2][2];
#pragma unroll
                for (int bj = 0; bj < 2; ++bj)
#pragma unroll
                    for (int n = 0; n < 2; ++n) acc[bj][n] = acc0[ai][bj][m][n] * rsx + bv[bj][n];
                if (pn < 6) {
                    const bool anyrope = isx && pn <= 2;
                    f32x4 cs = {1.f, 1.f, 1.f, 1.f}, sn = {0.f, 0.f, 0.f, 0.f};
                    if (anyrope) { const int pos = (wc & 1) ? pcol : prow; cs = *(const f32x4*)(tabA + pos * 32 + 4 * fq); sn = *(const f32x4*)(tabA + pos * 32 + 16 + 4 * fq); }
#pragma unroll
                    for (int bj = 0; bj < 2; ++bj) {
                        f32x4 v0 = acc[bj][0], v1 = acc[bj][1];
                        if (anyrope && (pn < 2 || bj == 0)) { const f32x4 a = v0 * cs - v1 * sn, b = v0 * sn + v1 * cs; v0 = a; v1 = b; }
                        if (pn < 2 || pn == 3) { v0 *= C2A; v1 *= C2A; }
                        bf16* p = proj + (size_t)row * PJS + pn * 256 + bj * 128 + wc * 32 + 4 * fq;
                        st4bf(p, v0); st4bf(p + 16, v1);
                    }
                } else if (pn == 6) {
                    float s = 0.f;
#pragma unroll
                    for (int bj = 0; bj < 2; ++bj) {
                        const f32x4 v0 = acc[bj][0], v1 = acc[bj][1];
                        s += (v0[0] * v0[0] + v0[1] * v0[1]) + (v0[2] * v0[2] + v0[3] * v0[3]) + (v1[0] * v1[0] + v1[1] * v1[1]) + (v1[2] * v1[2] + v1[3] * v1[3]);
                        bf16* p = cqb + (size_t)row * 256 + bj * 128 + wc * 32 + 4 * fq;
                        st4bf(p, v0); st4bf(p + 16, v1);
                    }
                    s += __shfl_xor(s, 16); s += __shfl_xor(s, 32);
                    if (fq == 0) atomicAdd(ssq_q + row, s);
                } else {
                    {
                        const f32x4 v0 = acc[0][0], v1 = acc[0][1];
                        float s = (v0[0] * v0[0] + v0[1] * v0[1]) + (v0[2] * v0[2] + v0[3] * v0[3]) + (v1[0] * v1[0] + v1[1] * v1[1]) + (v1[2] * v1[2] + v1[3] * v1[3]);
                        bf16* p = ckvb + (size_t)row * 128 + wc * 32 + 4 * fq;
                        st4bf(p, v0); st4bf(p + 16, v1);
                        s += __shfl_xor(s, 16); s += __shfl_xor(s, 32);
                        if (fq == 0) atomicAdd(ssq_kv + row, s);
                    }
                    if (wc == 0) {
                        f32x4 v0 = acc[1][0], v1 = acc[1][1];
                        if (isx) { v0 = rope8(v0, tabC + prow * 16, fq); v1 = rope8(v1, tabC + pcol * 16, fq); }
                        bf16* p = krr + (size_t)row * 32 + 4 * fq;
                        st4bf(p, v0); st4bf(p + 16, v1);
                    }
                }
            }
    }
};

struct EpiUQ {
    static constexpr bool PERM = false, AFTER_DRAIN = false;
    bf16* qm; const float* ssq_q; const float* tabC;
    DI void operator()(const f32x4 (&acc)[2][2][4][2], const pg8::Unit& u, int wr, int wc, int fr, int fq) const {
        const int pn = u.pn; const bool isx = u.pm < 128;
#pragma unroll
        for (int ai = 0; ai < 2; ++ai)
#pragma unroll
            for (int m = 0; m < 4; ++m) {
                int row = u.pm * 256 + ai * 128 + wr * 64 + m * 16 + fr;
                asm volatile("" : "+v"(row) :: "memory");
                const int tok = row & 4095, prow = tok >> 6, pcol = tok & 63;
                const float rs = rsqrtf(ssq_q[row] * (1.0f / 256.0f) + EPSN) * C2C;
#pragma unroll
                for (int bj = 0; bj < 2; ++bj)
#pragma unroll
                    for (int n = 0; n < 2; ++n) {
                        const int col0 = pn * 256 + bj * 128 + wc * 32 + n * 16;
                        if (col0 < 384) {
                            f32x4 v = acc[ai][bj][m][n] * rs;
                            const int g6 = (col0 >> 4) % 6;
                            if (isx && g6 >= 4) v = rope8(v, tabC + (g6 == 4 ? prow : pcol) * 16, fq);
                            st4bf(qm + (size_t)row * 384 + col0 + 4 * fq, v);
                        }
                    }
            }
    }
};

struct EpiUKV {
    static constexpr bool PERM = false, AFTER_DRAIN = false;
    bf16* kvm; const float* ssq_kv;
    DI void operator()(const f32x4 (&acc)[2][2][4][2], const pg8::Unit& u, int wr, int wc, int fr, int fq) const {
#pragma unroll
        for (int ai = 0; ai < 2; ++ai)
#pragma unroll
            for (int m = 0; m < 4; ++m) {
                int row = u.pm * 256 + ai * 128 + wr * 64 + m * 16 + fr;
                asm volatile("" : "+v"(row) :: "memory");
                const float rs = rsqrtf(ssq_kv[row] * (1.0f / 128.0f) + EPSN);
#pragma unroll
                for (int bj = 0; bj < 2; ++bj)
#pragma unroll
                    for (int n = 0; n < 2; ++n) {
                        const int col0 = u.pn * 256 + bj * 128 + wc * 32 + n * 16;
                        st4bf(kvm + (size_t)row * 512 + col0 + 4 * fq, acc[ai][bj][m][n] * rs);
                    }
            }
    }
};

struct EpiRelu2 {
    static constexpr bool PERM = true, AFTER_DRAIN = false;
    bf16* H; const float *ssqx, *bias;
    DI void operator()(const f32x4 (&acc)[2][2][4][2], const pg8::Unit& u, int wr, int wc, int fr, int fq) const {
        const int col0 = u.pn * 256 + wc * 32 + 8 * fq; const int mi = (u.pm < 128) ? (u.pm >> 4) : 8;
        f32x4 bv[2][2];
#pragma unroll
        for (int bj = 0; bj < 2; ++bj)
#pragma unroll
            for (int n = 0; n < 2; ++n) bv[bj][n] = *(const f32x4*)(bias + mi * 4096 + col0 + bj * 128 + 4 * n);
#pragma unroll
        for (int ai = 0; ai < 2; ++ai)
#pragma unroll
            for (int m = 0; m < 4; ++m) {
                int row = u.pm * 256 + ai * 128 + wr * 64 + m * 16 + fr;
                asm volatile("" : "+v"(row) :: "memory");
                const float rsx = rsqrtf(ssqx[row] * (1.0f / 1024.0f) + EPSN);
                bf16* rowp = H + (size_t)row * DFF + col0;
#pragma unroll
                for (int bj = 0; bj < 2; ++bj) {
                    f32x4 v0 = acc[ai][bj][m][0] * rsx + bv[bj][0], v1 = acc[ai][bj][m][1] * rsx + bv[bj][1];
#pragma unroll
                    for (int j = 0; j < 4; ++j) { const float a = fmaxf(v0[j], 0.f), b = fmaxf(v1[j], 0.f); v0[j] = a * a; v1[j] = b * b; }
                    u32x4 w; w.x = cvtpk(v0[0], v0[1]); w.y = cvtpk(v0[2], v0[3]); w.z = cvtpk(v1[0], v1[1]); w.w = cvtpk(v1[2], v1[3]);
                    *(GAS u32x4*)(rowp + bj * 128) = w;
                }
            }
    }
};

struct EpiResid {
    static constexpr bool PERM = false, AFTER_DRAIN = false;
    const float *srcx, *srcc; float *dstx, *dstc; const float* gate; bf16* xg; float* ssq_out; const float *gn, *scn; int donorm;
    DI void operator()(const f32x4 (&acc)[2][2][4][2], const pg8::Unit& u, int wr, int wc, int fr, int fq) const {
        const bool isx = u.pm < 128; const int mi = isx ? (u.pm >> 4) : 8;
        const int col0 = u.pn * 256 + wc * 32 + 4 * fq;
        f32x4 gv[2][2], gp[2][2];
#pragma unroll
        for (int bj = 0; bj < 2; ++bj)
#pragma unroll
            for (int n = 0; n < 2; ++n) { const int c = col0 + bj * 128 + n * 16; gv[bj][n] = *(const f32x4*)(gate + mi * 6144 + c);
                gp[bj][n] = donorm ? *(const f32x4*)(gn + c) * (*(const f32x4*)(scn + mi * 6144 + c) + 1.0f) : (f32x4){0.f, 0.f, 0.f, 0.f}; }
#pragma unroll
        for (int ai = 0; ai < 2; ++ai)
#pragma unroll
            for (int m = 0; m < 4; ++m) {
                int row = u.pm * 256 + ai * 128 + wr * 64 + m * 16 + fr;
                asm volatile("" : "+v"(row) :: "memory");
                const float* s = isx ? srcx + (size_t)row * DM : srcc + (size_t)(row - MX) * DM;
                float* d = isx ? dstx + (size_t)row * DM : dstc + (size_t)(row - MX) * DM;
                float ss = 0.f;
#pragma unroll
                for (int bj = 0; bj < 2; ++bj)
#pragma unroll
                    for (int n = 0; n < 2; ++n) { const int off = col0 + bj * 128 + n * 16;
                        const f32x4 xn = *(const GAS f32x4*)(s + off) + gv[bj][n] * acc[ai][bj][m][n];
                        *(GAS f32x4*)(d + off) = xn;
                        if (donorm) { ss += (xn[0] * xn[0] + xn[1] * xn[1]) + (xn[2] * xn[2] + xn[3] * xn[3]); st4bf(xg + (size_t)row * DM + off, xn * gp[bj][n]); } }
                if (donorm) { ss += __shfl_xor(ss, 16); ss += __shfl_xor(ss, 32); if (fq == 0) atomicAdd(ssq_out + row, ss); }
            }
    }
};

struct SplitOrder {
    int G, c, NS, ksub_bytes;
    DI void init(int G_, int c_, int NS_, int Ksub) { G = G_; c = c_; NS = NS_; ksub_bytes = Ksub * 2; }
    DI bool next(int i, pg8::Unit& u) const { const int idx = i * G + c; if (idx >= 32 * NS) return false; const int ks = idx % NS, tile = idx / NS; u.pn = tile & 3; u.pm = 128 + (tile >> 2); u.kb = ks * ksub_bytes; return true; }
    DI void a_ready(const pg8::Unit&) const {}
    DI void done(const pg8::Unit&) const {}
};
struct EpiPartial {
    static constexpr bool PERM = false, AFTER_DRAIN = false;
    float* part; int ksub_bytes;
    DI void operator()(const f32x4 (&acc)[2][2][4][2], const pg8::Unit& u, int wr, int wc, int fr, int fq) const {
        const int ks = u.kb / ksub_bytes; const int col0 = u.pn * 256 + wc * 32 + 4 * fq;
        float* base = part + (size_t)ks * MC * DM;
#pragma unroll
        for (int ai = 0; ai < 2; ++ai)
#pragma unroll
            for (int m = 0; m < 4; ++m) {
                int row = (u.pm - 128) * 256 + ai * 128 + wr * 64 + m * 16 + fr;
                asm volatile("" : "+v"(row) :: "memory");
                float* rowp = base + (size_t)row * DM + col0;
#pragma unroll
                for (int bj = 0; bj < 2; ++bj)
#pragma unroll
                    for (int n = 0; n < 2; ++n) *(GAS f32x4*)(rowp + bj * 128 + n * 16) = acc[ai][bj][m][n];
            }
    }
};
DI void ctx_finish(const float* part, int NS, const float* src, float* dst, const float* gate8, bf16* xg, float* ssq_out, const float* gn, const float* scn8, const int tid) {
    const int lane = tid & 63, gw = blockIdx.x * 8 + (tid >> 6), NGW = gridDim.x * 8;
    for (int row = gw; row < MC; row += NGW) {
        float s = 0.f;
#pragma unroll
        for (int j = 0; j < 4; ++j) {
            const int col = 256 * j + 4 * lane;
            f32x4 a = {0.f, 0.f, 0.f, 0.f};
            for (int ks = 0; ks < NS; ++ks) a += *(const GAS f32x4*)(part + ((size_t)ks * MC + row) * DM + col);
            const f32x4 xn = *(const GAS f32x4*)(src + (size_t)row * DM + col) + *(const GAS f32x4*)(gate8 + col) * a;
            *(GAS f32x4*)(dst + (size_t)row * DM + col) = xn;
            s += (xn[0] * xn[0] + xn[1] * xn[1]) + (xn[2] * xn[2] + xn[3] * xn[3]);
            st4bf(xg + (size_t)(MX + row) * DM + col, xn * (*(const GAS f32x4*)(gn + col) * (*(const GAS f32x4*)(scn8 + col) + 1.0f)));
        }
        s = wave_sum(s);
        if (lane == 0) ssq_out[MX + row] = s;
    }
}

DI void transpose_item(const float* W, int K, int N, bf16* WT, const float* kscale, LAS float* scr, int item, int lane) {
    const int nblk = N / 32, kb = item / nblk, nb = item % nblk, k0 = 64 * kb, n0 = 32 * nb;
#pragma unroll 16
    for (int i = 0; i < 32; ++i) { const int kk = 2 * i + (lane >> 5); float w = W[(size_t)(k0 + kk) * N + n0 + (lane & 31)]; if (kscale) w *= kscale[k0 + kk]; scr[kk * 33 + (lane & 31)] = w; }
    LDS_WAIT();
    const int c = lane & 7;
#pragma unroll
    for (int j = 0; j < 4; ++j) { const int n = (lane >> 3) + 8 * j; const LAS float* s = scr + (8 * c) * 33 + n;
        u32x4 o; o.x = cvtpk(s[0 * 33], s[1 * 33]); o.y = cvtpk(s[2 * 33], s[3 * 33]); o.z = cvtpk(s[4 * 33], s[5 * 33]); o.w = cvtpk(s[6 * 33], s[7 * 33]);
        *(u32x4*)(WT + (size_t)(n0 + n) * K + k0 + 8 * c) = o; }
    LDS_WAIT();
}

DI void gemv9_item(const float* W, int ldw, int nvalid, int n0, const LAS float* sl, LAS float* red, const float* addb, float* out, int ldo, const int tid) {
    const int col = tid & 63, kg = tid >> 6, n = n0 + col;
    float acc[9];
#pragma unroll
    for (int mi = 0; mi < 9; ++mi) acc[mi] = 0.f;
    if (n < nvalid) {
        const float* w = W + (size_t)(kg * 128) * ldw + n;
#pragma unroll 16
        for (int k = 0; k < 128; ++k) { const float wv = w[(size_t)k * ldw];
#pragma unroll
            for (int mi = 0; mi < 9; ++mi) acc[mi] += sl[mi * 1024 + kg * 128 + k] * wv; }
    }
#pragma unroll
    for (int mi = 0; mi < 9; ++mi) red[(kg * 9 + mi) * 64 + col] = acc[mi];
    __syncthreads();
    for (int o = tid; o < 576; o += NTHR) { const int mi = o >> 6, cq = o & 63; float sacc = (addb && n0 + cq < nvalid) ? addb[n0 + cq] : 0.f;
#pragma unroll
        for (int g = 0; g < 8; ++g) sacc += red[(g * 9 + mi) * 64 + cq];
        out[(size_t)mi * ldo + n0 + cq] = sacc; }
    __syncthreads();
}

struct Args { const float* in[19]; float* out; unsigned char* ws; int ph_lo, ph_hi; };

DI void prologue(const Args& a, LAS unsigned char* lds, const int tid) {
    const int lane = tid & 63, wave = __builtin_amdgcn_readfirstlane(tid >> 6);
    int G = gridDim.x; asm volatile("" : "+s"(G));
    const int bx = blockIdx.x;
    unsigned char* ws = a.ws;
    {
        LAS float* sl = (LAS float*)lds;
        LAS float* red = (LAS float*)(lds + 36864);
        const float* c = a.in[1]; const float* cc = a.in[3]; const float* w_ada = a.in[4]; const float* b_ada = a.in[5];
        float* mods = (float*)(ws + WS_MODS);
        for (int idx = tid; idx < 9 * 1024; idx += NTHR) { const int mi = idx >> 10, k = idx & 1023; const float v = mi < 8 ? c[mi * 1024 + k] : cc[k]; sl[idx] = v / (1.0f + expf(-v)); }
        __syncthreads();
        for (int item = bx; item < DEPTH * 96; item += G) {
            const int l = item / 96, n0 = (item % 96) * 64;
            gemv9_item(w_ada + (size_t)l * 1024 * 6144, 6144, 6144, n0, sl, red, b_ada + l * 6144, mods + (size_t)l * 9 * 6144, 6144, tid);
        }
    }
    {
        const int gid = bx * NTHR + tid, NG = G * NTHR;
        float* tabA = (float*)(ws + WS_TAB); float* tabC = tabA + 2048;
        if (gid < 1024) { const int pos = gid >> 4, i = gid & 15; const float fr = exp2f(-(float)i * (1.0f / 16.0f) * 13.287712379549449f); const float rev = ((float)pos * fr) * 0.15915494309189535f;
            tabA[pos * 32 + i] = __builtin_amdgcn_cosf(rev); tabA[pos * 32 + 16 + i] = __builtin_amdgcn_sinf(rev); }
        else if (gid < 1536) { const int g = gid - 1024, pos = g >> 3, i = g & 7; const float fr = exp2f(-(float)i * (1.0f / 8.0f) * 13.287712379549449f); const float rev = ((float)pos * fr) * 0.15915494309189535f;
            tabC[pos * 16 + i] = __builtin_amdgcn_cosf(rev); tabC[pos * 16 + 8 + i] = __builtin_amdgcn_sinf(rev); }
        float* ssq = (float*)(ws + WS_SSQ);
        for (int i = gid; i < DEPTH * 2 * MT; i += NG) ssq[i] = 0.f;
        float* ssqx = (float*)(ws + WS_SSQX);
        for (int i = gid; i < DEPTH * 2 * MT; i += NG) ssqx[i] = 0.f;
        const u32x4 z = {0u, 0u, 0u, 0u};
        for (int i = gid; i < DEPTH * 12288; i += NG) { const int l = i / 12288, r = i % 12288; ((u32x4*)(ws + WS_W + l * WL_STRIDE + WL_IN + (size_t)INW * 1024 * 2))[r] = z; }
        for (int i = gid; i < DEPTH * 4096; i += NG) { const int l = i / 4096, r = i % 4096; ((u32x4*)(ws + WS_W + l * WL_STRIDE + WL_UQ + (size_t)384 * 256 * 2))[r] = z; }
    }
    {
        LAS float* scr = (LAS float*)(lds + wave * 16384);
        const int gw = bx * 8 + wave, NGW = G * 8;
        constexpr int I_IN = 16 * 61, I_OUT = 16 * 32, I_W1 = 16 * 128, I_W2 = 64 * 32, I_UQ = 4 * 12, I_UKV = 2 * 16, I_L = I_IN + I_OUT + I_W1 + I_W2 + I_UQ + I_UKV;
        for (int it = gw; it < DEPTH * I_L; it += NGW) {
            const int l = it / I_L; int r = it % I_L; unsigned char* wb = ws + WS_W + l * WL_STRIDE;
            if (r < I_IN) { transpose_item(a.in[8] + (size_t)l * 1024 * INW, 1024, INW, (bf16*)(wb + WL_IN), nullptr, scr, r, lane); continue; } r -= I_IN;
            if (r < I_OUT) { transpose_item(a.in[15] + (size_t)l * 1024 * 1024, 1024, 1024, (bf16*)(wb + WL_OUT), nullptr, scr, r, lane); continue; } r -= I_OUT;
            if (r < I_W1) { transpose_item(a.in[16] + (size_t)l * 1024 * 4096, 1024, 4096, (bf16*)(wb + WL_W1), nullptr, scr, r, lane); continue; } r -= I_W1;
            if (r < I_W2) { transpose_item(a.in[17] + (size_t)l * 4096 * 1024, 4096, 1024, (bf16*)(wb + WL_W2), nullptr, scr, r, lane); continue; } r -= I_W2;
            if (r < I_UQ) { transpose_item(a.in[12] + (size_t)l * 256 * 384, 256, 384, (bf16*)(wb + WL_UQ), a.in[11] + l * 256, scr, r, lane); continue; } r -= I_UQ;
            transpose_item(a.in[14] + (size_t)l * 128 * 512, 128, 512, (bf16*)(wb + WL_UKV), a.in[13] + l * 128, scr, r, lane);
        }
    }
}

DI void phase1(const Args& a, LAS unsigned char* lds, const int tid) {
    unsigned char* ws = a.ws;
    int G = gridDim.x; asm volatile("" : "+s"(G));
    const int bx = blockIdx.x;
    const float* mods = (const float*)(ws + WS_MODS);
    {
        LAS float* sl = (LAS float*)lds; LAS float* red = (LAS float*)(lds + 36864);
        float* bias1 = (float*)(ws + WS_BIAS1); float* bias4 = (float*)(ws + WS_BIAS4);
        for (int item = bx; item < DEPTH * 96; item += G) {
            const int l = item / 96, r = item % 96, which = r < 32 ? 0 : 1, tile = which ? r - 32 : r;
            const float* mv = mods + (size_t)l * 9 * 6144 + (which ? 3 : 0) * 1024;
            for (int idx = tid; idx < 9 * 1024; idx += NTHR) sl[idx] = mv[(size_t)(idx >> 10) * 6144 + (idx & 1023)];
            __syncthreads();
            if (!which) gemv9_item(a.in[8] + (size_t)l * 1024 * INW, INW, INW, tile * 64, sl, red, nullptr, bias1 + (size_t)l * 9 * 2048, 2048, tid);
            else gemv9_item(a.in[16] + (size_t)l * 1024 * DFF, DFF, DFF, tile * 64, sl, red, nullptr, bias4 + (size_t)l * 9 * 4096, 4096, tid);
        }
    }
    {
        const int lane = tid & 63, gw = bx * 8 + (tid >> 6), NGW = G * 8;
        bf16* Hn = (bf16*)(ws + WS_HN); float* ssqx = (float*)(ws + WS_SSQX); const float* g = a.in[6];
        for (int row = gw; row < MT; row += NGW) {
            const float* src = row < MX ? a.in[0] + (size_t)row * DM : a.in[2] + (size_t)(row - MX) * DM;
            const int mi = row < MX ? (row >> 12) : 8;
            const f32x4* xr = (const f32x4*)src + lane;
            f32x4 v[4]; float s = 0.f;
#pragma unroll
            for (int j = 0; j < 4; ++j) { v[j] = xr[64 * j]; s += (v[j][0] * v[j][0] + v[j][1] * v[j][1]) + (v[j][2] * v[j][2] + v[j][3] * v[j][3]); }
            s = wave_sum(s);
            if (lane == 0) ssqx[row] = s;
            const float* mrow = mods + (size_t)mi * 6144 + 1024;
#pragma unroll
            for (int j = 0; j < 4; ++j) { const int col = 256 * j + 4 * lane;
                const f32x4 gg = *(const f32x4*)(g + col), sc = *(const f32x4*)(mrow + col);
                st4bf(Hn + (size_t)row * DM + col, v[j] * (gg * (sc + 1.0f))); }
        }
    }
}
DI void final_norm_phase(float* x, const float* g, const int tid) {
    const int lane = tid & 63, gw = blockIdx.x * 8 + (tid >> 6), NGW = gridDim.x * 8;
    for (int row = gw; row < MX; row += NGW) {
        f32x4* xr = (f32x4*)(x + (size_t)row * DM) + lane;
        f32x4 v[4]; float s = 0.f;
#pragma unroll
        for (int j = 0; j < 4; ++j) { v[j] = xr[64 * j]; s += (v[j][0] * v[j][0] + v[j][1] * v[j][1]) + (v[j][2] * v[j][2] + v[j][3] * v[j][3]); }
        const float r = rsqrtf(wave_sum(s) * (1.0f / DM) + EPSN);
#pragma unroll
        for (int j = 0; j < 4; ++j) { const f32x4 gg = *(const f32x4*)(g + 256 * j + 4 * lane); xr[64 * j] = v[j] * r * gg; }
    }
}

struct AttnP { const bf16 *proj, *qm, *kvm, *krr; bf16* mix; const float* sink; const float* rpb; };
constexpr int A_VS = 144, A_KB = 64 * 208, A_VB = 64 * A_VS, L_K = 0, L_V = 2 * A_KB, L_B = L_V + 2 * A_VB;

template <int TYPE> DI int key_row(int t, int j, int b, int nblk, int kr0, int kc0) {
    if (t < 4) return MX + b * 256 + t * 64 + j;
    const int tt = t - 4;
    if (TYPE == 0) return b * 4096 + (nblk - 1) * 128 + tt * 64 + j;
    if (TYPE == 1) { const int tr = tt / 3, tc = tt - 3 * tr; return b * 4096 + (kr0 + 4 * tr + (j >> 4)) * 64 + kc0 + 16 * tc + (j & 15); }
    return b * 4096 + tt * 64 + j;
}

constexpr float ATHR = 6.0f;
template <int TYPE> struct AttnCtx { int t_qi, t_h, kr0, kc0, qr, qc, wr_, wc_; };

template <int TYPE, int NKS, int KSTR> DI void at_mfma_block(f32x16& p0, f32x16& p1, f32x16& o0, f32x16& o1, const bf16x8 (&qf)[NKS], const bf16x8 (&pf)[4], float m_,
                                                             const LAS unsigned char* kb0, const LAS unsigned char* vb, bool do_s, bool do_pv) {
    if (do_s) {
        const float nm = -m_;
#pragma unroll
        for (int i = 0; i < 16; ++i) { p0[i] = nm; p1[i] = nm; }
#pragma unroll
        for (int ks = 0; ks < NKS; ++ks) {
            const bf16x8 a0 = *(const LAS bf16x8*)(kb0 + ks * 32), a1 = *(const LAS bf16x8*)(kb0 + 32 * KSTR + ks * 32);
            p0 = __builtin_amdgcn_mfma_f32_32x32x16_bf16(a0, qf[ks], p0, 0, 0, 0);
            p1 = __builtin_amdgcn_mfma_f32_32x32x16_bf16(a1, qf[ks], p1, 0, 0, 0);
            if (ks & 1) asm volatile("" ::: "memory");
        }
    }
    if (do_pv) {
#pragma unroll
        for (int s = 0; s < 4; ++s) {
#pragma unroll
            for (int c = 0; c < 2; ++c) {
                const s16x4 lo = __builtin_bit_cast(s16x4, __builtin_amdgcn_ds_read_tr16_b64_v4i16((LAS s16x4*)(vb + (16 * s) * A_VS + c * 64)));
                const s16x4 hi = __builtin_bit_cast(s16x4, __builtin_amdgcn_ds_read_tr16_b64_v4i16((LAS s16x4*)(vb + (16 * s + 8) * A_VS + c * 64)));
                const bf16x8 vf = __builtin_shufflevector(lo, hi, 0, 1, 2, 3, 4, 5, 6, 7);
                if (c == 0) o0 = __builtin_amdgcn_mfma_f32_32x32x16_bf16(vf, pf[s], o0, 0, 0, 0);
                else o1 = __builtin_amdgcn_mfma_f32_32x32x16_bf16(vf, pf[s], o1, 0, 0, 0);
            }
            asm volatile("" ::: "memory");
        }
    }
}

template <int TYPE> DI void at_valu_block(f32x16& p0, f32x16& p1, f32x16& o0, f32x16& o1, bf16x8 (&pf)[4], float& m_, float& l_, int t, bool first,
                                          int qi, int h, int kr0, int kc0, int qr, int qc, int wr_, int wc_, const LAS float* lbias) {
    if (t >= 4) {
        if (TYPE == 0) {
            const int d0 = 64 * (t - 4) - qi + 4 * h;
#pragma unroll
            for (int i = 0; i < 16; ++i) { const int e = d0 + (i & 3) + 8 * (i >> 2);
                if ((unsigned)e > 256u) p0[i] = -1e30f;
                if ((unsigned)(e + 32) > 256u) p1[i] = -1e30f; }
        } else if (TYPE == 1) {
            const int tt = t - 4, tr = tt / 3, tc = tt - 3 * tr;
            const int krb = kr0 + 4 * tr, kcb = kc0 + 16 * tc + 4 * h;
#pragma unroll
            for (int i = 0; i < 16; ++i) {
                const int kc = kcb + (i & 3) + 8 * ((i >> 2) & 1);
                const bool cv = (unsigned)(kc - wc_) < 16u;
                const int ci = kc - qc + 15;
                { const int kr = krb + (i >> 3); const bool v = cv && ((unsigned)(kr - wr_) < 8u); const int idx = v ? (kr - qr + 7) * 31 + ci : 0; const float bv = lbias[idx]; p0[i] = v ? p0[i] + bv : -1e30f; }
                { const int kr = krb + 2 + (i >> 3); const bool v = cv && ((unsigned)(kr - wr_) < 8u); const int idx = v ? (kr - qr + 7) * 31 + ci : 0; const float bv = lbias[idx]; p1[i] = v ? p1[i] + bv : -1e30f; }
            }
        }
    }
    asm volatile("s_nop 15\n\ts_nop 7" : "+v"(p0), "+v"(p1));
    float mxa = max3f(p0[0], p0[1], p1[0]), mxb = max3f(p0[2], p0[3], p1[1]); mxa = max3f(mxa, p1[2], p1[3]);
#pragma unroll
    for (int i = 4; i < 16; i += 4) { mxa = max3f(mxa, p0[i], p0[i + 1]); mxb = max3f(mxb, p0[i + 2], p0[i + 3]); mxa = max3f(mxa, p1[i], p1[i + 1]); mxb = max3f(mxb, p1[i + 2], p1[i + 3]); }
    float mx = max3f(mxa, mxb, mxb);
    mx = max3f(mx, __shfl_xor(mx, 32), mx);
    if (first || __any(mx > ATHR)) {
        const float dl = (TYPE != 0 && first) ? mx : fmaxf(mx, 0.f);
        const float alpha = fexp2(-dl);
        m_ += dl; l_ *= alpha;
#pragma unroll
        for (int i = 0; i < 16; ++i) { p0[i] -= dl; p1[i] -= dl; o0[i] *= alpha; o1[i] *= alpha; }
    }
    float ls = 0.f;
#pragma unroll
    for (int i = 0; i < 16; ++i) { p0[i] = fexp2(p0[i]); p1[i] = fexp2(p1[i]); ls += p0[i] + p1[i]; }
    l_ += ls;
#pragma unroll
    for (int s = 0; s < 4; ++s) {
        u32x4 pw;
        if (s < 2) { pw.x = cvtpk(p0[8 * s + 0], p0[8 * s + 1]); pw.y = cvtpk(p0[8 * s + 2], p0[8 * s + 3]); pw.z = cvtpk(p0[8 * s + 4], p0[8 * s + 5]); pw.w = cvtpk(p0[8 * s + 6], p0[8 * s + 7]); }
        else { const int s2 = s - 2; pw.x = cvtpk(p1[8 * s2 + 0], p1[8 * s2 + 1]); pw.y = cvtpk(p1[8 * s2 + 2], p1[8 * s2 + 3]); pw.z = cvtpk(p1[8 * s2 + 4], p1[8 * s2 + 5]); pw.w = cvtpk(p1[8 * s2 + 6], p1[8 * s2 + 7]); }
        pf[s] = __builtin_bit_cast(bf16x8, pw);
    }
}

template <int TYPE> DI void attn_unit(const AttnP& P, int uid, bool isctx, LAS unsigned char* lds, const int tid) {
    constexpr int DQK = TYPE == 2 ? 96 : 64, NKS = DQK / 16, KSTR = DQK * 2 + 16;
    const int lane = tid & 63, w = __builtin_amdgcn_readfirstlane(tid >> 6), r = lane & 31, h = lane >> 5;
    int b, hd, kvh = 0, qrow, nblk = 0, kr0 = 0, kc0 = 0, qr = 0, qc = 0, tb0 = 4, tb1 = 4;
    if (TYPE == 0) {
        int gp;
        if (!isctx) { b = uid >> 7; kvh = (uid >> 6) & 1; nblk = (uid >> 1) & 31; gp = uid & 1; qrow = b * 4096 + nblk * 128 + (w & 3) * 32 + r; tb0 = nblk == 0 ? 6 : 4; tb1 = nblk == 31 ? 8 : 10; }
        else { b = uid >> 3; kvh = (uid >> 2) & 1; gp = (uid >> 1) & 1; nblk = uid & 1; qrow = MX + b * 256 + nblk * 128 + (w & 3) * 32 + r; }
        hd = kvh * 4 + gp * 2 + (w >> 2);
    } else if (TYPE == 1) {
        if (!isctx) { b = uid >> 6; hd = (uid >> 4) & 3; const int ib = (uid >> 1) & 7, cp = uid & 1;
            qr = 8 * ib + 2 * (w & 3) + (r >> 4); qc = 16 * (2 * cp + (w >> 2)) + (r & 15); qrow = b * 4096 + qr * 64 + qc;
            kr0 = min(max(8 * ib - 4, 0), 48); kc0 = 16 * cp; tb1 = 16; }
        else { b = uid >> 2; hd = uid & 3; qrow = MX + b * 256 + w * 32 + r; }
    } else {
        if (!isctx) { b = uid >> 6; hd = (uid >> 4) & 3; qrow = b * 4096 + (uid & 15) * 256 + w * 32 + r; tb1 = 68; }
        else { b = uid >> 2; hd = uid & 3; qrow = MX + b * 256 + w * 32 + r; }
    }
    const int NTA = 4 + (tb1 - tb0);
    const bf16* qp; int ocol;
    if (TYPE == 0) { qp = P.proj + (size_t)qrow * PJS + hd * 64; ocol = hd * 64; }
    else if (TYPE == 1) { qp = P.proj + (size_t)qrow * PJS + 768 + hd * 64; ocol = 512 + hd * 64; }
    else { qp = P.qm + (size_t)qrow * 384 + hd * 96; ocol = 768 + hd * 64; }
    bf16x8 qf[NKS];
#pragma unroll
    for (int ks = 0; ks < NKS; ++ks) qf[ks] = *(const GAS bf16x8*)(qp + 16 * ks + 8 * h);

    float m_ = 0.f, l_ = 0.f;
    if (TYPE == 0) { m_ = P.sink[hd] * LOG2E; l_ = (h == 0) ? 1.f : 0.f; }
    f32x16 o0, o1, p0, p1;
#pragma unroll
    for (int i = 0; i < 16; ++i) { o0[i] = 0.f; o1[i] = 0.f; p0[i] = 0.f; p1[i] = 0.f; }
    bf16x8 pf[4];
#pragma unroll
    for (int s = 0; s < 4; ++s) pf[s] = (bf16x8){0, 0, 0, 0, 0, 0, 0, 0};

    u32x4 kreg, vreg, rreg = {0u, 0u, 0u, 0u};
    const int sj = tid >> 3, sc = tid & 7;
#define AT_TILE(it_) ((it_) < 4 ? (it_) : (it_) - 4 + tb0)
#define AT_LOADK(t) do { const int kr_ = key_row<TYPE>((t), sj, b, nblk, kr0, kc0); \
        if (TYPE == 2) { kreg = *(const GAS u32x4*)(P.kvm + (size_t)kr_ * 512 + hd * 128 + sc * 8); \
            if (tid < 256) { const int kr2_ = key_row<TYPE>((t), tid >> 2, b, nblk, kr0, kc0); rreg = *(const GAS u32x4*)(P.krr + (size_t)kr2_ * 32 + (tid & 3) * 8); } } \
        else kreg = *(const GAS u32x4*)(P.proj + (size_t)kr_ * PJS + (TYPE == 0 ? 512 + kvh * 64 : 1024 + hd * 64) + sc * 8); } while (0)
#define AT_LOADV(t) do { const int kr_ = key_row<TYPE>((t), sj, b, nblk, kr0, kc0); \
        if (TYPE == 2) vreg = *(const GAS u32x4*)(P.kvm + (size_t)kr_ * 512 + hd * 128 + 64 + sc * 8); \
        else vreg = *(const GAS u32x4*)(P.proj + (size_t)kr_ * PJS + (TYPE == 0 ? 640 + kvh * 64 : 1280 + hd * 64) + sc * 8); } while (0)
#define AT_STOREK(bi) do { *(LAS u32x4*)(lds + L_K + (bi) * A_KB + sj * KSTR + sc * 16) = kreg; \
        if (TYPE == 2) { if (tid < 256) *(LAS u32x4*)(lds + L_K + (bi) * A_KB + (tid >> 2) * KSTR + 128 + (tid & 3) * 16) = rreg; } } while (0)
#define AT_STOREV(bi) do { *(LAS u32x4*)(lds + L_V + (bi) * A_VB + sj * A_VS + sc * 16) = vreg; } while (0)
    AT_LOADK(0);
    __syncthreads();
    LAS float* lbias = (LAS float*)(lds + L_B);
    if (TYPE == 1 && !isctx) { if (tid < 465) lbias[tid] = ((const GAS float*)P.rpb)[hd * 465 + tid] * LOG2E; }
    AT_STOREK(0);
    AT_LOADK(AT_TILE(1)); AT_LOADV(0);
    __syncthreads();
    const int q4 = (lane & 15) >> 2, p4 = lane & 3, blk = (lane >> 4) & 1;
    const int voff = L_V + (4 * h + q4) * A_VS + (16 * blk + 4 * p4) * 2;
    const int koff = L_K + r * KSTR + 16 * h;
    const int wr_ = min(max(qr - 4, 0), 56), wc_ = min(max(qc - 8, 0), 48);
    const int qi = (w & 3) * 32 + r;
    const bool grp1 = (w >> 2) != 0;

#define AT_STAGE(it) do { if ((it) + 1 < NTA) AT_STOREK(((it) + 1) & 1); AT_STOREV((it) & 1); \
        if ((it) + 2 < NTA) AT_LOADK(AT_TILE((it) + 2)); if ((it) + 1 < NTA) AT_LOADV(AT_TILE((it) + 1)); __syncthreads(); } while (0)
    if (!grp1) {
        for (int it = 0; it < NTA; ++it) {
            const int t = AT_TILE(it);
            const LAS unsigned char* kb0 = lds + (it & 1) * A_KB + koff;
            const LAS unsigned char* vb = lds + ((it + 1) & 1) * A_VB + voff;
            at_mfma_block<TYPE, NKS, KSTR>(p0, p1, o0, o1, qf, pf, m_, kb0, vb, true, it > 0);
            at_valu_block<TYPE>(p0, p1, o0, o1, pf, m_, l_, t, it == 0, qi, h, kr0, kc0, qr, qc, wr_, wc_, lbias);
            AT_STAGE(it);
        }
        const LAS unsigned char* vb = lds + ((NTA - 1) & 1) * A_VB + voff;
        at_mfma_block<TYPE, NKS, KSTR>(p0, p1, o0, o1, qf, pf, m_, vb, vb, false, true);
    } else {
        for (int it = 0; it < NTA; ++it) {
            const int tp = AT_TILE(it - 1);
            const LAS unsigned char* kb0 = lds + (it & 1) * A_KB + koff;
            const LAS unsigned char* vb = lds + ((it + 1) & 1) * A_VB + voff;
            if (it > 0) at_valu_block<TYPE>(p0, p1, o0, o1, pf, m_, l_, tp, it == 1, qi, h, kr0, kc0, qr, qc, wr_, wc_, lbias);
            at_mfma_block<TYPE, NKS, KSTR>(p0, p1, o0, o1, qf, pf, m_, kb0, vb, true, it > 0);
            AT_STAGE(it);
        }
        const LAS unsigned char* vb = lds + ((NTA - 1) & 1) * A_VB + voff;
        at_valu_block<TYPE>(p0, p1, o0, o1, pf, m_, l_, AT_TILE(NTA - 1), false, qi, h, kr0, kc0, qr, qc, wr_, wc_, lbias);
        at_mfma_block<TYPE, NKS, KSTR>(p0, p1, o0, o1, qf, pf, m_, vb, vb, false, true);
    }
#undef AT_STAGE
#undef AT_LOADK
#undef AT_LOADV
#undef AT_STOREK
#undef AT_STOREV
#undef AT_TILE
    const float lt = l_ + __shfl_xor(l_, 32), inv = 1.0f / lt;
    bf16* op = P.mix + (size_t)qrow * DM + ocol + 4 * h;
#pragma unroll
    for (int g = 0; g < 4; ++g) {
        const f32x4 v0 = {o0[4 * g] * inv, o0[4 * g + 1] * inv, o0[4 * g + 2] * inv, o0[4 * g + 3] * inv};
        const f32x4 v1 = {o1[4 * g] * inv, o1[4 * g + 1] * inv, o1[4 * g + 2] * inv, o1[4 * g + 3] * inv};
        st4bf(op + 8 * g, v0); st4bf(op + 32 + 8 * g, v1);
    }
}

DI void attn_phase(const AttnP& P, bool last, LAS unsigned char* lds, const int tid_in) {
    const int G = gridDim.x, bx = blockIdx.x;
    const int vcu = (G % 8 == 0) ? (bx % 8) * (G / 8) + bx / 8 : bx;
    const int NU = 2048 + (last ? 0 : 128);
    for (int u = vcu; u < NU; u += G) {
        int tid = tid_in; asm volatile("" : "+v"(tid));
        if (u < 512) attn_unit<2>(P, u, false, lds, tid);
        else if (u < 1024) attn_unit<1>(P, u - 512, false, lds, tid);
        else if (u < 2048) attn_unit<0>(P, u - 1024, false, lds, tid);
        else if (u < 2080) attn_unit<2>(P, u - 2048, true, lds, tid);
        else if (u < 2112) attn_unit<1>(P, u - 2080, true, lds, tid);
        else attn_unit<0>(P, u - 2112, true, lds, tid);
    }
}

#define XB_TMO      128
#define XB_XCNT(j)  (256  + 64 * (j))
#define XB_XSUB(j)  (1280 + 64 * (j))
#define XB_XGEN(j)  (2304 + 64 * (j))
#define XB_TOP      3328
#define XB_TOPGEN   3392
#define XCD_BAR_WORDS 3456
#define XB_SPIN_CAP (1u << 18)

__device__ __forceinline__ unsigned xb_ld(unsigned* p)              { return __hip_atomic_load(p, __ATOMIC_RELAXED, __HIP_MEMORY_SCOPE_AGENT); }
__device__ __forceinline__ unsigned xb_add(unsigned* p, unsigned v) { return __hip_atomic_fetch_add(p, v, __ATOMIC_RELAXED, __HIP_MEMORY_SCOPE_AGENT); }
__device__ __forceinline__ unsigned xb_xcc_id() { return (unsigned)__builtin_amdgcn_s_getreg((3 << 11) | 20) & 0xFu; }
#define XB_SPIN(cond, bar) do { unsigned _sp = 0; while (cond) { __builtin_amdgcn_s_sleep(1); \
    if ((++_sp & 255u) == 0u) { if (xb_ld(&(bar)[XB_TMO])) break; if (_sp > XB_SPIN_CAP) { atomicAdd(&(bar)[XB_TMO], 1u); break; } } } } while (0)

struct XcdBarrier {
    unsigned* bar; unsigned x;
    volatile LAS unsigned* st;
};

__device__ __forceinline__ XcdBarrier xcd_barrier_post(unsigned* bar, volatile LAS unsigned* st) {
    XcdBarrier b; b.bar = bar; b.x = xb_xcc_id(); b.st = st;
    if (threadIdx.x == 0) (void)xb_add(&bar[XB_XCNT(b.x)], 1u);
    return b;
}
__device__ __forceinline__ void xcd_barrier_complete(unsigned* bar, unsigned x, unsigned& nloc, unsigned& nx) {
    const unsigned G = gridDim.x * gridDim.y * gridDim.z;
    unsigned sum, cnt, mine, sp = 0u;
    for (;;) {
        sum = 0u; cnt = 0u; mine = 0u;
#pragma unroll
        for (unsigned j = 0; j < 16; ++j) { const unsigned c = xb_ld(&bar[XB_XCNT(j)]); sum += c; cnt += (c > 0u) ? 1u : 0u; mine = (j == x) ? c : mine; }
        if (sum == G) break;
        __builtin_amdgcn_s_sleep(1);
        if ((++sp & 255u) == 0u) { if (xb_ld(&bar[XB_TMO])) break; if (sp > XB_SPIN_CAP) { atomicAdd(&bar[XB_TMO], 1u); break; } }
    }
    nloc = mine > 0u ? mine : 1u; nx = cnt > 0u ? cnt : 1u;
}

__device__ __forceinline__ void xcd_barrier(const XcdBarrier& b) {
    asm volatile("s_waitcnt vmcnt(0)" ::: "memory");
    __syncthreads();
    if (threadIdx.x == 0) {
        unsigned* bar = b.bar;
        __builtin_amdgcn_s_waitcnt(0);
        unsigned nloc = b.st[0], nx = b.st[1];
        if (nloc == 0u) { xcd_barrier_complete(bar, b.x, nloc, nx); b.st[0] = nloc; b.st[1] = nx; }
        const unsigned old = xb_add(&bar[XB_XSUB(b.x)], 1u);
        const unsigned gen = old / nloc;
        if (old + 1u == (gen + 1u) * nloc) {
            __builtin_amdgcn_fence(__ATOMIC_RELEASE, "agent");
            asm volatile("s_waitcnt vmcnt(0)" ::: "memory");
            const unsigned og = xb_add(&bar[XB_TOP], 1u);
            const unsigned tg = og / nx;
            if (og + 1u == (tg + 1u) * nx) xb_add(&bar[XB_TOPGEN], 1u);
            else XB_SPIN(xb_ld(&bar[XB_TOPGEN]) == tg, bar);
            __builtin_amdgcn_fence(__ATOMIC_ACQUIRE, "agent");
            xb_add(&bar[XB_XGEN(b.x)], 1u);
            asm volatile("s_waitcnt vmcnt(0)" ::: "memory");
        } else {
            XB_SPIN(xb_ld(&bar[XB_XGEN(b.x)]) == gen, bar);
            __builtin_amdgcn_fence(__ATOMIC_ACQUIRE, "agent");
            asm volatile("s_waitcnt vmcnt(0)" ::: "memory");
        }
    }
    __syncthreads();
}

constexpr int NPH = 3 + 6 * DEPTH;
__global__ void __launch_bounds__(NTHR) mk_fwd(Args a) {
    extern __shared__ __attribute__((aligned(16))) unsigned char lds_raw[];
    LAS unsigned char* lds = (LAS unsigned char*)lds_raw;
    const int G = gridDim.x, bx = blockIdx.x;
    const int ph_lo = a.ph_lo, ph_hi = a.ph_hi;
    volatile LAS unsigned* bst = (volatile LAS unsigned*)(lds + 131072);
    if (threadIdx.x < 2) bst[threadIdx.x] = 0u;
    __syncthreads();
    XcdBarrier xbar; xbar.bar = (unsigned*)(a.ws + WS_BAR); xbar.x = 0; xbar.st = bst;
    if (!MK_PER_PHASE) xbar = xcd_barrier_post((unsigned*)(a.ws + WS_BAR), bst);

    for (int ph = ph_lo; ph < ph_hi;) {
        int tid = threadIdx.x; asm volatile("" : "+v"(tid));
        unsigned char* ws = a.ws; asm volatile("" : "+s"(ws));
        float* mods = (float*)(ws + WS_MODS);
        const float* tabA = (const float*)(ws + WS_TAB); const float* tabC = tabA + 2048;
        float* Xc = (float*)(ws + WS_XC);
        bf16* Hn = (bf16*)(ws + WS_HN); bf16* H1 = (bf16*)(ws + WS_H1);
        bf16* proj = (bf16*)(ws + WS_PROJ); bf16* cqb = (bf16*)(ws + WS_CQ); bf16* ckvb = (bf16*)(ws + WS_CKV);
        bf16* qm = (bf16*)(ws + WS_QM); bf16* kvm = (bf16*)(ws + WS_KVM); bf16* krr = (bf16*)(ws + WS_KRR); bf16* mix = (bf16*)(ws + WS_MIX);

        if (ph == 0) prologue(a, lds, tid);
        else if (ph == 1) phase1(a, lds, tid);
        else if (ph == NPH - 1) final_norm_phase(a.out, a.in[18], tid);
        else {
            const int l = (ph - 2) / 6, s = (ph - 2) - 6 * l; const bool last = (l == DEPTH - 1);
            unsigned char* wb = ws + WS_W + (size_t)l * WL_STRIDE;
            const float* mods_l = mods + (size_t)l * 9 * 6144;
            float* ssq_q = (float*)(ws + WS_SSQ) + (size_t)l * 2 * MT; float* ssq_kv = ssq_q + MT;
            float* ssqx1 = (float*)(ws + WS_SSQX) + (size_t)l * 2 * MT; float* ssqx2 = ssqx1 + MT;
            const float* xsrc = (l == 0) ? a.in[0] : a.out;
            const float* csrc = (l == 0) ? a.in[2] : Xc;
            float* part = (float*)(ws + WS_PART);
            if (s == 0) {
                if (l > 0) {
                    const float* mods_p = mods + (size_t)(l - 1) * 9 * 6144;
                    ctx_finish(part, 8, Xc, Xc, mods_p + 5 * 1024 + 8 * 6144, Hn, ssqx1, a.in[6] + l * DM, mods_l + 1 * 1024 + 8 * 6144, tid);
                    xcd_barrier(xbar);
                }
                pg8::Gemm g{Hn, (const bf16*)(wb + WL_IN), MT, 2048, DM, DM}; pg8::StaticOrder S; S.init(MT, 2048, G, bx);
                EpiInProj E{proj, cqb, ckvb, krr, ssq_q, ssq_kv, tabA, tabC, ssqx1, (const float*)(ws + WS_BIAS1) + (size_t)l * 9 * 2048};
                pg8::gemm_phase<EpiInProj, pg8::StaticOrder, true, true>(lds, g, S, E, tid);
            } else if (s == 1) {
                { int Kq = 256; asm volatile("" : "+s"(Kq)); pg8::Gemm g{cqb, (const bf16*)(wb + WL_UQ), MT, 512, Kq, Kq}; pg8::StaticOrder S; S.init(MT, 512, G, bx);
                  EpiUQ E{qm, ssq_q, tabC}; pg8::gemm_phase<EpiUQ, pg8::StaticOrder, true, true>(lds, g, S, E, tid); }
                { int Kk = 128; asm volatile("" : "+s"(Kk)); pg8::Gemm g{ckvb, (const bf16*)(wb + WL_UKV), MT, 512, Kk, Kk}; pg8::StaticOrder S; S.init(MT, 512, G, (bx + G / 2) % G);
                  EpiUKV E{kvm, ssq_kv}; pg8::gemm_phase<EpiUKV, pg8::StaticOrder, true, true>(lds, g, S, E, tid); }
            } else if (s == 2) {
                AttnP P{proj, qm, kvm, krr, mix, a.in[9] + l * 8, a.in[10] + l * 4 * 465};
                attn_phase(P, last, lds, tid);
            } else if (s == 3 || s == 5) {
                const bool outp = (s == 3);
                const int Kfull = outp ? DM : DFF;
                {
                    pg8::Gemm g{outp ? mix : H1, (const bf16*)(wb + (outp ? WL_OUT : WL_W2)), MX, DM, Kfull, Kfull}; pg8::StaticOrder S; S.init(MX, DM, G, bx);
                    const int ln = outp ? l : l + 1;
                    const float* mods_n = mods + (size_t)(ln < DEPTH ? ln : 0) * 9 * 6144;
                    EpiResid E{(outp ? xsrc : a.out), (outp ? csrc : Xc), a.out, Xc, mods_l + (outp ? 2 : 5) * 1024, Hn,
                               outp ? ssqx2 : ssqx1 + (size_t)2 * MT, (outp ? a.in[7] : a.in[6]) + (ln < DEPTH ? ln : 0) * DM, mods_n + (outp ? 4 : 1) * 1024, (outp || !last) ? 1 : 0};
                    pg8::gemm_phase<EpiResid, pg8::StaticOrder, true, true>(lds, g, S, E, tid);
                }
                if (!last) {
                    int Ks = Kfull / 8; asm volatile("" : "+s"(Ks));
                    pg8::Gemm g{outp ? mix : H1, (const bf16*)(wb + (outp ? WL_OUT : WL_W2)), MT, DM, Ks, Kfull}; SplitOrder S; S.init(G, (bx + G / 2) % G, 8, Ks);
                    EpiPartial E{part, Ks * 2};
                    pg8::gemm_phase<EpiPartial, SplitOrder, true, true>(lds, g, S, E, tid);
                }
            } else {
                const int Mr = last ? MX : MT;
                if (!last) {
                    ctx_finish(part, 8, csrc, Xc, mods_l + 2 * 1024 + 8 * 6144, Hn, ssqx2, a.in[7] + l * DM, mods_l + 4 * 1024 + 8 * 6144, tid);
                    xcd_barrier(xbar);
                }
                pg8::Gemm g{Hn, (const bf16*)(wb + WL_W1), Mr, DFF, DM, DM}; pg8::StaticOrder S; S.init(Mr, DFF, G, bx);
                EpiRelu2 E{H1, ssqx2, (const float*)(ws + WS_BIAS4) + (size_t)l * 9 * 4096}; pg8::gemm_phase<EpiRelu2, pg8::StaticOrder, true, true>(lds, g, S, E, tid);
            }
        }
        ++ph;
        if (ph < ph_hi) { if (ph == 1) cg::this_grid().sync(); else xcd_barrier(xbar); }
    }
}

extern "C" void kernel_launch(void* const* d_in, const int* in_sizes, int n_in, void* d_out, int out_size, void* d_ws, size_t ws_size, hipStream_t stream) {
    static int grid = 0;
    if (grid == 0) {
        if (n_in != 19 || ws_size < WS_END) { fprintf(stderr, "kernel_launch: unexpected inputs (n_in %d, ws %zu)\n", n_in, ws_size); grid = -1; return; }
        int dev = 0, cus = 0, per_cu = 0;
        hipGetDevice(&dev); hipDeviceGetAttribute(&cus, hipDeviceAttributeMultiprocessorCount, dev);
        hipFuncSetAttribute((const void*)mk_fwd, hipFuncAttributeMaxDynamicSharedMemorySize, LDS_BYTES);
        hipOccupancyMaxActiveBlocksPerMultiprocessor(&per_cu, (const void*)mk_fwd, NTHR, LDS_BYTES);
        if (per_cu < 1) { fprintf(stderr, "kernel_launch: occupancy query says %d\n", per_cu); per_cu = 1; }
        (void)hipGetLastError();
        grid = cus * 1;
    }
    if (grid < 0) return;
    Args a{};
    for (int i = 0; i < 19; ++i) a.in[i] = (const float*)d_in[i];
    a.out = (float*)d_out; a.ws = (unsigned char*)d_ws;
#if MK_PER_PHASE
    for (int ph = 0; ph < NPH; ++ph) { a.ph_lo = ph; a.ph_hi = ph + 1; hipLaunchKernelGGL(mk_fwd, dim3(grid), dim3(NTHR), LDS_BYTES, stream, a); }
#else
    a.ph_lo = 0; a.ph_hi = NPH;
    (void)hipMemsetAsync((unsigned char*)d_ws + WS_BAR, 0, 16384, stream);
    void* args[] = {&a};
    hipError_t e = hipLaunchCooperativeKernel((const void*)mk_fwd, dim3(grid), dim3(NTHR), args, LDS_BYTES, stream);
    if (e != hipSuccess) fprintf(stderr, "cooperative launch failed: %s (grid %d)\n", hipGetErrorString(e), grid);
#endif
}
```

```cpp
#include <hip/hip_runtime.h>
#include <hip/hip_cooperative_groups.h>
#include <cstdio>
#include <cstdint>
namespace cg = cooperative_groups;
namespace pg8 {
#define PG8_LAS __attribute__((address_space(3)))
typedef unsigned short bf16_t;
typedef short bf16x8 __attribute__((ext_vector_type(8)));
typedef float f32x4 __attribute__((ext_vector_type(4)));
typedef unsigned u32x4 __attribute__((ext_vector_type(4)));
constexpr int BM = 256, BK = 64, HALF = 128, HTB = HALF * BK * 2  , STAGE_BYTES = 8 * HTB, NXCD = 8, WGM = 8;

__host__ __device__ __forceinline__ int lds_byte(int r, int c) { const int st = (r >> 4) * 2 + (c >> 5), rr = r & 15, cc = c & 31, ob = rr * 64 + cc * 2; return st * 1024 + (ob ^ (((ob >> 9) & 1) << 5)); }
__host__ __device__ __forceinline__ void stage_rc(int b, int& R, int& C) { const int st = b / 1024, sb = b % 1024, swz = sb ^ (((sb >> 9) & 1) << 5); R = (st >> 1) * 16 + swz / 64; C = (st & 1) * 32 + (swz % 64) / 2; }
__host__ __device__ __forceinline__ int perm32(int rho) { const int n = rho >> 4, i = rho & 15; return 8 * (i >> 2) + 4 * n + (i & 3); }

struct Unit { int pm, pn, kb; };
struct Gemm { const bf16_t* A; const bf16_t* Bt; int M, N, K, ld; };

struct StaticOrder {
    int nM, nN, nwg, G, c;
    __host__ __device__ void init(int M, int N, int G_, int c_) { nM = M / BM; nN = N / BM; nwg = nM * nN; G = G_; c = c_; }
    __host__ __device__ bool next(int i, Unit& u) const {
        const long L = (long)i * G + c; if (L >= nwg) return false;
        int wgid = (int)L; { const int q = nwg / NXCD, r = nwg % NXCD, xcd = wgid % NXCD, off = wgid / NXCD; wgid = (xcd < r ? xcd * (q + 1) : r * (q + 1) + (xcd - r) * q) + off; }
        const int nig = WGM * nN, gid = wgid / nig, fm = gid * WGM, gsz = (nM - fm) < WGM ? (nM - fm) : WGM;
        u.pm = fm + ((wgid % nig) % gsz); u.pn = (wgid % nig) / gsz; u.kb = 0; return true;
    }
    __device__ __forceinline__ void a_ready(const Unit&) const {}
    __device__ __forceinline__ void done(const Unit&) const {}
};

__device__ __forceinline__ unsigned cvt_pk_bf16(float lo, float hi) { unsigned r; asm volatile("v_cvt_pk_bf16_f32 %0, %1, %2" : "=v"(r) : "v"(lo), "v"(hi)); return r; }
template <class Epi, class Sched, bool ALIGN_EPI = false, bool SP2 = false>
__device__ __forceinline__ void gemm_phase(PG8_LAS unsigned char* lds, const Gemm g, const Sched& S, const Epi& E, const int tid) {
    const int wid = __builtin_amdgcn_readfirstlane(tid >> 6), lane = tid & 63, wr = wid >> 2, wc = wid & 3, fr = lane & 15, fq = lane >> 4;
    const int K = g.ld, nt = g.K / BK;
    unsigned voffA[2], voffB[2];
#pragma unroll
    for (int i = 0; i < 2; ++i) { int R, C; stage_rc(tid * 16 + i * 8192, R, C); const int Rb = Epi::PERM ? ((R & ~31) + perm32(R & 31)) : R;
        voffA[i] = (unsigned)(R * K + C) * 2u; voffB[i] = (unsigned)(Rb * K + C) * 2u; }
    const size_t kstep = (size_t)(BK * 2);
    const size_t hstep = (size_t)HALF * K * 2;
    const size_t tstep = 2 * hstep;
    const unsigned ldsw = (unsigned)wid * 1024u;
    const int aoff = lds_byte(wr * 64 + fr, fq * 8), boff = lds_byte(wc * 32 + fr, fq * 8);
#define PG8_SA(b, h) (((b) * 2 + (h)) * HTB)
#define PG8_SB(b, h) ((4 + (b) * 2 + (h)) * HTB)
#define PG8_STAGE(bufoff, gbase, voff) do { _Pragma("unroll") for (int _i = 0; _i < 2; ++_i) \
        __builtin_amdgcn_global_load_lds((const unsigned*)((const char*)(gbase) + (voff)[_i]), (PG8_LAS unsigned*)(lds + (bufoff) + ldsw + _i * 8192), 16, 0, 0); } while (0)
#define PG8_LDA(dst, b, h) do { _Pragma("unroll") for (int m = 0; m < 4; ++m) _Pragma("unroll") for (int k = 0; k < 2; ++k) dst[m][k] = *(const PG8_LAS bf16x8*)(lds + PG8_SA(b, h) + aoff + m * 2048 + k * 1024); } while (0)
#define PG8_LDB(dst, b, h) do { _Pragma("unroll") for (int n = 0; n < 2; ++n) _Pragma("unroll") for (int k = 0; k < 2; ++k) dst[n][k] = *(const PG8_LAS bf16x8*)(lds + PG8_SB(b, h) + boff + n * 2048 + k * 1024); } while (0)
#define PG8_MMA(ai, bj, At, Bt) do { __builtin_amdgcn_s_setprio(1); _Pragma("unroll") for (int m = 0; m < 4; ++m) _Pragma("unroll") for (int n = 0; n < 2; ++n) _Pragma("unroll") for (int k = 0; k < 2; ++k) \
        acc[ai][bj][m][n] = __builtin_amdgcn_mfma_f32_16x16x32_bf16(Bt[n][k], At[m][k], acc[ai][bj][m][n], 0, 0, 0); __builtin_amdgcn_s_setprio(0); } while (0)
#define PG8_WAIT_V(n) asm volatile("s_waitcnt vmcnt(" #n ")" ::: "memory")
#define PG8_WAIT_L(n) asm volatile("s_waitcnt lgkmcnt(" #n ")" ::: "memory")
#define PG8_BAR __builtin_amdgcn_s_barrier()
#define PG8_SCHED __builtin_amdgcn_sched_barrier(0)
    Unit cur, nxt; int ui = 0;
    if (!S.next(0, cur)) return;
    f32x4 acc[2][2][4][2];
#pragma unroll
    for (int a = 0; a < 2; ++a)
#pragma unroll
        for (int b = 0; b < 2; ++b)
#pragma unroll
            for (int m = 0; m < 4; ++m)
#pragma unroll
                for (int n = 0; n < 2; ++n) acc[a][b][m][n] = (f32x4){0.f, 0.f, 0.f, 0.f};
    bf16x8 At[4][2], B0[2][2], B1[2][2];
    const char* cA = (const char*)g.A + (size_t)cur.pm * tstep + cur.kb; const char* cB = (const char*)g.Bt + (size_t)cur.pn * tstep + cur.kb;
    S.a_ready(cur);
    if constexpr (SP2) {
        PG8_STAGE(PG8_SB(0, 0), cB, voffB); PG8_STAGE(PG8_SB(0, 1), cB + hstep, voffB); PG8_STAGE(PG8_SA(0, 0), cA, voffA); PG8_STAGE(PG8_SA(0, 1), cA + hstep, voffA);
        if (wr == 1) PG8_BAR;
        PG8_WAIT_V(2); PG8_BAR;
        PG8_STAGE(PG8_SB(1, 0), cB + kstep, voffB); PG8_STAGE(PG8_SA(1, 0), cA + kstep, voffA); PG8_STAGE(PG8_SB(1, 1), cB + hstep + kstep, voffB);
        PG8_WAIT_V(6); PG8_BAR;
    } else {
        PG8_STAGE(PG8_SB(0, 0), cB, voffB); PG8_STAGE(PG8_SA(0, 0), cA, voffA); PG8_STAGE(PG8_SB(0, 1), cB + hstep, voffB); PG8_STAGE(PG8_SA(0, 1), cA + hstep, voffA);
        if (wr == 1) PG8_BAR;
        PG8_WAIT_V(4); PG8_BAR;
        PG8_STAGE(PG8_SB(1, 0), cB + kstep, voffB); PG8_STAGE(PG8_SA(1, 0), cA + kstep, voffA); PG8_STAGE(PG8_SB(1, 1), cB + hstep + kstep, voffB);
        PG8_WAIT_V(6); PG8_BAR;
    }
    for (;;) {
        const bool has_next = S.next(ui + 1, nxt);
        const char* nA = has_next ? (const char*)g.A + (size_t)nxt.pm * tstep + nxt.kb : cA; const char* nB = has_next ? (const char*)g.Bt + (size_t)nxt.pn * tstep + nxt.kb : cB;
        for (int t = 0; t < nt; t += 2) {
            const bool last = (t == nt - 2);
            const char* a1 = cA + (size_t)(t + 1) * kstep;
            const char* a2 = last ? nA : cA + (size_t)(t + 2) * kstep; const char* b2 = last ? nB : cB + (size_t)(t + 2) * kstep;
            const char* a3 = a2 + kstep; const char* b3 = b2 + kstep;
            if (last && has_next) S.a_ready(nxt);
            if constexpr (SP2) {
            PG8_LDB(B0, 0, 0); PG8_LDB(B1, 0, 1); PG8_SCHED; PG8_LDA(At, 0, 0); PG8_STAGE(PG8_SA(1, 1), a1 + hstep, voffA);
            PG8_WAIT_V(8); PG8_WAIT_L(0); PG8_BAR; PG8_MMA(0, 0, At, B0); PG8_MMA(0, 1, At, B1); PG8_BAR; PG8_SCHED;
            PG8_LDA(At, 0, 1); PG8_STAGE(PG8_SB(0, 0), b2, voffB); PG8_STAGE(PG8_SB(0, 1), b2 + hstep, voffB); PG8_STAGE(PG8_SA(0, 0), a2, voffA);
            PG8_WAIT_V(8); PG8_WAIT_L(0); PG8_BAR; PG8_MMA(1, 0, At, B0); PG8_MMA(1, 1, At, B1); PG8_BAR; PG8_SCHED;
            PG8_LDB(B0, 1, 0); PG8_LDB(B1, 1, 1); PG8_SCHED; PG8_LDA(At, 1, 0); PG8_STAGE(PG8_SA(0, 1), a2 + hstep, voffA);
            PG8_WAIT_V(8); PG8_WAIT_L(0); PG8_BAR; PG8_MMA(0, 0, At, B0); PG8_MMA(0, 1, At, B1); PG8_BAR; PG8_SCHED;
            PG8_LDA(At, 1, 1); PG8_STAGE(PG8_SB(1, 0), b3, voffB); PG8_STAGE(PG8_SB(1, 1), b3 + hstep, voffB); PG8_STAGE(PG8_SA(1, 0), a3, voffA);
            PG8_WAIT_V(8); PG8_WAIT_L(0); PG8_BAR; PG8_MMA(1, 0, At, B0); PG8_MMA(1, 1, At, B1); PG8_BAR; PG8_SCHED;
            } else {
            PG8_LDB(B0, 0, 0); PG8_SCHED; PG8_LDA(At, 0, 0); PG8_STAGE(PG8_SA(1, 1), a1 + hstep, voffA);
            PG8_WAIT_L(8); PG8_BAR; PG8_WAIT_L(0); PG8_MMA(0, 0, At, B0); PG8_BAR; PG8_SCHED;
            PG8_LDB(B1, 0, 1); PG8_STAGE(PG8_SB(0, 0), b2, voffB);
            PG8_BAR; PG8_WAIT_L(0); PG8_MMA(0, 1, At, B1); PG8_BAR;
            PG8_LDA(At, 0, 1); PG8_STAGE(PG8_SA(0, 0), a2, voffA);
            PG8_BAR; PG8_WAIT_L(0); PG8_MMA(1, 0, At, B0); PG8_BAR; PG8_SCHED;
            PG8_STAGE(PG8_SB(0, 1), b2 + hstep, voffB);
            PG8_WAIT_V(6); PG8_BAR; PG8_MMA(1, 1, At, B1); PG8_BAR;
            PG8_LDB(B0, 1, 0); PG8_SCHED; PG8_LDA(At, 1, 0); PG8_STAGE(PG8_SA(0, 1), a2 + hstep, voffA);
            PG8_WAIT_L(8); PG8_BAR; PG8_WAIT_L(0); PG8_MMA(0, 0, At, B0); PG8_BAR; PG8_SCHED;
            PG8_LDB(B1, 1, 1); PG8_STAGE(PG8_SB(1, 0), b3, voffB);
            PG8_BAR; PG8_WAIT_L(0); PG8_MMA(0, 1, At, B1); PG8_BAR;
            PG8_LDA(At, 1, 1); PG8_STAGE(PG8_SA(1, 0), a3, voffA);
            PG8_BAR; PG8_WAIT_L(0); PG8_MMA(1, 0, At, B0); PG8_BAR; PG8_SCHED;
            PG8_STAGE(PG8_SB(1, 1), b3 + hstep, voffB);
            PG8_WAIT_V(6); PG8_BAR; PG8_MMA(1, 1, At, B1); PG8_BAR;
            }
        }
        if constexpr (ALIGN_EPI) { if (wr == 0) PG8_BAR; }
        if constexpr (!Epi::AFTER_DRAIN) { E(acc, cur, wr, wc, fr, fq); S.done(cur); }
        if (!has_next) break;
#pragma unroll
        for (int a = 0; a < 2; ++a)
#pragma unroll
            for (int b = 0; b < 2; ++b)
#pragma unroll
                for (int m = 0; m < 4; ++m)
#pragma unroll
                    for (int n = 0; n < 2; ++n) acc[a][b][m][n] = (f32x4){0.f, 0.f, 0.f, 0.f};
        cur = nxt; cA = nA; cB = nB; ++ui;
        if constexpr (ALIGN_EPI) { if (wr == 1) PG8_BAR; }
    }
    PG8_WAIT_V(0);
    if constexpr (!ALIGN_EPI) { if (wr == 0) PG8_BAR; }
    PG8_BAR;
    if constexpr (Epi::AFTER_DRAIN) { E.fused(acc, cur, wr, wc, fr, fq, lds, wid, lane); S.done(cur); }
#undef PG8_SA
#undef PG8_SB
#undef PG8_STAGE
#undef PG8_LDA
#undef PG8_LDB
#undef PG8_MMA
#undef PG8_WAIT_V
#undef PG8_WAIT_L
#undef PG8_BAR
#undef PG8_SCHED
}
}

#define LAS __attribute__((address_space(3)))
#define DI __device__ __forceinline__
#define GAS __attribute__((address_space(1)))
typedef unsigned short bf16;
typedef float f32x4 __attribute__((ext_vector_type(4)));
typedef float f32x16 __attribute__((ext_vector_type(16)));
typedef short bf16x8 __attribute__((ext_vector_type(8)));
typedef short s16x4 __attribute__((ext_vector_type(4)));
typedef unsigned u32x2 __attribute__((ext_vector_type(2)));
typedef unsigned u32x4 __attribute__((ext_vector_type(4)));
typedef float f32x2_t __attribute__((ext_vector_type(2)));
typedef __bf16 bf16x2_t __attribute__((ext_vector_type(2)));

#ifndef MK_MASK
#define MK_MASK 0x1ff
#endif
#define PH_EN(k) (((MK_MASK) >> (k)) & 1)
#ifndef MK_PER_PHASE
#define MK_PER_PHASE 0
#endif

constexpr int DM = 1024, NBATCH = 8, SEQ = 4096, DEPTH = 4, CTXL = 256, DFF = 4096;
constexpr int MX = NBATCH * SEQ, MC = NBATCH * CTXL, MT = MX + MC;
constexpr int INW = 1952, PJS = 1536;
constexpr float LOG2E = 1.4426950408889634f;
constexpr float C2A = 0.125f * LOG2E;
constexpr float C2C = 0.10206207261596575f * LOG2E;
constexpr float EPSN = 1e-6f;
constexpr int NTHR = 512;

constexpr size_t MiB = (size_t)1 << 20;
constexpr size_t WS_TAB = 0;
constexpr size_t WS_BAR = 65536;
constexpr size_t WS_MODS = 1 * MiB;
constexpr size_t WS_SSQ = 2 * MiB;
constexpr size_t WS_XC = 4 * MiB;
constexpr size_t WS_W = 12 * MiB;
constexpr size_t WL_IN = 0, WL_OUT = 4 * MiB, WL_W1 = 6 * MiB, WL_W2 = 14 * MiB, WL_UQ = 22 * MiB, WL_UKV = 22 * MiB + 256 * 1024, WL_STRIDE = 22 * MiB + 512 * 1024;
constexpr size_t WS_HN = 102 * MiB;
constexpr size_t WS_H1 = 170 * MiB;
constexpr size_t WS_PROJ = 170 * MiB;
constexpr size_t WS_CQ = 272 * MiB;
constexpr size_t WS_CKV = 289 * MiB;
constexpr size_t WS_QM = 298 * MiB;
constexpr size_t WS_KVM = 324 * MiB;
constexpr size_t WS_KRR = 358 * MiB;
constexpr size_t WS_MIX = 362 * MiB;
constexpr size_t WS_SSQX = 442 * MiB;
constexpr size_t WS_BIAS1 = 444 * MiB;
constexpr size_t WS_BIAS4 = 445 * MiB;
constexpr size_t WS_PART = 446 * MiB;
constexpr size_t WS_END = 510 * MiB;
constexpr int LDS_BYTES = 131072 + 256;

DI unsigned cvtpk(float lo, float hi) { f32x2_t v = {lo, hi}; bf16x2_t b = __builtin_convertvector(v, bf16x2_t); return __builtin_bit_cast(unsigned, b); }
DI void st4bf(bf16* p, f32x4 v) { u32x2 w; w.x = cvtpk(v[0], v[1]); w.y = cvtpk(v[2], v[3]); *(GAS u32x2*)p = w; }
DI float wave_sum(float v) {
#pragma unroll
    for (int o = 1; o < 64; o <<= 1) v += __shfl_xor(v, o);
    return v;
}
DI float fexp2(float x) { return __builtin_amdgcn_exp2f(x); }
DI float max3f(float a, float b, float c) { float r; asm("v_max3_f32 %0, %1, %2, %3" : "=v"(r) : "v"(a), "v"(b), "v"(c)); return r; }
#define LDS_WAIT() asm volatile("s_waitcnt lgkmcnt(0)" ::: "memory")

DI f32x4 rope8(f32x4 v, const float* tab  , int fq) {
    const int i0 = 4 * (fq & 1);
    const f32x4 cs = *(const f32x4*)(tab + i0), sn = *(const f32x4*)(tab + 8 + i0);
    f32x4 o;
#pragma unroll
    for (int j = 0; j < 4; ++j) { const float pr = __shfl_xor(v[j], 32); o[j] = (fq < 2) ? v[j] * cs[j] - pr * sn[j] : pr * sn[j] + v[j] * cs[j]; }
    return o;
}

struct EpiInProj {
    static constexpr bool PERM = false, AFTER_DRAIN = false;
    bf16 *proj, *cqb, *ckvb, *krr; float *ssq_q, *ssq_kv; const float *tabA, *tabC; const float *ssqx, *bias;
    DI void operator()(const f32x4 (&acc0)[2][2][4][2], const pg8::Unit& u, int wr, int wc, int fr, int fq) const {
        const int pn = u.pn; const bool isx = u.pm < 128; const int mi = isx ? (u.pm >> 4) : 8;
        f32x4 bv[2][2];
#pragma unroll
        for (int bj = 0; bj < 2; ++bj)
#pragma unroll
            for (int n = 0; n < 2; ++n) bv[bj][n] = *(const f32x4*)(bias + mi * 2048 + pn * 256 + bj * 128 + wc * 32 + n * 16 + 4 * fq);
#pragma unroll
        for (int ai = 0; ai < 2; ++ai)
#pragma unroll
            for (int m = 0; m < 4; ++m) {
                int row = u.pm * 256 + ai * 128 + wr * 64 + m * 16 + fr;
                asm volatile("" : "+v"(row) :: "memory");
                const int tok = row & 4095, prow = tok >> 6, pcol = tok & 63;
                const float rsx = rsqrtf(ssqx[row] * (1.0f / 1024.0f) + EPSN);
                f32x4 acc[2][2];
#pragma unroll
                for (int bj = 0; bj < 2; ++bj)
#pragma unroll
                    for (int n = 0; n < 2; ++n) acc[bj][n] = acc0[ai][bj][m][n] * rsx + bv[bj][n];
                if (pn < 6) {
                    const bool anyrope = isx && pn <= 2;
                    f32x4 cs = {1.f, 1.f, 1.f, 1.f}, sn = {0.f, 0.f, 0.f, 0.f};
                    if (anyrope) { const int pos = (wc & 1) ? pcol : prow; cs = *(const f32x4*)(tabA + pos * 32 + 4 * fq); sn = *(const f32x4*)(tabA + pos * 32 + 16 + 4 * fq); }
#pragma unroll
                    for (int bj = 0; bj < 2; ++bj) {
                        f32x4 v0 = acc[bj][0], v1 = acc[bj][1];
                        if (anyrope && (pn < 2 || bj == 0)) { const f32x4 a = v0 * cs - v1 * sn, b = v0 * sn + v1 * cs; v0 = a; v1 = b; }
                        if (pn < 2 || pn == 3) { v0 *= C2A; v1 *= C2A; }
                        bf16* p = proj + (size_t)row * PJS + pn * 256 + bj * 128 + wc * 32 + 4 * fq;
                        st4bf(p, v0); st4bf(p + 16, v1);
                    }
                } else if (pn == 6) {
                    float s = 0.f;
#pragma unroll
                    for (int bj = 0; bj < 2; ++bj) {
                        const f32x4 v0 = acc[bj][0], v1 = acc[bj][1];
                        s += (v0[0] * v0[0] + v0[1] * v0[1]) + (v0[2] * v0[2] + v0[3] * v0[3]) + (v1[0] * v1[0] + v1[1] * v1[1]) + (v1[2] * v1[2] + v1[3] * v1[3]);
                        bf16* p = cqb + (size_t)row * 256 + bj * 128 + wc * 32 + 4 * fq;
                        st4bf(p, v0); st4bf(p + 16, v1);
                    }
                    s += __shfl_xor(s, 16); s += __shfl_xor(s, 32);
                    if (fq == 0) atomicAdd(ssq_q + row, s);
                } else {
                    {
                        const f32x4 v0 = acc[0][0], v1 = acc[0][1];
                        float s = (v0[0] * v0[0] + v0[1] * v0[1]) + (v0[2] * v0[2] + v0[3] * v0[3]) + (v1[0] * v1[0] + v1[1] * v1[1]) + (v1[2] * v1[2] + v1[3] * v1[3]);
                        bf16* p = ckvb + (size_t)row * 128 + wc * 32 + 4 * fq;
                        st4bf(p, v0); st4bf(p + 16, v1);
                        s += __shfl_xor(s, 16); s += __shfl_xor(s, 32);
                        if (fq == 0) atomicAdd(ssq_kv + row, s);
                    }
                    if (wc == 0) {
                        f32x4 v0 = acc[1][0], v1 = acc[1][1];
                        if (isx) { v0 = rope8(v0, tabC + prow * 16, fq); v1 = rope8(v1, tabC + pcol * 16, fq); }
                        bf16* p = krr + (size_t)row * 32 + 4 * fq;
                        st4bf(p, v0); st4bf(p + 16, v1);
                    }
                }
            }
    }
};

struct EpiUQ {
    static constexpr bool PERM = false, AFTER_DRAIN = false;
    bf16* qm; const float* ssq_q; const float* tabC;
    DI void operator()(const f32x4 (&acc)[2][2][4][2], const pg8::Unit& u, int wr, int wc, int fr, int fq) const {
        const int pn = u.pn; const bool isx = u.pm < 128;
#pragma unroll
        for (int ai = 0; ai < 2; ++ai)
#pragma unroll
            for (int m = 0; m < 4; ++m) {
                int row = u.pm * 256 + ai * 128 + wr * 64 + m * 16 + fr;
                asm volatile("" : "+v"(row) :: "memory");
                const int tok = row & 4095, prow = tok >> 6, pcol = tok & 63;
                const float rs = rsqrtf(ssq_q[row] * (1.0f / 256.0f) + EPSN) * C2C;
#pragma unroll
                for (int bj = 0; bj < 2; ++bj)
#pragma unroll
                    for (int n = 0; n < 2; ++n) {
                        const int col0 = pn * 256 + bj * 128 + wc * 32 + n * 16;
                        if (col0 < 384) {
                            f32x4 v = acc[ai][bj][m][n] * rs;
                            const int g6 = (col0 >> 4) % 6;
                            if (isx && g6 >= 4) v = rope8(v, tabC + (g6 == 4 ? prow : pcol) * 16, fq);
                            st4bf(qm + (size_t)row * 384 + col0 + 4 * fq, v);
                        }
                    }
            }
    }
};

struct EpiUKV {
    static constexpr bool PERM = false, AFTER_DRAIN = false;
    bf16* kvm; const float* ssq_kv;
    DI void operator()(const f32x4 (&acc)[2][2][4][2], const pg8::Unit& u, int wr, int wc, int fr, int fq) const {
#pragma unroll
        for (int ai = 0; ai < 2; ++ai)
#pragma unroll
            for (int m = 0; m < 4; ++m) {
                int row = u.pm * 256 + ai * 128 + wr * 64 + m * 16 + fr;
                asm volatile("" : "+v"(row) :: "memory");
                const float rs = rsqrtf(ssq_kv[row] * (1.0f / 128.0f) + EPSN);
#pragma unroll
                for (int bj = 0; bj < 2; ++bj)
#pragma unroll
                    for (int n = 0; n < 2; ++n) {
                        const int col0 = u.pn * 256 + bj * 128 + wc * 32 + n * 16;
                        st4bf(kvm + (size_t)row * 512 + col0 + 4 * fq, acc[ai][bj][m][n] * rs);
                    }
            }
    }
};

struct EpiRelu2 {
    static constexpr bool PERM = true, AFTER_DRAIN = false;
    bf16* H; const float *ssqx, *bias;
    DI void operator()(const f32x4 (&acc)[2][2][4][2], const pg8::Unit& u, int wr, int wc, int fr, int fq) const {
        const int col0 = u.pn * 256 + wc * 32 + 8 * fq; const int mi = (u.pm < 128) ? (u.pm >> 4) : 8;
        f32x4 bv[2][2];
#pragma unroll
        for (int bj = 0; bj < 2; ++bj)
#pragma unroll
            for (int n = 0; n < 2; ++n) bv[bj][n] = *(const f32x4*)(bias + mi * 4096 + col0 + bj * 128 + 4 * n);
#pragma unroll
        for (int ai = 0; ai < 2; ++ai)
#pragma unroll
            for (int m = 0; m < 4; ++m) {
                int row = u.pm * 256 + ai * 128 + wr * 64 + m * 16 + fr;
                asm volatile("" : "+v"(row) :: "memory");
                const float rsx = rsqrtf(ssqx[row] * (1.0f / 1024.0f) + EPSN);
                bf16* rowp = H + (size_t)row * DFF + col0;
#pragma unroll
                for (int bj = 0; bj < 2; ++bj) {
                    f32x4 v0 = acc[ai][bj][m][0] * rsx + bv[bj][0], v1 = acc[ai][bj][m][1] * rsx + bv[bj][1];
#pragma unroll
                    for (int j = 0; j < 4; ++j) { const float a = fmaxf(v0[j], 0.f), b = fmaxf(v1[j], 0.f); v0[j] = a * a; v1[j] = b * b; }
                    u32x4 w; w.x = cvtpk(v0[0], v0[1]); w.y = cvtpk(v0[2], v0[3]); w.z = cvtpk(v1[0], v1[1]); w.w = cvtpk(v1[2], v1[3]);
                    *(GAS u32x4*)(rowp + bj * 128) = w;
                }
            }
    }
};

struct EpiResid {
    static constexpr bool PERM = false, AFTER_DRAIN = false;
    const float *srcx, *srcc; float *dstx, *dstc; const float* gate; bf16* xg; float* ssq_out; const float *gn, *scn; int donorm;
    DI void operator()(const f32x4 (&acc)[2][2][4][2], const pg8::Unit& u, int wr, int wc, int fr, int fq) const {
        const bool isx = u.pm < 128; const int mi = isx ? (u.pm >> 4) : 8;
        const int col0 = u.pn * 256 + wc * 32 + 4 * fq;
        f32x4 gv[2][2], gp[2][2];
#pragma unroll
        for (int bj = 0; bj < 2; ++bj)
#pragma unroll
            for (int n = 0; n < 2; ++n) { const int c = col0 + bj * 128 + n * 16; gv[bj][n] = *(const f32x4*)(gate + mi * 6144 + c);
                gp[bj][n] = donorm ? *(const f32x4*)(gn + c) * (*(const f32x4*)(scn + mi * 6144 + c) + 1.0f) : (f32x4){0.f, 0.f, 0.f, 0.f}; }
#pragma unroll
        for (int ai = 0; ai < 2; ++ai)
#pragma unroll
            for (int m = 0; m < 4; ++m) {
                int row = u.pm * 256 + ai * 128 + wr * 64 + m * 16 + fr;
                asm volatile("" : "+v"(row) :: "memory");
                const float* s = isx ? srcx + (size_t)row * DM : srcc + (size_t)(row - MX) * DM;
                float* d = isx ? dstx + (size_t)row * DM : dstc + (size_t)(row - MX) * DM;
                float ss = 0.f;
#pragma unroll
                for (int bj = 0; bj < 2; ++bj)
#pragma unroll
                    for (int n = 0; n < 2; ++n) { const int off = col0 + bj * 128 + n * 16;
                        const f32x4 xn = *(const GAS f32x4*)(s + off) + gv[bj][n] * acc[ai][bj][m][n];
                        *(GAS f32x4*)(d + off) = xn;
                        if (donorm) { ss += (xn[0] * xn[0] + xn[1] * xn[1]) + (xn[2] * xn[2] + xn[3] * xn[3]); st4bf(xg + (size_t)row * DM + off, xn * gp[bj][n]); } }
                if (donorm) { ss += __shfl_xor(ss, 16); ss += __shfl_xor(ss, 32); if (fq == 0) atomicAdd(ssq_out + row, ss); }
            }
    }
};

struct SplitOrder {
    int G, c, NS, ksub_bytes;
    DI void init(int G_, int c_, int NS_, int Ksub) { G = G_; c = c_; NS = NS_; ksub_bytes = Ksub * 2; }
    DI bool next(int i, pg8::Unit& u) const { const int idx = i * G + c; if (idx >= 32 * NS) return false; const int ks = idx % NS, tile = idx / NS; u.pn = tile & 3; u.pm = 128 + (tile >> 2); u.kb = ks * ksub_bytes; return true; }
    DI void a_ready(const pg8::Unit&) const {}
    DI void done(const pg8::Unit&) const {}
};
struct EpiPartial {
    static constexpr bool PERM = false, AFTER_DRAIN = false;
    float* part; int ksub_bytes;
    DI void operator()(const f32x4 (&acc)[2][2][4][2], const pg8::Unit& u, int wr, int wc, int fr, int fq) const {
        const int ks = u.kb / ksub_bytes; const int col0 = u.pn * 256 + wc * 32 + 4 * fq;
        float* base = part + (size_t)ks * MC * DM;
#pragma unroll
        for (int ai = 0; ai < 2; ++ai)
#pragma unroll
            for (int m = 0; m < 4; ++m) {
                int row = (u.pm - 128) * 256 + ai * 128 + wr * 64 + m * 16 + fr;
                asm volatile("" : "+v"(row) :: "memory");
                float* rowp = base + (size_t)row * DM + col0;
#pragma unroll
                for (int bj = 0; bj < 2; ++bj)
#pragma unroll
                    for (int n = 0; n < 2; ++n) *(GAS f32x4*)(rowp + bj * 128 + n * 16) = acc[ai][bj][m][n];
            }
    }
};
DI void ctx_finish(const float* part, int NS, const float* src, float* dst, const float* gate8, bf16* xg, float* ssq_out, const float* gn, const float* scn8, const int tid) {
    const int lane = tid & 63, gw = blockIdx.x * 8 + (tid >> 6), NGW = gridDim.x * 8;
    for (int row = gw; row < MC; row += NGW) {
        float s = 0.f;
#pragma unroll
        for (int j = 0; j < 4; ++j) {
            const int col = 256 * j + 4 * lane;
            f32x4 a = {0.f, 0.f, 0.f, 0.f};
            for (int ks = 0; ks < NS; ++ks) a += *(const GAS f32x4*)(part + ((size_t)ks * MC + row) * DM + col);
            const f32x4 xn = *(const GAS f32x4*)(src + (size_t)row * DM + col) + *(const GAS f32x4*)(gate8 + col) * a;
            *(GAS f32x4*)(dst + (size_t)row * DM + col) = xn;
            s += (xn[0] * xn[0] + xn[1] * xn[1]) + (xn[2] * xn[2] + xn[3] * xn[3]);
            st4bf(xg + (size_t)(MX + row) * DM + col, xn * (*(const GAS f32x4*)(gn + col) * (*(const GAS f32x4*)(scn8 + col) + 1.0f)));
        }
        s = wave_sum(s);
        if (lane == 0) ssq_out[MX + row] = s;
    }
}

DI void transpose_item(const float* W, int K, int N, bf16* WT, const float* kscale, LAS float* scr, int item, int lane) {
    const int nblk = N / 32, kb = item / nblk, nb = item % nblk, k0 = 64 * kb, n0 = 32 * nb;
#pragma unroll 16
    for (int i = 0; i < 32; ++i) { const int kk = 2 * i + (lane >> 5); float w = W[(size_t)(k0 + kk) * N + n0 + (lane & 31)]; if (kscale) w *= kscale[k0 + kk]; scr[kk * 33 + (lane & 31)] = w; }
    LDS_WAIT();
    const int c = lane & 7;
#pragma unroll
    for (int j = 0; j < 4; ++j) { const int n = (lane >> 3) + 8 * j; const LAS float* s = scr + (8 * c) * 33 + n;
        u32x4 o; o.x = cvtpk(s[0 * 33], s[1 * 33]); o.y = cvtpk(s[2 * 33], s[3 * 33]); o.z = cvtpk(s[4 * 33], s[5 * 33]); o.w = cvtpk(s[6 * 33], s[7 * 33]);
        *(u32x4*)(WT + (size_t)(n0 + n) * K + k0 + 8 * c) = o; }
    LDS_WAIT();
}

DI void gemv9_item(const float* W, int ldw, int nvalid, int n0, const LAS float* sl, LAS float* red, const float* addb, float* out, int ldo, const int tid) {
    const int col = tid & 31, kg = tid >> 5, n = n0 + col;
    float acc[9];
#pragma unroll
    for (int mi = 0; mi < 9; ++mi) acc[mi] = 0.f;
    if (n < nvalid) {
        const float* w = W + (size_t)(kg * 64) * ldw + n;
#pragma unroll 16
        for (int k = 0; k < 64; ++k) { const float wv = w[(size_t)k * ldw];
#pragma unroll
            for (int mi = 0; mi < 9; ++mi) acc[mi] += sl[mi * 1024 + kg * 64 + k] * wv; }
    }
#pragma unroll
    for (int mi = 0; mi < 9; ++mi) red[(kg * 9 + mi) * 32 + col] = acc[mi];
    __syncthreads();
    if (tid < 288) { const int mi = tid >> 5, cq = tid & 31; float sacc = (addb && n0 + cq < nvalid) ? addb[n0 + cq] : 0.f;
#pragma unroll
        for (int g = 0; g < 16; ++g) sacc += red[(g * 9 + mi) * 32 + cq];
        out[(size_t)mi * ldo + n0 + cq] = sacc; }
    __syncthreads();
}

struct Args { const float* in[19]; float* out; unsigned char* ws; int ph_lo, ph_hi; };

DI void prologue(const Args& a, LAS unsigned char* lds, const int tid) {
    const int lane = tid & 63, wave = __builtin_amdgcn_readfirstlane(tid >> 6);
    int G = gridDim.x; asm volatile("" : "+s"(G));
    const int bx = blockIdx.x;
    unsigned char* ws = a.ws;
    {
        LAS float* sl = (LAS float*)lds;
        LAS float* red = (LAS float*)(lds + 36864);
        const float* c = a.in[1]; const float* cc = a.in[3]; const float* w_ada = a.in[4]; const float* b_ada = a.in[5];
        float* mods = (float*)(ws + WS_MODS);
        for (int idx = tid; idx < 9 * 1024; idx += NTHR) { const int mi = idx >> 10, k = idx & 1023; const float v = mi < 8 ? c[mi * 1024 + k] : cc[k]; sl[idx] = v / (1.0f + expf(-v)); }
        __syncthreads();
        for (int item = bx; item < DEPTH * 192; item += G) {
            const int l = item / 192, n0 = (item % 192) * 32;
            gemv9_item(w_ada + (size_t)l * 1024 * 6144, 6144, 6144, n0, sl, red, b_ada + l * 6144, mods + (size_t)l * 9 * 6144, 6144, tid);
        }
    }
    {
        const int gid = bx * NTHR + tid, NG = G * NTHR;
        float* tabA = (float*)(ws + WS_TAB); float* tabC = tabA + 2048;
        if (gid < 1024) { const int pos = gid >> 4, i = gid & 15; const float fr = exp2f(-(float)i * (1.0f / 16.0f) * 13.287712379549449f); const float rev = ((float)pos * fr) * 0.15915494309189535f;
            tabA[pos * 32 + i] = __builtin_amdgcn_cosf(rev); tabA[pos * 32 + 16 + i] = __builtin_amdgcn_sinf(rev); }
        else if (gid < 1536) { const int g = gid - 1024, pos = g >> 3, i = g & 7; const float fr = exp2f(-(float)i * (1.0f / 8.0f) * 13.287712379549449f); const float rev = ((float)pos * fr) * 0.15915494309189535f;
            tabC[pos * 16 + i] = __builtin_amdgcn_cosf(rev); tabC[pos * 16 + 8 + i] = __builtin_amdgcn_sinf(rev); }
        float* ssq = (float*)(ws + WS_SSQ);
        for (int i = gid; i < DEPTH * 2 * MT; i += NG) ssq[i] = 0.f;
        float* ssqx = (float*)(ws + WS_SSQX);
        for (int i = gid; i < DEPTH * 2 * MT; i += NG) ssqx[i] = 0.f;
        const u32x4 z = {0u, 0u, 0u, 0u};
        for (int i = gid; i < DEPTH * 12288; i += NG) { const int l = i / 12288, r = i % 12288; ((u32x4*)(ws + WS_W + l * WL_STRIDE + WL_IN + (size_t)INW * 1024 * 2))[r] = z; }
        for (int i = gid; i < DEPTH * 4096; i += NG) { const int l = i / 4096, r = i % 4096; ((u32x4*)(ws + WS_W + l * WL_STRIDE + WL_UQ + (size_t)384 * 256 * 2))[r] = z; }
    }
    {
        LAS float* scr = (LAS float*)(lds + wave * 16384);
        const int gw = bx * 8 + wave, NGW = G * 8;
        constexpr int I_IN = 16 * 61, I_OUT = 16 * 32, I_W1 = 16 * 128, I_W2 = 64 * 32, I_UQ = 4 * 12, I_UKV = 2 * 16, I_L = I_IN + I_OUT + I_W1 + I_W2 + I_UQ + I_UKV;
        for (int it = gw; it < DEPTH * I_L; it += NGW) {
            const int l = it / I_L; int r = it % I_L; unsigned char* wb = ws + WS_W + l * WL_STRIDE;
            if (r < I_IN) { transpose_item(a.in[8] + (size_t)l * 1024 * INW, 1024, INW, (bf16*)(wb + WL_IN), nullptr, scr, r, lane); continue; } r -= I_IN;
            if (r < I_OUT) { transpose_item(a.in[15] + (size_t)l * 1024 * 1024, 1024, 1024, (bf16*)(wb + WL_OUT), nullptr, scr, r, lane); continue; } r -= I_OUT;
            if (r < I_W1) { transpose_item(a.in[16] + (size_t)l * 1024 * 4096, 1024, 4096, (bf16*)(wb + WL_W1), nullptr, scr, r, lane); continue; } r -= I_W1;
            if (r < I_W2) { transpose_item(a.in[17] + (size_t)l * 4096 * 1024, 4096, 1024, (bf16*)(wb + WL_W2), nullptr, scr, r, lane); continue; } r -= I_W2;
            if (r < I_UQ) { transpose_item(a.in[12] + (size_t)l * 256 * 384, 256, 384, (bf16*)(wb + WL_UQ), a.in[11] + l * 256, scr, r, lane); continue; } r -= I_UQ;
            transpose_item(a.in[14] + (size_t)l * 128 * 512, 128, 512, (bf16*)(wb + WL_UKV), a.in[13] + l * 128, scr, r, lane);
        }
    }
}

DI void phase1(const Args& a, LAS unsigned char* lds, const int tid) {
    unsigned char* ws = a.ws;
    int G = gridDim.x; asm volatile("" : "+s"(G));
    const int bx = blockIdx.x;
    const float* mods = (const float*)(ws + WS_MODS);
    {
        LAS float* sl = (LAS float*)lds; LAS float* red = (LAS float*)(lds + 36864);
        float* bias1 = (float*)(ws + WS_BIAS1); float* bias4 = (float*)(ws + WS_BIAS4);
        for (int item = bx; item < DEPTH * 192; item += G) {
            const int l = item / 192, r = item % 192, which = r < 64 ? 0 : 1, tile = which ? r - 64 : r;
            const float* mv = mods + (size_t)l * 9 * 6144 + (which ? 3 : 0) * 1024;
            for (int idx = tid; idx < 9 * 1024; idx += NTHR) sl[idx] = mv[(size_t)(idx >> 10) * 6144 + (idx & 1023)];
            __syncthreads();
            if (!which) gemv9_item(a.in[8] + (size_t)l * 1024 * INW, INW, INW, tile * 32, sl, red, nullptr, bias1 + (size_t)l * 9 * 2048, 2048, tid);
            else gemv9_item(a.in[16] + (size_t)l * 1024 * DFF, DFF, DFF, tile * 32, sl, red, nullptr, bias4 + (size_t)l * 9 * 4096, 4096, tid);
        }
    }
    {
        const int lane = tid & 63, gw = bx * 8 + (tid >> 6), NGW = G * 8;
        bf16* Hn = (bf16*)(ws + WS_HN); float* ssqx = (float*)(ws + WS_SSQX); const float* g = a.in[6];
        for (int row = gw; row < MT; row += NGW) {
            const float* src = row < MX ? a.in[0] + (size_t)row * DM : a.in[2] + (size_t)(row - MX) * DM;
            const int mi = row < MX ? (row >> 12) : 8;
            const f32x4* xr = (const f32x4*)src + lane;
            f32x4 v[4]; float s = 0.f;
#pragma unroll
            for (int j = 0; j < 4; ++j) { v[j] = xr[64 * j]; s += (v[j][0] * v[j][0] + v[j][1] * v[j][1]) + (v[j][2] * v[j][2] + v[j][3] * v[j][3]); }
            s = wave_sum(s);
            if (lane == 0) ssqx[row] = s;
            const float* mrow = mods + (size_t)mi * 6144 + 1024;
#pragma unroll
            for (int j = 0; j < 4; ++j) { const int col = 256 * j + 4 * lane;
                const f32x4 gg = *(const f32x4*)(g + col), sc = *(const f32x4*)(mrow + col);
                st4bf(Hn + (size_t)row * DM + col, v[j] * (gg * (sc + 1.0f))); }
        }
    }
}
DI void final_norm_phase(float* x, const float* g, const int tid) {
    const int lane = tid & 63, gw = blockIdx.x * 8 + (tid >> 6), NGW = gridDim.x * 8;
    for (int row = gw; row < MX; row += NGW) {
        f32x4* xr = (f32x4*)(x + (size_t)row * DM) + lane;
        f32x4 v[4]; float s = 0.f;
#pragma unroll
        for (int j = 0; j < 4; ++j) { v[j] = xr[64 * j]; s += (v[j][0] * v[j][0] + v[j][1] * v[j][1]) + (v[j][2] * v[j][2] + v[j][3] * v[j][3]); }
        const float r = rsqrtf(wave_sum(s) * (1.0f / DM) + EPSN);
#pragma unroll
        for (int j = 0; j < 4; ++j) { const f32x4 gg = *(const f32x4*)(g + 256 * j + 4 * lane); xr[64 * j] = v[j] * r * gg; }
    }
}

struct AttnP { const bf16 *proj, *qm, *kvm, *krr; bf16* mix; const float* sink; const float* rpb; };
constexpr int A_VS = 144, A_KB = 64 * 208, A_VB = 64 * A_VS, L_K = 0, L_V = 2 * A_KB, L_B = L_V + 2 * A_VB;

template <int TYPE> DI int key_row(int t, int j, int b, int nblk, int kr0, int kc0) {
    if (t < 4) return MX + b * 256 + t * 64 + j;
    const int tt = t - 4;
    if (TYPE == 0) return b * 4096 + (nblk - 1) * 128 + tt * 64 + j;
    if (TYPE == 1) { const int tr = tt / 3, tc = tt - 3 * tr; return b * 4096 + (kr0 + 4 * tr + (j >> 4)) * 64 + kc0 + 16 * tc + (j & 15); }
    return b * 4096 + tt * 64 + j;
}

constexpr float ATHR = 6.0f;
template <int TYPE> struct AttnCtx { int t_qi, t_h, kr0, kc0, qr, qc, wr_, wc_; };

template <int TYPE, int NKS, int KSTR> DI void at_mfma_block(f32x16& p0, f32x16& p1, f32x16& o0, f32x16& o1, const bf16x8 (&qf)[NKS], const bf16x8 (&pf)[4], float m_,
                                                             const LAS unsigned char* kb0, const LAS unsigned char* vb, bool do_s, bool do_pv) {
    if (do_s) {
        const float nm = -m_;
#pragma unroll
        for (int i = 0; i < 16; ++i) { p0[i] = nm; p1[i] = nm; }
#pragma unroll
        for (int ks = 0; ks < NKS; ++ks) {
            const bf16x8 a0 = *(const LAS bf16x8*)(kb0 + ks * 32), a1 = *(const LAS bf16x8*)(kb0 + 32 * KSTR + ks * 32);
            p0 = __builtin_amdgcn_mfma_f32_32x32x16_bf16(a0, qf[ks], p0, 0, 0, 0);
            p1 = __builtin_amdgcn_mfma_f32_32x32x16_bf16(a1, qf[ks], p1, 0, 0, 0);
            if (ks & 1) asm volatile("" ::: "memory");
        }
    }
    if (do_pv) {
#pragma unroll
        for (int s = 0; s < 4; ++s) {
#pragma unroll
            for (int c = 0; c < 2; ++c) {
                const s16x4 lo = __builtin_bit_cast(s16x4, __builtin_amdgcn_ds_read_tr16_b64_v4i16((LAS s16x4*)(vb + (16 * s) * A_VS + c * 64)));
                const s16x4 hi = __builtin_bit_cast(s16x4, __builtin_amdgcn_ds_read_tr16_b64_v4i16((LAS s16x4*)(vb + (16 * s + 8) * A_VS + c * 64)));
                const bf16x8 vf = __builtin_shufflevector(lo, hi, 0, 1, 2, 3, 4, 5, 6, 7);
                if (c == 0) o0 = __builtin_amdgcn_mfma_f32_32x32x16_bf16(vf, pf[s], o0, 0, 0, 0);
                else o1 = __builtin_amdgcn_mfma_f32_32x32x16_bf16(vf, pf[s], o1, 0, 0, 0);
            }
            asm volatile("" ::: "memory");
        }
    }
}

template <int TYPE> DI void at_valu_block(f32x16& p0, f32x16& p1, f32x16& o0, f32x16& o1, bf16x8 (&pf)[4], float& m_, float& l_, int t, bool first,
                                          int qi, int h, int kr0, int kc0, int qr, int qc, int wr_, int wc_, const LAS float* lbias) {
    if (t >= 4) {
        if (TYPE == 0) {
            const int d0 = 64 * (t - 4) - qi + 4 * h;
#pragma unroll
            for (int i = 0; i < 16; ++i) { const int e = d0 + (i & 3) + 8 * (i >> 2);
                if ((unsigned)e > 256u) p0[i] = -1e30f;
                if ((unsigned)(e + 32) > 256u) p1[i] = -1e30f; }
        } else if (TYPE == 1) {
            const int tt = t - 4, tr = tt / 3, tc = tt - 3 * tr;
            const int krb = kr0 + 4 * tr, kcb = kc0 + 16 * tc + 4 * h;
#pragma unroll
            for (int i = 0; i < 16; ++i) {
                const int kc = kcb + (i & 3) + 8 * ((i >> 2) & 1);
                const bool cv = (unsigned)(kc - wc_) < 16u;
                const int ci = kc - qc + 15;
                { const int kr = krb + (i >> 3); const bool v = cv && ((unsigned)(kr - wr_) < 8u); const int idx = v ? (kr - qr + 7) * 31 + ci : 0; const float bv = lbias[idx]; p0[i] = v ? p0[i] + bv : -1e30f; }
                { const int kr = krb + 2 + (i >> 3); const bool v = cv && ((unsigned)(kr - wr_) < 8u); const int idx = v ? (kr - qr + 7) * 31 + ci : 0; const float bv = lbias[idx]; p1[i] = v ? p1[i] + bv : -1e30f; }
            }
        }
    }
    asm volatile("s_nop 15\n\ts_nop 7" : "+v"(p0), "+v"(p1));
    float mxa = max3f(p0[0], p0[1], p1[0]), mxb = max3f(p0[2], p0[3], p1[1]); mxa = max3f(mxa, p1[2], p1[3]);
#pragma unroll
    for (int i = 4; i < 16; i += 4) { mxa = max3f(mxa, p0[i], p0[i + 1]); mxb = max3f(mxb, p0[i + 2], p0[i + 3]); mxa = max3f(mxa, p1[i], p1[i + 1]); mxb = max3f(mxb, p1[i + 2], p1[i + 3]); }
    float mx = max3f(mxa, mxb, mxb);
    mx = max3f(mx, __shfl_xor(mx, 32), mx);
    if (first || __any(mx > ATHR)) {
        const float dl = (TYPE != 0 && first) ? mx : fmaxf(mx, 0.f);
        const float alpha = fexp2(-dl);
        m_ += dl; l_ *= alpha;
#pragma unroll
        for (int i = 0; i < 16; ++i) { p0[i] -= dl; p1[i] -= dl; o0[i] *= alpha; o1[i] *= alpha; }
    }
    float ls = 0.f;
#pragma unroll
    for (int i = 0; i < 16; ++i) { p0[i] = fexp2(p0[i]); p1[i] = fexp2(p1[i]); ls += p0[i] + p1[i]; }
    l_ += ls;
#pragma unroll
    for (int s = 0; s < 4; ++s) {
        u32x4 pw;
        if (s < 2) { pw.x = cvtpk(p0[8 * s + 0], p0[8 * s + 1]); pw.y = cvtpk(p0[8 * s + 2], p0[8 * s + 3]); pw.z = cvtpk(p0[8 * s + 4], p0[8 * s + 5]); pw.w = cvtpk(p0[8 * s + 6], p0[8 * s + 7]); }
        else { const int s2 = s - 2; pw.x = cvtpk(p1[8 * s2 + 0], p1[8 * s2 + 1]); pw.y = cvtpk(p1[8 * s2 + 2], p1[8 * s2 + 3]); pw.z = cvtpk(p1[8 * s2 + 4], p1[8 * s2 + 5]); pw.w = cvtpk(p1[8 * s2 + 6], p1[8 * s2 + 7]); }
        pf[s] = __builtin_bit_cast(bf16x8, pw);
    }
}

template <int TYPE> DI void attn_unit(const AttnP& P, int uid, bool isctx, LAS unsigned char* lds, const int tid) {
    constexpr int DQK = TYPE == 2 ? 96 : 64, NKS = DQK / 16, KSTR = DQK * 2 + 16;
    const int lane = tid & 63, w = __builtin_amdgcn_readfirstlane(tid >> 6), r = lane & 31, h = lane >> 5;
    int b, hd, kvh = 0, qrow, nblk = 0, kr0 = 0, kc0 = 0, qr = 0, qc = 0, tb0 = 4, tb1 = 4;
    if (TYPE == 0) {
        int gp;
        if (!isctx) { b = uid >> 7; kvh = (uid >> 6) & 1; nblk = (uid >> 1) & 31; gp = uid & 1; qrow = b * 4096 + nblk * 128 + (w & 3) * 32 + r; tb0 = nblk == 0 ? 6 : 4; tb1 = nblk == 31 ? 8 : 10; }
        else { b = uid >> 3; kvh = (uid >> 2) & 1; gp = (uid >> 1) & 1; nblk = uid & 1; qrow = MX + b * 256 + nblk * 128 + (w & 3) * 32 + r; }
        hd = kvh * 4 + gp * 2 + (w >> 2);
    } else if (TYPE == 1) {
        if (!isctx) { b = uid >> 6; hd = (uid >> 4) & 3; const int ib = (uid >> 1) & 7, cp = uid & 1;
            qr = 8 * ib + 2 * (w & 3) + (r >> 4); qc = 16 * (2 * cp + (w >> 2)) + (r & 15); qrow = b * 4096 + qr * 64 + qc;
            kr0 = min(max(8 * ib - 4, 0), 48); kc0 = 16 * cp; tb1 = 16; }
        else { b = uid >> 2; hd = uid & 3; qrow = MX + b * 256 + w * 32 + r; }
    } else {
        if (!isctx) { b = uid >> 6; hd = (uid >> 4) & 3; qrow = b * 4096 + (uid & 15) * 256 + w * 32 + r; tb1 = 68; }
        else { b = uid >> 2; hd = uid & 3; qrow = MX + b * 256 + w * 32 + r; }
    }
    const int NTA = 4 + (tb1 - tb0);
    const bf16* qp; int ocol;
    if (TYPE == 0) { qp = P.proj + (size_t)qrow * PJS + hd * 64; ocol = hd * 64; }
    else if (TYPE == 1) { qp = P.proj + (size_t)qrow * PJS + 768 + hd * 64; ocol = 512 + hd * 64; }
    else { qp = P.qm + (size_t)qrow * 384 + hd * 96; ocol = 768 + hd * 64; }
    bf16x8 qf[NKS];
#pragma unroll
    for (int ks = 0; ks < NKS; ++ks) qf[ks] = *(const GAS bf16x8*)(qp + 16 * ks + 8 * h);

    float m_ = 0.f, l_ = 0.f;
    if (TYPE == 0) { m_ = P.sink[hd] * LOG2E; l_ = (h == 0) ? 1.f : 0.f; }
    f32x16 o0, o1, p0, p1;
#pragma unroll
    for (int i = 0; i < 16; ++i) { o0[i] = 0.f; o1[i] = 0.f; p0[i] = 0.f; p1[i] = 0.f; }
    bf16x8 pf[4];
#pragma unroll
    for (int s = 0; s < 4; ++s) pf[s] = (bf16x8){0, 0, 0, 0, 0, 0, 0, 0};

    u32x4 kreg, vreg, rreg = {0u, 0u, 0u, 0u};
    const int sj = tid >> 3, sc = tid & 7;
#define AT_TILE(it_) ((it_) < 4 ? (it_) : (it_) - 4 + tb0)
#define AT_LOADK(t) do { const int kr_ = key_row<TYPE>((t), sj, b, nblk, kr0, kc0); \
        if (TYPE == 2) { kreg = *(const GAS u32x4*)(P.kvm + (size_t)kr_ * 512 + hd * 128 + sc * 8); \
            if (tid < 256) { const int kr2_ = key_row<TYPE>((t), tid >> 2, b, nblk, kr0, kc0); rreg = *(const GAS u32x4*)(P.krr + (size_t)kr2_ * 32 + (tid & 3) * 8); } } \
        else kreg = *(const GAS u32x4*)(P.proj + (size_t)kr_ * PJS + (TYPE == 0 ? 512 + kvh * 64 : 1024 + hd * 64) + sc * 8); } while (0)
#define AT_LOADV(t) do { const int kr_ = key_row<TYPE>((t), sj, b, nblk, kr0, kc0); \
        if (TYPE == 2) vreg = *(const GAS u32x4*)(P.kvm + (size_t)kr_ * 512 + hd * 128 + 64 + sc * 8); \
        else vreg = *(const GAS u32x4*)(P.proj + (size_t)kr_ * PJS + (TYPE == 0 ? 640 + kvh * 64 : 1280 + hd * 64) + sc * 8); } while (0)
#define AT_STOREK(bi) do { *(LAS u32x4*)(lds + L_K + (bi) * A_KB + sj * KSTR + sc * 16) = kreg; \
        if (TYPE == 2) { if (tid < 256) *(LAS u32x4*)(lds + L_K + (bi) * A_KB + (tid >> 2) * KSTR + 128 + (tid & 3) * 16) = rreg; } } while (0)
#define AT_STOREV(bi) do { *(LAS u32x4*)(lds + L_V + (bi) * A_VB + sj * A_VS + sc * 16) = vreg; } while (0)
    AT_LOADK(0);
    __syncthreads();
    LAS float* lbias = (LAS float*)(lds + L_B);
    if (TYPE == 1 && !isctx) { if (tid < 465) lbias[tid] = ((const GAS float*)P.rpb)[hd * 465 + tid] * LOG2E; }
    AT_STOREK(0);
    AT_LOADK(AT_TILE(1)); AT_LOADV(0);
    __syncthreads();
    const int q4 = (lane & 15) >> 2, p4 = lane & 3, blk = (lane >> 4) & 1;
    const int voff = L_V + (4 * h + q4) * A_VS + (16 * blk + 4 * p4) * 2;
    const int koff = L_K + r * KSTR + 16 * h;
    const int wr_ = min(max(qr - 4, 0), 56), wc_ = min(max(qc - 8, 0), 48);
    const int qi = (w & 3) * 32 + r;
    const bool grp1 = (w >> 2) != 0;

#define AT_STAGE(it) do { if ((it) + 1 < NTA) AT_STOREK(((it) + 1) & 1); AT_STOREV((it) & 1); \
        if ((it) + 2 < NTA) AT_LOADK(AT_TILE((it) + 2)); if ((it) + 1 < NTA) AT_LOADV(AT_TILE((it) + 1)); __syncthreads(); } while (0)
    if (!grp1) {
        for (int it = 0; it < NTA; ++it) {
            const int t = AT_TILE(it);
            const LAS unsigned char* kb0 = lds + (it & 1) * A_KB + koff;
            const LAS unsigned char* vb = lds + ((it + 1) & 1) * A_VB + voff;
            at_mfma_block<TYPE, NKS, KSTR>(p0, p1, o0, o1, qf, pf, m_, kb0, vb, true, it > 0);
            at_valu_block<TYPE>(p0, p1, o0, o1, pf, m_, l_, t, it == 0, qi, h, kr0, kc0, qr, qc, wr_, wc_, lbias);
            AT_STAGE(it);
        }
        const LAS unsigned char* vb = lds + ((NTA - 1) & 1) * A_VB + voff;
        at_mfma_block<TYPE, NKS, KSTR>(p0, p1, o0, o1, qf, pf, m_, vb, vb, false, true);
    } else {
        for (int it = 0; it < NTA; ++it) {
            const int tp = AT_TILE(it - 1);
            const LAS unsigned char* kb0 = lds + (it & 1) * A_KB + koff;
            const LAS unsigned char* vb = lds + ((it + 1) & 1) * A_VB + voff;
            if (it > 0) at_valu_block<TYPE>(p0, p1, o0, o1, pf, m_, l_, tp, it == 1, qi, h, kr0, kc0, qr, qc, wr_, wc_, lbias);
            at_mfma_block<TYPE, NKS, KSTR>(p0, p1, o0, o1, qf, pf, m_, kb0, vb, true, it > 0);
            AT_STAGE(it);
        }
        const LAS unsigned char* vb = lds + ((NTA - 1) & 1) * A_VB + voff;
        at_valu_block<TYPE>(p0, p1, o0, o1, pf, m_, l_, AT_TILE(NTA - 1), false, qi, h, kr0, kc0, qr, qc, wr_, wc_, lbias);
        at_mfma_block<TYPE, NKS, KSTR>(p0, p1, o0, o1, qf, pf, m_, vb, vb, false, true);
    }
#undef AT_STAGE
#undef AT_LOADK
#undef AT_LOADV
#undef AT_STOREK
#undef AT_STOREV
#undef AT_TILE
    const float lt = l_ + __shfl_xor(l_, 32), inv = 1.0f / lt;
    bf16* op = P.mix + (size_t)qrow * DM + ocol + 4 * h;
#pragma unroll
    for (int g = 0; g < 4; ++g) {
        const f32x4 v0 = {o0[4 * g] * inv, o0[4 * g + 1] * inv, o0[4 * g + 2] * inv, o0[4 * g + 3] * inv};
        const f32x4 v1 = {o1[4 * g] * inv, o1[4 * g + 1] * inv, o1[4 * g + 2] * inv, o1[4 * g + 3] * inv};
        st4bf(op + 8 * g, v0); st4bf(op + 32 + 8 * g, v1);
    }
}

DI void attn_phase(const AttnP& P, bool last, LAS unsigned char* lds, const int tid_in) {
    const int G = gridDim.x, bx = blockIdx.x;
    const int vcu = (G % 8 == 0) ? (bx % 8) * (G / 8) + bx / 8 : bx;
    const int NU = 2048 + (last ? 0 : 128);
    for (int u = vcu; u < NU; u += G) {
        int tid = tid_in; asm volatile("" : "+v"(tid));
        if (u < 512) attn_unit<2>(P, u, false, lds, tid);
        else if (u < 1024) attn_unit<1>(P, u - 512, false, lds, tid);
        else if (u < 2048) attn_unit<0>(P, u - 1024, false, lds, tid);
        else if (u < 2080) attn_unit<2>(P, u - 2048, true, lds, tid);
        else if (u < 2112) attn_unit<1>(P, u - 2080, true, lds, tid);
        else attn_unit<0>(P, u - 2112, true, lds, tid);
    }
}

#define XB_TMO      128
#define XB_XCNT(j)  (256  + 64 * (j))
#define XB_XSUB(j)  (1280 + 64 * (j))
#define XB_XGEN(j)  (2304 + 64 * (j))
#define XB_TOP      3328
#define XB_TOPGEN   3392
#define XCD_BAR_WORDS 3456
#define XB_SPIN_CAP (1u << 18)

__device__ __forceinline__ unsigned xb_ld(unsigned* p)              { return __hip_atomic_load(p, __ATOMIC_RELAXED, __HIP_MEMORY_SCOPE_AGENT); }
__device__ __forceinline__ unsigned xb_add(unsigned* p, unsigned v) { return __hip_atomic_fetch_add(p, v, __ATOMIC_RELAXED, __HIP_MEMORY_SCOPE_AGENT); }
__device__ __forceinline__ unsigned xb_xcc_id() { return (unsigned)__builtin_amdgcn_s_getreg((3 << 11) | 20) & 0xFu; }
#define XB_SPIN(cond, bar) do { unsigned _sp = 0; while (cond) { __builtin_amdgcn_s_sleep(1); \
    if ((++_sp & 255u) == 0u) { if (xb_ld(&(bar)[XB_TMO])) break; if (_sp > XB_SPIN_CAP) { atomicAdd(&(bar)[XB_TMO], 1u); break; } } } } while (0)

struct XcdBarrier {
    unsigned* bar; unsigned x;
    volatile LAS unsigned* st;
};

__device__ __forceinline__ XcdBarrier xcd_barrier_post(unsigned* bar, volatile LAS unsigned* st) {
    XcdBarrier b; b.bar = bar; b.x = xb_xcc_id(); b.st = st;
    if (threadIdx.x == 0) (void)xb_add(&bar[XB_XCNT(b.x)], 1u);
    return b;
}
__device__ __forceinline__ void xcd_barrier_complete(unsigned* bar, unsigned x, unsigned& nloc, unsigned& nx) {
    const unsigned G = gridDim.x * gridDim.y * gridDim.z;
    unsigned sum, cnt, mine, sp = 0u;
    for (;;) {
        sum = 0u; cnt = 0u; mine = 0u;
#pragma unroll
        for (unsigned j = 0; j < 16; ++j) { const unsigned c = xb_ld(&bar[XB_XCNT(j)]); sum += c; cnt += (c > 0u) ? 1u : 0u; mine = (j == x) ? c : mine; }
        if (sum == G) break;
        __builtin_amdgcn_s_sleep(1);
        if ((++sp & 255u) == 0u) { if (xb_ld(&bar[XB_TMO])) break; if (sp > XB_SPIN_CAP) { atomicAdd(&bar[XB_TMO], 1u); break; } }
    }
    nloc = mine > 0u ? mine : 1u; nx = cnt > 0u ? cnt : 1u;
}

__device__ __forceinline__ void xcd_barrier(const XcdBarrier& b) {
    asm volatile("s_waitcnt vmcnt(0)" ::: "memory");
    __syncthreads();
    if (threadIdx.x == 0) {
        unsigned* bar = b.bar;
        __builtin_amdgcn_s_waitcnt(0);
        unsigned nloc = b.st[0], nx = b.st[1];
        if (nloc == 0u) { xcd_barrier_complete(bar, b.x, nloc, nx); b.st[0] = nloc; b.st[1] = nx; }
        const unsigned old = xb_add(&bar[XB_XSUB(b.x)], 1u);
        const unsigned gen = old / nloc;
        if (old + 1u == (gen + 1u) * nloc) {
            __builtin_amdgcn_fence(__ATOMIC_RELEASE, "agent");
            asm volatile("s_waitcnt vmcnt(0)" ::: "memory");
            const unsigned og = xb_add(&bar[XB_TOP], 1u);
            const unsigned tg = og / nx;
            if (og + 1u == (tg + 1u) * nx) xb_add(&bar[XB_TOPGEN], 1u);
            else XB_SPIN(xb_ld(&bar[XB_TOPGEN]) == tg, bar);
            __builtin_amdgcn_fence(__ATOMIC_ACQUIRE, "agent");
            xb_add(&bar[XB_XGEN(b.x)], 1u);
            asm volatile("s_waitcnt vmcnt(0)" ::: "memory");
        } else {
            XB_SPIN(xb_ld(&bar[XB_XGEN(b.x)]) == gen, bar);
            __builtin_amdgcn_fence(__ATOMIC_ACQUIRE, "agent");
            asm volatile("s_waitcnt vmcnt(0)" ::: "memory");
        }
    }
    __syncthreads();
}

constexpr int NPH = 3 + 6 * DEPTH;
__global__ void __launch_bounds__(NTHR) mk_fwd(Args a) {
    extern __shared__ __attribute__((aligned(16))) unsigned char lds_raw[];
    LAS unsigned char* lds = (LAS unsigned char*)lds_raw;
    const int G = gridDim.x, bx = blockIdx.x;
    const int ph_lo = a.ph_lo, ph_hi = a.ph_hi;
    volatile LAS unsigned* bst = (volatile LAS unsigned*)(lds + 131072);
    if (threadIdx.x < 2) bst[threadIdx.x] = 0u;
    __syncthreads();
    XcdBarrier xbar; xbar.bar = (unsigned*)(a.ws + WS_BAR); xbar.x = 0; xbar.st = bst;
    if (!MK_PER_PHASE) xbar = xcd_barrier_post((unsigned*)(a.ws + WS_BAR), bst);

    for (int ph = ph_lo; ph < ph_hi;) {
        int tid = threadIdx.x; asm volatile("" : "+v"(tid));
        unsigned char* ws = a.ws; asm volatile("" : "+s"(ws));
        float* mods = (float*)(ws + WS_MODS);
        const float* tabA = (const float*)(ws + WS_TAB); const float* tabC = tabA + 2048;
        float* Xc = (float*)(ws + WS_XC);
        bf16* Hn = (bf16*)(ws + WS_HN); bf16* H1 = (bf16*)(ws + WS_H1);
        bf16* proj = (bf16*)(ws + WS_PROJ); bf16* cqb = (bf16*)(ws + WS_CQ); bf16* ckvb = (bf16*)(ws + WS_CKV);
        bf16* qm = (bf16*)(ws + WS_QM); bf16* kvm = (bf16*)(ws + WS_KVM); bf16* krr = (bf16*)(ws + WS_KRR); bf16* mix = (bf16*)(ws + WS_MIX);

        if (ph == 0) prologue(a, lds, tid);
        else if (ph == 1) phase1(a, lds, tid);
        else if (ph == NPH - 1) final_norm_phase(a.out, a.in[18], tid);
        else {
            const int l = (ph - 2) / 6, s = (ph - 2) - 6 * l; const bool last = (l == DEPTH - 1);
            unsigned char* wb = ws + WS_W + (size_t)l * WL_STRIDE;
            const float* mods_l = mods + (size_t)l * 9 * 6144;
            float* ssq_q = (float*)(ws + WS_SSQ) + (size_t)l * 2 * MT; float* ssq_kv = ssq_q + MT;
            float* ssqx1 = (float*)(ws + WS_SSQX) + (size_t)l * 2 * MT; float* ssqx2 = ssqx1 + MT;
            const float* xsrc = (l == 0) ? a.in[0] : a.out;
            const float* csrc = (l == 0) ? a.in[2] : Xc;
            float* part = (float*)(ws + WS_PART);
            if (s == 0) {
                if (l > 0) {
                    const float* mods_p = mods + (size_t)(l - 1) * 9 * 6144;
                    ctx_finish(part, 8, Xc, Xc, mods_p + 5 * 1024 + 8 * 6144, Hn, ssqx1, a.in[6] + l * DM, mods_l + 1 * 1024 + 8 * 6144, tid);
                    xcd_barrier(xbar);
                }
                pg8::Gemm g{Hn, (const bf16*)(wb + WL_IN), MT, 2048, DM, DM}; pg8::StaticOrder S; S.init(MT, 2048, G, bx);
                EpiInProj E{proj, cqb, ckvb, krr, ssq_q, ssq_kv, tabA, tabC, ssqx1, (const float*)(ws + WS_BIAS1) + (size_t)l * 9 * 2048};
                pg8::gemm_phase<EpiInProj, pg8::StaticOrder, true, true>(lds, g, S, E, tid);
            } else if (s == 1) {
                { int Kq = 256; asm volatile("" : "+s"(Kq)); pg8::Gemm g{cqb, (const bf16*)(wb + WL_UQ), MT, 512, Kq, Kq}; pg8::StaticOrder S; S.init(MT, 512, G, bx);
                  EpiUQ E{qm, ssq_q, tabC}; pg8::gemm_phase<EpiUQ, pg8::StaticOrder, true, true>(lds, g, S, E, tid); }
                { int Kk = 128; asm volatile("" : "+s"(Kk)); pg8::Gemm g{ckvb, (const bf16*)(wb + WL_UKV), MT, 512, Kk, Kk}; pg8::StaticOrder S; S.init(MT, 512, G, (bx + G / 2) % G);
                  EpiUKV E{kvm, ssq_kv}; pg8::gemm_phase<EpiUKV, pg8::StaticOrder, true, true>(lds, g, S, E, tid); }
            } else if (s == 2) {
                AttnP P{proj, qm, kvm, krr, mix, a.in[9] + l * 8, a.in[10] + l * 4 * 465};
                attn_phase(P, last, lds, tid);
            } else if (s == 3 || s == 5) {
                const bool outp = (s == 3);
                const int Kfull = outp ? DM : DFF;
                {
                    pg8::Gemm g{outp ? mix : H1, (const bf16*)(wb + (outp ? WL_OUT : WL_W2)), MX, DM, Kfull, Kfull}; pg8::StaticOrder S; S.init(MX, DM, G, bx);
                    const int ln = outp ? l : l + 1;
                    const float* mods_n = mods + (size_t)(ln < DEPTH ? ln : 0) * 9 * 6144;
                    EpiResid E{(outp ? xsrc : a.out), (outp ? csrc : Xc), a.out, Xc, mods_l + (outp ? 2 : 5) * 1024, Hn,
                               outp ? ssqx2 : ssqx1 + (size_t)2 * MT, (outp ? a.in[7] : a.in[6]) + (ln < DEPTH ? ln : 0) * DM, mods_n + (outp ? 4 : 1) * 1024, (outp || !last) ? 1 : 0};
                    pg8::gemm_phase<EpiResid, pg8::StaticOrder, true, true>(lds, g, S, E, tid);
                }
                if (!last) {
                    int Ks = Kfull / 8; asm volatile("" : "+s"(Ks));
                    pg8::Gemm g{outp ? mix : H1, (const bf16*)(wb + (outp ? WL_OUT : WL_W2)), MT, DM, Ks, Kfull}; SplitOrder S; S.init(G, (bx + G / 2) % G, 8, Ks);
                    EpiPartial E{part, Ks * 2};
                    pg8::gemm_phase<EpiPartial, SplitOrder, true, true>(lds, g, S, E, tid);
                }
            } else {
                const int Mr = last ? MX : MT;
                if (!last) {
                    ctx_finish(part, 8, csrc, Xc, mods_l + 2 * 1024 + 8 * 6144, Hn, ssqx2, a.in[7] + l * DM, mods_l + 4 * 1024 + 8 * 6144, tid);
                    xcd_barrier(xbar);
                }
                pg8::Gemm g{Hn, (const bf16*)(wb + WL_W1), Mr, DFF, DM, DM}; pg8::StaticOrder S; S.init(Mr, DFF, G, bx);
                EpiRelu2 E{H1, ssqx2, (const float*)(ws + WS_BIAS4) + (size_t)l * 9 * 4096}; pg8::gemm_phase<EpiRelu2, pg8::StaticOrder, true, true>(lds, g, S, E, tid);
            }
        }
        ++ph;
        if (ph < ph_hi) { if (ph == 1) cg::this_grid().sync(); else xcd_barrier(xbar); }
    }
}

extern "C" void kernel_launch(void* const* d_in, const int* in_sizes, int n_in, void* d_out, int out_size, void* d_ws, size_t ws_size, hipStream_t stream) {
    static int grid = 0;
    if (grid == 0) {
        if (n_in != 19 || ws_size < WS_END) { fprintf(stderr, "kernel_launch: unexpected inputs (n_in %d, ws %zu)\n", n_in, ws_size); grid = -1; return; }
        int dev = 0, cus = 0, per_cu = 0;
        hipGetDevice(&dev); hipDeviceGetAttribute(&cus, hipDeviceAttributeMultiprocessorCount, dev);
        hipFuncSetAttribute((const void*)mk_fwd, hipFuncAttributeMaxDynamicSharedMemorySize, LDS_BYTES);
        hipOccupancyMaxActiveBlocksPerMultiprocessor(&per_cu, (const void*)mk_fwd, NTHR, LDS_BYTES);
        if (per_cu < 1) { fprintf(stderr, "kernel_launch: occupancy query says %d\n", per_cu); per_cu = 1; }
        (void)hipGetLastError();
        grid = cus * 1;
    }
    if (grid < 0) return;
    Args a{};
    for (int i = 0; i < 19; ++i) a.in[i] = (const float*)d_in[i];
    a.out = (float*)d_out; a.ws = (unsigned char*)d_ws;
#if MK_PER_PHASE
    for (int ph = 0; ph < NPH; ++ph) { a.ph_lo = ph; a.ph_hi = ph + 1; hipLaunchKernelGGL(mk_fwd, dim3(grid), dim3(NTHR), LDS_BYTES, stream, a); }
#else
    a.ph_lo = 0; a.ph_hi = NPH;
    (void)hipMemsetAsync((unsigned char*)d_ws + WS_BAR, 0, 16384, stream);
    void* args[] = {&a};
    hipError_t e = hipLaunchCooperativeKernel((const void*)mk_fwd, dim3(grid), dim3(NTHR), args, LDS_BYTES, stream);
    if (e != hipSuccess) fprintf(stderr, "cooperative launch failed: %s (grid %d)\n", hipGetErrorString(e), grid);
#endif
}
```

```cpp
#include <hip/hip_runtime.h>
#include <hip/hip_cooperative_groups.h>
#include <cstdio>
#include <cstdint>
namespace cg = cooperative_groups;
namespace pg8 {
#define PG8_LAS __attribute__((address_space(3)))
typedef unsigned short bf16_t;
typedef short bf16x8 __attribute__((ext_vector_type(8)));
typedef float f32x4 __attribute__((ext_vector_type(4)));
typedef unsigned u32x4 __attribute__((ext_vector_type(4)));
constexpr int BM = 256, BK = 64, HALF = 128, HTB = HALF * BK * 2  , STAGE_BYTES = 8 * HTB, NXCD = 8, WGM = 8;

__host__ __device__ __forceinline__ int lds_byte(int r, int c) { const int st = (r >> 4) * 2 + (c >> 5), rr = r & 15, cc = c & 31, ob = rr * 64 + cc * 2; return st * 1024 + (ob ^ (((ob >> 9) & 1) << 5)); }
__host__ __device__ __forceinline__ void stage_rc(int b, int& R, int& C) { const int st = b / 1024, sb = b % 1024, swz = sb ^ (((sb >> 9) & 1) << 5); R = (st >> 1) * 16 + swz / 64; C = (st & 1) * 32 + (swz % 64) / 2; }
__host__ __device__ __forceinline__ int perm32(int rho) { const int n = rho >> 4, i = rho & 15; return 8 * (i >> 2) + 4 * n + (i & 3); }

struct Unit { int pm, pn, kb; };
struct Gemm { const bf16_t* A; const bf16_t* Bt; int M, N, K, ld; };

struct StaticOrder {
    int nM, nN, nwg, G, c;
    __host__ __device__ void init(int M, int N, int G_, int c_) { nM = M / BM; nN = N / BM; nwg = nM * nN; G = G_; c = c_; }
    __host__ __device__ bool next(int i, Unit& u) const {
        const long L = (long)i * G + c; if (L >= nwg) return false;
        int wgid = (int)L; { const int q = nwg / NXCD, r = nwg % NXCD, xcd = wgid % NXCD, off = wgid / NXCD; wgid = (xcd < r ? xcd * (q + 1) : r * (q + 1) + (xcd - r) * q) + off; }
        const int nig = WGM * nN, gid = wgid / nig, fm = gid * WGM, gsz = (nM - fm) < WGM ? (nM - fm) : WGM;
        u.pm = fm + ((wgid % nig) % gsz); u.pn = (wgid % nig) / gsz; u.kb = 0; return true;
    }
    __device__ __forceinline__ void a_ready(const Unit&) const {}
    __device__ __forceinline__ void done(const Unit&) const {}
};

__device__ __forceinline__ unsigned cvt_pk_bf16(float lo, float hi) { unsigned r; asm volatile("v_cvt_pk_bf16_f32 %0, %1, %2" : "=v"(r) : "v"(lo), "v"(hi)); return r; }
template <class Epi, class Sched, bool ALIGN_EPI = false, bool SP2 = false>
__device__ __forceinline__ void gemm_phase(PG8_LAS unsigned char* lds, const Gemm g, const Sched& S, const Epi& E, const int tid) {
    const int wid = __builtin_amdgcn_readfirstlane(tid >> 6), lane = tid & 63, wr = wid >> 2, wc = wid & 3, fr = lane & 15, fq = lane >> 4;
    const int K = g.ld, nt = g.K / BK;
    unsigned voffA[2], voffB[2];
#pragma unroll
    for (int i = 0; i < 2; ++i) { int R, C; stage_rc(tid * 16 + i * 8192, R, C); const int Rb = Epi::PERM ? ((R & ~31) + perm32(R & 31)) : R;
        voffA[i] = (unsigned)(R * K + C) * 2u; voffB[i] = (unsigned)(Rb * K + C) * 2u; }
    const size_t kstep = (size_t)(BK * 2);
    const size_t hstep = (size_t)HALF * K * 2;
    const size_t tstep = 2 * hstep;
    const unsigned ldsw = (unsigned)wid * 1024u;
    const int aoff = lds_byte(wr * 64 + fr, fq * 8), boff = lds_byte(wc * 32 + fr, fq * 8);
#define PG8_SA(b, h) (((b) * 2 + (h)) * HTB)
#define PG8_SB(b, h) ((4 + (b) * 2 + (h)) * HTB)
#define PG8_STAGE(bufoff, gbase, voff) do { _Pragma("unroll") for (int _i = 0; _i < 2; ++_i) \
        __builtin_amdgcn_global_load_lds((const unsigned*)((const char*)(gbase) + (voff)[_i]), (PG8_LAS unsigned*)(lds + (bufoff) + ldsw + _i * 8192), 16, 0, 0); } while (0)
#define PG8_LDA(dst, b, h) do { _Pragma("unroll") for (int m = 0; m < 4; ++m) _Pragma("unroll") for (int k = 0; k < 2; ++k) dst[m][k] = *(const PG8_LAS bf16x8*)(lds + PG8_SA(b, h) + aoff + m * 2048 + k * 1024); } while (0)
#define PG8_LDB(dst, b, h) do { _Pragma("unroll") for (int n = 0; n < 2; ++n) _Pragma("unroll") for (int k = 0; k < 2; ++k) dst[n][k] = *(const PG8_LAS bf16x8*)(lds + PG8_SB(b, h) + boff + n * 2048 + k * 1024); } while (0)
#define PG8_MMA(ai, bj, At, Bt) do { __builtin_amdgcn_s_setprio(1); _Pragma("unroll") for (int m = 0; m < 4; ++m) _Pragma("unroll") for (int n = 0; n < 2; ++n) _Pragma("unroll") for (int k = 0; k < 2; ++k) \
        acc[ai][bj][m][n] = __builtin_amdgcn_mfma_f32_16x16x32_bf16(Bt[n][k], At[m][k], acc[ai][bj][m][n], 0, 0, 0); __builtin_amdgcn_s_setprio(0); } while (0)
#define PG8_WAIT_V(n) asm volatile("s_waitcnt vmcnt(" #n ")" ::: "memory")
#define PG8_WAIT_L(n) asm volatile("s_waitcnt lgkmcnt(" #n ")" ::: "memory")
#define PG8_BAR __builtin_amdgcn_s_barrier()
#define PG8_SCHED __builtin_amdgcn_sched_barrier(0)
    Unit cur, nxt; int ui = 0;
    if (!S.next(0, cur)) return;
    f32x4 acc[2][2][4][2];
#pragma unroll
    for (int a = 0; a < 2; ++a)
#pragma unroll
        for (int b = 0; b < 2; ++b)
#pragma unroll
            for (int m = 0; m < 4; ++m)
#pragma unroll
                for (int n = 0; n < 2; ++n) acc[a][b][m][n] = (f32x4){0.f, 0.f, 0.f, 0.f};
    bf16x8 At[4][2], B0[2][2], B1[2][2];
    const char* cA = (const char*)g.A + (size_t)cur.pm * tstep + cur.kb; const char* cB = (const char*)g.Bt + (size_t)cur.pn * tstep + cur.kb;
    S.a_ready(cur);
    if constexpr (SP2) {
        PG8_STAGE(PG8_SB(0, 0), cB, voffB); PG8_STAGE(PG8_SB(0, 1), cB + hstep, voffB); PG8_STAGE(PG8_SA(0, 0), cA, voffA); PG8_STAGE(PG8_SA(0, 1), cA + hstep, voffA);
        if (wr == 1) PG8_BAR;
        PG8_WAIT_V(2); PG8_BAR;
        PG8_STAGE(PG8_SB(1, 0), cB + kstep, voffB); PG8_STAGE(PG8_SA(1, 0), cA + kstep, voffA); PG8_STAGE(PG8_SB(1, 1), cB + hstep + kstep, voffB);
        PG8_WAIT_V(6); PG8_BAR;
    } else {
        PG8_STAGE(PG8_SB(0, 0), cB, voffB); PG8_STAGE(PG8_SA(0, 0), cA, voffA); PG8_STAGE(PG8_SB(0, 1), cB + hstep, voffB); PG8_STAGE(PG8_SA(0, 1), cA + hstep, voffA);
        if (wr == 1) PG8_BAR;
        PG8_WAIT_V(4); PG8_BAR;
        PG8_STAGE(PG8_SB(1, 0), cB + kstep, voffB); PG8_STAGE(PG8_SA(1, 0), cA + kstep, voffA); PG8_STAGE(PG8_SB(1, 1), cB + hstep + kstep, voffB);
        PG8_WAIT_V(6); PG8_BAR;
    }
    for (;;) {
        const bool has_next = S.next(ui + 1, nxt);
        const char* nA = has_next ? (const char*)g.A + (size_t)nxt.pm * tstep + nxt.kb : cA; const char* nB = has_next ? (const char*)g.Bt + (size_t)nxt.pn * tstep + nxt.kb : cB;
        for (int t = 0; t < nt; t += 2) {
            const bool last = (t == nt - 2);
            const char* a1 = cA + (size_t)(t + 1) * kstep;
            const char* a2 = last ? nA : cA + (size_t)(t + 2) * kstep; const char* b2 = last ? nB : cB + (size_t)(t + 2) * kstep;
            const char* a3 = a2 + kstep; const char* b3 = b2 + kstep;
            if (last && has_next) S.a_ready(nxt);
            if constexpr (SP2) {
            PG8_LDB(B0, 0, 0); PG8_LDB(B1, 0, 1); PG8_SCHED; PG8_LDA(At, 0, 0); PG8_STAGE(PG8_SA(1, 1), a1 + hstep, voffA);
            PG8_WAIT_V(8); PG8_WAIT_L(0); PG8_BAR; PG8_MMA(0, 0, At, B0); PG8_MMA(0, 1, At, B1); PG8_BAR; PG8_SCHED;
            PG8_LDA(At, 0, 1); PG8_STAGE(PG8_SB(0, 0), b2, voffB); PG8_STAGE(PG8_SB(0, 1), b2 + hstep, voffB); PG8_STAGE(PG8_SA(0, 0), a2, voffA);
            PG8_WAIT_V(8); PG8_WAIT_L(0); PG8_BAR; PG8_MMA(1, 0, At, B0); PG8_MMA(1, 1, At, B1); PG8_BAR; PG8_SCHED;
            PG8_LDB(B0, 1, 0); PG8_LDB(B1, 1, 1); PG8_SCHED; PG8_LDA(At, 1, 0); PG8_STAGE(PG8_SA(0, 1), a2 + hstep, voffA);
            PG8_WAIT_V(8); PG8_WAIT_L(0); PG8_BAR; PG8_MMA(0, 0, At, B0); PG8_MMA(0, 1, At, B1); PG8_BAR; PG8_SCHED;
            PG8_LDA(At, 1, 1); PG8_STAGE(PG8_SB(1, 0), b3, voffB); PG8_STAGE(PG8_SB(1, 1), b3 + hstep, voffB); PG8_STAGE(PG8_SA(1, 0), a3, voffA);
            PG8_WAIT_V(8); PG8_WAIT_L(0); PG8_BAR; PG8_MMA(1, 0, At, B0); PG8_MMA(1, 1, At, B1); PG8_BAR; PG8_SCHED;
            } else {
            PG8_LDB(B0, 0, 0); PG8_SCHED; PG8_LDA(At, 0, 0); PG8_STAGE(PG8_SA(1, 1), a1 + hstep, voffA);
            PG8_WAIT_L(8); PG8_BAR; PG8_WAIT_L(0); PG8_MMA(0, 0, At, B0); PG8_BAR; PG8_SCHED;
            PG8_LDB(B1, 0, 1); PG8_STAGE(PG8_SB(0, 0), b2, voffB);
            PG8_BAR; PG8_WAIT_L(0); PG8_MMA(0, 1, At, B1); PG8_BAR;
            PG8_LDA(At, 0, 1); PG8_STAGE(PG8_SA(0, 0), a2, voffA);
            PG8_BAR; PG8_WAIT_L(0); PG8_MMA(1, 0, At, B0); PG8_BAR; PG8_SCHED;
            PG8_STAGE(PG8_SB(0, 1), b2 + hstep, voffB);
            PG8_WAIT_V(6); PG8_BAR; PG8_MMA(1, 1, At, B1); PG8_BAR;
            PG8_LDB(B0, 1, 0); PG8_SCHED; PG8_LDA(At, 1, 0); PG8_STAGE(PG8_SA(0, 1), a2 + hstep, voffA);
            PG8_WAIT_L(8); PG8_BAR; PG8_WAIT_L(0); PG8_MMA(0, 0, At, B0); PG8_BAR; PG8_SCHED;
            PG8_LDB(B1, 1, 1); PG8_STAGE(PG8_SB(1, 0), b3, voffB);
            PG8_BAR; PG8_WAIT_L(0); PG8_MMA(0, 1, At, B1); PG8_BAR;
            PG8_LDA(At, 1, 1); PG8_STAGE(PG8_SA(1, 0), a3, voffA);
            PG8_BAR; PG8_WAIT_L(0); PG8_MMA(1, 0, At, B0); PG8_BAR; PG8_SCHED;
            PG8_STAGE(PG8_SB(1, 1), b3 + hstep, voffB);
            PG8_WAIT_V(6); PG8_BAR; PG8_MMA(1, 1, At, B1); PG8_BAR;
            }
        }
        if constexpr (ALIGN_EPI) { if (wr == 0) PG8_BAR; }
        if constexpr (!Epi::AFTER_DRAIN) { E(acc, cur, wr, wc, fr, fq); S.done(cur); }
        if (!has_next) break;
#pragma unroll
        for (int a = 0; a < 2; ++a)
#pragma unroll
            for (int b = 0; b < 2; ++b)
#pragma unroll
                for (int m = 0; m < 4; ++m)
#pragma unroll
                    for (int n = 0; n < 2; ++n) acc[a][b][m][n] = (f32x4){0.f, 0.f, 0.f, 0.f};
        cur = nxt; cA = nA; cB = nB; ++ui;
        if constexpr (ALIGN_EPI) { if (wr == 1) PG8_BAR; }
    }
    PG8_WAIT_V(0);
    if constexpr (!ALIGN_EPI) { if (wr == 0) PG8_BAR; }
    PG8_BAR;
    if constexpr (Epi::AFTER_DRAIN) { E.fused(acc, cur, wr, wc, fr, fq, lds, wid, lane); S.done(cur); }
#undef PG8_SA
#undef PG8_SB
#undef PG8_STAGE
#undef PG8_LDA
#undef PG8_LDB
#undef PG8_MMA
#undef PG8_WAIT_V
#undef PG8_WAIT_L
#undef PG8_BAR
#undef PG8_SCHED
}
}

#define LAS __attribute__((address_space(3)))
#define DI __device__ __forceinline__
#define GAS __attribute__((address_space(1)))
typedef unsigned short bf16;
typedef float f32x4 __attribute__((ext_vector_type(4)));
typedef float f32x16 __attribute__((ext_vector_type(16)));
typedef short bf16x8 __attribute__((ext_vector_type(8)));
typedef short s16x4 __attribute__((ext_vector_type(4)));
typedef unsigned u32x2 __attribute__((ext_vector_type(2)));
typedef unsigned u32x4 __attribute__((ext_vector_type(4)));
typedef float f32x2_t __attribute__((ext_vector_type(2)));
typedef __bf16 bf16x2_t __attribute__((ext_vector_type(2)));

#ifndef MK_MASK
#define MK_MASK 0x1ff
#endif
#define PH_EN(k) (((MK_MASK) >> (k)) & 1)
#ifndef MK_PER_PHASE
#define MK_PER_PHASE 0
#endif

constexpr int DM = 1024, NBATCH = 8, SEQ = 4096, DEPTH = 4, CTXL = 256, DFF = 4096;
constexpr int MX = NBATCH * SEQ, MC = NBATCH * CTXL, MT = MX + MC;
constexpr int INW = 1952, PJS = 1536;
constexpr float LOG2E = 1.4426950408889634f;
constexpr float C2A = 0.125f * LOG2E;
constexpr float C2C = 0.10206207261596575f * LOG2E;
constexpr float EPSN = 1e-6f;
constexpr int NTHR = 512;

constexpr size_t MiB = (size_t)1 << 20;
constexpr size_t WS_TAB = 0;
constexpr size_t WS_BAR = 65536;
constexpr size_t WS_MODS = 1 * MiB;
constexpr size_t WS_SSQ = 2 * MiB;
constexpr size_t WS_XC = 4 * MiB;
constexpr size_t WS_W = 12 * MiB;
constexpr size_t WL_IN = 0, WL_OUT = 4 * MiB, WL_W1 = 6 * MiB, WL_W2 = 14 * MiB, WL_UQ = 22 * MiB, WL_UKV = 22 * MiB + 256 * 1024, WL_STRIDE = 22 * MiB + 512 * 1024;
constexpr size_t WS_HN = 102 * MiB;
constexpr size_t WS_H1 = 170 * MiB;
constexpr size_t WS_PROJ = 170 * MiB;
constexpr size_t WS_CQ = 272 * MiB;
constexpr size_t WS_CKV = 289 * MiB;
constexpr size_t WS_QM = 298 * MiB;
constexpr size_t WS_KVM = 324 * MiB;
constexpr size_t WS_KRR = 358 * MiB;
constexpr size_t WS_MIX = 362 * MiB;
constexpr size_t WS_SSQX = 442 * MiB;
constexpr size_t WS_BIAS1 = 444 * MiB;
constexpr size_t WS_BIAS4 = 445 * MiB;
constexpr size_t WS_PART = 446 * MiB;
constexpr size_t WS_END = 510 * MiB;
constexpr int LDS_BYTES = 131072 + 256;

DI unsigned cvtpk(float lo, float hi) { f32x2_t v = {lo, hi}; bf16x2_t b = __builtin_convertvector(v, bf16x2_t); return __builtin_bit_cast(unsigned, b); }
DI void st4bf(bf16* p, f32x4 v) { u32x2 w; w.x = cvtpk(v[0], v[1]); w.y = cvtpk(v[2], v[3]); *(GAS u32x2*)p = w; }
DI float wave_sum(float v) {
#pragma unroll
    for (int o = 1; o < 64; o <<= 1) v += __shfl_xor(v, o);
    return v;
}
DI float fexp2(float x) { return __builtin_amdgcn_exp2f(x); }
DI float max3f(float a, float b, float c) { float r; asm("v_max3_f32 %0, %1, %2, %3" : "=v"(r) : "v"(a), "v"(b), "v"(c)); return r; }
#define LDS_WAIT() asm volatile("s_waitcnt lgkmcnt(0)" ::: "memory")

DI f32x4 rope8(f32x4 v, const float* tab  , int fq) {
    const int i0 = 4 * (fq & 1);
    const f32x4 cs = *(const f32x4*)(tab + i0), sn = *(const f32x4*)(tab + 8 + i0);
    f32x4 o;
#pragma unroll
    for (int j = 0; j < 4; ++j) { const float pr = __shfl_xor(v[j], 32); o[j] = (fq < 2) ? v[j] * cs[j] - pr * sn[j] : pr * sn[j] + v[j] * cs[j]; }
    return o;
}

struct EpiInProj {
    static constexpr bool PERM = false, AFTER_DRAIN = false;
    bf16 *proj, *cqb, *ckvb, *krr; float *ssq_q, *ssq_kv; const float *tabA, *tabC; const float *ssqx, *bias;
    DI void operator()(const f32x4 (&acc0)[2][2][4][2], const pg8::Unit& u, int wr, int wc, int fr, int fq) const {
        const int pn = u.pn; const bool isx = u.pm < 128; const int mi = isx ? (u.pm >> 4) : 8;
        f32x4 bv[2][2];
#pragma unroll
        for (int bj = 0; bj < 2; ++bj)
#pragma unroll
            for (int n = 0; n < 2; ++n) bv[bj][n] = *(const GAS f32x4*)(bias + mi * 2048 + pn * 256 + bj * 128 + wc * 32 + n * 16 + 4 * fq);
        float rsx[2][4];
#pragma unroll
        for (int ai = 0; ai < 2; ++ai)
#pragma unroll
            for (int m = 0; m < 4; ++m) { int row = u.pm * 256 + ai * 128 + wr * 64 + m * 16 + fr; asm volatile("" : "+v"(row)); rsx[ai][m] = ((const GAS float*)ssqx)[row]; }
#pragma unroll
        for (int ai = 0; ai < 2; ++ai)
#pragma unroll
            for (int m = 0; m < 4; ++m) rsx[ai][m] = rsqrtf(rsx[ai][m] * (1.0f / 1024.0f) + EPSN);
        const bool anyrope = isx && pn <= 2;
#pragma unroll
        for (int ai = 0; ai < 2; ++ai)
#pragma unroll
        for (int mh = 0; mh < 2; ++mh) {
            f32x4 cs[4], sn[4];
#pragma unroll
            for (int m = 2 * mh; m < 2 * mh + 2; ++m) { cs[m] = (f32x4){1.f, 1.f, 1.f, 1.f}; sn[m] = (f32x4){0.f, 0.f, 0.f, 0.f}; }
            if (anyrope) {
#pragma unroll
                for (int m = 2 * mh; m < 2 * mh + 2; ++m) { int row = u.pm * 256 + ai * 128 + wr * 64 + m * 16 + fr; asm volatile("" : "+v"(row)); const int tok = row & 4095; const int pos = (wc & 1) ? (tok & 63) : (tok >> 6);
                    cs[m] = *(const GAS f32x4*)(tabA + pos * 32 + 4 * fq); sn[m] = *(const GAS f32x4*)(tabA + pos * 32 + 16 + 4 * fq); }
            }
#pragma unroll
            for (int m = 2 * mh; m < 2 * mh + 2; ++m) {
                int row = u.pm * 256 + ai * 128 + wr * 64 + m * 16 + fr; asm volatile("" : "+v"(row));
                const int tok = row & 4095, prow = tok >> 6, pcol = tok & 63;
                f32x4 acc[2][2];
#pragma unroll
                for (int bj = 0; bj < 2; ++bj)
#pragma unroll
                    for (int n = 0; n < 2; ++n) acc[bj][n] = acc0[ai][bj][m][n] * rsx[ai][m] + bv[bj][n];
                if (pn < 6) {
#pragma unroll
                    for (int bj = 0; bj < 2; ++bj) {
                        f32x4 v0 = acc[bj][0], v1 = acc[bj][1];
                        if (anyrope && (pn < 2 || bj == 0)) { const f32x4 a = v0 * cs[m] - v1 * sn[m], b = v0 * sn[m] + v1 * cs[m]; v0 = a; v1 = b; }
                        if (pn < 2 || pn == 3) { v0 *= C2A; v1 *= C2A; }
                        bf16* p = proj + (size_t)row * PJS + pn * 256 + bj * 128 + wc * 32 + 4 * fq;
                        st4bf(p, v0); st4bf(p + 16, v1);
                    }
                } else if (pn == 6) {
                    float s = 0.f;
#pragma unroll
                    for (int bj = 0; bj < 2; ++bj) {
                        const f32x4 v0 = acc[bj][0], v1 = acc[bj][1];
                        s += (v0[0] * v0[0] + v0[1] * v0[1]) + (v0[2] * v0[2] + v0[3] * v0[3]) + (v1[0] * v1[0] + v1[1] * v1[1]) + (v1[2] * v1[2] + v1[3] * v1[3]);
                        bf16* p = cqb + (size_t)row * 256 + bj * 128 + wc * 32 + 4 * fq;
                        st4bf(p, v0); st4bf(p + 16, v1);
                    }
                    s += __shfl_xor(s, 16); s += __shfl_xor(s, 32);
                    if (fq == 0) atomicAdd(ssq_q + row, s);
                } else {
                    {
                        const f32x4 v0 = acc[0][0], v1 = acc[0][1];
                        float s = (v0[0] * v0[0] + v0[1] * v0[1]) + (v0[2] * v0[2] + v0[3] * v0[3]) + (v1[0] * v1[0] + v1[1] * v1[1]) + (v1[2] * v1[2] + v1[3] * v1[3]);
                        bf16* p = ckvb + (size_t)row * 128 + wc * 32 + 4 * fq;
                        st4bf(p, v0); st4bf(p + 16, v1);
                        s += __shfl_xor(s, 16); s += __shfl_xor(s, 32);
                        if (fq == 0) atomicAdd(ssq_kv + row, s);
                    }
                    if (wc == 0) {
                        f32x4 v0 = acc[1][0], v1 = acc[1][1];
                        if (isx) { v0 = rope8(v0, tabC + prow * 16, fq); v1 = rope8(v1, tabC + pcol * 16, fq); }
                        bf16* p = krr + (size_t)row * 32 + 4 * fq;
                        st4bf(p, v0); st4bf(p + 16, v1);
                    }
                }
            }
        }
    }
};

struct EpiUQ {
    static constexpr bool PERM = false, AFTER_DRAIN = false;
    bf16* qm; const float* ssq_q; const float* tabC;
    DI void operator()(const f32x4 (&acc)[2][2][4][2], const pg8::Unit& u, int wr, int wc, int fr, int fq) const {
        const int pn = u.pn; const bool isx = u.pm < 128;
        float rsq[2][4];
#pragma unroll
        for (int ai = 0; ai < 2; ++ai)
#pragma unroll
            for (int m = 0; m < 4; ++m) { int row = u.pm * 256 + ai * 128 + wr * 64 + m * 16 + fr; asm volatile("" : "+v"(row)); rsq[ai][m] = ((const GAS float*)ssq_q)[row]; }
#pragma unroll
        for (int ai = 0; ai < 2; ++ai)
#pragma unroll
            for (int m = 0; m < 4; ++m) {
                int row = u.pm * 256 + ai * 128 + wr * 64 + m * 16 + fr; asm volatile("" : "+v"(row));
                const int tok = row & 4095, prow = tok >> 6, pcol = tok & 63;
                const float rs = rsqrtf(rsq[ai][m] * (1.0f / 256.0f) + EPSN) * C2C;
#pragma unroll
                for (int bj = 0; bj < 2; ++bj)
#pragma unroll
                    for (int n = 0; n < 2; ++n) {
                        const int col0 = pn * 256 + bj * 128 + wc * 32 + n * 16;
                        if (col0 < 384) {
                            f32x4 v = acc[ai][bj][m][n] * rs;
                            const int g6 = (col0 >> 4) % 6;
                            if (isx && g6 >= 4) v = rope8(v, tabC + (g6 == 4 ? prow : pcol) * 16, fq);
                            st4bf(qm + (size_t)row * 384 + col0 + 4 * fq, v);
                        }
                    }
            }
    }
};

struct EpiUKV {
    static constexpr bool PERM = false, AFTER_DRAIN = false;
    bf16* kvm; const float* ssq_kv;
    DI void operator()(const f32x4 (&acc)[2][2][4][2], const pg8::Unit& u, int wr, int wc, int fr, int fq) const {
        float rsq[2][4];
#pragma unroll
        for (int ai = 0; ai < 2; ++ai)
#pragma unroll
            for (int m = 0; m < 4; ++m) { int row = u.pm * 256 + ai * 128 + wr * 64 + m * 16 + fr; asm volatile("" : "+v"(row)); rsq[ai][m] = ((const GAS float*)ssq_kv)[row]; }
#pragma unroll
        for (int ai = 0; ai < 2; ++ai)
#pragma unroll
            for (int m = 0; m < 4; ++m) {
                int row = u.pm * 256 + ai * 128 + wr * 64 + m * 16 + fr; asm volatile("" : "+v"(row));
                const float rs = rsqrtf(rsq[ai][m] * (1.0f / 128.0f) + EPSN);
#pragma unroll
                for (int bj = 0; bj < 2; ++bj)
#pragma unroll
                    for (int n = 0; n < 2; ++n) {
                        const int col0 = u.pn * 256 + bj * 128 + wc * 32 + n * 16;
                        st4bf(kvm + (size_t)row * 512 + col0 + 4 * fq, acc[ai][bj][m][n] * rs);
                    }
            }
    }
};

struct EpiRelu2 {
    static constexpr bool PERM = true, AFTER_DRAIN = false;
    bf16* H; const float *ssqx, *bias;
    DI void operator()(const f32x4 (&acc)[2][2][4][2], const pg8::Unit& u, int wr, int wc, int fr, int fq) const {
        const int col0 = u.pn * 256 + wc * 32 + 8 * fq; const int mi = (u.pm < 128) ? (u.pm >> 4) : 8;
        f32x4 bv[2][2];
#pragma unroll
        for (int bj = 0; bj < 2; ++bj)
#pragma unroll
            for (int n = 0; n < 2; ++n) bv[bj][n] = *(const GAS f32x4*)(bias + mi * 4096 + col0 + bj * 128 + 4 * n);
        float rsx[2][4];
#pragma unroll
        for (int ai = 0; ai < 2; ++ai)
#pragma unroll
            for (int m = 0; m < 4; ++m) { int row = u.pm * 256 + ai * 128 + wr * 64 + m * 16 + fr; asm volatile("" : "+v"(row)); rsx[ai][m] = ((const GAS float*)ssqx)[row]; }
#pragma unroll
        for (int ai = 0; ai < 2; ++ai)
#pragma unroll
            for (int m = 0; m < 4; ++m) {
                int row = u.pm * 256 + ai * 128 + wr * 64 + m * 16 + fr; asm volatile("" : "+v"(row));
                const float rs = rsqrtf(rsx[ai][m] * (1.0f / 1024.0f) + EPSN);
                bf16* rowp = H + (size_t)row * DFF + col0;
#pragma unroll
                for (int bj = 0; bj < 2; ++bj) {
                    f32x4 v0 = acc[ai][bj][m][0] * rs + bv[bj][0], v1 = acc[ai][bj][m][1] * rs + bv[bj][1];
#pragma unroll
                    for (int j = 0; j < 4; ++j) { const float a = fmaxf(v0[j], 0.f), b = fmaxf(v1[j], 0.f); v0[j] = a * a; v1[j] = b * b; }
                    u32x4 w; w.x = cvtpk(v0[0], v0[1]); w.y = cvtpk(v0[2], v0[3]); w.z = cvtpk(v1[0], v1[1]); w.w = cvtpk(v1[2], v1[3]);
                    *(GAS u32x4*)(rowp + bj * 128) = w;
                }
            }
    }
};

struct EpiResid {
    static constexpr bool PERM = false, AFTER_DRAIN = false;
    const float *srcx, *srcc; float *dstx, *dstc; const float* gate; bf16* xg; float* ssq_out; const float *gn, *scn; int donorm;
    DI void operator()(const f32x4 (&acc)[2][2][4][2], const pg8::Unit& u, int wr, int wc, int fr, int fq) const {
        const bool isx = u.pm < 128; const int mi = isx ? (u.pm >> 4) : 8;
        const int col0 = u.pn * 256 + wc * 32 + 4 * fq;
        f32x4 gv[2][2], gp[2][2];
#pragma unroll
        for (int bj = 0; bj < 2; ++bj)
#pragma unroll
            for (int n = 0; n < 2; ++n) { const int c = col0 + bj * 128 + n * 16; gv[bj][n] = *(const GAS f32x4*)(gate + mi * 6144 + c);
                gp[bj][n] = donorm ? *(const GAS f32x4*)(gn + c) * (*(const GAS f32x4*)(scn + mi * 6144 + c) + 1.0f) : (f32x4){0.f, 0.f, 0.f, 0.f}; }
#pragma unroll
        for (int ai = 0; ai < 2; ++ai)
#pragma unroll
        for (int mh = 0; mh < 2; ++mh) {
            f32x4 xs[4][2][2];
#pragma unroll
            for (int m = 2 * mh; m < 2 * mh + 2; ++m) {
                int row = u.pm * 256 + ai * 128 + wr * 64 + m * 16 + fr; asm volatile("" : "+v"(row));
                const float* s = isx ? srcx + (size_t)row * DM : srcc + (size_t)(row - MX) * DM;
#pragma unroll
                for (int bj = 0; bj < 2; ++bj)
#pragma unroll
                    for (int n = 0; n < 2; ++n) xs[m][bj][n] = *(const GAS f32x4*)(s + col0 + bj * 128 + n * 16);
            }
#pragma unroll
            for (int m = 2 * mh; m < 2 * mh + 2; ++m) {
                int row = u.pm * 256 + ai * 128 + wr * 64 + m * 16 + fr; asm volatile("" : "+v"(row));
                float* d = isx ? dstx + (size_t)row * DM : dstc + (size_t)(row - MX) * DM;
                float ss = 0.f;
#pragma unroll
                for (int bj = 0; bj < 2; ++bj)
#pragma unroll
                    for (int n = 0; n < 2; ++n) { const int off = col0 + bj * 128 + n * 16;
                        const f32x4 xn = xs[m][bj][n] + gv[bj][n] * acc[ai][bj][m][n];
                        *(GAS f32x4*)(d + off) = xn;
                        if (donorm) { ss += (xn[0] * xn[0] + xn[1] * xn[1]) + (xn[2] * xn[2] + xn[3] * xn[3]); st4bf(xg + (size_t)row * DM + off, xn * gp[bj][n]); } }
                if (donorm) { ss += __shfl_xor(ss, 16); ss += __shfl_xor(ss, 32); if (fq == 0) atomicAdd(ssq_out + row, ss); }
            }
        }
    }
};

struct SplitOrder {
    int G, c, NS, ksub_bytes;
    DI void init(int G_, int c_, int NS_, int Ksub) { G = G_; c = c_; NS = NS_; ksub_bytes = Ksub * 2; }
    DI bool next(int i, pg8::Unit& u) const { const int idx = i * G + c; if (idx >= 32 * NS) return false; const int ks = idx % NS, tile = idx / NS; u.pn = tile & 3; u.pm = 128 + (tile >> 2); u.kb = ks * ksub_bytes; return true; }
    DI void a_ready(const pg8::Unit&) const {}
    DI void done(const pg8::Unit&) const {}
};
struct EpiPartial {
    static constexpr bool PERM = false, AFTER_DRAIN = false;
    float* part; int ksub_bytes;
    DI void operator()(const f32x4 (&acc)[2][2][4][2], const pg8::Unit& u, int wr, int wc, int fr, int fq) const {
        const int ks = u.kb / ksub_bytes; const int col0 = u.pn * 256 + wc * 32 + 4 * fq;
        float* base = part + (size_t)ks * MC * DM;
#pragma unroll
        for (int ai = 0; ai < 2; ++ai)
#pragma unroll
            for (int m = 0; m < 4; ++m) {
                int row = (u.pm - 128) * 256 + ai * 128 + wr * 64 + m * 16 + fr;
                asm volatile("" : "+v"(row) :: "memory");
                float* rowp = base + (size_t)row * DM + col0;
#pragma unroll
                for (int bj = 0; bj < 2; ++bj)
#pragma unroll
                    for (int n = 0; n < 2; ++n) *(GAS f32x4*)(rowp + bj * 128 + n * 16) = acc[ai][bj][m][n];
            }
    }
};
DI void ctx_finish(const float* part, int NS, const float* src, float* dst, const float* gate8, bf16* xg, float* ssq_out, const float* gn, const float* scn8, const int tid) {
    const int lane = tid & 63, gw = blockIdx.x * 8 + (tid >> 6), NGW = gridDim.x * 8;
    for (int row = gw; row < MC; row += NGW) {
        float s = 0.f;
#pragma unroll
        for (int j = 0; j < 4; ++j) {
            const int col = 256 * j + 4 * lane;
            f32x4 a = {0.f, 0.f, 0.f, 0.f};
            for (int ks = 0; ks < NS; ++ks) a += *(const GAS f32x4*)(part + ((size_t)ks * MC + row) * DM + col);
            const f32x4 xn = *(const GAS f32x4*)(src + (size_t)row * DM + col) + *(const GAS f32x4*)(gate8 + col) * a;
            *(GAS f32x4*)(dst + (size_t)row * DM + col) = xn;
            s += (xn[0] * xn[0] + xn[1] * xn[1]) + (xn[2] * xn[2] + xn[3] * xn[3]);
            st4bf(xg + (size_t)(MX + row) * DM + col, xn * (*(const GAS f32x4*)(gn + col) * (*(const GAS f32x4*)(scn8 + col) + 1.0f)));
        }
        s = wave_sum(s);
        if (lane == 0) ssq_out[MX + row] = s;
    }
}

DI void transpose_item(const float* W, int K, int N, bf16* WT, const float* kscale, LAS float* scr, int item, int lane) {
    const int nblk = N / 32, kb = item / nblk, nb = item % nblk, k0 = 64 * kb, n0 = 32 * nb;
#pragma unroll 16
    for (int i = 0; i < 32; ++i) { const int kk = 2 * i + (lane >> 5); float w = W[(size_t)(k0 + kk) * N + n0 + (lane & 31)]; if (kscale) w *= kscale[k0 + kk]; scr[kk * 33 + (lane & 31)] = w; }
    LDS_WAIT();
    const int c = lane & 7;
#pragma unroll
    for (int j = 0; j < 4; ++j) { const int n = (lane >> 3) + 8 * j; const LAS float* s = scr + (8 * c) * 33 + n;
        u32x4 o; o.x = cvtpk(s[0 * 33], s[1 * 33]); o.y = cvtpk(s[2 * 33], s[3 * 33]); o.z = cvtpk(s[4 * 33], s[5 * 33]); o.w = cvtpk(s[6 * 33], s[7 * 33]);
        *(u32x4*)(WT + (size_t)(n0 + n) * K + k0 + 8 * c) = o; }
    LDS_WAIT();
}

DI void gemv9_item(const float* W, int ldw, int nvalid, int n0, const LAS float* sl, LAS float* red, const float* addb, float* out, int ldo, const int tid) {
    const int col = tid & 31, kg = tid >> 5, n = n0 + col;
    float acc[9];
#pragma unroll
    for (int mi = 0; mi < 9; ++mi) acc[mi] = 0.f;
    if (n < nvalid) {
        const float* w = W + (size_t)(kg * 64) * ldw + n;
#pragma unroll 16
        for (int k = 0; k < 64; ++k) { const float wv = w[(size_t)k * ldw];
#pragma unroll
            for (int mi = 0; mi < 9; ++mi) acc[mi] += sl[mi * 1024 + kg * 64 + k] * wv; }
    }
#pragma unroll
    for (int mi = 0; mi < 9; ++mi) red[(kg * 9 + mi) * 32 + col] = acc[mi];
    __syncthreads();
    if (tid < 288) { const int mi = tid >> 5, cq = tid & 31; float sacc = (addb && n0 + cq < nvalid) ? addb[n0 + cq] : 0.f;
#pragma unroll
        for (int g = 0; g < 16; ++g) sacc += red[(g * 9 + mi) * 32 + cq];
        out[(size_t)mi * ldo + n0 + cq] = sacc; }
    __syncthreads();
}

struct Args { const float* in[19]; float* out; unsigned char* ws; int ph_lo, ph_hi; };

DI void prologue(const Args& a, LAS unsigned char* lds, const int tid) {
    const int lane = tid & 63, wave = __builtin_amdgcn_readfirstlane(tid >> 6);
    int G = gridDim.x; asm volatile("" : "+s"(G));
    const int bx = blockIdx.x;
    unsigned char* ws = a.ws;
    {
        LAS float* sl = (LAS float*)lds;
        LAS float* red = (LAS float*)(lds + 36864);
        const float* c = a.in[1]; const float* cc = a.in[3]; const float* w_ada = a.in[4]; const float* b_ada = a.in[5];
        float* mods = (float*)(ws + WS_MODS);
        for (int idx = tid; idx < 9 * 1024; idx += NTHR) { const int mi = idx >> 10, k = idx & 1023; const float v = mi < 8 ? c[mi * 1024 + k] : cc[k]; sl[idx] = v / (1.0f + expf(-v)); }
        __syncthreads();
        for (int item = bx; item < DEPTH * 192; item += G) {
            const int l = item / 192, n0 = (item % 192) * 32;
            gemv9_item(w_ada + (size_t)l * 1024 * 6144, 6144, 6144, n0, sl, red, b_ada + l * 6144, mods + (size_t)l * 9 * 6144, 6144, tid);
        }
    }
    {
        const int gid = bx * NTHR + tid, NG = G * NTHR;
        float* tabA = (float*)(ws + WS_TAB); float* tabC = tabA + 2048;
        if (gid < 1024) { const int pos = gid >> 4, i = gid & 15; const float fr = exp2f(-(float)i * (1.0f / 16.0f) * 13.287712379549449f); const float rev = ((float)pos * fr) * 0.15915494309189535f;
            tabA[pos * 32 + i] = __builtin_amdgcn_cosf(rev); tabA[pos * 32 + 16 + i] = __builtin_amdgcn_sinf(rev); }
        else if (gid < 1536) { const int g = gid - 1024, pos = g >> 3, i = g & 7; const float fr = exp2f(-(float)i * (1.0f / 8.0f) * 13.287712379549449f); const float rev = ((float)pos * fr) * 0.15915494309189535f;
            tabC[pos * 16 + i] = __builtin_amdgcn_cosf(rev); tabC[pos * 16 + 8 + i] = __builtin_amdgcn_sinf(rev); }
        float* ssq = (float*)(ws + WS_SSQ);
        for (int i = gid; i < DEPTH * 2 * MT; i += NG) ssq[i] = 0.f;
        float* ssqx = (float*)(ws + WS_SSQX);
        for (int i = gid; i < DEPTH * 2 * MT; i += NG) ssqx[i] = 0.f;
        const u32x4 z = {0u, 0u, 0u, 0u};
        for (int i = gid; i < DEPTH * 12288; i += NG) { const int l = i / 12288, r = i % 12288; ((u32x4*)(ws + WS_W + l * WL_STRIDE + WL_IN + (size_t)INW * 1024 * 2))[r] = z; }
        for (int i = gid; i < DEPTH * 4096; i += NG) { const int l = i / 4096, r = i % 4096; ((u32x4*)(ws + WS_W + l * WL_STRIDE + WL_UQ + (size_t)384 * 256 * 2))[r] = z; }
    }
    {
        LAS float* scr = (LAS float*)(lds + wave * 16384);
        const int gw = bx * 8 + wave, NGW = G * 8;
        constexpr int I_IN = 16 * 61, I_OUT = 16 * 32, I_W1 = 16 * 128, I_W2 = 64 * 32, I_UQ = 4 * 12, I_UKV = 2 * 16, I_L = I_IN + I_OUT + I_W1 + I_W2 + I_UQ + I_UKV;
        for (int it = gw; it < DEPTH * I_L; it += NGW) {
            const int l = it / I_L; int r = it % I_L; unsigned char* wb = ws + WS_W + l * WL_STRIDE;
            if (r < I_IN) { transpose_item(a.in[8] + (size_t)l * 1024 * INW, 1024, INW, (bf16*)(wb + WL_IN), nullptr, scr, r, lane); continue; } r -= I_IN;
            if (r < I_OUT) { transpose_item(a.in[15] + (size_t)l * 1024 * 1024, 1024, 1024, (bf16*)(wb + WL_OUT), nullptr, scr, r, lane); continue; } r -= I_OUT;
            if (r < I_W1) { transpose_item(a.in[16] + (size_t)l * 1024 * 4096, 1024, 4096, (bf16*)(wb + WL_W1), nullptr, scr, r, lane); continue; } r -= I_W1;
            if (r < I_W2) { transpose_item(a.in[17] + (size_t)l * 4096 * 1024, 4096, 1024, (bf16*)(wb + WL_W2), nullptr, scr, r, lane); continue; } r -= I_W2;
            if (r < I_UQ) { transpose_item(a.in[12] + (size_t)l * 256 * 384, 256, 384, (bf16*)(wb + WL_UQ), a.in[11] + l * 256, scr, r, lane); continue; } r -= I_UQ;
            transpose_item(a.in[14] + (size_t)l * 128 * 512, 128, 512, (bf16*)(wb + WL_UKV), a.in[13] + l * 128, scr, r, lane);
        }
    }
}

DI void phase1(const Args& a, LAS unsigned char* lds, const int tid) {
    unsigned char* ws = a.ws;
    int G = gridDim.x; asm volatile("" : "+s"(G));
    const int bx = blockIdx.x;
    const float* mods = (const float*)(ws + WS_MODS);
    {
        LAS float* sl = (LAS float*)lds; LAS float* red = (LAS float*)(lds + 36864);
        float* bias1 = (float*)(ws + WS_BIAS1); float* bias4 = (float*)(ws + WS_BIAS4);
        for (int item = bx; item < DEPTH * 192; item += G) {
            const int l = item / 192, r = item % 192, which = r < 64 ? 0 : 1, tile = which ? r - 64 : r;
            const float* mv = mods + (size_t)l * 9 * 6144 + (which ? 3 : 0) * 1024;
            for (int idx = tid; idx < 9 * 1024; idx += NTHR) sl[idx] = mv[(size_t)(idx >> 10) * 6144 + (idx & 1023)];
            __syncthreads();
            if (!which) gemv9_item(a.in[8] + (size_t)l * 1024 * INW, INW, INW, tile * 32, sl, red, nullptr, bias1 + (size_t)l * 9 * 2048, 2048, tid);
            else gemv9_item(a.in[16] + (size_t)l * 1024 * DFF, DFF, DFF, tile * 32, sl, red, nullptr, bias4 + (size_t)l * 9 * 4096, 4096, tid);
        }
    }
    {
        const int lane = tid & 63, gw = bx * 8 + (tid >> 6), NGW = G * 8;
        bf16* Hn = (bf16*)(ws + WS_HN); float* ssqx = (float*)(ws + WS_SSQX); const float* g = a.in[6];
        for (int row = gw; row < MT; row += NGW) {
            const float* src = row < MX ? a.in[0] + (size_t)row * DM : a.in[2] + (size_t)(row - MX) * DM;
            const int mi = row < MX ? (row >> 12) : 8;
            const f32x4* xr = (const f32x4*)src + lane;
            f32x4 v[4]; float s = 0.f;
#pragma unroll
            for (int j = 0; j < 4; ++j) { v[j] = xr[64 * j]; s += (v[j][0] * v[j][0] + v[j][1] * v[j][1]) + (v[j][2] * v[j][2] + v[j][3] * v[j][3]); }
            s = wave_sum(s);
            if (lane == 0) ssqx[row] = s;
            const float* mrow = mods + (size_t)mi * 6144 + 1024;
#pragma unroll
            for (int j = 0; j < 4; ++j) { const int col = 256 * j + 4 * lane;
                const f32x4 gg = *(const f32x4*)(g + col), sc = *(const f32x4*)(mrow + col);
                st4bf(Hn + (size_t)row * DM + col, v[j] * (gg * (sc + 1.0f))); }
        }
    }
}
DI void final_norm_phase(float* x, const float* g, const int tid) {
    const int lane = tid & 63, gw = blockIdx.x * 8 + (tid >> 6), NGW = gridDim.x * 8;
    for (int row = gw; row < MX; row += NGW) {
        f32x4* xr = (f32x4*)(x + (size_t)row * DM) + lane;
        f32x4 v[4]; float s = 0.f;
#pragma unroll
        for (int j = 0; j < 4; ++j) { v[j] = xr[64 * j]; s += (v[j][0] * v[j][0] + v[j][1] * v[j][1]) + (v[j][2] * v[j][2] + v[j][3] * v[j][3]); }
        const float r = rsqrtf(wave_sum(s) * (1.0f / DM) + EPSN);
#pragma unroll
        for (int j = 0; j < 4; ++j) { const f32x4 gg = *(const f32x4*)(g + 256 * j + 4 * lane); xr[64 * j] = v[j] * r * gg; }
    }
}

struct AttnP { const bf16 *proj, *qm, *kvm, *krr; bf16* mix; const float* sink; const float* rpb; };
constexpr int A_VS = 144, A_KB = 64 * 208, A_VB = 64 * A_VS, L_K = 0, L_V = 2 * A_KB, L_B = L_V + 2 * A_VB;

template <int TYPE> DI int key_row(int t, int j, int b, int nblk, int kr0, int kc0) {
    if (t < 4) return MX + b * 256 + t * 64 + j;
    const int tt = t - 4;
    if (TYPE == 0) return b * 4096 + (nblk - 1) * 128 + tt * 64 + j;
    if (TYPE == 1) { const int tr = tt / 3, tc = tt - 3 * tr; return b * 4096 + (kr0 + 4 * tr + (j >> 4)) * 64 + kc0 + 16 * tc + (j & 15); }
    return b * 4096 + tt * 64 + j;
}

constexpr float ATHR = 6.0f;
template <int TYPE> struct AttnCtx { int t_qi, t_h, kr0, kc0, qr, qc, wr_, wc_; };

template <int TYPE, int NKS, int KSTR> DI void at_mfma_block(f32x16& p0, f32x16& p1, f32x16& o0, f32x16& o1, const bf16x8 (&qf)[NKS], const bf16x8 (&pf)[4], float m_,
                                                             const LAS unsigned char* kb0, const LAS unsigned char* vb, bool do_s, bool do_pv) {
    if (do_s) {
        const float nm = -m_;
#pragma unroll
        for (int i = 0; i < 16; ++i) { p0[i] = nm; p1[i] = nm; }
#pragma unroll
        for (int ks = 0; ks < NKS; ++ks) {
            const bf16x8 a0 = *(const LAS bf16x8*)(kb0 + ks * 32), a1 = *(const LAS bf16x8*)(kb0 + 32 * KSTR + ks * 32);
            p0 = __builtin_amdgcn_mfma_f32_32x32x16_bf16(a0, qf[ks], p0, 0, 0, 0);
            p1 = __builtin_amdgcn_mfma_f32_32x32x16_bf16(a1, qf[ks], p1, 0, 0, 0);
            if (ks & 1) asm volatile("" ::: "memory");
        }
    }
    if (do_pv) {
#pragma unroll
        for (int s = 0; s < 4; ++s) {
#pragma unroll
            for (int c = 0; c < 2; ++c) {
                const s16x4 lo = __builtin_bit_cast(s16x4, __builtin_amdgcn_ds_read_tr16_b64_v4i16((LAS s16x4*)(vb + (16 * s) * A_VS + c * 64)));
                const s16x4 hi = __builtin_bit_cast(s16x4, __builtin_amdgcn_ds_read_tr16_b64_v4i16((LAS s16x4*)(vb + (16 * s + 8) * A_VS + c * 64)));
                const bf16x8 vf = __builtin_shufflevector(lo, hi, 0, 1, 2, 3, 4, 5, 6, 7);
                if (c == 0) o0 = __builtin_amdgcn_mfma_f32_32x32x16_bf16(vf, pf[s], o0, 0, 0, 0);
                else o1 = __builtin_amdgcn_mfma_f32_32x32x16_bf16(vf, pf[s], o1, 0, 0, 0);
            }
            asm volatile("" ::: "memory");
        }
    }
}

template <int TYPE> DI void at_valu_block(f32x16& p0, f32x16& p1, f32x16& o0, f32x16& o1, bf16x8 (&pf)[4], float& m_, float& l_, int t, bool first,
                                          int qi, int h, int kr0, int kc0, int qr, int qc, int wr_, int wc_, const LAS float* lbias) {
    if (t >= 4) {
        if (TYPE == 0) {
            const int d0 = 64 * (t - 4) - qi + 4 * h;
#pragma unroll
            for (int i = 0; i < 16; ++i) { const int e = d0 + (i & 3) + 8 * (i >> 2);
                if ((unsigned)e > 256u) p0[i] = -1e30f;
                if ((unsigned)(e + 32) > 256u) p1[i] = -1e30f; }
        } else if (TYPE == 1) {
            const int tt = t - 4, tr = tt / 3, tc = tt - 3 * tr;
            const int krb = kr0 + 4 * tr, kcb = kc0 + 16 * tc + 4 * h;
#pragma unroll
            for (int i = 0; i < 16; ++i) {
                const int kc = kcb + (i & 3) + 8 * ((i >> 2) & 1);
                const bool cv = (unsigned)(kc - wc_) < 16u;
                const int ci = kc - qc + 15;
                { const int kr = krb + (i >> 3); const bool v = cv && ((unsigned)(kr - wr_) < 8u); const int idx = v ? (kr - qr + 7) * 31 + ci : 0; const float bv = lbias[idx]; p0[i] = v ? p0[i] + bv : -1e30f; }
                { const int kr = krb + 2 + (i >> 3); const bool v = cv && ((unsigned)(kr - wr_) < 8u); const int idx = v ? (kr - qr + 7) * 31 + ci : 0; const float bv = lbias[idx]; p1[i] = v ? p1[i] + bv : -1e30f; }
            }
        }
    }
    asm volatile("s_nop 15\n\ts_nop 7" : "+v"(p0), "+v"(p1));
    float mxa = max3f(p0[0], p0[1], p1[0]), mxb = max3f(p0[2], p0[3], p1[1]); mxa = max3f(mxa, p1[2], p1[3]);
#pragma unroll
    for (int i = 4; i < 16; i += 4) { mxa = max3f(mxa, p0[i], p0[i + 1]); mxb = max3f(mxb, p0[i + 2], p0[i + 3]); mxa = max3f(mxa, p1[i], p1[i + 1]); mxb = max3f(mxb, p1[i + 2], p1[i + 3]); }
    float mx = max3f(mxa, mxb, mxb);
    mx = max3f(mx, __shfl_xor(mx, 32), mx);
    if (first || __any(mx > ATHR)) {
        const float dl = (TYPE != 0 && first) ? mx : fmaxf(mx, 0.f);
        const float alpha = fexp2(-dl);
        m_ += dl; l_ *= alpha;
#pragma unroll
        for (int i = 0; i < 16; ++i) { p0[i] -= dl; p1[i] -= dl; o0[i] *= alpha; o1[i] *= alpha; }
    }
    float ls = 0.f;
#pragma unroll
    for (int i = 0; i < 16; ++i) { p0[i] = fexp2(p0[i]); p1[i] = fexp2(p1[i]); ls += p0[i] + p1[i]; }
    l_ += ls;
#pragma unroll
    for (int s = 0; s < 4; ++s) {
        u32x4 pw;
        if (s < 2) { pw.x = cvtpk(p0[8 * s + 0], p0[8 * s + 1]); pw.y = cvtpk(p0[8 * s + 2], p0[8 * s + 3]); pw.z = cvtpk(p0[8 * s + 4], p0[8 * s + 5]); pw.w = cvtpk(p0[8 * s + 6], p0[8 * s + 7]); }
        else { const int s2 = s - 2; pw.x = cvtpk(p1[8 * s2 + 0], p1[8 * s2 + 1]); pw.y = cvtpk(p1[8 * s2 + 2], p1[8 * s2 + 3]); pw.z = cvtpk(p1[8 * s2 + 4], p1[8 * s2 + 5]); pw.w = cvtpk(p1[8 * s2 + 6], p1[8 * s2 + 7]); }
        pf[s] = __builtin_bit_cast(bf16x8, pw);
    }
}

template <int TYPE> DI void attn_unit(const AttnP& P, int uid, bool isctx, LAS unsigned char* lds, const int tid) {
    constexpr int DQK = TYPE == 2 ? 96 : 64, NKS = DQK / 16, KSTR = DQK * 2 + 16;
    const int lane = tid & 63, w = __builtin_amdgcn_readfirstlane(tid >> 6), r = lane & 31, h = lane >> 5;
    int b, hd, kvh = 0, qrow, nblk = 0, kr0 = 0, kc0 = 0, qr = 0, qc = 0, tb0 = 4, tb1 = 4;
    if (TYPE == 0) {
        int gp;
        if (!isctx) { b = uid >> 7; kvh = (uid >> 6) & 1; nblk = (uid >> 1) & 31; gp = uid & 1; qrow = b * 4096 + nblk * 128 + (w & 3) * 32 + r; tb0 = nblk == 0 ? 6 : 4; tb1 = nblk == 31 ? 8 : 10; }
        else { b = uid >> 3; kvh = (uid >> 2) & 1; gp = (uid >> 1) & 1; nblk = uid & 1; qrow = MX + b * 256 + nblk * 128 + (w & 3) * 32 + r; }
        hd = kvh * 4 + gp * 2 + (w >> 2);
    } else if (TYPE == 1) {
        if (!isctx) { b = uid >> 6; hd = (uid >> 4) & 3; const int ib = (uid >> 1) & 7, cp = uid & 1;
            qr = 8 * ib + 2 * (w & 3) + (r >> 4); qc = 16 * (2 * cp + (w >> 2)) + (r & 15); qrow = b * 4096 + qr * 64 + qc;
            kr0 = min(max(8 * ib - 4, 0), 48); kc0 = 16 * cp; tb1 = 16; }
        else { b = uid >> 2; hd = uid & 3; qrow = MX + b * 256 + w * 32 + r; }
    } else {
        if (!isctx) { b = uid >> 6; hd = (uid >> 4) & 3; qrow = b * 4096 + (uid & 15) * 256 + w * 32 + r; tb1 = 68; }
        else { b = uid >> 2; hd = uid & 3; qrow = MX + b * 256 + w * 32 + r; }
    }
    const int NTA = 4 + (tb1 - tb0);
    const bf16* qp; int ocol;
    if (TYPE == 0) { qp = P.proj + (size_t)qrow * PJS + hd * 64; ocol = hd * 64; }
    else if (TYPE == 1) { qp = P.proj + (size_t)qrow * PJS + 768 + hd * 64; ocol = 512 + hd * 64; }
    else { qp = P.qm + (size_t)qrow * 384 + hd * 96; ocol = 768 + hd * 64; }
    bf16x8 qf[NKS];
#pragma unroll
    for (int ks = 0; ks < NKS; ++ks) qf[ks] = *(const GAS bf16x8*)(qp + 16 * ks + 8 * h);

    float m_ = 0.f, l_ = 0.f;
    if (TYPE == 0) { m_ = P.sink[hd] * LOG2E; l_ = (h == 0) ? 1.f : 0.f; }
    f32x16 o0, o1, p0, p1;
#pragma unroll
    for (int i = 0; i < 16; ++i) { o0[i] = 0.f; o1[i] = 0.f; p0[i] = 0.f; p1[i] = 0.f; }
    bf16x8 pf[4];
#pragma unroll
    for (int s = 0; s < 4; ++s) pf[s] = (bf16x8){0, 0, 0, 0, 0, 0, 0, 0};

    u32x4 kreg, vreg, rreg = {0u, 0u, 0u, 0u};
    const int sj = tid >> 3, sc = tid & 7;
#define AT_TILE(it_) ((it_) < 4 ? (it_) : (it_) - 4 + tb0)
#define AT_LOADK(t) do { const int kr_ = key_row<TYPE>((t), sj, b, nblk, kr0, kc0); \
        if (TYPE == 2) { kreg = *(const GAS u32x4*)(P.kvm + (size_t)kr_ * 512 + hd * 128 + sc * 8); \
            if (tid < 256) { const int kr2_ = key_row<TYPE>((t), tid >> 2, b, nblk, kr0, kc0); rreg = *(const GAS u32x4*)(P.krr + (size_t)kr2_ * 32 + (tid & 3) * 8); } } \
        else kreg = *(const GAS u32x4*)(P.proj + (size_t)kr_ * PJS + (TYPE == 0 ? 512 + kvh * 64 : 1024 + hd * 64) + sc * 8); } while (0)
#define AT_LOADV(t) do { const int kr_ = key_row<TYPE>((t), sj, b, nblk, kr0, kc0); \
        if (TYPE == 2) vreg = *(const GAS u32x4*)(P.kvm + (size_t)kr_ * 512 + hd * 128 + 64 + sc * 8); \
        else vreg = *(const GAS u32x4*)(P.proj + (size_t)kr_ * PJS + (TYPE == 0 ? 640 + kvh * 64 : 1280 + hd * 64) + sc * 8); } while (0)
#define AT_STOREK(bi) do { *(LAS u32x4*)(lds + L_K + (bi) * A_KB + sj * KSTR + sc * 16) = kreg; \
        if (TYPE == 2) { if (tid < 256) *(LAS u32x4*)(lds + L_K + (bi) * A_KB + (tid >> 2) * KSTR + 128 + (tid & 3) * 16) = rreg; } } while (0)
#define AT_STOREV(bi) do { *(LAS u32x4*)(lds + L_V + (bi) * A_VB + sj * A_VS + sc * 16) = vreg; } while (0)
    AT_LOADK(0);
    __syncthreads();
    LAS float* lbias = (LAS float*)(lds + L_B);
    if (TYPE == 1 && !isctx) { if (tid < 465) lbias[tid] = ((const GAS float*)P.rpb)[hd * 465 + tid] * LOG2E; }
    AT_STOREK(0);
    AT_LOADK(AT_TILE(1)); AT_LOADV(0);
    __syncthreads();
    const int q4 = (lane & 15) >> 2, p4 = lane & 3, blk = (lane >> 4) & 1;
    const int voff = L_V + (4 * h + q4) * A_VS + (16 * blk + 4 * p4) * 2;
    const int koff = L_K + r * KSTR + 16 * h;
    const int wr_ = min(max(qr - 4, 0), 56), wc_ = min(max(qc - 8, 0), 48);
    const int qi = (w & 3) * 32 + r;
    const bool grp1 = (w >> 2) != 0;

#define AT_STAGE(it) do { if ((it) + 1 < NTA) AT_STOREK(((it) + 1) & 1); AT_STOREV((it) & 1); \
        if ((it) + 2 < NTA) AT_LOADK(AT_TILE((it) + 2)); if ((it) + 1 < NTA) AT_LOADV(AT_TILE((it) + 1)); __syncthreads(); } while (0)
    if (!grp1) {
        for (int it = 0; it < NTA; ++it) {
            const int t = AT_TILE(it);
            const LAS unsigned char* kb0 = lds + (it & 1) * A_KB + koff;
            const LAS unsigned char* vb = lds + ((it + 1) & 1) * A_VB + voff;
            at_mfma_block<TYPE, NKS, KSTR>(p0, p1, o0, o1, qf, pf, m_, kb0, vb, true, it > 0);
            at_valu_block<TYPE>(p0, p1, o0, o1, pf, m_, l_, t, it == 0, qi, h, kr0, kc0, qr, qc, wr_, wc_, lbias);
            AT_STAGE(it);
        }
        const LAS unsigned char* vb = lds + ((NTA - 1) & 1) * A_VB + voff;
        at_mfma_block<TYPE, NKS, KSTR>(p0, p1, o0, o1, qf, pf, m_, vb, vb, false, true);
    } else {
        for (int it = 0; it < NTA; ++it) {
            const int tp = AT_TILE(it - 1);
            const LAS unsigned char* kb0 = lds + (it & 1) * A_KB + koff;
            const LAS unsigned char* vb = lds + ((it + 1) & 1) * A_VB + voff;
            if (it > 0) at_valu_block<TYPE>(p0, p1, o0, o1, pf, m_, l_, tp, it == 1, qi, h, kr0, kc0, qr, qc, wr_, wc_, lbias);
            at_mfma_block<TYPE, NKS, KSTR>(p0, p1, o0, o1, qf, pf, m_, kb0, vb, true, it > 0);
            AT_STAGE(it);
        }
        const LAS unsigned char* vb = lds + ((NTA - 1) & 1) * A_VB + voff;
        at_valu_block<TYPE>(p0, p1, o0, o1, pf, m_, l_, AT_TILE(NTA - 1), false, qi, h, kr0, kc0, qr, qc, wr_, wc_, lbias);
        at_mfma_block<TYPE, NKS, KSTR>(p0, p1, o0, o1, qf, pf, m_, vb, vb, false, true);
    }
#undef AT_STAGE
#undef AT_LOADK
#undef AT_LOADV
#undef AT_STOREK
#undef AT_STOREV
#undef AT_TILE
    const float lt = l_ + __shfl_xor(l_, 32), inv = 1.0f / lt;
    bf16* op = P.mix + (size_t)qrow * DM + ocol + 4 * h;
#pragma unroll
    for (int g = 0; g < 4; ++g) {
        const f32x4 v0 = {o0[4 * g] * inv, o0[4 * g + 1] * inv, o0[4 * g + 2] * inv, o0[4 * g + 3] * inv};
        const f32x4 v1 = {o1[4 * g] * inv, o1[4 * g + 1] * inv, o1[4 * g + 2] * inv, o1[4 * g + 3] * inv};
        st4bf(op + 8 * g, v0); st4bf(op + 32 + 8 * g, v1);
    }
}

DI void attn_phase(const AttnP& P, bool last, LAS unsigned char* lds, const int tid_in) {
    const int G = gridDim.x, bx = blockIdx.x;
    const int vcu = (G % 8 == 0) ? (bx % 8) * (G / 8) + bx / 8 : bx;
    const int NU = 2048 + (last ? 0 : 128);
    for (int u = vcu; u < NU; u += G) {
        int tid = tid_in; asm volatile("" : "+v"(tid));
        if (u < 512) attn_unit<2>(P, u, false, lds, tid);
        else if (u < 1024) attn_unit<1>(P, u - 512, false, lds, tid);
        else if (u < 2048) attn_unit<0>(P, u - 1024, false, lds, tid);
        else if (u < 2080) attn_unit<2>(P, u - 2048, true, lds, tid);
        else if (u < 2112) attn_unit<1>(P, u - 2080, true, lds, tid);
        else attn_unit<0>(P, u - 2112, true, lds, tid);
    }
}

#define XB_TMO      128
#define XB_XCNT(j)  (256  + 64 * (j))
#define XB_XSUB(j)  (1280 + 64 * (j))
#define XB_XGEN(j)  (2304 + 64 * (j))
#define XB_TOP      3328
#define XB_TOPGEN   3392
#define XCD_BAR_WORDS 3456
#define XB_SPIN_CAP (1u << 18)

__device__ __forceinline__ unsigned xb_ld(unsigned* p)              { return __hip_atomic_load(p, __ATOMIC_RELAXED, __HIP_MEMORY_SCOPE_AGENT); }
__device__ __forceinline__ unsigned xb_add(unsigned* p, unsigned v) { return __hip_atomic_fetch_add(p, v, __ATOMIC_RELAXED, __HIP_MEMORY_SCOPE_AGENT); }
__device__ __forceinline__ unsigned xb_xcc_id() { return (unsigned)__builtin_amdgcn_s_getreg((3 << 11) | 20) & 0xFu; }
#define XB_SPIN(cond, bar) do { unsigned _sp = 0; while (cond) { __builtin_amdgcn_s_sleep(1); \
    if ((++_sp & 255u) == 0u) { if (xb_ld(&(bar)[XB_TMO])) break; if (_sp > XB_SPIN_CAP) { atomicAdd(&(bar)[XB_TMO], 1u); break; } } } } while (0)

struct XcdBarrier {
    unsigned* bar; unsigned x;
    volatile LAS unsigned* st;
};

__device__ __forceinline__ XcdBarrier xcd_barrier_post(unsigned* bar, volatile LAS unsigned* st) {
    XcdBarrier b; b.bar = bar; b.x = xb_xcc_id(); b.st = st;
    if (threadIdx.x == 0) (void)xb_add(&bar[XB_XCNT(b.x)], 1u);
    return b;
}
__device__ __forceinline__ void xcd_barrier_complete(unsigned* bar, unsigned x, unsigned& nloc, unsigned& nx) {
    const unsigned G = gridDim.x * gridDim.y * gridDim.z;
    unsigned sum, cnt, mine, sp = 0u;
    for (;;) {
        sum = 0u; cnt = 0u; mine = 0u;
#pragma unroll
        for (unsigned j = 0; j < 16; ++j) { const unsigned c = xb_ld(&bar[XB_XCNT(j)]); sum += c; cnt += (c > 0u) ? 1u : 0u; mine = (j == x) ? c : mine; }
        if (sum == G) break;
        __builtin_amdgcn_s_sleep(1);
        if ((++sp & 255u) == 0u) { if (xb_ld(&bar[XB_TMO])) break; if (sp > XB_SPIN_CAP) { atomicAdd(&bar[XB_TMO], 1u); break; } }
    }
    nloc = mine > 0u ? mine : 1u; nx = cnt > 0u ? cnt : 1u;
}

__device__ __forceinline__ void xcd_barrier(const XcdBarrier& b) {
    asm volatile("s_waitcnt vmcnt(0)" ::: "memory");
    __syncthreads();
    if (threadIdx.x == 0) {
        unsigned* bar = b.bar;
        __builtin_amdgcn_s_waitcnt(0);
        unsigned nloc = b.st[0], nx = b.st[1];
        if (nloc == 0u) { xcd_barrier_complete(bar, b.x, nloc, nx); b.st[0] = nloc; b.st[1] = nx; }
        const unsigned old = xb_add(&bar[XB_XSUB(b.x)], 1u);
        const unsigned gen = old / nloc;
        if (old + 1u == (gen + 1u) * nloc) {
            __builtin_amdgcn_fence(__ATOMIC_RELEASE, "agent");
            asm volatile("s_waitcnt vmcnt(0)" ::: "memory");
            const unsigned og = xb_add(&bar[XB_TOP], 1u);
            const unsigned tg = og / nx;
            if (og + 1u == (tg + 1u) * nx) xb_add(&bar[XB_TOPGEN], 1u);
            else XB_SPIN(xb_ld(&bar[XB_TOPGEN]) == tg, bar);
            __builtin_amdgcn_fence(__ATOMIC_ACQUIRE, "agent");
            xb_add(&bar[XB_XGEN(b.x)], 1u);
            asm volatile("s_waitcnt vmcnt(0)" ::: "memory");
        } else {
            XB_SPIN(xb_ld(&bar[XB_XGEN(b.x)]) == gen, bar);
            __builtin_amdgcn_fence(__ATOMIC_ACQUIRE, "agent");
            asm volatile("s_waitcnt vmcnt(0)" ::: "memory");
        }
    }
    __syncthreads();
}

constexpr int NPH = 3 + 6 * DEPTH;
__global__ void __launch_bounds__(NTHR) mk_fwd(Args a) {
    extern __shared__ __attribute__((aligned(16))) unsigned char lds_raw[];
    LAS unsigned char* lds = (LAS unsigned char*)lds_raw;
    const int G = gridDim.x, bx = blockIdx.x;
    const int ph_lo = a.ph_lo, ph_hi = a.ph_hi;
    volatile LAS unsigned* bst = (volatile LAS unsigned*)(lds + 131072);
    if (threadIdx.x < 2) bst[threadIdx.x] = 0u;
    __syncthreads();
    XcdBarrier xbar; xbar.bar = (unsigned*)(a.ws + WS_BAR); xbar.x = 0; xbar.st = bst;
    if (!MK_PER_PHASE) xbar = xcd_barrier_post((unsigned*)(a.ws + WS_BAR), bst);

    for (int ph = ph_lo; ph < ph_hi;) {
        int tid = threadIdx.x; asm volatile("" : "+v"(tid));
        unsigned char* ws = a.ws; asm volatile("" : "+s"(ws));
        float* mods = (float*)(ws + WS_MODS);
        const float* tabA = (const float*)(ws + WS_TAB); const float* tabC = tabA + 2048;
        float* Xc = (float*)(ws + WS_XC);
        bf16* Hn = (bf16*)(ws + WS_HN); bf16* H1 = (bf16*)(ws + WS_H1);
        bf16* proj = (bf16*)(ws + WS_PROJ); bf16* cqb = (bf16*)(ws + WS_CQ); bf16* ckvb = (bf16*)(ws + WS_CKV);
        bf16* qm = (bf16*)(ws + WS_QM); bf16* kvm = (bf16*)(ws + WS_KVM); bf16* krr = (bf16*)(ws + WS_KRR); bf16* mix = (bf16*)(ws + WS_MIX);

        if (ph == 0) prologue(a, lds, tid);
        else if (ph == 1) phase1(a, lds, tid);
        else if (ph == NPH - 1) final_norm_phase(a.out, a.in[18], tid);
        else {
            const int l = (ph - 2) / 6, s = (ph - 2) - 6 * l; const bool last = (l == DEPTH - 1);
            unsigned char* wb = ws + WS_W + (size_t)l * WL_STRIDE;
            const float* mods_l = mods + (size_t)l * 9 * 6144;
            float* ssq_q = (float*)(ws + WS_SSQ) + (size_t)l * 2 * MT; float* ssq_kv = ssq_q + MT;
            float* ssqx1 = (float*)(ws + WS_SSQX) + (size_t)l * 2 * MT; float* ssqx2 = ssqx1 + MT;
            const float* xsrc = (l == 0) ? a.in[0] : a.out;
            const float* csrc = (l == 0) ? a.in[2] : Xc;
            float* part = (float*)(ws + WS_PART);
            if (s == 0) {
                if (l > 0) {
                    const float* mods_p = mods + (size_t)(l - 1) * 9 * 6144;
                    ctx_finish(part, 8, Xc, Xc, mods_p + 5 * 1024 + 8 * 6144, Hn, ssqx1, a.in[6] + l * DM, mods_l + 1 * 1024 + 8 * 6144, tid);
                    xcd_barrier(xbar);
                }
                pg8::Gemm g{Hn, (const bf16*)(wb + WL_IN), MT, 2048, DM, DM}; pg8::StaticOrder S; S.init(MT, 2048, G, bx);
                EpiInProj E{proj, cqb, ckvb, krr, ssq_q, ssq_kv, tabA, tabC, ssqx1, (const float*)(ws + WS_BIAS1) + (size_t)l * 9 * 2048};
                pg8::gemm_phase<EpiInProj, pg8::StaticOrder, true, true>(lds, g, S, E, tid);
            } else if (s == 1) {
                { int Kq = 256; asm volatile("" : "+s"(Kq)); pg8::Gemm g{cqb, (const bf16*)(wb + WL_UQ), MT, 512, Kq, Kq}; pg8::StaticOrder S; S.init(MT, 512, G, bx);
                  EpiUQ E{qm, ssq_q, tabC}; pg8::gemm_phase<EpiUQ, pg8::StaticOrder, true, true>(lds, g, S, E, tid); }
                { int Kk = 128; asm volatile("" : "+s"(Kk)); pg8::Gemm g{ckvb, (const bf16*)(wb + WL_UKV), MT, 512, Kk, Kk}; pg8::StaticOrder S; S.init(MT, 512, G, (bx + G / 2) % G);
                  EpiUKV E{kvm, ssq_kv}; pg8::gemm_phase<EpiUKV, pg8::StaticOrder, true, true>(lds, g, S, E, tid); }
            } else if (s == 2) {
                AttnP P{proj, qm, kvm, krr, mix, a.in[9] + l * 8, a.in[10] + l * 4 * 465};
                attn_phase(P, last, lds, tid);
            } else if (s == 3 || s == 5) {
                const bool outp = (s == 3);
                const int Kfull = outp ? DM : DFF;
                {
                    pg8::Gemm g{outp ? mix : H1, (const bf16*)(wb + (outp ? WL_OUT : WL_W2)), MX, DM, Kfull, Kfull}; pg8::StaticOrder S; S.init(MX, DM, G, bx);
                    const int ln = outp ? l : l + 1;
                    const float* mods_n = mods + (size_t)(ln < DEPTH ? ln : 0) * 9 * 6144;
                    EpiResid E{(outp ? xsrc : a.out), (outp ? csrc : Xc), a.out, Xc, mods_l + (outp ? 2 : 5) * 1024, Hn,
                               outp ? ssqx2 : ssqx1 + (size_t)2 * MT, (outp ? a.in[7] : a.in[6]) + (ln < DEPTH ? ln : 0) * DM, mods_n + (outp ? 4 : 1) * 1024, (outp || !last) ? 1 : 0};
                    pg8::gemm_phase<EpiResid, pg8::StaticOrder, true, true>(lds, g, S, E, tid);
                }
                if (!last) {
                    int Ks = Kfull / 8; asm volatile("" : "+s"(Ks));
                    pg8::Gemm g{outp ? mix : H1, (const bf16*)(wb + (outp ? WL_OUT : WL_W2)), MT, DM, Ks, Kfull}; SplitOrder S; S.init(G, (bx + G / 2) % G, 8, Ks);
                    EpiPartial E{part, Ks * 2};
                    pg8::gemm_phase<EpiPartial, SplitOrder, true, true>(lds, g, S, E, tid);
                }
            } else {
                const int Mr = last ? MX : MT;
                if (!last) {
                    ctx_finish(part, 8, csrc, Xc, mods_l + 2 * 1024 + 8 * 6144, Hn, ssqx2, a.in[7] + l * DM, mods_l + 4 * 1024 + 8 * 6144, tid);
                    xcd_barrier(xbar);
                }
                pg8::Gemm g{Hn, (const bf16*)(wb + WL_W1), Mr, DFF, DM, DM}; pg8::StaticOrder S; S.init(Mr, DFF, G, bx);
                EpiRelu2 E{H1, ssqx2, (const float*)(ws + WS_BIAS4) + (size_t)l * 9 * 4096}; pg8::gemm_phase<EpiRelu2, pg8::StaticOrder, true, true>(lds, g, S, E, tid);
            }
        }
        ++ph;
        if (ph < ph_hi) { if (ph == 1) cg::this_grid().sync(); else xcd_barrier(xbar); }
    }
}

extern "C" void kernel_launch(void* const* d_in, const int* in_sizes, int n_in, void* d_out, int out_size, void* d_ws, size_t ws_size, hipStream_t stream) {
    static int grid = 0;
    if (grid == 0) {
        if (n_in != 19 || ws_size < WS_END) { fprintf(stderr, "kernel_launch: unexpected inputs (n_in %d, ws %zu)\n", n_in, ws_size); grid = -1; return; }
        int dev = 0, cus = 0, per_cu = 0;
        hipGetDevice(&dev); hipDeviceGetAttribute(&cus, hipDeviceAttributeMultiprocessorCount, dev);
        hipFuncSetAttribute((const void*)mk_fwd, hipFuncAttributeMaxDynamicSharedMemorySize, LDS_BYTES);
        hipOccupancyMaxActiveBlocksPerMultiprocessor(&per_cu, (const void*)mk_fwd, NTHR, LDS_BYTES);
        if (per_cu < 1) { fprintf(stderr, "kernel_launch: occupancy query says %d\n", per_cu); per_cu = 1; }
        (void)hipGetLastError();
        grid = cus * 1;
    }
    if (grid < 0) return;
    Args a{};
    for (int i = 0; i < 19; ++i) a.in[i] = (const float*)d_in[i];
    a.out = (float*)d_out; a.ws = (unsigned char*)d_ws;
#if MK_PER_PHASE
    for (int ph = 0; ph < NPH; ++ph) { a.ph_lo = ph; a.ph_hi = ph + 1; hipLaunchKernelGGL(mk_fwd, dim3(grid), dim3(NTHR), LDS_BYTES, stream, a); }
#else
    a.ph_lo = 0; a.ph_hi = NPH;
    (void)hipMemsetAsync((unsigned char*)d_ws + WS_BAR, 0, 16384, stream);
    void* args[] = {&a};
    hipError_t e = hipLaunchCooperativeKernel((const void*)mk_fwd, dim3(grid), dim3(NTHR), args, LDS_BYTES, stream);
    if (e != hipSuccess) fprintf(stderr, "cooperative launch failed: %s (grid %d)\n", hipGetErrorString(e), grid);
#endif
}
```

```cpp
#include <hip/hip_runtime.h>
#include <hip/hip_cooperative_groups.h>
#include <cstdio>
#include <cstdint>
namespace cg = cooperative_groups;
namespace pg8 {
#define PG8_LAS __attribute__((address_space(3)))
typedef unsigned short bf16_t;
typedef short bf16x8 __attribute__((ext_vector_type(8)));
typedef float f32x4 __attribute__((ext_vector_type(4)));
typedef unsigned u32x4 __attribute__((ext_vector_type(4)));
constexpr int BM = 256, BK = 64, HALF = 128, HTB = HALF * BK * 2  , STAGE_BYTES = 8 * HTB, NXCD = 8, WGM = 8;

__host__ __device__ __forceinline__ int lds_byte(int r, int c) { const int st = (r >> 4) * 2 + (c >> 5), rr = r & 15, cc = c & 31, ob = rr * 64 + cc * 2; return st * 1024 + (ob ^ (((ob >> 9) & 1) << 5)); }
__host__ __device__ __forceinline__ void stage_rc(int b, int& R, int& C) { const int st = b / 1024, sb = b % 1024, swz = sb ^ (((sb >> 9) & 1) << 5); R = (st >> 1) * 16 + swz / 64; C = (st & 1) * 32 + (swz % 64) / 2; }
__host__ __device__ __forceinline__ int perm32(int rho) { const int n = rho >> 4, i = rho & 15; return 8 * (i >> 2) + 4 * n + (i & 3); }

struct Unit { int pm, pn, kb; };
struct Gemm { const bf16_t* A; const bf16_t* Bt; int M, N, K, ld; };

struct StaticOrder {
    int nM, nN, nwg, G, c;
    __host__ __device__ void init(int M, int N, int G_, int c_) { nM = M / BM; nN = N / BM; nwg = nM * nN; G = G_; c = c_; }
    __host__ __device__ bool next(int i, Unit& u) const {
        const long L = (long)i * G + c; if (L >= nwg) return false;
        int wgid = (int)L; { const int q = nwg / NXCD, r = nwg % NXCD, xcd = wgid % NXCD, off = wgid / NXCD; wgid = (xcd < r ? xcd * (q + 1) : r * (q + 1) + (xcd - r) * q) + off; }
        const int nig = WGM * nN, gid = wgid / nig, fm = gid * WGM, gsz = (nM - fm) < WGM ? (nM - fm) : WGM;
        u.pm = fm + ((wgid % nig) % gsz); u.pn = (wgid % nig) / gsz; u.kb = 0; return true;
    }
    __device__ __forceinline__ void a_ready(const Unit&) const {}
    __device__ __forceinline__ void done(const Unit&) const {}
};

__device__ __forceinline__ unsigned cvt_pk_bf16(float lo, float hi) { unsigned r; asm volatile("v_cvt_pk_bf16_f32 %0, %1, %2" : "=v"(r) : "v"(lo), "v"(hi)); return r; }
template <class Epi, class Sched, bool ALIGN_EPI = false, bool SP2 = false>
__device__ __forceinline__ void gemm_phase(PG8_LAS unsigned char* lds, const Gemm g, const Sched& S, const Epi& E, const int tid) {
    const int wid = __builtin_amdgcn_readfirstlane(tid >> 6), lane = tid & 63, wr = wid >> 2, wc = wid & 3, fr = lane & 15, fq = lane >> 4;
    const int K = g.ld, nt = g.K / BK;
    unsigned voffA[2], voffB[2];
#pragma unroll
    for (int i = 0; i < 2; ++i) { int R, C; stage_rc(tid * 16 + i * 8192, R, C); const int Rb = Epi::PERM ? ((R & ~31) + perm32(R & 31)) : R;
        voffA[i] = (unsigned)(R * K + C) * 2u; voffB[i] = (unsigned)(Rb * K + C) * 2u; }
    const size_t kstep = (size_t)(BK * 2);
    const size_t hstep = (size_t)HALF * K * 2;
    const size_t tstep = 2 * hstep;
    const unsigned ldsw = (unsigned)wid * 1024u;
    const int aoff = lds_byte(wr * 64 + fr, fq * 8), boff = lds_byte(wc * 32 + fr, fq * 8);
#define PG8_SA(b, h) (((b) * 2 + (h)) * HTB)
#define PG8_SB(b, h) ((4 + (b) * 2 + (h)) * HTB)
#define PG8_STAGE(bufoff, gbase, voff) do { _Pragma("unroll") for (int _i = 0; _i < 2; ++_i) \
        __builtin_amdgcn_global_load_lds((const unsigned*)((const char*)(gbase) + (voff)[_i]), (PG8_LAS unsigned*)(lds + (bufoff) + ldsw + _i * 8192), 16, 0, 0); } while (0)
#define PG8_LDA(dst, b, h) do { _Pragma("unroll") for (int m = 0; m < 4; ++m) _Pragma("unroll") for (int k = 0; k < 2; ++k) dst[m][k] = *(const PG8_LAS bf16x8*)(lds + PG8_SA(b, h) + aoff + m * 2048 + k * 1024); } while (0)
#define PG8_LDB(dst, b, h) do { _Pragma("unroll") for (int n = 0; n < 2; ++n) _Pragma("unroll") for (int k = 0; k < 2; ++k) dst[n][k] = *(const PG8_LAS bf16x8*)(lds + PG8_SB(b, h) + boff + n * 2048 + k * 1024); } while (0)
#define PG8_MMA(ai, bj, At, Bt) do { __builtin_amdgcn_s_setprio(1); _Pragma("unroll") for (int m = 0; m < 4; ++m) _Pragma("unroll") for (int n = 0; n < 2; ++n) _Pragma("unroll") for (int k = 0; k < 2; ++k) \
        acc[ai][bj][m][n] = __builtin_amdgcn_mfma_f32_16x16x32_bf16(Bt[n][k], At[m][k], acc[ai][bj][m][n], 0, 0, 0); __builtin_amdgcn_s_setprio(0); } while (0)
#define PG8_WAIT_V(n) asm volatile("s_waitcnt vmcnt(" #n ")" ::: "memory")
#define PG8_WAIT_L(n) asm volatile("s_waitcnt lgkmcnt(" #n ")" ::: "memory")
#define PG8_BAR __builtin_amdgcn_s_barrier()
#define PG8_SCHED __builtin_amdgcn_sched_barrier(0)
    Unit cur, nxt; int ui = 0;
    if (!S.next(0, cur)) return;
    f32x4 acc[2][2][4][2];
#pragma unroll
    for (int a = 0; a < 2; ++a)
#pragma unroll
        for (int b = 0; b < 2; ++b)
#pragma unroll
            for (int m = 0; m < 4; ++m)
#pragma unroll
                for (int n = 0; n < 2; ++n) acc[a][b][m][n] = (f32x4){0.f, 0.f, 0.f, 0.f};
    bf16x8 At[4][2], B0[2][2], B1[2][2];
    const char* cA = (const char*)g.A + (size_t)cur.pm * tstep + cur.kb; const char* cB = (const char*)g.Bt + (size_t)cur.pn * tstep + cur.kb;
    S.a_ready(cur);
    if constexpr (SP2) {
        PG8_STAGE(PG8_SB(0, 0), cB, voffB); PG8_STAGE(PG8_SB(0, 1), cB + hstep, voffB); PG8_STAGE(PG8_SA(0, 0), cA, voffA); PG8_STAGE(PG8_SA(0, 1), cA + hstep, voffA);
        if (wr == 1) PG8_BAR;
        PG8_WAIT_V(2); PG8_BAR;
        PG8_STAGE(PG8_SB(1, 0), cB + kstep, voffB); PG8_STAGE(PG8_SA(1, 0), cA + kstep, voffA); PG8_STAGE(PG8_SB(1, 1), cB + hstep + kstep, voffB);
        PG8_WAIT_V(6); PG8_BAR;
    } else {
        PG8_STAGE(PG8_SB(0, 0), cB, voffB); PG8_STAGE(PG8_SA(0, 0), cA, voffA); PG8_STAGE(PG8_SB(0, 1), cB + hstep, voffB); PG8_STAGE(PG8_SA(0, 1), cA + hstep, voffA);
        if (wr == 1) PG8_BAR;
        PG8_WAIT_V(4); PG8_BAR;
        PG8_STAGE(PG8_SB(1, 0), cB + kstep, voffB); PG8_STAGE(PG8_SA(1, 0), cA + kstep, voffA); PG8_STAGE(PG8_SB(1, 1), cB + hstep + kstep, voffB);
        PG8_WAIT_V(6); PG8_BAR;
    }
    for (;;) {
        const bool has_next = S.next(ui + 1, nxt);
        const char* nA = has_next ? (const char*)g.A + (size_t)nxt.pm * tstep + nxt.kb : cA; const char* nB = has_next ? (const char*)g.Bt + (size_t)nxt.pn * tstep + nxt.kb : cB;
        for (int t = 0; t < nt; t += 2) {
            const bool last = (t == nt - 2);
            const char* a1 = cA + (size_t)(t + 1) * kstep;
            const char* a2 = last ? nA : cA + (size_t)(t + 2) * kstep; const char* b2 = last ? nB : cB + (size_t)(t + 2) * kstep;
            const char* a3 = a2 + kstep; const char* b3 = b2 + kstep;
            if (last && has_next) S.a_ready(nxt);
            if constexpr (SP2) {
            PG8_LDB(B0, 0, 0); PG8_LDB(B1, 0, 1); PG8_SCHED; PG8_LDA(At, 0, 0); PG8_STAGE(PG8_SA(1, 1), a1 + hstep, voffA);
            PG8_WAIT_V(8); PG8_WAIT_L(0); PG8_BAR; PG8_MMA(0, 0, At, B0); PG8_MMA(0, 1, At, B1); PG8_BAR; PG8_SCHED;
            PG8_LDA(At, 0, 1); PG8_STAGE(PG8_SB(0, 0), b2, voffB); PG8_STAGE(PG8_SB(0, 1), b2 + hstep, voffB); PG8_STAGE(PG8_SA(0, 0), a2, voffA);
            PG8_WAIT_V(8); PG8_WAIT_L(0); PG8_BAR; PG8_MMA(1, 0, At, B0); PG8_MMA(1, 1, At, B1); PG8_BAR; PG8_SCHED;
            PG8_LDB(B0, 1, 0); PG8_LDB(B1, 1, 1); PG8_SCHED; PG8_LDA(At, 1, 0); PG8_STAGE(PG8_SA(0, 1), a2 + hstep, voffA);
            PG8_WAIT_V(8); PG8_WAIT_L(0); PG8_BAR; PG8_MMA(0, 0, At, B0); PG8_MMA(0, 1, At, B1); PG8_BAR; PG8_SCHED;
            PG8_LDA(At, 1, 1); PG8_STAGE(PG8_SB(1, 0), b3, voffB); PG8_STAGE(PG8_SB(1, 1), b3 + hstep, voffB); PG8_STAGE(PG8_SA(1, 0), a3, voffA);
            PG8_WAIT_V(8); PG8_WAIT_L(0); PG8_BAR; PG8_MMA(1, 0, At, B0); PG8_MMA(1, 1, At, B1); PG8_BAR; PG8_SCHED;
            } else {
            PG8_LDB(B0, 0, 0); PG8_SCHED; PG8_LDA(At, 0, 0); PG8_STAGE(PG8_SA(1, 1), a1 + hstep, voffA);
            PG8_WAIT_L(8); PG8_BAR; PG8_WAIT_L(0); PG8_MMA(0, 0, At, B0); PG8_BAR; PG8_SCHED;
            PG8_LDB(B1, 0, 1); PG8_STAGE(PG8_SB(0, 0), b2, voffB);
            PG8_BAR; PG8_WAIT_L(0); PG8_MMA(0, 1, At, B1); PG8_BAR;
            PG8_LDA(At, 0, 1); PG8_STAGE(PG8_SA(0, 0), a2, voffA);
            PG8_BAR; PG8_WAIT_L(0); PG8_MMA(1, 0, At, B0); PG8_BAR; PG8_SCHED;
            PG8_STAGE(PG8_SB(0, 1), b2 + hstep, voffB);
            PG8_WAIT_V(6); PG8_BAR; PG8_MMA(1, 1, At, B1); PG8_BAR;
            PG8_LDB(B0, 1, 0); PG8_SCHED; PG8_LDA(At, 1, 0); PG8_STAGE(PG8_SA(0, 1), a2 + hstep, voffA);
            PG8_WAIT_L(8); PG8_BAR; PG8_WAIT_L(0); PG8_MMA(0, 0, At, B0); PG8_BAR; PG8_SCHED;
            PG8_LDB(B1, 1, 1); PG8_STAGE(PG8_SB(1, 0), b3, voffB);
            PG8_BAR; PG8_WAIT_L(0); PG8_MMA(0, 1, At, B1); PG8_BAR;
            PG8_LDA(At, 1, 1); PG8_STAGE(PG8_SA(1, 0), a3, voffA);
            PG8_BAR; PG8_WAIT_L(0); PG8_MMA(1, 0, At, B0); PG8_BAR; PG8_SCHED;
            PG8_STAGE(PG8_SB(1, 1), b3 + hstep, voffB);
            PG8_WAIT_V(6); PG8_BAR; PG8_MMA(1, 1, At, B1); PG8_BAR;
            }
        }
        if constexpr (ALIGN_EPI) { if (wr == 0) PG8_BAR; }
        if constexpr (!Epi::AFTER_DRAIN) { E(acc, cur, wr, wc, fr, fq); S.done(cur); }
        if (!has_next) break;
#pragma unroll
        for (int a = 0; a < 2; ++a)
#pragma unroll
            for (int b = 0; b < 2; ++b)
#pragma unroll
                for (int m = 0; m < 4; ++m)
#pragma unroll
                    for (int n = 0; n < 2; ++n) acc[a][b][m][n] = (f32x4){0.f, 0.f, 0.f, 0.f};
        cur = nxt; cA = nA; cB = nB; ++ui;
        if constexpr (ALIGN_EPI) { if (wr == 1) PG8_BAR; }
    }
    PG8_WAIT_V(0);
    if constexpr (!ALIGN_EPI) { if (wr == 0) PG8_BAR; }
    PG8_BAR;
    if constexpr (Epi::AFTER_DRAIN) { E.fused(acc, cur, wr, wc, fr, fq, lds, wid, lane); S.done(cur); }
#undef PG8_SA
#undef PG8_SB
#undef PG8_STAGE
#undef PG8_LDA
#undef PG8_LDB
#undef PG8_MMA
#undef PG8_WAIT_V
#undef PG8_WAIT_L
#undef PG8_BAR
#undef PG8_SCHED
}
}

#define LAS __attribute__((address_space(3)))
#define DI __device__ __forceinline__
#define GAS __attribute__((address_space(1)))
typedef unsigned short bf16;
typedef float f32x4 __attribute__((ext_vector_type(4)));
typedef float f32x16 __attribute__((ext_vector_type(16)));
typedef short bf16x8 __attribute__((ext_vector_type(8)));
typedef short s16x4 __attribute__((ext_vector_type(4)));
typedef unsigned u32x2 __attribute__((ext_vector_type(2)));
typedef unsigned u32x4 __attribute__((ext_vector_type(4)));
typedef float f32x2_t __attribute__((ext_vector_type(2)));
typedef __bf16 bf16x2_t __attribute__((ext_vector_type(2)));

#ifndef MK_MASK
#define MK_MASK 0x1ff
#endif
#define PH_EN(k) (((MK_MASK) >> (k)) & 1)
#ifndef MK_PER_PHASE
#define MK_PER_PHASE 0
#endif

constexpr int DM = 1024, NBATCH = 8, SEQ = 4096, DEPTH = 4, CTXL = 256, DFF = 4096;
constexpr int MX = NBATCH * SEQ, MC = NBATCH * CTXL, MT = MX + MC;
constexpr int INW = 1952, PJS = 1536;
constexpr float LOG2E = 1.4426950408889634f;
constexpr float C2A = 0.125f * LOG2E;
constexpr float C2C = 0.10206207261596575f * LOG2E;
constexpr float EPSN = 1e-6f;
constexpr int NTHR = 512;

constexpr size_t MiB = (size_t)1 << 20;
constexpr size_t WS_TAB = 0;
constexpr size_t WS_BAR = 65536;
constexpr size_t WS_MODS = 1 * MiB;
constexpr size_t WS_SSQ = 2 * MiB;
constexpr size_t WS_XC = 4 * MiB;
constexpr size_t WS_W = 12 * MiB;
constexpr size_t WL_IN = 0, WL_OUT = 4 * MiB, WL_W1 = 6 * MiB, WL_W2 = 14 * MiB, WL_UQ = 22 * MiB, WL_UKV = 22 * MiB + 256 * 1024, WL_STRIDE = 22 * MiB + 512 * 1024;
constexpr size_t WS_HN = 102 * MiB;
constexpr size_t WS_H1 = 170 * MiB;
constexpr size_t WS_PROJ = 170 * MiB;
constexpr size_t WS_CQ = 272 * MiB;
constexpr size_t WS_CKV = 289 * MiB;
constexpr size_t WS_QM = 298 * MiB;
constexpr size_t WS_KVM = 324 * MiB;
constexpr size_t WS_KRR = 358 * MiB;
constexpr size_t WS_MIX = 362 * MiB;
constexpr size_t WS_SSQX = 442 * MiB;
constexpr size_t WS_BIAS1 = 444 * MiB;
constexpr size_t WS_BIAS4 = 445 * MiB;
constexpr size_t WS_PART = 446 * MiB;
constexpr size_t WS_END = 510 * MiB;
constexpr int LDS_BYTES = 131072 + 256;

DI unsigned cvtpk(float lo, float hi) { f32x2_t v = {lo, hi}; bf16x2_t b = __builtin_convertvector(v, bf16x2_t); return __builtin_bit_cast(unsigned, b); }
DI void st4bf(bf16* p, f32x4 v) { u32x2 w; w.x = cvtpk(v[0], v[1]); w.y = cvtpk(v[2], v[3]); *(GAS u32x2*)p = w; }
DI float wave_sum(float v) {
#pragma unroll
    for (int o = 1; o < 64; o <<= 1) v += __shfl_xor(v, o);
    return v;
}
DI float fexp2(float x) { return __builtin_amdgcn_exp2f(x); }
DI float max3f(float a, float b, float c) { float r; asm("v_max3_f32 %0, %1, %2, %3" : "=v"(r) : "v"(a), "v"(b), "v"(c)); return r; }
#define LDS_WAIT() asm volatile("s_waitcnt lgkmcnt(0)" ::: "memory")

DI f32x4 rope8(f32x4 v, const float* tab  , int fq) {
    const int i0 = 4 * (fq & 1);
    const f32x4 cs = *(const f32x4*)(tab + i0), sn = *(const f32x4*)(tab + 8 + i0);
    f32x4 o;
#pragma unroll
    for (int j = 0; j < 4; ++j) { const float pr = __shfl_xor(v[j], 32); o[j] = (fq < 2) ? v[j] * cs[j] - pr * sn[j] : pr * sn[j] + v[j] * cs[j]; }
    return o;
}

struct EpiInProj {
    static constexpr bool PERM = false, AFTER_DRAIN = false;
    bf16 *proj, *cqb, *ckvb, *krr; float *ssq_q, *ssq_kv; const float *tabA, *tabC; const float *ssqx, *bias;
    DI void operator()(const f32x4 (&acc0)[2][2][4][2], const pg8::Unit& u, int wr, int wc, int fr, int fq) const {
        const int pn = u.pn; const bool isx = u.pm < 128; const int mi = isx ? (u.pm >> 4) : 8;
        f32x4 bv[2][2];
#pragma unroll
        for (int bj = 0; bj < 2; ++bj)
#pragma unroll
            for (int n = 0; n < 2; ++n) bv[bj][n] = *(const GAS f32x4*)(bias + mi * 2048 + pn * 256 + bj * 128 + wc * 32 + n * 16 + 4 * fq);
        float rsx[2][4];
#pragma unroll
        for (int ai = 0; ai < 2; ++ai)
#pragma unroll
            for (int m = 0; m < 4; ++m) { int row = u.pm * 256 + ai * 128 + wr * 64 + m * 16 + fr; asm volatile("" : "+v"(row)); rsx[ai][m] = ((const GAS float*)ssqx)[row]; }
#pragma unroll
        for (int ai = 0; ai < 2; ++ai)
#pragma unroll
            for (int m = 0; m < 4; ++m) rsx[ai][m] = rsqrtf(rsx[ai][m] * (1.0f / 1024.0f) + EPSN);
        const bool anyrope = isx && pn <= 2;
#pragma unroll
        for (int ai = 0; ai < 2; ++ai)
#pragma unroll
        for (int mh = 0; mh < 2; ++mh) {
            f32x4 cs[4], sn[4];
#pragma unroll
            for (int m = 2 * mh; m < 2 * mh + 2; ++m) { cs[m] = (f32x4){1.f, 1.f, 1.f, 1.f}; sn[m] = (f32x4){0.f, 0.f, 0.f, 0.f}; }
            if (anyrope) {
#pragma unroll
                for (int m = 2 * mh; m < 2 * mh + 2; ++m) { int row = u.pm * 256 + ai * 128 + wr * 64 + m * 16 + fr; asm volatile("" : "+v"(row)); const int tok = row & 4095; const int pos = (wc & 1) ? (tok & 63) : (tok >> 6);
                    cs[m] = *(const GAS f32x4*)(tabA + pos * 32 + 4 * fq); sn[m] = *(const GAS f32x4*)(tabA + pos * 32 + 16 + 4 * fq); }
            }
#pragma unroll
            for (int m = 2 * mh; m < 2 * mh + 2; ++m) {
                int row = u.pm * 256 + ai * 128 + wr * 64 + m * 16 + fr; asm volatile("" : "+v"(row));
                const int tok = row & 4095, prow = tok >> 6, pcol = tok & 63;
                f32x4 acc[2][2];
#pragma unroll
                for (int bj = 0; bj < 2; ++bj)
#pragma unroll
                    for (int n = 0; n < 2; ++n) acc[bj][n] = acc0[ai][bj][m][n] * rsx[ai][m] + bv[bj][n];
                if (pn < 6) {
#pragma unroll
                    for (int bj = 0; bj < 2; ++bj) {
                        f32x4 v0 = acc[bj][0], v1 = acc[bj][1];
                        if (anyrope && (pn < 2 || bj == 0)) { const f32x4 a = v0 * cs[m] - v1 * sn[m], b = v0 * sn[m] + v1 * cs[m]; v0 = a; v1 = b; }
                        if (pn < 2 || pn == 3) { v0 *= C2A; v1 *= C2A; }
                        bf16* p = proj + (size_t)row * PJS + pn * 256 + bj * 128 + wc * 32 + 4 * fq;
                        st4bf(p, v0); st4bf(p + 16, v1);
                    }
                } else if (pn == 6) {
                    float s = 0.f;
#pragma unroll
                    for (int bj = 0; bj < 2; ++bj) {
                        const f32x4 v0 = acc[bj][0], v1 = acc[bj][1];
                        s += (v0[0] * v0[0] + v0[1] * v0[1]) + (v0[2] * v0[2] + v0[3] * v0[3]) + (v1[0] * v1[0] + v1[1] * v1[1]) + (v1[2] * v1[2] + v1[3] * v1[3]);
                        bf16* p = cqb + (size_t)row * 256 + bj * 128 + wc * 32 + 4 * fq;
                        st4bf(p, v0); st4bf(p + 16, v1);
                    }
                    s += __shfl_xor(s, 16); s += __shfl_xor(s, 32);
                    if (fq == 0) atomicAdd(ssq_q + row, s);
                } else {
                    {
                        const f32x4 v0 = acc[0][0], v1 = acc[0][1];
                        float s = (v0[0] * v0[0] + v0[1] * v0[1]) + (v0[2] * v0[2] + v0[3] * v0[3]) + (v1[0] * v1[0] + v1[1] * v1[1]) + (v1[2] * v1[2] + v1[3] * v1[3]);
                        bf16* p = ckvb + (size_t)row * 128 + wc * 32 + 4 * fq;
                        st4bf(p, v0); st4bf(p + 16, v1);
                        s += __shfl_xor(s, 16); s += __shfl_xor(s, 32);
                        if (fq == 0) atomicAdd(ssq_kv + row, s);
                    }
                    if (wc == 0) {
                        f32x4 v0 = acc[1][0], v1 = acc[1][1];
                        if (isx) { v0 = rope8(v0, tabC + prow * 16, fq); v1 = rope8(v1, tabC + pcol * 16, fq); }
                        bf16* p = krr + (size_t)row * 32 + 4 * fq;
                        st4bf(p, v0); st4bf(p + 16, v1);
                    }
                }
            }
        }
    }
};

struct EpiUQ {
    static constexpr bool PERM = false, AFTER_DRAIN = false;
    bf16* qm; const float* ssq_q; const float* tabC;
    DI void operator()(const f32x4 (&acc)[2][2][4][2], const pg8::Unit& u, int wr, int wc, int fr, int fq) const {
        const int pn = u.pn; const bool isx = u.pm < 128;
        float rsq[2][4];
#pragma unroll
        for (int ai = 0; ai < 2; ++ai)
#pragma unroll
            for (int m = 0; m < 4; ++m) { int row = u.pm * 256 + ai * 128 + wr * 64 + m * 16 + fr; asm volatile("" : "+v"(row)); rsq[ai][m] = ((const GAS float*)ssq_q)[row]; }
#pragma unroll
        for (int ai = 0; ai < 2; ++ai)
#pragma unroll
            for (int m = 0; m < 4; ++m) {
                int row = u.pm * 256 + ai * 128 + wr * 64 + m * 16 + fr; asm volatile("" : "+v"(row));
                const int tok = row & 4095, prow = tok >> 6, pcol = tok & 63;
                const float rs = rsqrtf(rsq[ai][m] * (1.0f / 256.0f) + EPSN) * C2C;
#pragma unroll
                for (int bj = 0; bj < 2; ++bj)
#pragma unroll
                    for (int n = 0; n < 2; ++n) {
                        const int col0 = pn * 256 + bj * 128 + wc * 32 + n * 16;
                        if (col0 < 384) {
                            f32x4 v = acc[ai][bj][m][n] * rs;
                            const int g6 = (col0 >> 4) % 6;
                            if (isx && g6 >= 4) v = rope8(v, tabC + (g6 == 4 ? prow : pcol) * 16, fq);
                            st4bf(qm + (size_t)row * 384 + col0 + 4 * fq, v);
                        }
                    }
            }
    }
};

struct EpiUKV {
    static constexpr bool PERM = false, AFTER_DRAIN = false;
    bf16* kvm; const float* ssq_kv;
    DI void operator()(const f32x4 (&acc)[2][2][4][2], const pg8::Unit& u, int wr, int wc, int fr, int fq) const {
        float rsq[2][4];
#pragma unroll
        for (int ai = 0; ai < 2; ++ai)
#pragma unroll
            for (int m = 0; m < 4; ++m) { int row = u.pm * 256 + ai * 128 + wr * 64 + m * 16 + fr; asm volatile("" : "+v"(row)); rsq[ai][m] = ((const GAS float*)ssq_kv)[row]; }
#pragma unroll
        for (int ai = 0; ai < 2; ++ai)
#pragma unroll
            for (int m = 0; m < 4; ++m) {
                int row = u.pm * 256 + ai * 128 + wr * 64 + m * 16 + fr; asm volatile("" : "+v"(row));
                const float rs = rsqrtf(rsq[ai][m] * (1.0f / 128.0f) + EPSN);
#pragma unroll
                for (int bj = 0; bj < 2; ++bj)
#pragma unroll
                    for (int n = 0; n < 2; ++n) {
                        const int col0 = u.pn * 256 + bj * 128 + wc * 32 + n * 16;
                        st4bf(kvm + (size_t)row * 512 + col0 + 4 * fq, acc[ai][bj][m][n] * rs);
                    }
            }
    }
};

struct EpiRelu2 {
    static constexpr bool PERM = true, AFTER_DRAIN = false;
    bf16* H; const float *ssqx, *bias;
    DI void operator()(const f32x4 (&acc)[2][2][4][2], const pg8::Unit& u, int wr, int wc, int fr, int fq) const {
        const int col0 = u.pn * 256 + wc * 32 + 8 * fq; const int mi = (u.pm < 128) ? (u.pm >> 4) : 8;
        f32x4 bv[2][2];
#pragma unroll
        for (int bj = 0; bj < 2; ++bj)
#pragma unroll
            for (int n = 0; n < 2; ++n) bv[bj][n] = *(const GAS f32x4*)(bias + mi * 4096 + col0 + bj * 128 + 4 * n);
        float rsx[2][4];
#pragma unroll
        for (int ai = 0; ai < 2; ++ai)
#pragma unroll
            for (int m = 0; m < 4; ++m) { int row = u.pm * 256 + ai * 128 + wr * 64 + m * 16 + fr; asm volatile("" : "+v"(row)); rsx[ai][m] = ((const GAS float*)ssqx)[row]; }
#pragma unroll
        for (int ai = 0; ai < 2; ++ai)
#pragma unroll
            for (int m = 0; m < 4; ++m) {
                int row = u.pm * 256 + ai * 128 + wr * 64 + m * 16 + fr; asm volatile("" : "+v"(row));
                const float rs = rsqrtf(rsx[ai][m] * (1.0f / 1024.0f) + EPSN);
                bf16* rowp = H + (size_t)row * DFF + col0;
#pragma unroll
                for (int bj = 0; bj < 2; ++bj) {
                    f32x4 v0 = acc[ai][bj][m][0] * rs + bv[bj][0], v1 = acc[ai][bj][m][1] * rs + bv[bj][1];
#pragma unroll
                    for (int j = 0; j < 4; ++j) { const float a = fmaxf(v0[j], 0.f), b = fmaxf(v1[j], 0.f); v0[j] = a * a; v1[j] = b * b; }
                    u32x4 w; w.x = cvtpk(v0[0], v0[1]); w.y = cvtpk(v0[2], v0[3]); w.z = cvtpk(v1[0], v1[1]); w.w = cvtpk(v1[2], v1[3]);
                    *(GAS u32x4*)(rowp + bj * 128) = w;
                }
            }
    }
};

struct EpiResid {
    static constexpr bool PERM = false, AFTER_DRAIN = false;
    const float *srcx, *srcc; float *dstx, *dstc; const float* gate; bf16* xg; float* ssq_out; const float *gn, *scn; int donorm;
    DI void operator()(const f32x4 (&acc)[2][2][4][2], const pg8::Unit& u, int wr, int wc, int fr, int fq) const {
        const bool isx = u.pm < 128; const int mi = isx ? (u.pm >> 4) : 8;
        const int col0 = u.pn * 256 + wc * 32 + 4 * fq;
        f32x4 gv[2][2], gp[2][2];
#pragma unroll
        for (int bj = 0; bj < 2; ++bj)
#pragma unroll
            for (int n = 0; n < 2; ++n) { const int c = col0 + bj * 128 + n * 16; gv[bj][n] = *(const GAS f32x4*)(gate + mi * 6144 + c);
                gp[bj][n] = donorm ? *(const GAS f32x4*)(gn + c) * (*(const GAS f32x4*)(scn + mi * 6144 + c) + 1.0f) : (f32x4){0.f, 0.f, 0.f, 0.f}; }
#pragma unroll
        for (int ai = 0; ai < 2; ++ai)
#pragma unroll
        for (int mh = 0; mh < 2; ++mh) {
            f32x4 xs[4][2][2];
#pragma unroll
            for (int m = 2 * mh; m < 2 * mh + 2; ++m) {
                int row = u.pm * 256 + ai * 128 + wr * 64 + m * 16 + fr; asm volatile("" : "+v"(row));
                const float* s = isx ? srcx + (size_t)row * DM : srcc + (size_t)(row - MX) * DM;
#pragma unroll
                for (int bj = 0; bj < 2; ++bj)
#pragma unroll
                    for (int n = 0; n < 2; ++n) xs[m][bj][n] = *(const GAS f32x4*)(s + col0 + bj * 128 + n * 16);
            }
#pragma unroll
            for (int m = 2 * mh; m < 2 * mh + 2; ++m) {
                int row = u.pm * 256 + ai * 128 + wr * 64 + m * 16 + fr; asm volatile("" : "+v"(row));
                float* d = isx ? dstx + (size_t)row * DM : dstc + (size_t)(row - MX) * DM;
                float ss = 0.f;
#pragma unroll
                for (int bj = 0; bj < 2; ++bj)
#pragma unroll
                    for (int n = 0; n < 2; ++n) { const int off = col0 + bj * 128 + n * 16;
                        const f32x4 xn = xs[m][bj][n] + gv[bj][n] * acc[ai][bj][m][n];
                        *(GAS f32x4*)(d + off) = xn;
                        if (donorm) { ss += (xn[0] * xn[0] + xn[1] * xn[1]) + (xn[2] * xn[2] + xn[3] * xn[3]); st4bf(xg + (size_t)row * DM + off, xn * gp[bj][n]); } }
                if (donorm) { ss += __shfl_xor(ss, 16); ss += __shfl_xor(ss, 32); if (fq == 0) atomicAdd(ssq_out + row, ss); }
            }
        }
    }
};

struct SplitOrder {
    int G, c, NS, ksub_bytes;
    DI void init(int G_, int c_, int NS_, int Ksub) { G = G_; c = c_; NS = NS_; ksub_bytes = Ksub * 2; }
    DI bool next(int i, pg8::Unit& u) const { const int idx = i * G + c; if (idx >= 32 * NS) return false; const int ks = idx % NS, tile = idx / NS; u.pn = tile & 3; u.pm = 128 + (tile >> 2); u.kb = ks * ksub_bytes; return true; }
    DI void a_ready(const pg8::Unit&) const {}
    DI void done(const pg8::Unit&) const {}
};
struct EpiPartial {
    static constexpr bool PERM = false, AFTER_DRAIN = false;
    float* part; int ksub_bytes;
    DI void operator()(const f32x4 (&acc)[2][2][4][2], const pg8::Unit& u, int wr, int wc, int fr, int fq) const {
        const int ks = u.kb / ksub_bytes; const int col0 = u.pn * 256 + wc * 32 + 4 * fq;
        float* base = part + (size_t)ks * MC * DM;
#pragma unroll
        for (int ai = 0; ai < 2; ++ai)
#pragma unroll
            for (int m = 0; m < 4; ++m) {
                int row = (u.pm - 128) * 256 + ai * 128 + wr * 64 + m * 16 + fr;
                asm volatile("" : "+v"(row) :: "memory");
                float* rowp = base + (size_t)row * DM + col0;
#pragma unroll
                for (int bj = 0; bj < 2; ++bj)
#pragma unroll
                    for (int n = 0; n < 2; ++n) *(GAS f32x4*)(rowp + bj * 128 + n * 16) = acc[ai][bj][m][n];
            }
    }
};
DI void ctx_finish(const float* part, int NS, const float* src, float* dst, const float* gate8, bf16* xg, float* ssq_out, const float* gn, const float* scn8, const int tid) {
    const int lane = tid & 63, gw = blockIdx.x * 8 + (tid >> 6), NGW = gridDim.x * 8;
    for (int row = gw; row < MC; row += NGW) {
        float s = 0.f;
#pragma unroll
        for (int j = 0; j < 4; ++j) {
            const int col = 256 * j + 4 * lane;
            f32x4 a = {0.f, 0.f, 0.f, 0.f};
            for (int ks = 0; ks < NS; ++ks) a += *(const GAS f32x4*)(part + ((size_t)ks * MC + row) * DM + col);
            const f32x4 xn = *(const GAS f32x4*)(src + (size_t)row * DM + col) + *(const GAS f32x4*)(gate8 + col) * a;
            *(GAS f32x4*)(dst + (size_t)row * DM + col) = xn;
            s += (xn[0] * xn[0] + xn[1] * xn[1]) + (xn[2] * xn[2] + xn[3] * xn[3]);
            st4bf(xg + (size_t)(MX + row) * DM + col, xn * (*(const GAS f32x4*)(gn + col) * (*(const GAS f32x4*)(scn8 + col) + 1.0f)));
        }
        s = wave_sum(s);
        if (lane == 0) ssq_out[MX + row] = s;
    }
}

DI void transpose_item(const float* W, int K, int N, bf16* WT, const float* kscale, LAS float* scr, int item, int lane) {
    const int nblk = N / 32, kb = item / nblk, nb = item % nblk, k0 = 64 * kb, n0 = 32 * nb;
#pragma unroll 16
    for (int i = 0; i < 32; ++i) { const int kk = 2 * i + (lane >> 5); float w = W[(size_t)(k0 + kk) * N + n0 + (lane & 31)]; if (kscale) w *= kscale[k0 + kk]; scr[kk * 33 + (lane & 31)] = w; }
    LDS_WAIT();
    const int c = lane & 7;
#pragma unroll
    for (int j = 0; j < 4; ++j) { const int n = (lane >> 3) + 8 * j; const LAS float* s = scr + (8 * c) * 33 + n;
        u32x4 o; o.x = cvtpk(s[0 * 33], s[1 * 33]); o.y = cvtpk(s[2 * 33], s[3 * 33]); o.z = cvtpk(s[4 * 33], s[5 * 33]); o.w = cvtpk(s[6 * 33], s[7 * 33]);
        *(u32x4*)(WT + (size_t)(n0 + n) * K + k0 + 8 * c) = o; }
    LDS_WAIT();
}

DI void gemv9_item(const float* W, int ldw, int nvalid, int n0, const LAS float* sl, LAS float* red, const float* addb, float* out, int ldo, const int tid) {
    const int col = tid & 31, kg = tid >> 5, n = n0 + col;
    float acc[9];
#pragma unroll
    for (int mi = 0; mi < 9; ++mi) acc[mi] = 0.f;
    if (n < nvalid) {
        const float* w = W + (size_t)(kg * 64) * ldw + n;
#pragma unroll 16
        for (int k = 0; k < 64; ++k) { const float wv = w[(size_t)k * ldw];
#pragma unroll
            for (int mi = 0; mi < 9; ++mi) acc[mi] += sl[mi * 1024 + kg * 64 + k] * wv; }
    }
#pragma unroll
    for (int mi = 0; mi < 9; ++mi) red[(kg * 9 + mi) * 32 + col] = acc[mi];
    __syncthreads();
    if (tid < 288) { const int mi = tid >> 5, cq = tid & 31; float sacc = (addb && n0 + cq < nvalid) ? addb[n0 + cq] : 0.f;
#pragma unroll
        for (int g = 0; g < 16; ++g) sacc += red[(g * 9 + mi) * 32 + cq];
        out[(size_t)mi * ldo + n0 + cq] = sacc; }
    __syncthreads();
}

struct Args { const float* in[19]; float* out; unsigned char* ws; int ph_lo, ph_hi; };

DI void prologue(const Args& a, LAS unsigned char* lds, const int tid) {
    const int lane = tid & 63, wave = __builtin_amdgcn_readfirstlane(tid >> 6);
    int G = gridDim.x; asm volatile("" : "+s"(G));
    const int bx = blockIdx.x;
    unsigned char* ws = a.ws;
    {
        LAS float* sl = (LAS float*)lds;
        LAS float* red = (LAS float*)(lds + 36864);
        const float* c = a.in[1]; const float* cc = a.in[3]; const float* w_ada = a.in[4]; const float* b_ada = a.in[5];
        float* mods = (float*)(ws + WS_MODS);
        for (int idx = tid; idx < 9 * 1024; idx += NTHR) { const int mi = idx >> 10, k = idx & 1023; const float v = mi < 8 ? c[mi * 1024 + k] : cc[k]; sl[idx] = v / (1.0f + expf(-v)); }
        __syncthreads();
        for (int item = bx; item < DEPTH * 192; item += G) {
            const int l = item / 192, n0 = (item % 192) * 32;
            gemv9_item(w_ada + (size_t)l * 1024 * 6144, 6144, 6144, n0, sl, red, b_ada + l * 6144, mods + (size_t)l * 9 * 6144, 6144, tid);
        }
    }
    {
        const int gid = bx * NTHR + tid, NG = G * NTHR;
        float* tabA = (float*)(ws + WS_TAB); float* tabC = tabA + 2048;
        if (gid < 1024) { const int pos = gid >> 4, i = gid & 15; const float fr = exp2f(-(float)i * (1.0f / 16.0f) * 13.287712379549449f); const float rev = ((float)pos * fr) * 0.15915494309189535f;
            tabA[pos * 32 + i] = __builtin_amdgcn_cosf(rev); tabA[pos * 32 + 16 + i] = __builtin_amdgcn_sinf(rev); }
        else if (gid < 1536) { const int g = gid - 1024, pos = g >> 3, i = g & 7; const float fr = exp2f(-(float)i * (1.0f / 8.0f) * 13.287712379549449f); const float rev = ((float)pos * fr) * 0.15915494309189535f;
            tabC[pos * 16 + i] = __builtin_amdgcn_cosf(rev); tabC[pos * 16 + 8 + i] = __builtin_amdgcn_sinf(rev); }
        float* ssq = (float*)(ws + WS_SSQ);
        for (int i = gid; i < DEPTH * 2 * MT; i += NG) ssq[i] = 0.f;
        float* ssqx = (float*)(ws + WS_SSQX);
        for (int i = gid; i < DEPTH * 2 * MT; i += NG) ssqx[i] = 0.f;
        const u32x4 z = {0u, 0u, 0u, 0u};
        for (int i = gid; i < DEPTH * 12288; i += NG) { const int l = i / 12288, r = i % 12288; ((u32x4*)(ws + WS_W + l * WL_STRIDE + WL_IN + (size_t)INW * 1024 * 2))[r] = z; }
        for (int i = gid; i < DEPTH * 4096; i += NG) { const int l = i / 4096, r = i % 4096; ((u32x4*)(ws + WS_W + l * WL_STRIDE + WL_UQ + (size_t)384 * 256 * 2))[r] = z; }
    }
    {
        LAS float* scr = (LAS float*)(lds + wave * 16384);
        const int gw = bx * 8 + wave, NGW = G * 8;
        constexpr int I_IN = 16 * 61, I_OUT = 16 * 32, I_W1 = 16 * 128, I_W2 = 64 * 32, I_UQ = 4 * 12, I_UKV = 2 * 16, I_L = I_IN + I_OUT + I_W1 + I_W2 + I_UQ + I_UKV;
        for (int it = gw; it < DEPTH * I_L; it += NGW) {
            const int l = it / I_L; int r = it % I_L; unsigned char* wb = ws + WS_W + l * WL_STRIDE;
            if (r < I_IN) { transpose_item(a.in[8] + (size_t)l * 1024 * INW, 1024, INW, (bf16*)(wb + WL_IN), nullptr, scr, r, lane); continue; } r -= I_IN;
            if (r < I_OUT) { transpose_item(a.in[15] + (size_t)l * 1024 * 1024, 1024, 1024, (bf16*)(wb + WL_OUT), nullptr, scr, r, lane); continue; } r -= I_OUT;
            if (r < I_W1) { transpose_item(a.in[16] + (size_t)l * 1024 * 4096, 1024, 4096, (bf16*)(wb + WL_W1), nullptr, scr, r, lane); continue; } r -= I_W1;
            if (r < I_W2) { transpose_item(a.in[17] + (size_t)l * 4096 * 1024, 4096, 1024, (bf16*)(wb + WL_W2), nullptr, scr, r, lane); continue; } r -= I_W2;
            if (r < I_UQ) { transpose_item(a.in[12] + (size_t)l * 256 * 384, 256, 384, (bf16*)(wb + WL_UQ), a.in[11] + l * 256, scr, r, lane); continue; } r -= I_UQ;
            transpose_item(a.in[14] + (size_t)l * 128 * 512, 128, 512, (bf16*)(wb + WL_UKV), a.in[13] + l * 128, scr, r, lane);
        }
    }
}

DI void phase1(const Args& a, LAS unsigned char* lds, const int tid) {
    unsigned char* ws = a.ws;
    int G = gridDim.x; asm volatile("" : "+s"(G));
    const int bx = blockIdx.x;
    const float* mods = (const float*)(ws + WS_MODS);
    {
        LAS float* sl = (LAS float*)lds; LAS float* red = (LAS float*)(lds + 36864);
        float* bias1 = (float*)(ws + WS_BIAS1); float* bias4 = (float*)(ws + WS_BIAS4);
        for (int item = bx; item < DEPTH * 192; item += G) {
            const int l = item / 192, r = item % 192, which = r < 64 ? 0 : 1, tile = which ? r - 64 : r;
            const float* mv = mods + (size_t)l * 9 * 6144 + (which ? 3 : 0) * 1024;
            for (int idx = tid; idx < 9 * 1024; idx += NTHR) sl[idx] = mv[(size_t)(idx >> 10) * 6144 + (idx & 1023)];
            __syncthreads();
            if (!which) gemv9_item(a.in[8] + (size_t)l * 1024 * INW, INW, INW, tile * 32, sl, red, nullptr, bias1 + (size_t)l * 9 * 2048, 2048, tid);
            else gemv9_item(a.in[16] + (size_t)l * 1024 * DFF, DFF, DFF, tile * 32, sl, red, nullptr, bias4 + (size_t)l * 9 * 4096, 4096, tid);
        }
    }
    {
        const int lane = tid & 63, gw = bx * 8 + (tid >> 6), NGW = G * 8;
        bf16* Hn = (bf16*)(ws + WS_HN); float* ssqx = (float*)(ws + WS_SSQX); const float* g = a.in[6];
        f32x4 gg[4];
#pragma unroll
        for (int j = 0; j < 4; ++j) gg[j] = *(const GAS f32x4*)(g + 256 * j + 4 * lane);
        for (int row0 = gw; row0 < MT; row0 += 4 * NGW) {
            f32x4 v[4][4];
#pragma unroll
            for (int q = 0; q < 4; ++q) { const int row = row0 + q * NGW;
                if (row < MT) { const float* src = row < MX ? a.in[0] + (size_t)row * DM : a.in[2] + (size_t)(row - MX) * DM;
                    const GAS f32x4* xr = (const GAS f32x4*)src + lane;
#pragma unroll
                    for (int j = 0; j < 4; ++j) v[q][j] = xr[64 * j]; } }
#pragma unroll
            for (int q = 0; q < 4; ++q) { const int row = row0 + q * NGW;
                if (row < MT) { const int mi = row < MX ? (row >> 12) : 8; float s = 0.f;
#pragma unroll
                    for (int j = 0; j < 4; ++j) s += (v[q][j][0] * v[q][j][0] + v[q][j][1] * v[q][j][1]) + (v[q][j][2] * v[q][j][2] + v[q][j][3] * v[q][j][3]);
                    s = wave_sum(s);
                    if (lane == 0) ssqx[row] = s;
                    const float* mrow = mods + (size_t)mi * 6144 + 1024;
#pragma unroll
                    for (int j = 0; j < 4; ++j) { const int col = 256 * j + 4 * lane;
                        const f32x4 sc = *(const GAS f32x4*)(mrow + col);
                        st4bf(Hn + (size_t)row * DM + col, v[q][j] * (gg[j] * (sc + 1.0f))); } } }
        }
    }
}
DI void final_norm_phase(float* x, const float* g, const int tid) {
    const int lane = tid & 63, gw = blockIdx.x * 8 + (tid >> 6), NGW = gridDim.x * 8;
    f32x4 gg[4];
#pragma unroll
    for (int j = 0; j < 4; ++j) gg[j] = *(const GAS f32x4*)(g + 256 * j + 4 * lane);
    for (int row0 = gw; row0 < MX; row0 += 4 * NGW) {
        f32x4 v[4][4];
#pragma unroll
        for (int q = 0; q < 4; ++q) { const int row = row0 + q * NGW;
            if (row < MX) { const GAS f32x4* xr = (const GAS f32x4*)(x + (size_t)row * DM) + lane;
#pragma unroll
                for (int j = 0; j < 4; ++j) v[q][j] = xr[64 * j]; } }
#pragma unroll
        for (int q = 0; q < 4; ++q) { const int row = row0 + q * NGW;
            if (row < MX) { float s = 0.f;
#pragma unroll
                for (int j = 0; j < 4; ++j) s += (v[q][j][0] * v[q][j][0] + v[q][j][1] * v[q][j][1]) + (v[q][j][2] * v[q][j][2] + v[q][j][3] * v[q][j][3]);
                const float r = rsqrtf(wave_sum(s) * (1.0f / DM) + EPSN);
                GAS f32x4* xw = (GAS f32x4*)(x + (size_t)row * DM) + lane;
#pragma unroll
                for (int j = 0; j < 4; ++j) xw[64 * j] = v[q][j] * r * gg[j]; } }
    }
}

struct AttnP { const bf16 *proj, *qm, *kvm, *krr; bf16* mix; const float* sink; const float* rpb; };
constexpr int A_VS = 144, A_KB = 64 * 208, A_VB = 64 * A_VS, L_K = 0, L_V = 2 * A_KB, L_B = L_V + 2 * A_VB;

template <int TYPE> DI int key_row(int t, int j, int b, int nblk, int kr0, int kc0) {
    if (t < 4) return MX + b * 256 + t * 64 + j;
    const int tt = t - 4;
    if (TYPE == 0) return b * 4096 + (nblk - 1) * 128 + tt * 64 + j;
    if (TYPE == 1) { const int tr = tt / 3, tc = tt - 3 * tr; return b * 4096 + (kr0 + 4 * tr + (j >> 4)) * 64 + kc0 + 16 * tc + (j & 15); }
    return b * 4096 + tt * 64 + j;
}

constexpr float ATHR = 6.0f;
template <int TYPE> struct AttnCtx { int t_qi, t_h, kr0, kc0, qr, qc, wr_, wc_; };

#define AT_SB() __builtin_amdgcn_sched_barrier(0)
template <int TYPE, int NKS, int KSTR> DI void at_mfma_block(f32x16& p0, f32x16& p1, f32x16& o0, f32x16& o1, const bf16x8 (&qf)[NKS], const bf16x8 (&pf)[4], float m_,
                                                             const LAS unsigned char* kb0, const LAS unsigned char* vb, bool do_s, bool do_pv) {
    constexpr int NST = NKS + 4;
    bf16x8 fr[NST][2];
    const int first = do_s ? 0 : NKS, last = do_pv ? NST : NKS;
#define AT_LD(i_) do { if ((i_) >= first && (i_) < last) { \
        if ((i_) < NKS) { fr[i_][0] = *(const LAS bf16x8*)(kb0 + (i_) * 32); fr[i_][1] = *(const LAS bf16x8*)(kb0 + 32 * KSTR + (i_) * 32); } \
        else { const int s_ = (i_) - NKS; \
            const s16x4 l0_ = __builtin_bit_cast(s16x4, __builtin_amdgcn_ds_read_tr16_b64_v4i16((LAS s16x4*)(vb + (16 * s_) * A_VS))); \
            const s16x4 h0_ = __builtin_bit_cast(s16x4, __builtin_amdgcn_ds_read_tr16_b64_v4i16((LAS s16x4*)(vb + (16 * s_ + 8) * A_VS))); \
            const s16x4 l1_ = __builtin_bit_cast(s16x4, __builtin_amdgcn_ds_read_tr16_b64_v4i16((LAS s16x4*)(vb + (16 * s_) * A_VS + 64))); \
            const s16x4 h1_ = __builtin_bit_cast(s16x4, __builtin_amdgcn_ds_read_tr16_b64_v4i16((LAS s16x4*)(vb + (16 * s_ + 8) * A_VS + 64))); \
            fr[i_][0] = __builtin_shufflevector(l0_, h0_, 0, 1, 2, 3, 4, 5, 6, 7); fr[i_][1] = __builtin_shufflevector(l1_, h1_, 0, 1, 2, 3, 4, 5, 6, 7); } } } while (0)
    if (do_s) {
        const float nm = -m_;
#pragma unroll
        for (int i = 0; i < 16; ++i) { p0[i] = nm; p1[i] = nm; }
    }
#pragma unroll
    for (int i = 0; i < NST; ++i) {
        if (i == 0) { AT_LD(0); AT_LD(1); }
        if (i == NKS && !do_s) { AT_LD(NKS); AT_LD(NKS + 1); }
        if (i + 2 < NST) AT_LD(i + 2);
        AT_SB();
        if (i >= first && i < last) {
            if (i < NKS) { p0 = __builtin_amdgcn_mfma_f32_32x32x16_bf16(fr[i][0], qf[i < NKS ? i : 0], p0, 0, 0, 0); p1 = __builtin_amdgcn_mfma_f32_32x32x16_bf16(fr[i][1], qf[i < NKS ? i : 0], p1, 0, 0, 0); }
            else { o0 = __builtin_amdgcn_mfma_f32_32x32x16_bf16(fr[i][0], pf[i >= NKS ? i - NKS : 0], o0, 0, 0, 0); o1 = __builtin_amdgcn_mfma_f32_32x32x16_bf16(fr[i][1], pf[i >= NKS ? i - NKS : 0], o1, 0, 0, 0); }
        }
        AT_SB();
    }
#undef AT_LD
}

template <int TYPE> DI void at_valu_block(f32x16& p0, f32x16& p1, f32x16& o0, f32x16& o1, bf16x8 (&pf)[4], float& m_, float& l_, int t, bool first,
                                          int qi, int h, int kr0, int kc0, int qr, int qc, int wr_, int wc_, const LAS float* lbias) {
    if (t >= 4) {
        if (TYPE == 0) {
            const int d0 = 64 * (t - 4) - qi + 4 * h;
#pragma unroll
            for (int i = 0; i < 16; ++i) { const int e = d0 + (i & 3) + 8 * (i >> 2);
                if ((unsigned)e > 256u) p0[i] = -1e30f;
                if ((unsigned)(e + 32) > 256u) p1[i] = -1e30f; }
        } else if (TYPE == 1) {
            const int tt = t - 4, tr = tt / 3, tc = tt - 3 * tr;
            const int krb = kr0 + 4 * tr, kcb = kc0 + 16 * tc + 4 * h;
#pragma unroll
            for (int i = 0; i < 16; ++i) {
                const int kc = kcb + (i & 3) + 8 * ((i >> 2) & 1);
                const bool cv = (unsigned)(kc - wc_) < 16u;
                const int ci = kc - qc + 15;
                { const int kr = krb + (i >> 3); const bool v = cv && ((unsigned)(kr - wr_) < 8u); const int idx = v ? (kr - qr + 7) * 31 + ci : 0; const float bv = lbias[idx]; p0[i] = v ? p0[i] + bv : -1e30f; }
                { const int kr = krb + 2 + (i >> 3); const bool v = cv && ((unsigned)(kr - wr_) < 8u); const int idx = v ? (kr - qr + 7) * 31 + ci : 0; const float bv = lbias[idx]; p1[i] = v ? p1[i] + bv : -1e30f; }
            }
        }
    }
    asm volatile("s_nop 15\n\ts_nop 7" : "+v"(p0), "+v"(p1));
    float mxa = max3f(p0[0], p0[1], p1[0]), mxb = max3f(p0[2], p0[3], p1[1]); mxa = max3f(mxa, p1[2], p1[3]);
#pragma unroll
    for (int i = 4; i < 16; i += 4) { mxa = max3f(mxa, p0[i], p0[i + 1]); mxb = max3f(mxb, p0[i + 2], p0[i + 3]); mxa = max3f(mxa, p1[i], p1[i + 1]); mxb = max3f(mxb, p1[i + 2], p1[i + 3]); }
    float mx = max3f(mxa, mxb, mxb);
    mx = max3f(mx, __shfl_xor(mx, 32), mx);
    if (first || __any(mx > ATHR)) {
        const float dl = (TYPE != 0 && first) ? mx : fmaxf(mx, 0.f);
        const float alpha = fexp2(-dl);
        m_ += dl; l_ *= alpha;
#pragma unroll
        for (int i = 0; i < 16; ++i) { p0[i] -= dl; p1[i] -= dl; o0[i] *= alpha; o1[i] *= alpha; }
    }
    float ls = 0.f;
#pragma unroll
    for (int i = 0; i < 16; ++i) { p0[i] = fexp2(p0[i]); p1[i] = fexp2(p1[i]); ls += p0[i] + p1[i]; }
    l_ += ls;
#pragma unroll
    for (int s = 0; s < 4; ++s) {
        u32x4 pw;
        if (s < 2) { pw.x = cvtpk(p0[8 * s + 0], p0[8 * s + 1]); pw.y = cvtpk(p0[8 * s + 2], p0[8 * s + 3]); pw.z = cvtpk(p0[8 * s + 4], p0[8 * s + 5]); pw.w = cvtpk(p0[8 * s + 6], p0[8 * s + 7]); }
        else { const int s2 = s - 2; pw.x = cvtpk(p1[8 * s2 + 0], p1[8 * s2 + 1]); pw.y = cvtpk(p1[8 * s2 + 2], p1[8 * s2 + 3]); pw.z = cvtpk(p1[8 * s2 + 4], p1[8 * s2 + 5]); pw.w = cvtpk(p1[8 * s2 + 6], p1[8 * s2 + 7]); }
        pf[s] = __builtin_bit_cast(bf16x8, pw);
    }
}

template <int TYPE> DI void attn_unit(const AttnP& P, int uid, bool isctx, LAS unsigned char* lds, const int tid) {
    constexpr int DQK = TYPE == 2 ? 96 : 64, NKS = DQK / 16, KSTR = DQK * 2 + 16;
    const int lane = tid & 63, w = __builtin_amdgcn_readfirstlane(tid >> 6), r = lane & 31, h = lane >> 5;
    int b, hd, kvh = 0, qrow, nblk = 0, kr0 = 0, kc0 = 0, qr = 0, qc = 0, tb0 = 4, tb1 = 4;
    if (TYPE == 0) {
        int gp;
        if (!isctx) { b = uid >> 7; kvh = (uid >> 6) & 1; nblk = (uid >> 1) & 31; gp = uid & 1; qrow = b * 4096 + nblk * 128 + (w & 3) * 32 + r; tb0 = nblk == 0 ? 6 : 4; tb1 = nblk == 31 ? 8 : 10; }
        else { b = uid >> 3; kvh = (uid >> 2) & 1; gp = (uid >> 1) & 1; nblk = uid & 1; qrow = MX + b * 256 + nblk * 128 + (w & 3) * 32 + r; }
        hd = kvh * 4 + gp * 2 + (w >> 2);
    } else if (TYPE == 1) {
        if (!isctx) { b = uid >> 6; hd = (uid >> 4) & 3; const int ib = (uid >> 1) & 7, cp = uid & 1;
            qr = 8 * ib + 2 * (w & 3) + (r >> 4); qc = 16 * (2 * cp + (w >> 2)) + (r & 15); qrow = b * 4096 + qr * 64 + qc;
            kr0 = min(max(8 * ib - 4, 0), 48); kc0 = 16 * cp; tb1 = 16; }
        else { b = uid >> 2; hd = uid & 3; qrow = MX + b * 256 + w * 32 + r; }
    } else {
        if (!isctx) { b = uid >> 6; hd = (uid >> 4) & 3; qrow = b * 4096 + (uid & 15) * 256 + w * 32 + r; tb1 = 68; }
        else { b = uid >> 2; hd = uid & 3; qrow = MX + b * 256 + w * 32 + r; }
    }
    const int NTA = 4 + (tb1 - tb0);
    const bf16* qp; int ocol;
    if (TYPE == 0) { qp = P.proj + (size_t)qrow * PJS + hd * 64; ocol = hd * 64; }
    else if (TYPE == 1) { qp = P.proj + (size_t)qrow * PJS + 768 + hd * 64; ocol = 512 + hd * 64; }
    else { qp = P.qm + (size_t)qrow * 384 + hd * 96; ocol = 768 + hd * 64; }
    bf16x8 qf[NKS];
#pragma unroll
    for (int ks = 0; ks < NKS; ++ks) qf[ks] = *(const GAS bf16x8*)(qp + 16 * ks + 8 * h);

    float m_ = 0.f, l_ = 0.f;
    if (TYPE == 0) { m_ = P.sink[hd] * LOG2E; l_ = (h == 0) ? 1.f : 0.f; }
    f32x16 o0, o1, p0, p1;
#pragma unroll
    for (int i = 0; i < 16; ++i) { o0[i] = 0.f; o1[i] = 0.f; p0[i] = 0.f; p1[i] = 0.f; }
    bf16x8 pf[4];
#pragma unroll
    for (int s = 0; s < 4; ++s) pf[s] = (bf16x8){0, 0, 0, 0, 0, 0, 0, 0};

    u32x4 kreg, vreg, rreg = {0u, 0u, 0u, 0u};
    const int sj = tid >> 3, sc = tid & 7;
#define AT_TILE(it_) ((it_) < 4 ? (it_) : (it_) - 4 + tb0)
#define AT_LOADK(t) do { const int kr_ = key_row<TYPE>((t), sj, b, nblk, kr0, kc0); \
        if (TYPE == 2) { kreg = *(const GAS u32x4*)(P.kvm + (size_t)kr_ * 512 + hd * 128 + sc * 8); \
            if (tid < 256) { const int kr2_ = key_row<TYPE>((t), tid >> 2, b, nblk, kr0, kc0); rreg = *(const GAS u32x4*)(P.krr + (size_t)kr2_ * 32 + (tid & 3) * 8); } } \
        else kreg = *(const GAS u32x4*)(P.proj + (size_t)kr_ * PJS + (TYPE == 0 ? 512 + kvh * 64 : 1024 + hd * 64) + sc * 8); } while (0)
#define AT_LOADV(t) do { const int kr_ = key_row<TYPE>((t), sj, b, nblk, kr0, kc0); \
        if (TYPE == 2) vreg = *(const GAS u32x4*)(P.kvm + (size_t)kr_ * 512 + hd * 128 + 64 + sc * 8); \
        else vreg = *(const GAS u32x4*)(P.proj + (size_t)kr_ * PJS + (TYPE == 0 ? 640 + kvh * 64 : 1280 + hd * 64) + sc * 8); } while (0)
#define AT_STOREK(bi) do { *(LAS u32x4*)(lds + L_K + (bi) * A_KB + sj * KSTR + sc * 16) = kreg; \
        if (TYPE == 2) { if (tid < 256) *(LAS u32x4*)(lds + L_K + (bi) * A_KB + (tid >> 2) * KSTR + 128 + (tid & 3) * 16) = rreg; } } while (0)
#define AT_STOREV(bi) do { *(LAS u32x4*)(lds + L_V + (bi) * A_VB + sj * A_VS + sc * 16) = vreg; } while (0)
    AT_LOADK(0);
    __syncthreads();
    LAS float* lbias = (LAS float*)(lds + L_B);
    if (TYPE == 1 && !isctx) { if (tid < 465) lbias[tid] = ((const GAS float*)P.rpb)[hd * 465 + tid] * LOG2E; }
    AT_STOREK(0);
    AT_LOADK(AT_TILE(1)); AT_LOADV(0);
    __syncthreads();
    const int q4 = (lane & 15) >> 2, p4 = lane & 3, blk = (lane >> 4) & 1;
    const int voff = L_V + (4 * h + q4) * A_VS + (16 * blk + 4 * p4) * 2;
    const int koff = L_K + r * KSTR + 16 * h;
    const int wr_ = min(max(qr - 4, 0), 56), wc_ = min(max(qc - 8, 0), 48);
    const int qi = (w & 3) * 32 + r;
    const bool grp1 = (w >> 2) != 0;

#define AT_STAGE(it) do { if ((it) + 1 < NTA) AT_STOREK(((it) + 1) & 1); AT_STOREV((it) & 1); \
        if ((it) + 2 < NTA) AT_LOADK(AT_TILE((it) + 2)); if ((it) + 1 < NTA) AT_LOADV(AT_TILE((it) + 1)); __syncthreads(); } while (0)
    if (!grp1) {
        for (int it = 0; it < NTA; ++it) {
            const int t = AT_TILE(it);
            const LAS unsigned char* kb0 = lds + (it & 1) * A_KB + koff;
            const LAS unsigned char* vb = lds + ((it + 1) & 1) * A_VB + voff;
            at_mfma_block<TYPE, NKS, KSTR>(p0, p1, o0, o1, qf, pf, m_, kb0, vb, true, it > 0);
            at_valu_block<TYPE>(p0, p1, o0, o1, pf, m_, l_, t, it == 0, qi, h, kr0, kc0, qr, qc, wr_, wc_, lbias);
            AT_STAGE(it);
        }
        const LAS unsigned char* vb = lds + ((NTA - 1) & 1) * A_VB + voff;
        at_mfma_block<TYPE, NKS, KSTR>(p0, p1, o0, o1, qf, pf, m_, vb, vb, false, true);
    } else {
        for (int it = 0; it < NTA; ++it) {
            const int tp = AT_TILE(it - 1);
            const LAS unsigned char* kb0 = lds + (it & 1) * A_KB + koff;
            const LAS unsigned char* vb = lds + ((it + 1) & 1) * A_VB + voff;
            if (it > 0) at_valu_block<TYPE>(p0, p1, o0, o1, pf, m_, l_, tp, it == 1, qi, h, kr0, kc0, qr, qc, wr_, wc_, lbias);
            at_mfma_block<TYPE, NKS, KSTR>(p0, p1, o0, o1, qf, pf, m_, kb0, vb, true, it > 0);
            AT_STAGE(it);
        }
        const LAS unsigned char* vb = lds + ((NTA - 1) & 1) * A_VB + voff;
        at_valu_block<TYPE>(p0, p1, o0, o1, pf, m_, l_, AT_TILE(NTA - 1), false, qi, h, kr0, kc0, qr, qc, wr_, wc_, lbias);
        at_mfma_block<TYPE, NKS, KSTR>(p0, p1, o0, o1, qf, pf, m_, vb, vb, false, true);
    }
#undef AT_STAGE
#undef AT_LOADK
#undef AT_LOADV
#undef AT_STOREK
#undef AT_STOREV
#undef AT_TILE
    const float lt = l_ + __shfl_xor(l_, 32), inv = 1.0f / lt;
    bf16* op = P.mix + (size_t)qrow * DM + ocol + 4 * h;
#pragma unroll
    for (int g = 0; g < 4; ++g) {
        const f32x4 v0 = {o0[4 * g] * inv, o0[4 * g + 1] * inv, o0[4 * g + 2] * inv, o0[4 * g + 3] * inv};
        const f32x4 v1 = {o1[4 * g] * inv, o1[4 * g + 1] * inv, o1[4 * g + 2] * inv, o1[4 * g + 3] * inv};
        st4bf(op + 8 * g, v0); st4bf(op + 32 + 8 * g, v1);
    }
}

DI void attn_phase(const AttnP& P, bool last, LAS unsigned char* lds, const int tid_in) {
    const int G = gridDim.x, bx = blockIdx.x;
    const int vcu = (G % 8 == 0) ? (bx % 8) * (G / 8) + bx / 8 : bx;
    const int NU = 2048 + (last ? 0 : 128);
    for (int u = vcu; u < NU; u += G) {
        int tid = tid_in; asm volatile("" : "+v"(tid));
        if (u < 512) attn_unit<2>(P, u, false, lds, tid);
        else if (u < 1024) attn_unit<1>(P, u - 512, false, lds, tid);
        else if (u < 2048) attn_unit<0>(P, u - 1024, false, lds, tid);
        else if (u < 2080) attn_unit<2>(P, u - 2048, true, lds, tid);
        else if (u < 2112) attn_unit<1>(P, u - 2080, true, lds, tid);
        else attn_unit<0>(P, u - 2112, true, lds, tid);
    }
}

#define XB_TMO      128
#define XB_XCNT(j)  (256  + 64 * (j))
#define XB_XSUB(j)  (1280 + 64 * (j))
#define XB_XGEN(j)  (2304 + 64 * (j))
#define XB_TOP      3328
#define XB_TOPGEN   3392
#define XCD_BAR_WORDS 3456
#define XB_SPIN_CAP (1u << 18)

__device__ __forceinline__ unsigned xb_ld(unsigned* p)              { return __hip_atomic_load(p, __ATOMIC_RELAXED, __HIP_MEMORY_SCOPE_AGENT); }
__device__ __forceinline__ unsigned xb_add(unsigned* p, unsigned v) { return __hip_atomic_fetch_add(p, v, __ATOMIC_RELAXED, __HIP_MEMORY_SCOPE_AGENT); }
__device__ __forceinline__ unsigned xb_xcc_id() { return (unsigned)__builtin_amdgcn_s_getreg((3 << 11) | 20) & 0xFu; }
#define XB_SPIN(cond, bar) do { unsigned _sp = 0; while (cond) { __builtin_amdgcn_s_sleep(1); \
    if ((++_sp & 255u) == 0u) { if (xb_ld(&(bar)[XB_TMO])) break; if (_sp > XB_SPIN_CAP) { atomicAdd(&(bar)[XB_TMO], 1u); break; } } } } while (0)

struct XcdBarrier {
    unsigned* bar; unsigned x;
    volatile LAS unsigned* st;
};

__device__ __forceinline__ XcdBarrier xcd_barrier_post(unsigned* bar, volatile LAS unsigned* st) {
    XcdBarrier b; b.bar = bar; b.x = xb_xcc_id(); b.st = st;
    if (threadIdx.x == 0) (void)xb_add(&bar[XB_XCNT(b.x)], 1u);
    return b;
}
__device__ __forceinline__ void xcd_barrier_complete(unsigned* bar, unsigned x, unsigned& nloc, unsigned& nx) {
    const unsigned G = gridDim.x * gridDim.y * gridDim.z;
    unsigned sum, cnt, mine, sp = 0u;
    for (;;) {
        sum = 0u; cnt = 0u; mine = 0u;
#pragma unroll
        for (unsigned j = 0; j < 16; ++j) { const unsigned c = xb_ld(&bar[XB_XCNT(j)]); sum += c; cnt += (c > 0u) ? 1u : 0u; mine = (j == x) ? c : mine; }
        if (sum == G) break;
        __builtin_amdgcn_s_sleep(1);
        if ((++sp & 255u) == 0u) { if (xb_ld(&bar[XB_TMO])) break; if (sp > XB_SPIN_CAP) { atomicAdd(&bar[XB_TMO], 1u); break; } }
    }
    nloc = mine > 0u ? mine : 1u; nx = cnt > 0u ? cnt : 1u;
}

__device__ __forceinline__ void xcd_barrier(const XcdBarrier& b) {
    asm volatile("s_waitcnt vmcnt(0)" ::: "memory");
    __syncthreads();
    if (threadIdx.x == 0) {
        unsigned* bar = b.bar;
        __builtin_amdgcn_s_waitcnt(0);
        unsigned nloc = b.st[0], nx = b.st[1];
        if (nloc == 0u) { xcd_barrier_complete(bar, b.x, nloc, nx); b.st[0] = nloc; b.st[1] = nx; }
        const unsigned old = xb_add(&bar[XB_XSUB(b.x)], 1u);
        const unsigned gen = old / nloc;
        if (old + 1u == (gen + 1u) * nloc) {
            __builtin_amdgcn_fence(__ATOMIC_RELEASE, "agent");
            asm volatile("s_waitcnt vmcnt(0)" ::: "memory");
            const unsigned og = xb_add(&bar[XB_TOP], 1u);
            const unsigned tg = og / nx;
            if (og + 1u == (tg + 1u) * nx) xb_add(&bar[XB_TOPGEN], 1u);
            else XB_SPIN(xb_ld(&bar[XB_TOPGEN]) == tg, bar);
            __builtin_amdgcn_fence(__ATOMIC_ACQUIRE, "agent");
            xb_add(&bar[XB_XGEN(b.x)], 1u);
            asm volatile("s_waitcnt vmcnt(0)" ::: "memory");
        } else {
            XB_SPIN(xb_ld(&bar[XB_XGEN(b.x)]) == gen, bar);
            __builtin_amdgcn_fence(__ATOMIC_ACQUIRE, "agent");
            asm volatile("s_waitcnt vmcnt(0)" ::: "memory");
        }
    }
    __syncthreads();
}

constexpr int NPH = 3 + 6 * DEPTH;
__global__ void __launch_bounds__(NTHR) mk_fwd(Args a) {
    extern __shared__ __attribute__((aligned(16))) unsigned char lds_raw[];
    LAS unsigned char* lds = (LAS unsigned char*)lds_raw;
    const int G = gridDim.x, bx = blockIdx.x;
    const int ph_lo = a.ph_lo, ph_hi = a.ph_hi;
    volatile LAS unsigned* bst = (volatile LAS unsigned*)(lds + 131072);
    if (threadIdx.x < 2) bst[threadIdx.x] = 0u;
    __syncthreads();
    XcdBarrier xbar; xbar.bar = (unsigned*)(a.ws + WS_BAR); xbar.x = 0; xbar.st = bst;
    if (!MK_PER_PHASE) xbar = xcd_barrier_post((unsigned*)(a.ws + WS_BAR), bst);

    for (int ph = ph_lo; ph < ph_hi;) {
        int tid = threadIdx.x; asm volatile("" : "+v"(tid));
        unsigned char* ws = a.ws; asm volatile("" : "+s"(ws));
        float* mods = (float*)(ws + WS_MODS);
        const float* tabA = (const float*)(ws + WS_TAB); const float* tabC = tabA + 2048;
        float* Xc = (float*)(ws + WS_XC);
        bf16* Hn = (bf16*)(ws + WS_HN); bf16* H1 = (bf16*)(ws + WS_H1);
        bf16* proj = (bf16*)(ws + WS_PROJ); bf16* cqb = (bf16*)(ws + WS_CQ); bf16* ckvb = (bf16*)(ws + WS_CKV);
        bf16* qm = (bf16*)(ws + WS_QM); bf16* kvm = (bf16*)(ws + WS_KVM); bf16* krr = (bf16*)(ws + WS_KRR); bf16* mix = (bf16*)(ws + WS_MIX);

        if (ph == 0) prologue(a, lds, tid);
        else if (ph == 1) phase1(a, lds, tid);
        else if (ph == NPH - 1) final_norm_phase(a.out, a.in[18], tid);
        else {
            const int l = (ph - 2) / 6, s = (ph - 2) - 6 * l; const bool last = (l == DEPTH - 1);
            unsigned char* wb = ws + WS_W + (size_t)l * WL_STRIDE;
            const float* mods_l = mods + (size_t)l * 9 * 6144;
            float* ssq_q = (float*)(ws + WS_SSQ) + (size_t)l * 2 * MT; float* ssq_kv = ssq_q + MT;
            float* ssqx1 = (float*)(ws + WS_SSQX) + (size_t)l * 2 * MT; float* ssqx2 = ssqx1 + MT;
            const float* xsrc = (l == 0) ? a.in[0] : a.out;
            const float* csrc = (l == 0) ? a.in[2] : Xc;
            float* part = (float*)(ws + WS_PART);
            if (s == 0) {
                if (l > 0) {
                    const float* mods_p = mods + (size_t)(l - 1) * 9 * 6144;
                    ctx_finish(part, 8, Xc, Xc, mods_p + 5 * 1024 + 8 * 6144, Hn, ssqx1, a.in[6] + l * DM, mods_l + 1 * 1024 + 8 * 6144, tid);
                    xcd_barrier(xbar);
                }
                pg8::Gemm g{Hn, (const bf16*)(wb + WL_IN), MT, 2048, DM, DM}; pg8::StaticOrder S; S.init(MT, 2048, G, bx);
                EpiInProj E{proj, cqb, ckvb, krr, ssq_q, ssq_kv, tabA, tabC, ssqx1, (const float*)(ws + WS_BIAS1) + (size_t)l * 9 * 2048};
                pg8::gemm_phase<EpiInProj, pg8::StaticOrder, true, true>(lds, g, S, E, tid);
            } else if (s == 1) {
                { int Kq = 256; asm volatile("" : "+s"(Kq)); pg8::Gemm g{cqb, (const bf16*)(wb + WL_UQ), MT, 512, Kq, Kq}; pg8::StaticOrder S; S.init(MT, 512, G, bx);
                  EpiUQ E{qm, ssq_q, tabC}; pg8::gemm_phase<EpiUQ, pg8::StaticOrder, true, true>(lds, g, S, E, tid); }
                { int Kk = 128; asm volatile("" : "+s"(Kk)); pg8::Gemm g{ckvb, (const bf16*)(wb + WL_UKV), MT, 512, Kk, Kk}; pg8::StaticOrder S; S.init(MT, 512, G, (bx + G / 2) % G);
                  EpiUKV E{kvm, ssq_kv}; pg8::gemm_phase<EpiUKV, pg8::StaticOrder, true, true>(lds, g, S, E, tid); }
            } else if (s == 2) {
                AttnP P{proj, qm, kvm, krr, mix, a.in[9] + l * 8, a.in[10] + l * 4 * 465};
                attn_phase(P, last, lds, tid);
            } else if (s == 3 || s == 5) {
                const bool outp = (s == 3);
                const int Kfull = outp ? DM : DFF;
                {
                    pg8::Gemm g{outp ? mix : H1, (const bf16*)(wb + (outp ? WL_OUT : WL_W2)), MX, DM, Kfull, Kfull}; pg8::StaticOrder S; S.init(MX, DM, G, bx);
                    const int ln = outp ? l : l + 1;
                    const float* mods_n = mods + (size_t)(ln < DEPTH ? ln : 0) * 9 * 6144;
                    EpiResid E{(outp ? xsrc : a.out), (outp ? csrc : Xc), a.out, Xc, mods_l + (outp ? 2 : 5) * 1024, Hn,
                               outp ? ssqx2 : ssqx1 + (size_t)2 * MT, (outp ? a.in[7] : a.in[6]) + (ln < DEPTH ? ln : 0) * DM, mods_n + (outp ? 4 : 1) * 1024, (outp || !last) ? 1 : 0};
                    pg8::gemm_phase<EpiResid, pg8::StaticOrder, true, true>(lds, g, S, E, tid);
                }
                if (!last) {
                    int Ks = Kfull / 8; asm volatile("" : "+s"(Ks));
                    pg8::Gemm g{outp ? mix : H1, (const bf16*)(wb + (outp ? WL_OUT : WL_W2)), MT, DM, Ks, Kfull}; SplitOrder S; S.init(G, (bx + G / 2) % G, 8, Ks);
                    EpiPartial E{part, Ks * 2};
                    pg8::gemm_phase<EpiPartial, SplitOrder, true, true>(lds, g, S, E, tid);
                }
            } else {
                const int Mr = last ? MX : MT;
                if (!last) {
                    ctx_finish(part, 8, csrc, Xc, mods_l + 2 * 1024 + 8 * 6144, Hn, ssqx2, a.in[7] + l * DM, mods_l + 4 * 1024 + 8 * 6144, tid);
                    xcd_barrier(xbar);
                }
                pg8::Gemm g{Hn, (const bf16*)(wb + WL_W1), Mr, DFF, DM, DM}; pg8::StaticOrder S; S.init(Mr, DFF, G, bx);
                EpiRelu2 E{H1, ssqx2, (const float*)(ws + WS_BIAS4) + (size_t)l * 9 * 4096}; pg8::gemm_phase<EpiRelu2, pg8::StaticOrder, true, true>(lds, g, S, E, tid);
            }
        }
        ++ph;
        if (ph < ph_hi) { if (ph == 1) cg::this_grid().sync(); else xcd_barrier(xbar); }
    }
}

extern "C" void kernel_launch(void* const* d_in, const int* in_sizes, int n_in, void* d_out, int out_size, void* d_ws, size_t ws_size, hipStream_t stream) {
    static int grid = 0;
    if (grid == 0) {
        if (n_in != 19 || ws_size < WS_END) { fprintf(stderr, "kernel_launch: unexpected inputs (n_in %d, ws %zu)\n", n_in, ws_size); grid = -1; return; }
        int dev = 0, cus = 0, per_cu = 0;
        hipGetDevice(&dev); hipDeviceGetAttribute(&cus, hipDeviceAttributeMultiprocessorCount, dev);
        hipFuncSetAttribute((const void*)mk_fwd, hipFuncAttributeMaxDynamicSharedMemorySize, LDS_BYTES);
        hipOccupancyMaxActiveBlocksPerMultiprocessor(&per_cu, (const void*)mk_fwd, NTHR, LDS_BYTES);
        if (per_cu < 1) { fprintf(stderr, "kernel_launch: occupancy query says %d\n", per_cu); per_cu = 1; }
        (void)hipGetLastError();
        grid = cus * 1;
    }
    if (grid < 0) return;
    Args a{};
    for (int i = 0; i < 19; ++i) a.in[i] = (const float*)d_in[i];
    a.out = (float*)d_out; a.ws = (unsigned char*)d_ws;
#if MK_PER_PHASE
    for (int ph = 0; ph < NPH; ++ph) { a.ph_lo = ph; a.ph_hi = ph + 1; hipLaunchKernelGGL(mk_fwd, dim3(grid), dim3(NTHR), LDS_BYTES, stream, a); }
#else
    a.ph_lo = 0; a.ph_hi = NPH;
    (void)hipMemsetAsync((unsigned char*)d_ws + WS_BAR, 0, 16384, stream);
    void* args[] = {&a};
    hipError_t e = hipLaunchCooperativeKernel((const void*)mk_fwd, dim3(grid), dim3(NTHR), args, LDS_BYTES, stream);
    if (e != hipSuccess) fprintf(stderr, "cooperative launch failed: %s (grid %d)\n", hipGetErrorString(e), grid);
#endif
}
```

```cpp
#include <hip/hip_runtime.h>
#include <hip/hip_cooperative_groups.h>
#include <cstdio>
#include <cstdint>
namespace cg = cooperative_groups;
namespace pg8 {
#define PG8_LAS __attribute__((address_space(3)))
typedef unsigned short bf16_t;
typedef short bf16x8 __attribute__((ext_vector_type(8)));
typedef float f32x4 __attribute__((ext_vector_type(4)));
typedef unsigned u32x4 __attribute__((ext_vector_type(4)));
constexpr int BM = 256, BK = 64, HALF = 128, HTB = HALF * BK * 2  , STAGE_BYTES = 8 * HTB, NXCD = 8, WGM = 8;

__host__ __device__ __forceinline__ int lds_byte(int r, int c) { const int st = (r >> 4) * 2 + (c >> 5), rr = r & 15, cc = c & 31, ob = rr * 64 + cc * 2; return st * 1024 + (ob ^ (((ob >> 9) & 1) << 5)); }
__host__ __device__ __forceinline__ void stage_rc(int b, int& R, int& C) { const int st = b / 1024, sb = b % 1024, swz = sb ^ (((sb >> 9) & 1) << 5); R = (st >> 1) * 16 + swz / 64; C = (st & 1) * 32 + (swz % 64) / 2; }
__host__ __device__ __forceinline__ int perm32(int rho) { const int n = rho >> 4, i = rho & 15; return 8 * (i >> 2) + 4 * n + (i & 3); }

struct Unit { int pm, pn, kb; };
struct Gemm { const bf16_t* A; const bf16_t* Bt; int M, N, K, ld; };

struct StaticOrder {
    int nM, nN, nwg, G, c;
    __host__ __device__ void init(int M, int N, int G_, int c_) { nM = M / BM; nN = N / BM; nwg = nM * nN; G = G_; c = c_; }
    __host__ __device__ bool next(int i, Unit& u) const {
        const long L = (long)i * G + c; if (L >= nwg) return false;
        int wgid = (int)L; { const int q = nwg / NXCD, r = nwg % NXCD, xcd = wgid % NXCD, off = wgid / NXCD; wgid = (xcd < r ? xcd * (q + 1) : r * (q + 1) + (xcd - r) * q) + off; }
        const int nig = WGM * nN, gid = wgid / nig, fm = gid * WGM, gsz = (nM - fm) < WGM ? (nM - fm) : WGM;
        u.pm = fm + ((wgid % nig) % gsz); u.pn = (wgid % nig) / gsz; u.kb = 0; return true;
    }
    __device__ __forceinline__ void a_ready(const Unit&) const {}
    __device__ __forceinline__ void done(const Unit&) const {}
};

__device__ __forceinline__ unsigned cvt_pk_bf16(float lo, float hi) { unsigned r; asm volatile("v_cvt_pk_bf16_f32 %0, %1, %2" : "=v"(r) : "v"(lo), "v"(hi)); return r; }
template <class Epi, class Sched, bool ALIGN_EPI = false, bool SP2 = false>
__device__ __forceinline__ void gemm_phase(PG8_LAS unsigned char* lds, const Gemm g, const Sched& S, const Epi& E, const int tid) {
    const int wid = __builtin_amdgcn_readfirstlane(tid >> 6), lane = tid & 63, wr = wid >> 2, wc = wid & 3, fr = lane & 15, fq = lane >> 4;
    const int K = g.ld, nt = g.K / BK;
    unsigned voffA[2], voffB[2];
#pragma unroll
    for (int i = 0; i < 2; ++i) { int R, C; stage_rc(tid * 16 + i * 8192, R, C); const int Rb = Epi::PERM ? ((R & ~31) + perm32(R & 31)) : R;
        voffA[i] = (unsigned)(R * K + C) * 2u; voffB[i] = (unsigned)(Rb * K + C) * 2u; }
    const size_t kstep = (size_t)(BK * 2);
    const size_t hstep = (size_t)HALF * K * 2;
    const size_t tstep = 2 * hstep;
    const unsigned ldsw = (unsigned)wid * 1024u;
    const int aoff = lds_byte(wr * 64 + fr, fq * 8), boff = lds_byte(wc * 32 + fr, fq * 8);
#define PG8_SA(b, h) (((b) * 2 + (h)) * HTB)
#define PG8_SB(b, h) ((4 + (b) * 2 + (h)) * HTB)
#define PG8_STAGE(bufoff, gbase, voff) do { _Pragma("unroll") for (int _i = 0; _i < 2; ++_i) \
        __builtin_amdgcn_global_load_lds((const unsigned*)((const char*)(gbase) + (voff)[_i]), (PG8_LAS unsigned*)(lds + (bufoff) + ldsw + _i * 8192), 16, 0, 0); } while (0)
#define PG8_LDA(dst, b, h) do { _Pragma("unroll") for (int m = 0; m < 4; ++m) _Pragma("unroll") for (int k = 0; k < 2; ++k) dst[m][k] = *(const PG8_LAS bf16x8*)(lds + PG8_SA(b, h) + aoff + m * 2048 + k * 1024); } while (0)
#define PG8_LDB(dst, b, h) do { _Pragma("unroll") for (int n = 0; n < 2; ++n) _Pragma("unroll") for (int k = 0; k < 2; ++k) dst[n][k] = *(const PG8_LAS bf16x8*)(lds + PG8_SB(b, h) + boff + n * 2048 + k * 1024); } while (0)
#define PG8_MMA(ai, bj, At, Bt) do { __builtin_amdgcn_s_setprio(1); _Pragma("unroll") for (int m = 0; m < 4; ++m) _Pragma("unroll") for (int n = 0; n < 2; ++n) _Pragma("unroll") for (int k = 0; k < 2; ++k) \
        acc[ai][bj][m][n] = __builtin_amdgcn_mfma_f32_16x16x32_bf16(Bt[n][k], At[m][k], acc[ai][bj][m][n], 0, 0, 0); __builtin_amdgcn_s_setprio(0); } while (0)
#define PG8_WAIT_V(n) asm volatile("s_waitcnt vmcnt(" #n ")" ::: "memory")
#define PG8_WAIT_L(n) asm volatile("s_waitcnt lgkmcnt(" #n ")" ::: "memory")
#define PG8_BAR __builtin_amdgcn_s_barrier()
#define PG8_SCHED __builtin_amdgcn_sched_barrier(0)
    Unit cur, nxt; int ui = 0;
    if (!S.next(0, cur)) return;
    f32x4 acc[2][2][4][2];
#pragma unroll
    for (int a = 0; a < 2; ++a)
#pragma unroll
        for (int b = 0; b < 2; ++b)
#pragma unroll
            for (int m = 0; m < 4; ++m)
#pragma unroll
                for (int n = 0; n < 2; ++n) acc[a][b][m][n] = (f32x4){0.f, 0.f, 0.f, 0.f};
    bf16x8 At[4][2], B0[2][2], B1[2][2];
    const char* cA = (const char*)g.A + (size_t)cur.pm * tstep + cur.kb; const char* cB = (const char*)g.Bt + (size_t)cur.pn * tstep + cur.kb;
    S.a_ready(cur);
    if constexpr (SP2) {
        PG8_STAGE(PG8_SB(0, 0), cB, voffB); PG8_STAGE(PG8_SB(0, 1), cB + hstep, voffB); PG8_STAGE(PG8_SA(0, 0), cA, voffA); PG8_STAGE(PG8_SA(0, 1), cA + hstep, voffA);
        if (wr == 1) PG8_BAR;
        PG8_WAIT_V(2); PG8_BAR;
        PG8_STAGE(PG8_SB(1, 0), cB + kstep, voffB); PG8_STAGE(PG8_SA(1, 0), cA + kstep, voffA); PG8_STAGE(PG8_SB(1, 1), cB + hstep + kstep, voffB);
        PG8_WAIT_V(6); PG8_BAR;
    } else {
        PG8_STAGE(PG8_SB(0, 0), cB, voffB); PG8_STAGE(PG8_SA(0, 0), cA, voffA); PG8_STAGE(PG8_SB(0, 1), cB + hstep, voffB); PG8_STAGE(PG8_SA(0, 1), cA + hstep, voffA);
        if (wr == 1) PG8_BAR;
        PG8_WAIT_V(4); PG8_BAR;
        PG8_STAGE(PG8_SB(1, 0), cB + kstep, voffB); PG8_STAGE(PG8_SA(1, 0), cA + kstep, voffA); PG8_STAGE(PG8_SB(1, 1), cB + hstep + kstep, voffB);
        PG8_WAIT_V(6); PG8_BAR;
    }
    for (;;) {
        const bool has_next = S.next(ui + 1, nxt);
        const char* nA = has_next ? (const char*)g.A + (size_t)nxt.pm * tstep + nxt.kb : cA; const char* nB = has_next ? (const char*)g.Bt + (size_t)nxt.pn * tstep + nxt.kb : cB;
        for (int t = 0; t < nt; t += 2) {
            const bool last = (t == nt - 2);
            const char* a1 = cA + (size_t)(t + 1) * kstep;
            const char* a2 = last ? nA : cA + (size_t)(t + 2) * kstep; const char* b2 = last ? nB : cB + (size_t)(t + 2) * kstep;
            const char* a3 = a2 + kstep; const char* b3 = b2 + kstep;
            if (last && has_next) S.a_ready(nxt);
            if constexpr (SP2) {
            PG8_LDB(B0, 0, 0); PG8_LDB(B1, 0, 1); PG8_SCHED; PG8_LDA(At, 0, 0); PG8_STAGE(PG8_SA(1, 1), a1 + hstep, voffA);
            PG8_WAIT_V(8); PG8_WAIT_L(0); PG8_BAR; PG8_MMA(0, 0, At, B0); PG8_MMA(0, 1, At, B1); PG8_BAR; PG8_SCHED;
            PG8_LDA(At, 0, 1); PG8_STAGE(PG8_SB(0, 0), b2, voffB); PG8_STAGE(PG8_SB(0, 1), b2 + hstep, voffB); PG8_STAGE(PG8_SA(0, 0), a2, voffA);
            PG8_WAIT_V(8); PG8_WAIT_L(0); PG8_BAR; PG8_MMA(1, 0, At, B0); PG8_MMA(1, 1, At, B1); PG8_BAR; PG8_SCHED;
            PG8_LDB(B0, 1, 0); PG8_LDB(B1, 1, 1); PG8_SCHED; PG8_LDA(At, 1, 0); PG8_STAGE(PG8_SA(0, 1), a2 + hstep, voffA);
            PG8_WAIT_V(8); PG8_WAIT_L(0); PG8_BAR; PG8_MMA(0, 0, At, B0); PG8_MMA(0, 1, At, B1); PG8_BAR; PG8_SCHED;
            PG8_LDA(At, 1, 1); PG8_STAGE(PG8_SB(1, 0), b3, voffB); PG8_STAGE(PG8_SB(1, 1), b3 + hstep, voffB); PG8_STAGE(PG8_SA(1, 0), a3, voffA);
            PG8_WAIT_V(8); PG8_WAIT_L(0); PG8_BAR; PG8_MMA(1, 0, At, B0); PG8_MMA(1, 1, At, B1); PG8_BAR; PG8_SCHED;
            } else {
            PG8_LDB(B0, 0, 0); PG8_SCHED; PG8_LDA(At, 0, 0); PG8_STAGE(PG8_SA(1, 1), a1 + hstep, voffA);
            PG8_WAIT_L(8); PG8_BAR; PG8_WAIT_L(0); PG8_MMA(0, 0, At, B0); PG8_BAR; PG8_SCHED;
            PG8_LDB(B1, 0, 1); PG8_STAGE(PG8_SB(0, 0), b2, voffB);
            PG8_BAR; PG8_WAIT_L(0); PG8_MMA(0, 1, At, B1); PG8_BAR;
            PG8_LDA(At, 0, 1); PG8_STAGE(PG8_SA(0, 0), a2, voffA);
            PG8_BAR; PG8_WAIT_L(0); PG8_MMA(1, 0, At, B0); PG8_BAR; PG8_SCHED;
            PG8_STAGE(PG8_SB(0, 1), b2 + hstep, voffB);
            PG8_WAIT_V(6); PG8_BAR; PG8_MMA(1, 1, At, B1); PG8_BAR;
            PG8_LDB(B0, 1, 0); PG8_SCHED; PG8_LDA(At, 1, 0); PG8_STAGE(PG8_SA(0, 1), a2 + hstep, voffA);
            PG8_WAIT_L(8); PG8_BAR; PG8_WAIT_L(0); PG8_MMA(0, 0, At, B0); PG8_BAR; PG8_SCHED;
            PG8_LDB(B1, 1, 1); PG8_STAGE(PG8_SB(1, 0), b3, voffB);
            PG8_BAR; PG8_WAIT_L(0); PG8_MMA(0, 1, At, B1); PG8_BAR;
            PG8_LDA(At, 1, 1); PG8_STAGE(PG8_SA(1, 0), a3, voffA);
            PG8_BAR; PG8_WAIT_L(0); PG8_MMA(1, 0, At, B0); PG8_BAR; PG8_SCHED;
            PG8_STAGE(PG8_SB(1, 1), b3 + hstep, voffB);
            PG8_WAIT_V(6); PG8_BAR; PG8_MMA(1, 1, At, B1); PG8_BAR;
            }
        }
        if constexpr (ALIGN_EPI) { if (wr == 0) PG8_BAR; }
        if constexpr (!Epi::AFTER_DRAIN) { E(acc, cur, wr, wc, fr, fq); S.done(cur); }
        if (!has_next) break;
#pragma unroll
        for (int a = 0; a < 2; ++a)
#pragma unroll
            for (int b = 0; b < 2; ++b)
#pragma unroll
                for (int m = 0; m < 4; ++m)
#pragma unroll
                    for (int n = 0; n < 2; ++n) acc[a][b][m][n] = (f32x4){0.f, 0.f, 0.f, 0.f};
        cur = nxt; cA = nA; cB = nB; ++ui;
        if constexpr (ALIGN_EPI) { if (wr == 1) PG8_BAR; }
    }
    PG8_WAIT_V(0);
    if constexpr (!ALIGN_EPI) { if (wr == 0) PG8_BAR; }
    PG8_BAR;
    if constexpr (Epi::AFTER_DRAIN) { E.fused(acc, cur, wr, wc, fr, fq, lds, wid, lane); S.done(cur); }
#undef PG8_SA
#undef PG8_SB
#undef PG8_STAGE
#undef PG8_LDA
#undef PG8_LDB
#undef PG8_MMA
#undef PG8_WAIT_V
#undef PG8_WAIT_L
#undef PG8_BAR
#undef PG8_SCHED
}
}

#define LAS __attribute__((address_space(3)))
#define DI __device__ __forceinline__
#define GAS __attribute__((address_space(1)))
typedef unsigned short bf16;
typedef float f32x4 __attribute__((ext_vector_type(4)));
typedef float f32x16 __attribute__((ext_vector_type(16)));
typedef short bf16x8 __attribute__((ext_vector_type(8)));
typedef short s16x4 __attribute__((ext_vector_type(4)));
typedef unsigned u32x2 __attribute__((ext_vector_type(2)));
typedef unsigned u32x4 __attribute__((ext_vector_type(4)));
typedef float f32x2_t __attribute__((ext_vector_type(2)));
typedef __bf16 bf16x2_t __attribute__((ext_vector_type(2)));

#ifndef MK_MASK
#define MK_MASK 0x1ff
#endif
#define PH_EN(k) (((MK_MASK) >> (k)) & 1)
#ifndef MK_PER_PHASE
#define MK_PER_PHASE 0
#endif

constexpr int DM = 1024, NBATCH = 8, SEQ = 4096, DEPTH = 4, CTXL = 256, DFF = 4096;
constexpr int MX = NBATCH * SEQ, MC = NBATCH * CTXL, MT = MX + MC;
constexpr int INW = 1952, PJS = 1536;
constexpr float LOG2E = 1.4426950408889634f;
constexpr float C2A = 0.125f * LOG2E;
constexpr float C2C = 0.10206207261596575f * LOG2E;
constexpr float EPSN = 1e-6f;
constexpr int NTHR = 512;

constexpr size_t MiB = (size_t)1 << 20;
constexpr size_t WS_TAB = 0;
constexpr size_t WS_BAR = 65536;
constexpr size_t WS_MODS = 1 * MiB;
constexpr size_t WS_SSQ = 2 * MiB;
constexpr size_t WS_XC = 4 * MiB;
constexpr size_t WS_W = 12 * MiB;
constexpr size_t WL_IN = 0, WL_OUT = 4 * MiB, WL_W1 = 6 * MiB, WL_W2 = 14 * MiB, WL_UQ = 22 * MiB, WL_UKV = 22 * MiB + 256 * 1024, WL_STRIDE = 22 * MiB + 512 * 1024;
constexpr size_t WS_HN = 102 * MiB;
constexpr size_t WS_H1 = 170 * MiB;
constexpr size_t WS_PROJ = 170 * MiB;
constexpr size_t WS_CQ = 272 * MiB;
constexpr size_t WS_CKV = 289 * MiB;
constexpr size_t WS_QM = 298 * MiB;
constexpr size_t WS_KVM = 324 * MiB;
constexpr size_t WS_KRR = 358 * MiB;
constexpr size_t WS_MIX = 362 * MiB;
constexpr size_t WS_SSQX = 442 * MiB;
constexpr size_t WS_BIAS1 = 444 * MiB;
constexpr size_t WS_BIAS4 = 445 * MiB;
constexpr size_t WS_PART = 446 * MiB;
constexpr size_t WS_END = 510 * MiB;
constexpr int LDS_BYTES = 131072 + 256;

DI unsigned cvtpk(float lo, float hi) { f32x2_t v = {lo, hi}; bf16x2_t b = __builtin_convertvector(v, bf16x2_t); return __builtin_bit_cast(unsigned, b); }
DI void st4bf(bf16* p, f32x4 v) { u32x2 w; w.x = cvtpk(v[0], v[1]); w.y = cvtpk(v[2], v[3]); *(GAS u32x2*)p = w; }
DI float wave_sum(float v) {
#pragma unroll
    for (int o = 1; o < 64; o <<= 1) v += __shfl_xor(v, o);
    return v;
}
DI float fexp2(float x) { return __builtin_amdgcn_exp2f(x); }
DI float max3f(float a, float b, float c) { float r; asm("v_max3_f32 %0, %1, %2, %3" : "=v"(r) : "v"(a), "v"(b), "v"(c)); return r; }
#define LDS_WAIT() asm volatile("s_waitcnt lgkmcnt(0)" ::: "memory")

DI f32x4 rope8(f32x4 v, const float* tab  , int fq) {
    const int i0 = 4 * (fq & 1);
    const f32x4 cs = *(const f32x4*)(tab + i0), sn = *(const f32x4*)(tab + 8 + i0);
    f32x4 o;
#pragma unroll
    for (int j = 0; j < 4; ++j) { const float pr = __shfl_xor(v[j], 32); o[j] = (fq < 2) ? v[j] * cs[j] - pr * sn[j] : pr * sn[j] + v[j] * cs[j]; }
    return o;
}

struct EpiInProj {
    static constexpr bool PERM = false, AFTER_DRAIN = false;
    bf16 *proj, *cqb, *ckvb, *krr; float *ssq_q, *ssq_kv; const float *tabA, *tabC; const float *ssqx, *bias;
    DI void operator()(const f32x4 (&acc0)[2][2][4][2], const pg8::Unit& u, int wr, int wc, int fr, int fq) const {
        const int pn = u.pn; const bool isx = u.pm < 128; const int mi = isx ? (u.pm >> 4) : 8;
        f32x4 bv[2][2];
#pragma unroll
        for (int bj = 0; bj < 2; ++bj)
#pragma unroll
            for (int n = 0; n < 2; ++n) bv[bj][n] = *(const GAS f32x4*)(bias + mi * 2048 + pn * 256 + bj * 128 + wc * 32 + n * 16 + 4 * fq);
        float rsx[2][4];
#pragma unroll
        for (int ai = 0; ai < 2; ++ai)
#pragma unroll
            for (int m = 0; m < 4; ++m) { int row = u.pm * 256 + ai * 128 + wr * 64 + m * 16 + fr; asm volatile("" : "+v"(row)); rsx[ai][m] = ((const GAS float*)ssqx)[row]; }
#pragma unroll
        for (int ai = 0; ai < 2; ++ai)
#pragma unroll
            for (int m = 0; m < 4; ++m) rsx[ai][m] = rsqrtf(rsx[ai][m] * (1.0f / 1024.0f) + EPSN);
        const bool anyrope = isx && pn <= 2;
#pragma unroll
        for (int ai = 0; ai < 2; ++ai)
#pragma unroll
        for (int mh = 0; mh < 2; ++mh) {
            f32x4 cs[4], sn[4];
#pragma unroll
            for (int m = 2 * mh; m < 2 * mh + 2; ++m) { cs[m] = (f32x4){1.f, 1.f, 1.f, 1.f}; sn[m] = (f32x4){0.f, 0.f, 0.f, 0.f}; }
            if (anyrope) {
#pragma unroll
                for (int m = 2 * mh; m < 2 * mh + 2; ++m) { int row = u.pm * 256 + ai * 128 + wr * 64 + m * 16 + fr; asm volatile("" : "+v"(row)); const int tok = row & 4095; const int pos = (wc & 1) ? (tok & 63) : (tok >> 6);
                    cs[m] = *(const GAS f32x4*)(tabA + pos * 32 + 4 * fq); sn[m] = *(const GAS f32x4*)(tabA + pos * 32 + 16 + 4 * fq); }
            }
#pragma unroll
            for (int m = 2 * mh; m < 2 * mh + 2; ++m) {
                int row = u.pm * 256 + ai * 128 + wr * 64 + m * 16 + fr; asm volatile("" : "+v"(row));
                const int tok = row & 4095, prow = tok >> 6, pcol = tok & 63;
                f32x4 acc[2][2];
#pragma unroll
                for (int bj = 0; bj < 2; ++bj)
#pragma unroll
                    for (int n = 0; n < 2; ++n) acc[bj][n] = acc0[ai][bj][m][n] * rsx[ai][m] + bv[bj][n];
                if (pn < 6) {
#pragma unroll
                    for (int bj = 0; bj < 2; ++bj) {
                        f32x4 v0 = acc[bj][0], v1 = acc[bj][1];
                        if (anyrope && (pn < 2 || bj == 0)) { const f32x4 a = v0 * cs[m] - v1 * sn[m], b = v0 * sn[m] + v1 * cs[m]; v0 = a; v1 = b; }
                        if (pn < 2 || pn == 3) { v0 *= C2A; v1 *= C2A; }
                        bf16* p = proj + (size_t)row * PJS + pn * 256 + bj * 128 + wc * 32 + 4 * fq;
                        st4bf(p, v0); st4bf(p + 16, v1);
                    }
                } else if (pn == 6) {
                    float s = 0.f;
#pragma unroll
                    for (int bj = 0; bj < 2; ++bj) {
                        const f32x4 v0 = acc[bj][0], v1 = acc[bj][1];
                        s += (v0[0] * v0[0] + v0[1] * v0[1]) + (v0[2] * v0[2] + v0[3] * v0[3]) + (v1[0] * v1[0] + v1[1] * v1[1]) + (v1[2] * v1[2] + v1[3] * v1[3]);
                        bf16* p = cqb + (size_t)row * 256 + bj * 128 + wc * 32 + 4 * fq;
                        st4bf(p, v0); st4bf(p + 16, v1);
                    }
                    s += __shfl_xor(s, 16); s += __shfl_xor(s, 32);
                    if (fq == 0) atomicAdd(ssq_q + row, s);
                } else {
                    {
                        const f32x4 v0 = acc[0][0], v1 = acc[0][1];
                        float s = (v0[0] * v0[0] + v0[1] * v0[1]) + (v0[2] * v0[2] + v0[3] * v0[3]) + (v1[0] * v1[0] + v1[1] * v1[1]) + (v1[2] * v1[2] + v1[3] * v1[3]);
                        bf16* p = ckvb + (size_t)row * 128 + wc * 32 + 4 * fq;
                        st4bf(p, v0); st4bf(p + 16, v1);
                        s += __shfl_xor(s, 16); s += __shfl_xor(s, 32);
                        if (fq == 0) atomicAdd(ssq_kv + row, s);
                    }
                    if (wc == 0) {
                        f32x4 v0 = acc[1][0], v1 = acc[1][1];
                        if (isx) { v0 = rope8(v0, tabC + prow * 16, fq); v1 = rope8(v1, tabC + pcol * 16, fq); }
                        bf16* p = krr + (size_t)row * 32 + 4 * fq;
                        st4bf(p, v0); st4bf(p + 16, v1);
                    }
                }
            }
        }
    }
};

struct EpiUQ {
    static constexpr bool PERM = false, AFTER_DRAIN = false;
    bf16* qm; const float* ssq_q; const float* tabC;
    DI void operator()(const f32x4 (&acc)[2][2][4][2], const pg8::Unit& u, int wr, int wc, int fr, int fq) const {
        const int pn = u.pn; const bool isx = u.pm < 128;
        float rsq[2][4];
#pragma unroll
        for (int ai = 0; ai < 2; ++ai)
#pragma unroll
            for (int m = 0; m < 4; ++m) { int row = u.pm * 256 + ai * 128 + wr * 64 + m * 16 + fr; asm volatile("" : "+v"(row)); rsq[ai][m] = ((const GAS float*)ssq_q)[row]; }
#pragma unroll
        for (int ai = 0; ai < 2; ++ai)
#pragma unroll
            for (int m = 0; m < 4; ++m) {
                int row = u.pm * 256 + ai * 128 + wr * 64 + m * 16 + fr; asm volatile("" : "+v"(row));
                const int tok = row & 4095, prow = tok >> 6, pcol = tok & 63;
                const float rs = rsqrtf(rsq[ai][m] * (1.0f / 256.0f) + EPSN) * C2C;
#pragma unroll
                for (int bj = 0; bj < 2; ++bj)
#pragma unroll
                    for (int n = 0; n < 2; ++n) {
                        const int col0 = pn * 256 + bj * 128 + wc * 32 + n * 16;
                        if (col0 < 384) {
                            f32x4 v = acc[ai][bj][m][n] * rs;
                            const int g6 = (col0 >> 4) % 6;
                            if (isx && g6 >= 4) v = rope8(v, tabC + (g6 == 4 ? prow : pcol) * 16, fq);
                            st4bf(qm + (size_t)row * 384 + col0 + 4 * fq, v);
                        }
                    }
            }
    }
};

struct EpiUKV {
    static constexpr bool PERM = false, AFTER_DRAIN = false;
    bf16* kvm; const float* ssq_kv;
    DI void operator()(const f32x4 (&acc)[2][2][4][2], const pg8::Unit& u, int wr, int wc, int fr, int fq) const {
        float rsq[2][4];
#pragma unroll
        for (int ai = 0; ai < 2; ++ai)
#pragma unroll
            for (int m = 0; m < 4; ++m) { int row = u.pm * 256 + ai * 128 + wr * 64 + m * 16 + fr; asm volatile("" : "+v"(row)); rsq[ai][m] = ((const GAS float*)ssq_kv)[row]; }
#pragma unroll
        for (int ai = 0; ai < 2; ++ai)
#pragma unroll
            for (int m = 0; m < 4; ++m) {
                int row = u.pm * 256 + ai * 128 + wr * 64 + m * 16 + fr; asm volatile("" : "+v"(row));
                const float rs = rsqrtf(rsq[ai][m] * (1.0f / 128.0f) + EPSN);
#pragma unroll
                for (int bj = 0; bj < 2; ++bj)
#pragma unroll
                    for (int n = 0; n < 2; ++n) {
                        const int col0 = u.pn * 256 + bj * 128 + wc * 32 + n * 16;
                        st4bf(kvm + (size_t)row * 512 + col0 + 4 * fq, acc[ai][bj][m][n] * rs);
                    }
            }
    }
};

struct EpiRelu2 {
    static constexpr bool PERM = true, AFTER_DRAIN = false;
    bf16* H; const float *ssqx, *bias;
    DI void operator()(const f32x4 (&acc)[2][2][4][2], const pg8::Unit& u, int wr, int wc, int fr, int fq) const {
        const int col0 = u.pn * 256 + wc * 32 + 8 * fq; const int mi = (u.pm < 128) ? (u.pm >> 4) : 8;
        f32x4 bv[2][2];
#pragma unroll
        for (int bj = 0; bj < 2; ++bj)
#pragma unroll
            for (int n = 0; n < 2; ++n) bv[bj][n] = *(const GAS f32x4*)(bias + mi * 4096 + col0 + bj * 128 + 4 * n);
        float rsx[2][4];
#pragma unroll
        for (int ai = 0; ai < 2; ++ai)
#pragma unroll
            for (int m = 0; m < 4; ++m) { int row = u.pm * 256 + ai * 128 + wr * 64 + m * 16 + fr; asm volatile("" : "+v"(row)); rsx[ai][m] = ((const GAS float*)ssqx)[row]; }
#pragma unroll
        for (int ai = 0; ai < 2; ++ai)
#pragma unroll
            for (int m = 0; m < 4; ++m) {
                int row = u.pm * 256 + ai * 128 + wr * 64 + m * 16 + fr; asm volatile("" : "+v"(row));
                const float rs = rsqrtf(rsx[ai][m] * (1.0f / 1024.0f) + EPSN);
                bf16* rowp = H + (size_t)row * DFF + col0;
#pragma unroll
                for (int bj = 0; bj < 2; ++bj) {
                    f32x4 v0 = acc[ai][bj][m][0] * rs + bv[bj][0], v1 = acc[ai][bj][m][1] * rs + bv[bj][1];
#pragma unroll
                    for (int j = 0; j < 4; ++j) { const float a = fmaxf(v0[j], 0.f), b = fmaxf(v1[j], 0.f); v0[j] = a * a; v1[j] = b * b; }
                    u32x4 w; w.x = cvtpk(v0[0], v0[1]); w.y = cvtpk(v0[2], v0[3]); w.z = cvtpk(v1[0], v1[1]); w.w = cvtpk(v1[2], v1[3]);
                    *(GAS u32x4*)(rowp + bj * 128) = w;
                }
            }
    }
};

struct EpiResid {
    static constexpr bool PERM = false, AFTER_DRAIN = false;
    const float *srcx, *srcc; float *dstx, *dstc; const float* gate; bf16* xg; float* ssq_out; const float *gn, *scn; int donorm;
    DI void operator()(const f32x4 (&acc)[2][2][4][2], const pg8::Unit& u, int wr, int wc, int fr, int fq) const {
        const bool isx = u.pm < 128; const int mi = isx ? (u.pm >> 4) : 8;
        const int col0 = u.pn * 256 + wc * 32 + 4 * fq;
        f32x4 gv[2][2], gp[2][2];
#pragma unroll
        for (int bj = 0; bj < 2; ++bj)
#pragma unroll
            for (int n = 0; n < 2; ++n) { const int c = col0 + bj * 128 + n * 16; gv[bj][n] = *(const GAS f32x4*)(gate + mi * 6144 + c);
                gp[bj][n] = donorm ? *(const GAS f32x4*)(gn + c) * (*(const GAS f32x4*)(scn + mi * 6144 + c) + 1.0f) : (f32x4){0.f, 0.f, 0.f, 0.f}; }
#pragma unroll
        for (int ai = 0; ai < 2; ++ai)
#pragma unroll
        for (int mh = 0; mh < 2; ++mh) {
            f32x4 xs[4][2][2];
#pragma unroll
            for (int m = 2 * mh; m < 2 * mh + 2; ++m) {
                int row = u.pm * 256 + ai * 128 + wr * 64 + m * 16 + fr; asm volatile("" : "+v"(row));
                const float* s = isx ? srcx + (size_t)row * DM : srcc + (size_t)(row - MX) * DM;
#pragma unroll
                for (int bj = 0; bj < 2; ++bj)
#pragma unroll
                    for (int n = 0; n < 2; ++n) xs[m][bj][n] = *(const GAS f32x4*)(s + col0 + bj * 128 + n * 16);
            }
#pragma unroll
            for (int m = 2 * mh; m < 2 * mh + 2; ++m) {
                int row = u.pm * 256 + ai * 128 + wr * 64 + m * 16 + fr; asm volatile("" : "+v"(row));
                float* d = isx ? dstx + (size_t)row * DM : dstc + (size_t)(row - MX) * DM;
                float ss = 0.f;
#pragma unroll
                for (int bj = 0; bj < 2; ++bj)
#pragma unroll
                    for (int n = 0; n < 2; ++n) { const int off = col0 + bj * 128 + n * 16;
                        const f32x4 xn = xs[m][bj][n] + gv[bj][n] * acc[ai][bj][m][n];
                        *(GAS f32x4*)(d + off) = xn;
                        if (donorm) { ss += (xn[0] * xn[0] + xn[1] * xn[1]) + (xn[2] * xn[2] + xn[3] * xn[3]); st4bf(xg + (size_t)row * DM + off, xn * gp[bj][n]); } }
                if (donorm) { ss += __shfl_xor(ss, 16); ss += __shfl_xor(ss, 32); if (fq == 0) atomicAdd(ssq_out + row, ss); }
            }
        }
    }
};

struct SplitOrder {
    int G, c, NS, ksub_bytes;
    DI void init(int G_, int c_, int NS_, int Ksub) { G = G_; c = c_; NS = NS_; ksub_bytes = Ksub * 2; }
    DI bool next(int i, pg8::Unit& u) const { const int idx = i * G + c; if (idx >= 32 * NS) return false; const int ks = idx % NS, tile = idx / NS; u.pn = tile & 3; u.pm = 128 + (tile >> 2); u.kb = ks * ksub_bytes; return true; }
    DI void a_ready(const pg8::Unit&) const {}
    DI void done(const pg8::Unit&) const {}
};
struct EpiPartial {
    static constexpr bool PERM = false, AFTER_DRAIN = false;
    float* part; int ksub_bytes;
    DI void operator()(const f32x4 (&acc)[2][2][4][2], const pg8::Unit& u, int wr, int wc, int fr, int fq) const {
        const int ks = u.kb / ksub_bytes; const int col0 = u.pn * 256 + wc * 32 + 4 * fq;
        float* base = part + (size_t)ks * MC * DM;
#pragma unroll
        for (int ai = 0; ai < 2; ++ai)
#pragma unroll
            for (int m = 0; m < 4; ++m) {
                int row = (u.pm - 128) * 256 + ai * 128 + wr * 64 + m * 16 + fr;
                asm volatile("" : "+v"(row) :: "memory");
                float* rowp = base + (size_t)row * DM + col0;
#pragma unroll
                for (int bj = 0; bj < 2; ++bj)
#pragma unroll
                    for (int n = 0; n < 2; ++n) *(GAS f32x4*)(rowp + bj * 128 + n * 16) = acc[ai][bj][m][n];
            }
    }
};
DI void ctx_finish(const float* part, int NS, const float* src, float* dst, const float* gate8, bf16* xg, float* ssq_out, const float* gn, const float* scn8, const int tid) {
    const int lane = tid & 63, gw = blockIdx.x * 8 + (tid >> 6), NGW = gridDim.x * 8;
    for (int row = gw; row < MC; row += NGW) {
        float s = 0.f;
#pragma unroll
        for (int j = 0; j < 4; ++j) {
            const int col = 256 * j + 4 * lane;
            f32x4 a = {0.f, 0.f, 0.f, 0.f};
            for (int ks = 0; ks < NS; ++ks) a += *(const GAS f32x4*)(part + ((size_t)ks * MC + row) * DM + col);
            const f32x4 xn = *(const GAS f32x4*)(src + (size_t)row * DM + col) + *(const GAS f32x4*)(gate8 + col) * a;
            *(GAS f32x4*)(dst + (size_t)row * DM + col) = xn;
            s += (xn[0] * xn[0] + xn[1] * xn[1]) + (xn[2] * xn[2] + xn[3] * xn[3]);
            st4bf(xg + (size_t)(MX + row) * DM + col, xn * (*(const GAS f32x4*)(gn + col) * (*(const GAS f32x4*)(scn8 + col) + 1.0f)));
        }
        s = wave_sum(s);
        if (lane == 0) ssq_out[MX + row] = s;
    }
}

DI void transpose_item(const float* W, int K, int N, bf16* WT, const float* kscale, LAS float* scr, int item, int lane) {
    const int nblk = N / 32, kb = item / nblk, nb = item % nblk, k0 = 64 * kb, n0 = 32 * nb;
#pragma unroll 16
    for (int i = 0; i < 32; ++i) { const int kk = 2 * i + (lane >> 5); float w = W[(size_t)(k0 + kk) * N + n0 + (lane & 31)]; if (kscale) w *= kscale[k0 + kk]; scr[kk * 33 + (lane & 31)] = w; }
    LDS_WAIT();
    const int c = lane & 7;
#pragma unroll
    for (int j = 0; j < 4; ++j) { const int n = (lane >> 3) + 8 * j; const LAS float* s = scr + (8 * c) * 33 + n;
        u32x4 o; o.x = cvtpk(s[0 * 33], s[1 * 33]); o.y = cvtpk(s[2 * 33], s[3 * 33]); o.z = cvtpk(s[4 * 33], s[5 * 33]); o.w = cvtpk(s[6 * 33], s[7 * 33]);
        *(u32x4*)(WT + (size_t)(n0 + n) * K + k0 + 8 * c) = o; }
    LDS_WAIT();
}

DI void gemv9_item(const float* W, int ldw, int nvalid, int n0, const LAS float* sl, LAS float* red, const float* addb, float* out, int ldo, const int tid) {
    const int col = tid & 31, kg = tid >> 5, n = n0 + col;
    float acc[9];
#pragma unroll
    for (int mi = 0; mi < 9; ++mi) acc[mi] = 0.f;
    if (n < nvalid) {
        const float* w = W + (size_t)(kg * 64) * ldw + n;
#pragma unroll 16
        for (int k = 0; k < 64; ++k) { const float wv = w[(size_t)k * ldw];
#pragma unroll
            for (int mi = 0; mi < 9; ++mi) acc[mi] += sl[mi * 1024 + kg * 64 + k] * wv; }
    }
#pragma unroll
    for (int mi = 0; mi < 9; ++mi) red[(kg * 9 + mi) * 32 + col] = acc[mi];
    __syncthreads();
    if (tid < 288) { const int mi = tid >> 5, cq = tid & 31; float sacc = (addb && n0 + cq < nvalid) ? addb[n0 + cq] : 0.f;
#pragma unroll
        for (int g = 0; g < 16; ++g) sacc += red[(g * 9 + mi) * 32 + cq];
        out[(size_t)mi * ldo + n0 + cq] = sacc; }
    __syncthreads();
}

struct Args { const float* in[19]; float* out; unsigned char* ws; int ph_lo, ph_hi; };

DI void prologue(const Args& a, LAS unsigned char* lds, const int tid) {
    const int lane = tid & 63, wave = __builtin_amdgcn_readfirstlane(tid >> 6);
    int G = gridDim.x; asm volatile("" : "+s"(G));
    const int bx = blockIdx.x;
    unsigned char* ws = a.ws;
    {
        LAS float* sl = (LAS float*)lds;
        LAS float* red = (LAS float*)(lds + 36864);
        const float* c = a.in[1]; const float* cc = a.in[3]; const float* w_ada = a.in[4]; const float* b_ada = a.in[5];
        float* mods = (float*)(ws + WS_MODS);
        for (int idx = tid; idx < 9 * 1024; idx += NTHR) { const int mi = idx >> 10, k = idx & 1023; const float v = mi < 8 ? c[mi * 1024 + k] : cc[k]; sl[idx] = v / (1.0f + expf(-v)); }
        __syncthreads();
        for (int item = bx; item < DEPTH * 192; item += G) {
            const int l = item / 192, n0 = (item % 192) * 32;
            gemv9_item(w_ada + (size_t)l * 1024 * 6144, 6144, 6144, n0, sl, red, b_ada + l * 6144, mods + (size_t)l * 9 * 6144, 6144, tid);
        }
    }
    {
        const int gid = bx * NTHR + tid, NG = G * NTHR;
        float* tabA = (float*)(ws + WS_TAB); float* tabC = tabA + 2048;
        if (gid < 1024) { const int pos = gid >> 4, i = gid & 15; const float fr = exp2f(-(float)i * (1.0f / 16.0f) * 13.287712379549449f); const float rev = ((float)pos * fr) * 0.15915494309189535f;
            tabA[pos * 32 + i] = __builtin_amdgcn_cosf(rev); tabA[pos * 32 + 16 + i] = __builtin_amdgcn_sinf(rev); }
        else if (gid < 1536) { const int g = gid - 1024, pos = g >> 3, i = g & 7; const float fr = exp2f(-(float)i * (1.0f / 8.0f) * 13.287712379549449f); const float rev = ((float)pos * fr) * 0.15915494309189535f;
            tabC[pos * 16 + i] = __builtin_amdgcn_cosf(rev); tabC[pos * 16 + 8 + i] = __builtin_amdgcn_sinf(rev); }
        float* ssq = (float*)(ws + WS_SSQ);
        for (int i = gid; i < DEPTH * 2 * MT; i += NG) ssq[i] = 0.f;
        float* ssqx = (float*)(ws + WS_SSQX);
        for (int i = gid; i < DEPTH * 2 * MT; i += NG) ssqx[i] = 0.f;
        const u32x4 z = {0u, 0u, 0u, 0u};
        for (int i = gid; i < DEPTH * 12288; i += NG) { const int l = i / 12288, r = i % 12288; ((u32x4*)(ws + WS_W + l * WL_STRIDE + WL_IN + (size_t)INW * 1024 * 2))[r] = z; }
        for (int i = gid; i < DEPTH * 4096; i += NG) { const int l = i / 4096, r = i % 4096; ((u32x4*)(ws + WS_W + l * WL_STRIDE + WL_UQ + (size_t)384 * 256 * 2))[r] = z; }
    }
    {
        LAS float* scr = (LAS float*)(lds + wave * 16384);
        const int gw = bx * 8 + wave, NGW = G * 8;
        constexpr int I_IN = 16 * 61, I_OUT = 16 * 32, I_W1 = 16 * 128, I_W2 = 64 * 32, I_UQ = 4 * 12, I_UKV = 2 * 16, I_L = I_IN + I_OUT + I_W1 + I_W2 + I_UQ + I_UKV;
        for (int it = gw; it < DEPTH * I_L; it += NGW) {
            const int l = it / I_L; int r = it % I_L; unsigned char* wb = ws + WS_W + l * WL_STRIDE;
            if (r < I_IN) { transpose_item(a.in[8] + (size_t)l * 1024 * INW, 1024, INW, (bf16*)(wb + WL_IN), nullptr, scr, r, lane); continue; } r -= I_IN;
            if (r < I_OUT) { transpose_item(a.in[15] + (size_t)l * 1024 * 1024, 1024, 1024, (bf16*)(wb + WL_OUT), nullptr, scr, r, lane); continue; } r -= I_OUT;
            if (r < I_W1) { transpose_item(a.in[16] + (size_t)l * 1024 * 4096, 1024, 4096, (bf16*)(wb + WL_W1), nullptr, scr, r, lane); continue; } r -= I_W1;
            if (r < I_W2) { transpose_item(a.in[17] + (size_t)l * 4096 * 1024, 4096, 1024, (bf16*)(wb + WL_W2), nullptr, scr, r, lane); continue; } r -= I_W2;
            if (r < I_UQ) { transpose_item(a.in[12] + (size_t)l * 256 * 384, 256, 384, (bf16*)(wb + WL_UQ), a.in[11] + l * 256, scr, r, lane); continue; } r -= I_UQ;
            transpose_item(a.in[14] + (size_t)l * 128 * 512, 128, 512, (bf16*)(wb + WL_UKV), a.in[13] + l * 128, scr, r, lane);
        }
    }
}

DI void phase1(const Args& a, LAS unsigned char* lds, const int tid) {
    unsigned char* ws = a.ws;
    int G = gridDim.x; asm volatile("" : "+s"(G));
    const int bx = blockIdx.x;
    const float* mods = (const float*)(ws + WS_MODS);
    {
        LAS float* sl = (LAS float*)lds; LAS float* red = (LAS float*)(lds + 36864);
        float* bias1 = (float*)(ws + WS_BIAS1); float* bias4 = (float*)(ws + WS_BIAS4);
        for (int item = bx; item < DEPTH * 192; item += G) {
            const int l = item / 192, r = item % 192, which = r < 64 ? 0 : 1, tile = which ? r - 64 : r;
            const float* mv = mods + (size_t)l * 9 * 6144 + (which ? 3 : 0) * 1024;
            for (int idx = tid; idx < 9 * 1024; idx += NTHR) sl[idx] = mv[(size_t)(idx >> 10) * 6144 + (idx & 1023)];
            __syncthreads();
            if (!which) gemv9_item(a.in[8] + (size_t)l * 1024 * INW, INW, INW, tile * 32, sl, red, nullptr, bias1 + (size_t)l * 9 * 2048, 2048, tid);
            else gemv9_item(a.in[16] + (size_t)l * 1024 * DFF, DFF, DFF, tile * 32, sl, red, nullptr, bias4 + (size_t)l * 9 * 4096, 4096, tid);
        }
    }
    {
        const int lane = tid & 63, gw = bx * 8 + (tid >> 6), NGW = G * 8;
        bf16* Hn = (bf16*)(ws + WS_HN); float* ssqx = (float*)(ws + WS_SSQX); const float* g = a.in[6];
        f32x4 gg[4];
#pragma unroll
        for (int j = 0; j < 4; ++j) gg[j] = *(const GAS f32x4*)(g + 256 * j + 4 * lane);
        for (int row0 = gw; row0 < MT; row0 += 4 * NGW) {
            f32x4 v[4][4];
#pragma unroll
            for (int q = 0; q < 4; ++q) { const int row = row0 + q * NGW;
                if (row < MT) { const float* src = row < MX ? a.in[0] + (size_t)row * DM : a.in[2] + (size_t)(row - MX) * DM;
                    const GAS f32x4* xr = (const GAS f32x4*)src + lane;
#pragma unroll
                    for (int j = 0; j < 4; ++j) v[q][j] = xr[64 * j]; } }
#pragma unroll
            for (int q = 0; q < 4; ++q) { const int row = row0 + q * NGW;
                if (row < MT) { const int mi = row < MX ? (row >> 12) : 8; float s = 0.f;
#pragma unroll
                    for (int j = 0; j < 4; ++j) s += (v[q][j][0] * v[q][j][0] + v[q][j][1] * v[q][j][1]) + (v[q][j][2] * v[q][j][2] + v[q][j][3] * v[q][j][3]);
                    s = wave_sum(s);
                    if (lane == 0) ssqx[row] = s;
                    const float* mrow = mods + (size_t)mi * 6144 + 1024;
#pragma unroll
                    for (int j = 0; j < 4; ++j) { const int col = 256 * j + 4 * lane;
                        const f32x4 sc = *(const GAS f32x4*)(mrow + col);
                        st4bf(Hn + (size_t)row * DM + col, v[q][j] * (gg[j] * (sc + 1.0f))); } } }
        }
    }
}
DI void final_norm_phase(float* x, const float* g, const int tid) {
    const int lane = tid & 63, gw = blockIdx.x * 8 + (tid >> 6), NGW = gridDim.x * 8;
    f32x4 gg[4];
#pragma unroll
    for (int j = 0; j < 4; ++j) gg[j] = *(const GAS f32x4*)(g + 256 * j + 4 * lane);
    for (int row0 = gw; row0 < MX; row0 += 4 * NGW) {
        f32x4 v[4][4];
#pragma unroll
        for (int q = 0; q < 4; ++q) { const int row = row0 + q * NGW;
            if (row < MX) { const GAS f32x4* xr = (const GAS f32x4*)(x + (size_t)row * DM) + lane;
#pragma unroll
                for (int j = 0; j < 4; ++j) v[q][j] = xr[64 * j]; } }
#pragma unroll
        for (int q = 0; q < 4; ++q) { const int row = row0 + q * NGW;
            if (row < MX) { float s = 0.f;
#pragma unroll
                for (int j = 0; j < 4; ++j) s += (v[q][j][0] * v[q][j][0] + v[q][j][1] * v[q][j][1]) + (v[q][j][2] * v[q][j][2] + v[q][j][3] * v[q][j][3]);
                const float r = rsqrtf(wave_sum(s) * (1.0f / DM) + EPSN);
                GAS f32x4* xw = (GAS f32x4*)(x + (size_t)row * DM) + lane;
#pragma unroll
                for (int j = 0; j < 4; ++j) xw[64 * j] = v[q][j] * r * gg[j]; } }
    }
}

struct AttnP { const bf16 *proj, *qm, *kvm, *krr; bf16* mix; const float* sink; const float* rpb; };
constexpr int A_VS = 144, A_KB = 64 * 208, A_VB = 64 * A_VS, L_K = 0, L_V = 2 * A_KB, L_B = L_V + 2 * A_VB;

template <int TYPE> DI int key_row(int t, int j, int b, int nblk, int kr0, int kc0) {
    if (t < 4) return MX + b * 256 + t * 64 + j;
    const int tt = t - 4;
    if (TYPE == 0) return b * 4096 + (nblk - 1) * 128 + tt * 64 + j;
    if (TYPE == 1) { const int tr = tt / 3, tc = tt - 3 * tr; return b * 4096 + (kr0 + 4 * tr + (j >> 4)) * 64 + kc0 + 16 * tc + (j & 15); }
    if (TYPE == 3) { const int tr = tt >> 1, tc = tt & 1; return b * 4096 + (kr0 + 4 * tr + (j >> 4)) * 64 + kc0 + 16 * tc + (j & 15); }
    return b * 4096 + tt * 64 + j;
}

constexpr float ATHR = 6.0f;
template <int TYPE> struct AttnCtx { int t_qi, t_h, kr0, kc0, qr, qc, wr_, wc_; };

#define AT_SB() __builtin_amdgcn_sched_barrier(0)
template <int TYPE, int NKS, int KSTR> DI void at_mfma_block(f32x16& p0, f32x16& p1, f32x16& o0, f32x16& o1, const bf16x8 (&qf)[NKS], const bf16x8 (&pf)[4], float m_,
                                                             const LAS unsigned char* kb0, const LAS unsigned char* vb, bool do_s, bool do_pv) {
    constexpr int NST = NKS + 4, PD = (TYPE == 3) ? 1 : 2;
    bf16x8 fr[NST][2];
    const int first = do_s ? 0 : NKS, last = do_pv ? NST : NKS;
#define AT_LD(i_) do { if ((i_) >= first && (i_) < last) { \
        if ((i_) < NKS) { fr[i_][0] = *(const LAS bf16x8*)(kb0 + (i_) * 32); fr[i_][1] = *(const LAS bf16x8*)(kb0 + 32 * KSTR + (i_) * 32); } \
        else { const int s_ = (i_) - NKS; \
            const s16x4 l0_ = __builtin_bit_cast(s16x4, __builtin_amdgcn_ds_read_tr16_b64_v4i16((LAS s16x4*)(vb + (16 * s_) * A_VS))); \
            const s16x4 h0_ = __builtin_bit_cast(s16x4, __builtin_amdgcn_ds_read_tr16_b64_v4i16((LAS s16x4*)(vb + (16 * s_ + 8) * A_VS))); \
            const s16x4 l1_ = __builtin_bit_cast(s16x4, __builtin_amdgcn_ds_read_tr16_b64_v4i16((LAS s16x4*)(vb + (16 * s_) * A_VS + 64))); \
            const s16x4 h1_ = __builtin_bit_cast(s16x4, __builtin_amdgcn_ds_read_tr16_b64_v4i16((LAS s16x4*)(vb + (16 * s_ + 8) * A_VS + 64))); \
            fr[i_][0] = __builtin_shufflevector(l0_, h0_, 0, 1, 2, 3, 4, 5, 6, 7); fr[i_][1] = __builtin_shufflevector(l1_, h1_, 0, 1, 2, 3, 4, 5, 6, 7); } } } while (0)
    if (do_s) {
        const float nm = -m_;
#pragma unroll
        for (int i = 0; i < 16; ++i) { p0[i] = nm; p1[i] = nm; }
    }
#pragma unroll
    for (int i = 0; i < NST; ++i) {
        if (i == 0) { AT_LD(0); if (PD > 1) AT_LD(1); }
        if (i + PD < NST) AT_LD(i + PD);
        AT_SB();
        if (i >= first && i < last) {
            if (i < NKS) { p0 = __builtin_amdgcn_mfma_f32_32x32x16_bf16(fr[i][0], qf[i < NKS ? i : 0], p0, 0, 0, 0); p1 = __builtin_amdgcn_mfma_f32_32x32x16_bf16(fr[i][1], qf[i < NKS ? i : 0], p1, 0, 0, 0); }
            else { o0 = __builtin_amdgcn_mfma_f32_32x32x16_bf16(fr[i][0], pf[i >= NKS ? i - NKS : 0], o0, 0, 0, 0); o1 = __builtin_amdgcn_mfma_f32_32x32x16_bf16(fr[i][1], pf[i >= NKS ? i - NKS : 0], o1, 0, 0, 0); }
        }
        AT_SB();
    }
#undef AT_LD
}

template <int TYPE> DI void at_valu_block(f32x16& p0, f32x16& p1, f32x16& o0, f32x16& o1, bf16x8 (&pf)[4], float& m_, float& l_, int t, bool first,
                                          int qi, int h, int kr0, int kc0, int qr, int qc, int wr_, int wc_, const LAS float* lbias) {
    if (t >= 4) {
        if (TYPE == 0) {
            const int d0 = 64 * (t - 4) - qi + 4 * h;
#pragma unroll
            for (int i = 0; i < 16; ++i) { const int e = d0 + (i & 3) + 8 * (i >> 2);
                if ((unsigned)e > 256u) p0[i] = -1e30f;
                if ((unsigned)(e + 32) > 256u) p1[i] = -1e30f; }
        } else if (TYPE == 1 || TYPE == 3) {
            const int tt = t - 4, tr = (TYPE == 3) ? (tt >> 1) : tt / 3, tc = (TYPE == 3) ? (tt & 1) : tt - 3 * tr;
            const int krb = kr0 + 4 * tr, kcb = kc0 + 16 * tc + 4 * h;
#pragma unroll
            for (int i = 0; i < 16; ++i) {
                const int kc = kcb + (i & 3) + 8 * ((i >> 2) & 1);
                const bool cv = (unsigned)(kc - wc_) < 16u;
                const int ci = kc - qc + 15;
                { const int kr = krb + (i >> 3); const bool v = cv && ((unsigned)(kr - wr_) < 8u); const int idx = v ? (kr - qr + 7) * 31 + ci : 0; const float bv = lbias[idx]; p0[i] = v ? p0[i] + bv : -1e30f; }
                { const int kr = krb + 2 + (i >> 3); const bool v = cv && ((unsigned)(kr - wr_) < 8u); const int idx = v ? (kr - qr + 7) * 31 + ci : 0; const float bv = lbias[idx]; p1[i] = v ? p1[i] + bv : -1e30f; }
            }
        }
    }
    asm volatile("s_nop 15\n\ts_nop 7" : "+v"(p0), "+v"(p1));
    float mxa = max3f(p0[0], p0[1], p1[0]), mxb = max3f(p0[2], p0[3], p1[1]); mxa = max3f(mxa, p1[2], p1[3]);
#pragma unroll
    for (int i = 4; i < 16; i += 4) { mxa = max3f(mxa, p0[i], p0[i + 1]); mxb = max3f(mxb, p0[i + 2], p0[i + 3]); mxa = max3f(mxa, p1[i], p1[i + 1]); mxb = max3f(mxb, p1[i + 2], p1[i + 3]); }
    float mx = max3f(mxa, mxb, mxb);
    mx = max3f(mx, __shfl_xor(mx, 32), mx);
    if (first || __any(mx > ATHR)) {
        const float dl = (TYPE != 0 && first) ? mx : fmaxf(mx, 0.f);
        const float alpha = fexp2(-dl);
        m_ += dl; l_ *= alpha;
#pragma unroll
        for (int i = 0; i < 16; ++i) { p0[i] -= dl; p1[i] -= dl; o0[i] *= alpha; o1[i] *= alpha; }
    }
    float ls = 0.f;
#pragma unroll
    for (int i = 0; i < 16; ++i) { p0[i] = fexp2(p0[i]); p1[i] = fexp2(p1[i]); ls += p0[i] + p1[i]; }
    l_ += ls;
#pragma unroll
    for (int s = 0; s < 4; ++s) {
        u32x4 pw;
        if (s < 2) { pw.x = cvtpk(p0[8 * s + 0], p0[8 * s + 1]); pw.y = cvtpk(p0[8 * s + 2], p0[8 * s + 3]); pw.z = cvtpk(p0[8 * s + 4], p0[8 * s + 5]); pw.w = cvtpk(p0[8 * s + 6], p0[8 * s + 7]); }
        else { const int s2 = s - 2; pw.x = cvtpk(p1[8 * s2 + 0], p1[8 * s2 + 1]); pw.y = cvtpk(p1[8 * s2 + 2], p1[8 * s2 + 3]); pw.z = cvtpk(p1[8 * s2 + 4], p1[8 * s2 + 5]); pw.w = cvtpk(p1[8 * s2 + 6], p1[8 * s2 + 7]); }
        pf[s] = __builtin_bit_cast(bf16x8, pw);
    }
}

template <int TYPE> DI void attn_unit(const AttnP& P, int uid, bool isctx, LAS unsigned char* lds, const int tid) {
    constexpr int DQK = TYPE == 2 ? 96 : 64, NKS = DQK / 16, KSTR = DQK * 2 + 16;
    const int lane = tid & 63, w = __builtin_amdgcn_readfirstlane(tid >> 6), r = lane & 31, h = lane >> 5;
    int b, hd, kvh = 0, qrow, nblk = 0, kr0 = 0, kc0 = 0, qr = 0, qc = 0, tb0 = 4, tb1 = 4;
    if (TYPE == 0) {
        int gp;
        if (!isctx) { b = uid >> 7; kvh = (uid >> 6) & 1; nblk = (uid >> 1) & 31; gp = uid & 1; qrow = b * 4096 + nblk * 128 + (w & 3) * 32 + r; tb0 = nblk == 0 ? 6 : 4; tb1 = nblk == 31 ? 8 : 10; }
        else { b = uid >> 3; kvh = (uid >> 2) & 1; gp = (uid >> 1) & 1; nblk = uid & 1; qrow = MX + b * 256 + nblk * 128 + (w & 3) * 32 + r; }
        hd = kvh * 4 + gp * 2 + (w >> 2);
    } else if (TYPE == 1 || TYPE == 3) {
        if (!isctx) { b = uid >> 6; hd = (uid >> 4) & 3; const int ib = (uid >> 1) & 7, cp = uid & 1;
            qr = 8 * ib + 2 * (w & 3) + (r >> 4); qc = 16 * (2 * cp + (w >> 2)) + (r & 15); qrow = b * 4096 + qr * 64 + qc;
            kr0 = min(max(8 * ib - 4, 0), 48);
            if (TYPE == 3) { kc0 = min(max(16 * (2 * cp + (w >> 2)) - 8, 0), 32); tb1 = 12; }
            else { kc0 = 16 * cp; tb1 = 16; } }
        else { b = uid >> 2; hd = uid & 3; qrow = MX + b * 256 + w * 32 + r; }
    } else {
        if (!isctx) { b = uid >> 6; hd = (uid >> 4) & 3; qrow = b * 4096 + (uid & 15) * 256 + w * 32 + r; tb1 = 68; }
        else { b = uid >> 2; hd = uid & 3; qrow = MX + b * 256 + w * 32 + r; }
    }
    const int NTA = 4 + (tb1 - tb0);
    const bf16* qp; int ocol;
    if (TYPE == 0) { qp = P.proj + (size_t)qrow * PJS + hd * 64; ocol = hd * 64; }
    else if (TYPE == 1 || TYPE == 3) { qp = P.proj + (size_t)qrow * PJS + 768 + hd * 64; ocol = 512 + hd * 64; }
    else { qp = P.qm + (size_t)qrow * 384 + hd * 96; ocol = 768 + hd * 64; }
    bf16x8 qf[NKS];
#pragma unroll
    for (int ks = 0; ks < NKS; ++ks) qf[ks] = *(const GAS bf16x8*)(qp + 16 * ks + 8 * h);

    float m_ = 0.f, l_ = 0.f;
    if (TYPE == 0) { m_ = P.sink[hd] * LOG2E; l_ = (h == 0) ? 1.f : 0.f; }
    f32x16 o0, o1, p0, p1;
#pragma unroll
    for (int i = 0; i < 16; ++i) { o0[i] = 0.f; o1[i] = 0.f; p0[i] = 0.f; p1[i] = 0.f; }
    bf16x8 pf[4];
#pragma unroll
    for (int s = 0; s < 4; ++s) pf[s] = (bf16x8){0, 0, 0, 0, 0, 0, 0, 0};

    u32x4 kreg, vreg, rreg = {0u, 0u, 0u, 0u}, kreg2, vreg2;
    constexpr int A_HALF = 2 * A_KB + 2 * A_VB;
    const int HB = (TYPE == 3) ? (w >> 2) * A_HALF : 0;
    const int sj = (TYPE == 3) ? ((tid & 255) >> 3) : (tid >> 3), sc = tid & 7;
#define AT_TILE(it_) ((it_) < 4 ? (it_) : (it_) - 4 + tb0)
#define AT_LOADK(t) do { const int kr_ = key_row<TYPE>((t), sj, b, nblk, kr0, kc0); \
        if (TYPE == 2) { kreg = *(const GAS u32x4*)(P.kvm + (size_t)kr_ * 512 + hd * 128 + sc * 8); \
            if (tid < 256) { const int kr2_ = key_row<TYPE>((t), tid >> 2, b, nblk, kr0, kc0); rreg = *(const GAS u32x4*)(P.krr + (size_t)kr2_ * 32 + (tid & 3) * 8); } } \
        else { kreg = *(const GAS u32x4*)(P.proj + (size_t)kr_ * PJS + (TYPE == 0 ? 512 + kvh * 64 : 1024 + hd * 64) + sc * 8); \
            if (TYPE == 3) { const int kr2_ = key_row<TYPE>((t), sj + 32, b, nblk, kr0, kc0); kreg2 = *(const GAS u32x4*)(P.proj + (size_t)kr2_ * PJS + 1024 + hd * 64 + sc * 8); } } } while (0)
#define AT_LOADV(t) do { const int kr_ = key_row<TYPE>((t), sj, b, nblk, kr0, kc0); \
        if (TYPE == 2) vreg = *(const GAS u32x4*)(P.kvm + (size_t)kr_ * 512 + hd * 128 + 64 + sc * 8); \
        else { vreg = *(const GAS u32x4*)(P.proj + (size_t)kr_ * PJS + (TYPE == 0 ? 640 + kvh * 64 : 1280 + hd * 64) + sc * 8); \
            if (TYPE == 3) { const int kr2_ = key_row<TYPE>((t), sj + 32, b, nblk, kr0, kc0); vreg2 = *(const GAS u32x4*)(P.proj + (size_t)kr2_ * PJS + 1280 + hd * 64 + sc * 8); } } } while (0)
#define AT_STOREK(bi) do { *(LAS u32x4*)(lds + HB + L_K + (bi) * A_KB + sj * KSTR + sc * 16) = kreg; \
        if (TYPE == 3) *(LAS u32x4*)(lds + HB + L_K + (bi) * A_KB + (sj + 32) * KSTR + sc * 16) = kreg2; \
        if (TYPE == 2) { if (tid < 256) *(LAS u32x4*)(lds + L_K + (bi) * A_KB + (tid >> 2) * KSTR + 128 + (tid & 3) * 16) = rreg; } } while (0)
#define AT_STOREV(bi) do { *(LAS u32x4*)(lds + HB + L_V + (bi) * A_VB + sj * A_VS + sc * 16) = vreg; \
        if (TYPE == 3) *(LAS u32x4*)(lds + HB + L_V + (bi) * A_VB + (sj + 32) * A_VS + sc * 16) = vreg2; } while (0)
    AT_LOADK(0);
    __syncthreads();
    LAS float* lbias = (LAS float*)(lds + (TYPE == 3 ? 2 * A_HALF : L_B));
    if ((TYPE == 1 || TYPE == 3) && !isctx) { if (tid < 465) lbias[tid] = ((const GAS float*)P.rpb)[hd * 465 + tid] * LOG2E; }
    AT_STOREK(0);
    AT_LOADK(AT_TILE(1)); AT_LOADV(0);
    __syncthreads();
    const int q4 = (lane & 15) >> 2, p4 = lane & 3, blk = (lane >> 4) & 1;
    const int voff = HB + L_V + (4 * h + q4) * A_VS + (16 * blk + 4 * p4) * 2;
    const int koff = HB + L_K + r * KSTR + 16 * h;
    const int wr_ = min(max(qr - 4, 0), 56), wc_ = min(max(qc - 8, 0), 48);
    const int qi = (w & 3) * 32 + r;
    const bool grp1 = (w >> 2) != 0;

#define AT_STAGE(it) do { if ((it) + 1 < NTA) AT_STOREK(((it) + 1) & 1); AT_STOREV((it) & 1); \
        if ((it) + 2 < NTA) AT_LOADK(AT_TILE((it) + 2)); if ((it) + 1 < NTA) AT_LOADV(AT_TILE((it) + 1)); __syncthreads(); } while (0)
    if (!grp1) {
        for (int it = 0; it < NTA; ++it) {
            const int t = AT_TILE(it);
            const LAS unsigned char* kb0 = lds + (it & 1) * A_KB + koff;
            const LAS unsigned char* vb = lds + ((it + 1) & 1) * A_VB + voff;
            at_mfma_block<TYPE, NKS, KSTR>(p0, p1, o0, o1, qf, pf, m_, kb0, vb, true, it > 0);
            at_valu_block<TYPE>(p0, p1, o0, o1, pf, m_, l_, t, it == 0, qi, h, kr0, kc0, qr, qc, wr_, wc_, lbias);
            AT_STAGE(it);
        }
        const LAS unsigned char* vb = lds + ((NTA - 1) & 1) * A_VB + voff;
        at_mfma_block<TYPE, NKS, KSTR>(p0, p1, o0, o1, qf, pf, m_, vb, vb, false, true);
    } else {
        for (int it = 0; it < NTA; ++it) {
            const int tp = AT_TILE(it - 1);
            const LAS unsigned char* kb0 = lds + (it & 1) * A_KB + koff;
            const LAS unsigned char* vb = lds + ((it + 1) & 1) * A_VB + voff;
            if (it > 0) at_valu_block<TYPE>(p0, p1, o0, o1, pf, m_, l_, tp, it == 1, qi, h, kr0, kc0, qr, qc, wr_, wc_, lbias);
            at_mfma_block<TYPE, NKS, KSTR>(p0, p1, o0, o1, qf, pf, m_, kb0, vb, true, it > 0);
            AT_STAGE(it);
        }
        const LAS unsigned char* vb = lds + ((NTA - 1) & 1) * A_VB + voff;
        at_valu_block<TYPE>(p0, p1, o0, o1, pf, m_, l_, AT_TILE(NTA - 1), false, qi, h, kr0, kc0, qr, qc, wr_, wc_, lbias);
        at_mfma_block<TYPE, NKS, KSTR>(p0, p1, o0, o1, qf, pf, m_, vb, vb, false, true);
    }
#undef AT_STAGE
#undef AT_LOADK
#undef AT_LOADV
#undef AT_STOREK
#undef AT_STOREV
#undef AT_TILE
    const float lt = l_ + __shfl_xor(l_, 32), inv = 1.0f / lt;
    bf16* op = P.mix + (size_t)qrow * DM + ocol + 4 * h;
#pragma unroll
    for (int g = 0; g < 4; ++g) {
        const f32x4 v0 = {o0[4 * g] * inv, o0[4 * g + 1] * inv, o0[4 * g + 2] * inv, o0[4 * g + 3] * inv};
        const f32x4 v1 = {o1[4 * g] * inv, o1[4 * g + 1] * inv, o1[4 * g + 2] * inv, o1[4 * g + 3] * inv};
        st4bf(op + 8 * g, v0); st4bf(op + 32 + 8 * g, v1);
    }
}

DI void attn_phase(const AttnP& P, bool last, LAS unsigned char* lds, const int tid_in) {
    const int G = gridDim.x, bx = blockIdx.x;
    const int vcu = (G % 8 == 0) ? (bx % 8) * (G / 8) + bx / 8 : bx;
    const int NU = 2048 + (last ? 0 : 128);
    for (int u = vcu; u < NU; u += G) {
        int tid = tid_in; asm volatile("" : "+v"(tid));
        if (u < 512) attn_unit<2>(P, u, false, lds, tid);
        else if (u < 1024) attn_unit<3>(P, u - 512, false, lds, tid);
        else if (u < 2048) attn_unit<0>(P, u - 1024, false, lds, tid);
        else if (u < 2080) attn_unit<2>(P, u - 2048, true, lds, tid);
        else if (u < 2112) attn_unit<1>(P, u - 2080, true, lds, tid);
        else attn_unit<0>(P, u - 2112, true, lds, tid);
    }
}

#define XB_TMO      128
#define XB_XCNT(j)  (256  + 64 * (j))
#define XB_XSUB(j)  (1280 + 64 * (j))
#define XB_XGEN(j)  (2304 + 64 * (j))
#define XB_TOP      3328
#define XB_TOPGEN   3392
#define XCD_BAR_WORDS 3456
#define XB_SPIN_CAP (1u << 18)

__device__ __forceinline__ unsigned xb_ld(unsigned* p)              { return __hip_atomic_load(p, __ATOMIC_RELAXED, __HIP_MEMORY_SCOPE_AGENT); }
__device__ __forceinline__ unsigned xb_add(unsigned* p, unsigned v) { return __hip_atomic_fetch_add(p, v, __ATOMIC_RELAXED, __HIP_MEMORY_SCOPE_AGENT); }
__device__ __forceinline__ unsigned xb_xcc_id() { return (unsigned)__builtin_amdgcn_s_getreg((3 << 11) | 20) & 0xFu; }
#define XB_SPIN(cond, bar) do { unsigned _sp = 0; while (cond) { __builtin_amdgcn_s_sleep(1); \
    if ((++_sp & 255u) == 0u) { if (xb_ld(&(bar)[XB_TMO])) break; if (_sp > XB_SPIN_CAP) { atomicAdd(&(bar)[XB_TMO], 1u); break; } } } } while (0)

struct XcdBarrier {
    unsigned* bar; unsigned x;
    volatile LAS unsigned* st;
};

__device__ __forceinline__ XcdBarrier xcd_barrier_post(unsigned* bar, volatile LAS unsigned* st) {
    XcdBarrier b; b.bar = bar; b.x = xb_xcc_id(); b.st = st;
    if (threadIdx.x == 0) (void)xb_add(&bar[XB_XCNT(b.x)], 1u);
    return b;
}
__device__ __forceinline__ void xcd_barrier_complete(unsigned* bar, unsigned x, unsigned& nloc, unsigned& nx) {
    const unsigned G = gridDim.x * gridDim.y * gridDim.z;
    unsigned sum, cnt, mine, sp = 0u;
    for (;;) {
        sum = 0u; cnt = 0u; mine = 0u;
#pragma unroll
        for (unsigned j = 0; j < 16; ++j) { const unsigned c = xb_ld(&bar[XB_XCNT(j)]); sum += c; cnt += (c > 0u) ? 1u : 0u; mine = (j == x) ? c : mine; }
        if (sum == G) break;
        __builtin_amdgcn_s_sleep(1);
        if ((++sp & 255u) == 0u) { if (xb_ld(&bar[XB_TMO])) break; if (sp > XB_SPIN_CAP) { atomicAdd(&bar[XB_TMO], 1u); break; } }
    }
    nloc = mine > 0u ? mine : 1u; nx = cnt > 0u ? cnt : 1u;
}

__device__ __forceinline__ void xcd_barrier(const XcdBarrier& b) {
    asm volatile("s_waitcnt vmcnt(0)" ::: "memory");
    __syncthreads();
    if (threadIdx.x == 0) {
        unsigned* bar = b.bar;
        __builtin_amdgcn_s_waitcnt(0);
        unsigned nloc = b.st[0], nx = b.st[1];
        if (nloc == 0u) { xcd_barrier_complete(bar, b.x, nloc, nx); b.st[0] = nloc; b.st[1] = nx; }
        const unsigned old = xb_add(&bar[XB_XSUB(b.x)], 1u);
        const unsigned gen = old / nloc;
        if (old + 1u == (gen + 1u) * nloc) {
            __builtin_amdgcn_fence(__ATOMIC_RELEASE, "agent");
            asm volatile("s_waitcnt vmcnt(0)" ::: "memory");
            const unsigned og = xb_add(&bar[XB_TOP], 1u);
            const unsigned tg = og / nx;
            if (og + 1u == (tg + 1u) * nx) xb_add(&bar[XB_TOPGEN], 1u);
            else XB_SPIN(xb_ld(&bar[XB_TOPGEN]) == tg, bar);
            __builtin_amdgcn_fence(__ATOMIC_ACQUIRE, "agent");
            xb_add(&bar[XB_XGEN(b.x)], 1u);
            asm volatile("s_waitcnt vmcnt(0)" ::: "memory");
        } else {
            XB_SPIN(xb_ld(&bar[XB_XGEN(b.x)]) == gen, bar);
            __builtin_amdgcn_fence(__ATOMIC_ACQUIRE, "agent");
            asm volatile("s_waitcnt vmcnt(0)" ::: "memory");
        }
    }
    __syncthreads();
}

constexpr int NPH = 3 + 6 * DEPTH;
__global__ void __launch_bounds__(NTHR) mk_fwd(Args a) {
    extern __shared__ __attribute__((aligned(16))) unsigned char lds_raw[];
    LAS unsigned char* lds = (LAS unsigned char*)lds_raw;
    const int G = gridDim.x, bx = blockIdx.x;
    const int ph_lo = a.ph_lo, ph_hi = a.ph_hi;
    volatile LAS unsigned* bst = (volatile LAS unsigned*)(lds + 131072);
    if (threadIdx.x < 2) bst[threadIdx.x] = 0u;
    __syncthreads();
    XcdBarrier xbar; xbar.bar = (unsigned*)(a.ws + WS_BAR); xbar.x = 0; xbar.st = bst;
    if (!MK_PER_PHASE) xbar = xcd_barrier_post((unsigned*)(a.ws + WS_BAR), bst);

    for (int ph = ph_lo; ph < ph_hi;) {
        int tid = threadIdx.x; asm volatile("" : "+v"(tid));
        unsigned char* ws = a.ws; asm volatile("" : "+s"(ws));
        float* mods = (float*)(ws + WS_MODS);
        const float* tabA = (const float*)(ws + WS_TAB); const float* tabC = tabA + 2048;
        float* Xc = (float*)(ws + WS_XC);
        bf16* Hn = (bf16*)(ws + WS_HN); bf16* H1 = (bf16*)(ws + WS_H1);
        bf16* proj = (bf16*)(ws + WS_PROJ); bf16* cqb = (bf16*)(ws + WS_CQ); bf16* ckvb = (bf16*)(ws + WS_CKV);
        bf16* qm = (bf16*)(ws + WS_QM); bf16* kvm = (bf16*)(ws + WS_KVM); bf16* krr = (bf16*)(ws + WS_KRR); bf16* mix = (bf16*)(ws + WS_MIX);

        if (ph == 0) prologue(a, lds, tid);
        else if (ph == 1) phase1(a, lds, tid);
        else if (ph == NPH - 1) final_norm_phase(a.out, a.in[18], tid);
        else {
            const int l = (ph - 2) / 6, s = (ph - 2) - 6 * l; const bool last = (l == DEPTH - 1);
            unsigned char* wb = ws + WS_W + (size_t)l * WL_STRIDE;
            const float* mods_l = mods + (size_t)l * 9 * 6144;
            float* ssq_q = (float*)(ws + WS_SSQ) + (size_t)l * 2 * MT; float* ssq_kv = ssq_q + MT;
            float* ssqx1 = (float*)(ws + WS_SSQX) + (size_t)l * 2 * MT; float* ssqx2 = ssqx1 + MT;
            const float* xsrc = (l == 0) ? a.in[0] : a.out;
            const float* csrc = (l == 0) ? a.in[2] : Xc;
            float* part = (float*)(ws + WS_PART);
            if (s == 0) {
                if (l > 0) {
                    const float* mods_p = mods + (size_t)(l - 1) * 9 * 6144;
                    ctx_finish(part, 8, Xc, Xc, mods_p + 5 * 1024 + 8 * 6144, Hn, ssqx1, a.in[6] + l * DM, mods_l + 1 * 1024 + 8 * 6144, tid);
                    xcd_barrier(xbar);
                }
                pg8::Gemm g{Hn, (const bf16*)(wb + WL_IN), MT, 2048, DM, DM}; pg8::StaticOrder S; S.init(MT, 2048, G, bx);
                EpiInProj E{proj, cqb, ckvb, krr, ssq_q, ssq_kv, tabA, tabC, ssqx1, (const float*)(ws + WS_BIAS1) + (size_t)l * 9 * 2048};
                pg8::gemm_phase<EpiInProj, pg8::StaticOrder, true, true>(lds, g, S, E, tid);
            } else if (s == 1) {
                { int Kq = 256; asm volatile("" : "+s"(Kq)); pg8::Gemm g{cqb, (const bf16*)(wb + WL_UQ), MT, 512, Kq, Kq}; pg8::StaticOrder S; S.init(MT, 512, G, bx);
                  EpiUQ E{qm, ssq_q, tabC}; pg8::gemm_phase<EpiUQ, pg8::StaticOrder, true, true>(lds, g, S, E, tid); }
                { int Kk = 128; asm volatile("" : "+s"(Kk)); pg8::Gemm g{ckvb, (const bf16*)(wb + WL_UKV), MT, 512, Kk, Kk}; pg8::StaticOrder S; S.init(MT, 512, G, (bx + G / 2) % G);
                  EpiUKV E{kvm, ssq_kv}; pg8::gemm_phase<EpiUKV, pg8::StaticOrder, true, true>(lds, g, S, E, tid); }
            } else if (s == 2) {
                AttnP P{proj, qm, kvm, krr, mix, a.in[9] + l * 8, a.in[10] + l * 4 * 465};
                attn_phase(P, last, lds, tid);
            } else if (s == 3 || s == 5) {
                const bool outp = (s == 3);
                const int Kfull = outp ? DM : DFF;
                {
                    pg8::Gemm g{outp ? mix : H1, (const bf16*)(wb + (outp ? WL_OUT : WL_W2)), MX, DM, Kfull, Kfull}; pg8::StaticOrder S; S.init(MX, DM, G, bx);
                    const int ln = outp ? l : l + 1;
                    const float* mods_n = mods + (size_t)(ln < DEPTH ? ln : 0) * 9 * 6144;
                    EpiResid E{(outp ? xsrc : a.out), (outp ? csrc : Xc), a.out, Xc, mods_l + (outp ? 2 : 5) * 1024, Hn,
                               outp ? ssqx2 : ssqx1 + (size_t)2 * MT, (outp ? a.in[7] : a.in[6]) + (ln < DEPTH ? ln : 0) * DM, mods_n + (outp ? 4 : 1) * 1024, (outp || !last) ? 1 : 0};
                    pg8::gemm_phase<EpiResid, pg8::StaticOrder, true, true>(lds, g, S, E, tid);
                }
                if (!last) {
                    int Ks = Kfull / 8; asm volatile("" : "+s"(Ks));
                    pg8::Gemm g{outp ? mix : H1, (const bf16*)(wb + (outp ? WL_OUT : WL_W2)), MT, DM, Ks, Kfull}; SplitOrder S; S.init(G, (bx + G / 2) % G, 8, Ks);
                    EpiPartial E{part, Ks * 2};
                    pg8::gemm_phase<EpiPartial, SplitOrder, true, true>(lds, g, S, E, tid);
                }
            } else {
                const int Mr = last ? MX : MT;
                if (!last) {
                    ctx_finish(part, 8, csrc, Xc, mods_l + 2 * 1024 + 8 * 6144, Hn, ssqx2, a.in[7] + l * DM, mods_l + 4 * 1024 + 8 * 6144, tid);
                    xcd_barrier(xbar);
                }
                pg8::Gemm g{Hn, (const bf16*)(wb + WL_W1), Mr, DFF, DM, DM}; pg8::StaticOrder S; S.init(Mr, DFF, G, bx);
                EpiRelu2 E{H1, ssqx2, (const float*)(ws + WS_BIAS4) + (size_t)l * 9 * 4096}; pg8::gemm_phase<EpiRelu2, pg8::StaticOrder, true, true>(lds, g, S, E, tid);
            }
        }
        ++ph;
        if (ph < ph_hi) { if (ph == 1) cg::this_grid().sync(); else xcd_barrier(xbar); }
    }
}

extern "C" void kernel_launch(void* const* d_in, const int* in_sizes, int n_in, void* d_out, int out_size, void* d_ws, size_t ws_size, hipStream_t stream) {
    static int grid = 0;
    if (grid == 0) {
        if (n_in != 19 || ws_size < WS_END) { fprintf(stderr, "kernel_launch: unexpected inputs (n_in %d, ws %zu)\n", n_in, ws_size); grid = -1; return; }
        int dev = 0, cus = 0, per_cu = 0;
        hipGetDevice(&dev); hipDeviceGetAttribute(&cus, hipDeviceAttributeMultiprocessorCount, dev);
        hipFuncSetAttribute((const void*)mk_fwd, hipFuncAttributeMaxDynamicSharedMemorySize, LDS_BYTES);
        hipOccupancyMaxActiveBlocksPerMultiprocessor(&per_cu, (const void*)mk_fwd, NTHR, LDS_BYTES);
        if (per_cu < 1) { fprintf(stderr, "kernel_launch: occupancy query says %d\n", per_cu); per_cu = 1; }
        (void)hipGetLastError();
        grid = cus * 1;
    }
    if (grid < 0) return;
    Args a{};
    for (int i = 0; i < 19; ++i) a.in[i] = (const float*)d_in[i];
    a.out = (float*)d_out; a.ws = (unsigned char*)d_ws;
#if MK_PER_PHASE
    for (int ph = 0; ph < NPH; ++ph) { a.ph_lo = ph; a.ph_hi = ph + 1; hipLaunchKernelGGL(mk_fwd, dim3(grid), dim3(NTHR), LDS_BYTES, stream, a); }
#else
    a.ph_lo = 0; a.ph_hi = NPH;
    (void)hipMemsetAsync((unsigned char*)d_ws + WS_BAR, 0, 16384, stream);
    void* args[] = {&a};
    hipError_t e = hipLaunchCooperativeKernel((const void*)mk_fwd, dim3(grid), dim3(NTHR), args, LDS_BYTES, stream);
    if (e != hipSuccess) fprintf(stderr, "cooperative launch failed: %s (grid %d)\n", hipGetErrorString(e), grid);
#endif
}
```

```cpp
#include <hip/hip_runtime.h>
#include <hip/hip_cooperative_groups.h>
#include <cstdio>
#include <cstdint>
namespace cg = cooperative_groups;
namespace pg8 {
#define PG8_LAS __attribute__((address_space(3)))
typedef unsigned short bf16_t;
typedef short bf16x8 __attribute__((ext_vector_type(8)));
typedef float f32x4 __attribute__((ext_vector_type(4)));
typedef unsigned u32x4 __attribute__((ext_vector_type(4)));
constexpr int BM = 256, BK = 64, HALF = 128, HTB = HALF * BK * 2  , STAGE_BYTES = 8 * HTB, NXCD = 8, WGM = 8;

__host__ __device__ __forceinline__ int lds_byte(int r, int c) { const int st = (r >> 4) * 2 + (c >> 5), rr = r & 15, cc = c & 31, ob = rr * 64 + cc * 2; return st * 1024 + (ob ^ (((ob >> 9) & 1) << 5)); }
__host__ __device__ __forceinline__ void stage_rc(int b, int& R, int& C) { const int st = b / 1024, sb = b % 1024, swz = sb ^ (((sb >> 9) & 1) << 5); R = (st >> 1) * 16 + swz / 64; C = (st & 1) * 32 + (swz % 64) / 2; }
__host__ __device__ __forceinline__ int perm32(int rho) { const int n = rho >> 4, i = rho & 15; return 8 * (i >> 2) + 4 * n + (i & 3); }

struct Unit { int pm, pn, kb; };
struct Gemm { const bf16_t* A; const bf16_t* Bt; int M, N, K, ld; };

struct StaticOrder {
    int nM, nN, nwg, G, c;
    __host__ __device__ void init(int M, int N, int G_, int c_) { nM = M / BM; nN = N / BM; nwg = nM * nN; G = G_; c = c_; }
    __host__ __device__ bool next(int i, Unit& u) const {
        const long L = (long)i * G + c; if (L >= nwg) return false;
        int wgid = (int)L; { const int q = nwg / NXCD, r = nwg % NXCD, xcd = wgid % NXCD, off = wgid / NXCD; wgid = (xcd < r ? xcd * (q + 1) : r * (q + 1) + (xcd - r) * q) + off; }
        const int nig = WGM * nN, gid = wgid / nig, fm = gid * WGM, gsz = (nM - fm) < WGM ? (nM - fm) : WGM;
        u.pm = fm + ((wgid % nig) % gsz); u.pn = (wgid % nig) / gsz; u.kb = 0; return true;
    }
    __device__ __forceinline__ void a_ready(const Unit&) const {}
    __device__ __forceinline__ void done(const Unit&) const {}
};

__device__ __forceinline__ unsigned cvt_pk_bf16(float lo, float hi) { unsigned r; asm volatile("v_cvt_pk_bf16_f32 %0, %1, %2" : "=v"(r) : "v"(lo), "v"(hi)); return r; }
template <class Epi, class Sched, bool ALIGN_EPI = false, bool SP2 = false>
__device__ __forceinline__ void gemm_phase(PG8_LAS unsigned char* lds, const Gemm g, const Sched& S, const Epi& E, const int tid) {
    const int wid = __builtin_amdgcn_readfirstlane(tid >> 6), lane = tid & 63, wr = wid >> 2, wc = wid & 3, fr = lane & 15, fq = lane >> 4;
    const int K = g.ld, nt = g.K / BK;
    unsigned voffA[2], voffB[2];
#pragma unroll
    for (int i = 0; i < 2; ++i) { int R, C; stage_rc(tid * 16 + i * 8192, R, C); const int Rb = Epi::PERM ? ((R & ~31) + perm32(R & 31)) : R;
        voffA[i] = (unsigned)(R * K + C) * 2u; voffB[i] = (unsigned)(Rb * K + C) * 2u; }
    const size_t kstep = (size_t)(BK * 2);
    const size_t hstep = (size_t)HALF * K * 2;
    const size_t tstep = 2 * hstep;
    const unsigned ldsw = (unsigned)wid * 1024u;
    const int aoff = lds_byte(wr * 64 + fr, fq * 8), boff = lds_byte(wc * 32 + fr, fq * 8);
#define PG8_SA(b, h) (((b) * 2 + (h)) * HTB)
#define PG8_SB(b, h) ((4 + (b) * 2 + (h)) * HTB)
#define PG8_STAGE(bufoff, gbase, voff) do { _Pragma("unroll") for (int _i = 0; _i < 2; ++_i) \
        __builtin_amdgcn_global_load_lds((const unsigned*)((const char*)(gbase) + (voff)[_i]), (PG8_LAS unsigned*)(lds + (bufoff) + ldsw + _i * 8192), 16, 0, 0); } while (0)
#define PG8_LDA(dst, b, h) do { _Pragma("unroll") for (int m = 0; m < 4; ++m) _Pragma("unroll") for (int k = 0; k < 2; ++k) dst[m][k] = *(const PG8_LAS bf16x8*)(lds + PG8_SA(b, h) + aoff + m * 2048 + k * 1024); } while (0)
#define PG8_LDB(dst, b, h) do { _Pragma("unroll") for (int n = 0; n < 2; ++n) _Pragma("unroll") for (int k = 0; k < 2; ++k) dst[n][k] = *(const PG8_LAS bf16x8*)(lds + PG8_SB(b, h) + boff + n * 2048 + k * 1024); } while (0)
#define PG8_MMA(ai, bj, At, Bt) do { __builtin_amdgcn_s_setprio(1); _Pragma("unroll") for (int m = 0; m < 4; ++m) _Pragma("unroll") for (int n = 0; n < 2; ++n) _Pragma("unroll") for (int k = 0; k < 2; ++k) \
        acc[ai][bj][m][n] = __builtin_amdgcn_mfma_f32_16x16x32_bf16(Bt[n][k], At[m][k], acc[ai][bj][m][n], 0, 0, 0); __builtin_amdgcn_s_setprio(0); } while (0)
#define PG8_WAIT_V(n) asm volatile("s_waitcnt vmcnt(" #n ")" ::: "memory")
#define PG8_WAIT_L(n) asm volatile("s_waitcnt lgkmcnt(" #n ")" ::: "memory")
#define PG8_BAR __builtin_amdgcn_s_barrier()
#define PG8_SCHED __builtin_amdgcn_sched_barrier(0)
    Unit cur, nxt; int ui = 0;
    if (!S.next(0, cur)) return;
    f32x4 acc[2][2][4][2];
#pragma unroll
    for (int a = 0; a < 2; ++a)
#pragma unroll
        for (int b = 0; b < 2; ++b)
#pragma unroll
            for (int m = 0; m < 4; ++m)
#pragma unroll
                for (int n = 0; n < 2; ++n) acc[a][b][m][n] = (f32x4){0.f, 0.f, 0.f, 0.f};
    bf16x8 At[4][2], B0[2][2], B1[2][2];
    const char* cA = (const char*)g.A + (size_t)cur.pm * tstep + cur.kb; const char* cB = (const char*)g.Bt + (size_t)cur.pn * tstep + cur.kb;
    S.a_ready(cur);
    if constexpr (SP2) {
        PG8_STAGE(PG8_SB(0, 0), cB, voffB); PG8_STAGE(PG8_SB(0, 1), cB + hstep, voffB); PG8_STAGE(PG8_SA(0, 0), cA, voffA); PG8_STAGE(PG8_SA(0, 1), cA + hstep, voffA);
        if (wr == 1) PG8_BAR;
        PG8_WAIT_V(2); PG8_BAR;
        PG8_STAGE(PG8_SB(1, 0), cB + kstep, voffB); PG8_STAGE(PG8_SA(1, 0), cA + kstep, voffA); PG8_STAGE(PG8_SB(1, 1), cB + hstep + kstep, voffB);
        PG8_WAIT_V(6); PG8_BAR;
    } else {
        PG8_STAGE(PG8_SB(0, 0), cB, voffB); PG8_STAGE(PG8_SA(0, 0), cA, voffA); PG8_STAGE(PG8_SB(0, 1), cB + hstep, voffB); PG8_STAGE(PG8_SA(0, 1), cA + hstep, voffA);
        if (wr == 1) PG8_BAR;
        PG8_WAIT_V(4); PG8_BAR;
        PG8_STAGE(PG8_SB(1, 0), cB + kstep, voffB); PG8_STAGE(PG8_SA(1, 0), cA + kstep, voffA); PG8_STAGE(PG8_SB(1, 1), cB + hstep + kstep, voffB);
        PG8_WAIT_V(6); PG8_BAR;
    }
    for (;;) {
        const bool has_next = S.next(ui + 1, nxt);
        const char* nA = has_next ? (const char*)g.A + (size_t)nxt.pm * tstep + nxt.kb : cA; const char* nB = has_next ? (const char*)g.Bt + (size_t)nxt.pn * tstep + nxt.kb : cB;
        for (int t = 0; t < nt; t += 2) {
            const bool last = (t == nt - 2);
            const char* a1 = cA + (size_t)(t + 1) * kstep;
            const char* a2 = last ? nA : cA + (size_t)(t + 2) * kstep; const char* b2 = last ? nB : cB + (size_t)(t + 2) * kstep;
            const char* a3 = a2 + kstep; const char* b3 = b2 + kstep;
            if (last && has_next) S.a_ready(nxt);
            if constexpr (SP2) {
            PG8_LDB(B0, 0, 0); PG8_LDB(B1, 0, 1); PG8_SCHED; PG8_LDA(At, 0, 0); PG8_STAGE(PG8_SA(1, 1), a1 + hstep, voffA);
            PG8_WAIT_V(8); PG8_WAIT_L(0); PG8_BAR; PG8_MMA(0, 0, At, B0); PG8_MMA(0, 1, At, B1); PG8_BAR; PG8_SCHED;
            PG8_LDA(At, 0, 1); PG8_STAGE(PG8_SB(0, 0), b2, voffB); PG8_STAGE(PG8_SB(0, 1), b2 + hstep, voffB); PG8_STAGE(PG8_SA(0, 0), a2, voffA);
            PG8_WAIT_V(8); PG8_WAIT_L(0); PG8_BAR; PG8_MMA(1, 0, At, B0); PG8_MMA(1, 1, At, B1); PG8_BAR; PG8_SCHED;
            PG8_LDB(B0, 1, 0); PG8_LDB(B1, 1, 1); PG8_SCHED; PG8_LDA(At, 1, 0); PG8_STAGE(PG8_SA(0, 1), a2 + hstep, voffA);
            PG8_WAIT_V(8); PG8_WAIT_L(0); PG8_BAR; PG8_MMA(0, 0, At, B0); PG8_MMA(0, 1, At, B1); PG8_BAR; PG8_SCHED;
            PG8_LDA(At, 1, 1); PG8_STAGE(PG8_SB(1, 0), b3, voffB); PG8_STAGE(PG8_SB(1, 1), b3 + hstep, voffB); PG8_STAGE(PG8_SA(1, 0), a3, voffA);
            PG8_WAIT_V(8); PG8_WAIT_L(0); PG8_BAR; PG8_MMA(1, 0, At, B0); PG8_MMA(1, 1, At, B1); PG8_BAR; PG8_SCHED;
            } else {
            PG8_LDB(B0, 0, 0); PG8_SCHED; PG8_LDA(At, 0, 0); PG8_STAGE(PG8_SA(1, 1), a1 + hstep, voffA);
            PG8_WAIT_L(8); PG8_BAR; PG8_WAIT_L(0); PG8_MMA(0, 0, At, B0); PG8_BAR; PG8_SCHED;
            PG8_LDB(B1, 0, 1); PG8_STAGE(PG8_SB(0, 0), b2, voffB);
            PG8_BAR; PG8_WAIT_L(0); PG8_MMA(0, 1, At, B1); PG8_BAR;
            PG8_LDA(At, 0, 1); PG8_STAGE(PG8_SA(0, 0), a2, voffA);
            PG8_BAR; PG8_WAIT_L(0); PG8_MMA(1, 0, At, B0); PG8_BAR; PG8_SCHED;
            PG8_STAGE(PG8_SB(0, 1), b2 + hstep, voffB);
            PG8_WAIT_V(6); PG8_BAR; PG8_MMA(1, 1, At, B1); PG8_BAR;
            PG8_LDB(B0, 1, 0); PG8_SCHED; PG8_LDA(At, 1, 0); PG8_STAGE(PG8_SA(0, 1), a2 + hstep, voffA);
            PG8_WAIT_L(8); PG8_BAR; PG8_WAIT_L(0); PG8_MMA(0, 0, At, B0); PG8_BAR; PG8_SCHED;
            PG8_LDB(B1, 1, 1); PG8_STAGE(PG8_SB(1, 0), b3, voffB);
            PG8_BAR; PG8_WAIT_L(0); PG8_MMA(0, 1, At, B1); PG8_BAR;
            PG8_LDA(At, 1, 1); PG8_STAGE(PG8_SA(1, 0), a3, voffA);
            PG8_BAR; PG8_WAIT_L(0); PG8_MMA(1, 0, At, B0); PG8_BAR; PG8_SCHED;
            PG8_STAGE(PG8_SB(1, 1), b3 + hstep, voffB);
            PG8_WAIT_V(6); PG8_BAR; PG8_MMA(1, 1, At, B1); PG8_BAR;
            }
        }
        if constexpr (ALIGN_EPI) { if (wr == 0) PG8_BAR; }
        if constexpr (!Epi::AFTER_DRAIN) { E(acc, cur, wr, wc, fr, fq); S.done(cur); }
        if (!has_next) break;
#pragma unroll
        for (int a = 0; a < 2; ++a)
#pragma unroll
            for (int b = 0; b < 2; ++b)
#pragma unroll
                for (int m = 0; m < 4; ++m)
#pragma unroll
                    for (int n = 0; n < 2; ++n) acc[a][b][m][n] = (f32x4){0.f, 0.f, 0.f, 0.f};
        cur = nxt; cA = nA; cB = nB; ++ui;
        if constexpr (ALIGN_EPI) { if (wr == 1) PG8_BAR; }
    }
    PG8_WAIT_V(0);
    if constexpr (!ALIGN_EPI) { if (wr == 0) PG8_BAR; }
    PG8_BAR;
    if constexpr (Epi::AFTER_DRAIN) { E.fused(acc, cur, wr, wc, fr, fq, lds, wid, lane); S.done(cur); }
#undef PG8_SA
#undef PG8_SB
#undef PG8_STAGE
#undef PG8_LDA
#undef PG8_LDB
#undef PG8_MMA
#undef PG8_WAIT_V
#undef PG8_WAIT_L
#undef PG8_BAR
#undef PG8_SCHED
}
}

#define LAS __attribute__((address_space(3)))
#define DI __device__ __forceinline__
#define GAS __attribute__((address_space(1)))
typedef unsigned short bf16;
typedef float f32x4 __attribute__((ext_vector_type(4)));
typedef float f32x16 __attribute__((ext_vector_type(16)));
typedef short bf16x8 __attribute__((ext_vector_type(8)));
typedef short s16x4 __attribute__((ext_vector_type(4)));
typedef unsigned u32x2 __attribute__((ext_vector_type(2)));
typedef unsigned u32x4 __attribute__((ext_vector_type(4)));
typedef float f32x2_t __attribute__((ext_vector_type(2)));
typedef __bf16 bf16x2_t __attribute__((ext_vector_type(2)));

#ifndef MK_MASK
#define MK_MASK 0x1ff
#endif
#define PH_EN(k) (((MK_MASK) >> (k)) & 1)
#ifndef MK_PER_PHASE
#define MK_PER_PHASE 0
#endif

constexpr int DM = 1024, NBATCH = 8, SEQ = 4096, DEPTH = 4, CTXL = 256, DFF = 4096;
constexpr int MX = NBATCH * SEQ, MC = NBATCH * CTXL, MT = MX + MC;
constexpr int INW = 1952, PJS = 1536;
constexpr float LOG2E = 1.4426950408889634f;
constexpr float C2A = 0.125f * LOG2E;
constexpr float C2C = 0.10206207261596575f * LOG2E;
constexpr float EPSN = 1e-6f;
constexpr int NTHR = 512;

constexpr size_t MiB = (size_t)1 << 20;
constexpr size_t WS_TAB = 0;
constexpr size_t WS_BAR = 65536;
constexpr size_t WS_MODS = 1 * MiB;
constexpr size_t WS_SSQ = 2 * MiB;
constexpr size_t WS_XC = 4 * MiB;
constexpr size_t WS_W = 12 * MiB;
constexpr size_t WL_IN = 0, WL_OUT = 4 * MiB, WL_W1 = 6 * MiB, WL_W2 = 14 * MiB, WL_UQ = 22 * MiB, WL_UKV = 22 * MiB + 256 * 1024, WL_STRIDE = 22 * MiB + 512 * 1024;
constexpr size_t WS_HN = 102 * MiB;
constexpr size_t WS_H1 = 170 * MiB;
constexpr size_t WS_PROJ = 170 * MiB;
constexpr size_t WS_CQ = 272 * MiB;
constexpr size_t WS_CKV = 289 * MiB;
constexpr size_t WS_QM = 298 * MiB;
constexpr size_t WS_KVM = 324 * MiB;
constexpr size_t WS_KRR = 358 * MiB;
constexpr size_t WS_MIX = 362 * MiB;
constexpr size_t WS_SSQX = 442 * MiB;
constexpr size_t WS_BIAS1 = 444 * MiB;
constexpr size_t WS_BIAS4 = 445 * MiB;
constexpr size_t WS_PART = 446 * MiB;
constexpr size_t WS_END = 510 * MiB;
constexpr int LDS_BYTES = 131072 + 256;

DI unsigned cvtpk(float lo, float hi) { f32x2_t v = {lo, hi}; bf16x2_t b = __builtin_convertvector(v, bf16x2_t); return __builtin_bit_cast(unsigned, b); }
DI void st4bf(bf16* p, f32x4 v) { u32x2 w; w.x = cvtpk(v[0], v[1]); w.y = cvtpk(v[2], v[3]); *(GAS u32x2*)p = w; }
DI float wave_sum(float v) {
#pragma unroll
    for (int o = 1; o < 64; o <<= 1) v += __shfl_xor(v, o);
    return v;
}
DI float fexp2(float x) { return __builtin_amdgcn_exp2f(x); }
DI float max3f(float a, float b, float c) { float r; asm("v_max3_f32 %0, %1, %2, %3" : "=v"(r) : "v"(a), "v"(b), "v"(c)); return r; }
#define LDS_WAIT() asm volatile("s_waitcnt lgkmcnt(0)" ::: "memory")

DI f32x4 rope8(f32x4 v, const float* tab  , int fq) {
    const int i0 = 4 * (fq & 1);
    const f32x4 cs = *(const f32x4*)(tab + i0), sn = *(const f32x4*)(tab + 8 + i0);
    f32x4 o;
#pragma unroll
    for (int j = 0; j < 4; ++j) { const float pr = __shfl_xor(v[j], 32); o[j] = (fq < 2) ? v[j] * cs[j] - pr * sn[j] : pr * sn[j] + v[j] * cs[j]; }
    return o;
}

struct EpiInProj {
    static constexpr bool PERM = false, AFTER_DRAIN = false;
    bf16 *proj, *cqb, *ckvb, *krr; float *ssq_q, *ssq_kv; const float *tabA, *tabC; const float *ssqx, *bias;
    DI void operator()(const f32x4 (&acc0)[2][2][4][2], const pg8::Unit& u, int wr, int wc, int fr, int fq) const {
        const int pn = u.pn; const bool isx = u.pm < 128; const int mi = isx ? (u.pm >> 4) : 8;
        f32x4 bv[2][2];
#pragma unroll
        for (int bj = 0; bj < 2; ++bj)
#pragma unroll
            for (int n = 0; n < 2; ++n) bv[bj][n] = *(const GAS f32x4*)(bias + mi * 2048 + pn * 256 + bj * 128 + wc * 32 + n * 16 + 4 * fq);
        float rsx[2][4];
#pragma unroll
        for (int ai = 0; ai < 2; ++ai)
#pragma unroll
            for (int m = 0; m < 4; ++m) { int row = u.pm * 256 + ai * 128 + wr * 64 + m * 16 + fr; asm volatile("" : "+v"(row)); rsx[ai][m] = ((const GAS float*)ssqx)[row]; }
#pragma unroll
        for (int ai = 0; ai < 2; ++ai)
#pragma unroll
            for (int m = 0; m < 4; ++m) rsx[ai][m] = rsqrtf(rsx[ai][m] * (1.0f / 1024.0f) + EPSN);
        const bool anyrope = isx && pn <= 2;
#pragma unroll
        for (int ai = 0; ai < 2; ++ai)
#pragma unroll
        for (int mh = 0; mh < 2; ++mh) {
            f32x4 cs[4], sn[4];
#pragma unroll
            for (int m = 2 * mh; m < 2 * mh + 2; ++m) { cs[m] = (f32x4){1.f, 1.f, 1.f, 1.f}; sn[m] = (f32x4){0.f, 0.f, 0.f, 0.f}; }
            if (anyrope) {
#pragma unroll
                for (int m = 2 * mh; m < 2 * mh + 2; ++m) { int row = u.pm * 256 + ai * 128 + wr * 64 + m * 16 + fr; asm volatile("" : "+v"(row)); const int tok = row & 4095; const int pos = (wc & 1) ? (tok & 63) : (tok >> 6);
                    cs[m] = *(const GAS f32x4*)(tabA + pos * 32 + 4 * fq); sn[m] = *(const GAS f32x4*)(tabA + pos * 32 + 16 + 4 * fq); }
            }
#pragma unroll
            for (int m = 2 * mh; m < 2 * mh + 2; ++m) {
                int row = u.pm * 256 + ai * 128 + wr * 64 + m * 16 + fr; asm volatile("" : "+v"(row));
                const int tok = row & 4095, prow = tok >> 6, pcol = tok & 63;
                f32x4 acc[2][2];
#pragma unroll
                for (int bj = 0; bj < 2; ++bj)
#pragma unroll
                    for (int n = 0; n < 2; ++n) acc[bj][n] = acc0[ai][bj][m][n] * rsx[ai][m] + bv[bj][n];
                if (pn < 6) {
#pragma unroll
                    for (int bj = 0; bj < 2; ++bj) {
                        f32x4 v0 = acc[bj][0], v1 = acc[bj][1];
                        if (anyrope && (pn < 2 || bj == 0)) { const f32x4 a = v0 * cs[m] - v1 * sn[m], b = v0 * sn[m] + v1 * cs[m]; v0 = a; v1 = b; }
                        if (pn < 2 || pn == 3) { v0 *= C2A; v1 *= C2A; }
                        bf16* p = proj + (size_t)row * PJS + pn * 256 + bj * 128 + wc * 32 + 4 * fq;
                        st4bf(p, v0); st4bf(p + 16, v1);
                    }
                } else if (pn == 6) {
                    float s = 0.f;
#pragma unroll
                    for (int bj = 0; bj < 2; ++bj) {
                        const f32x4 v0 = acc[bj][0], v1 = acc[bj][1];
                        s += (v0[0] * v0[0] + v0[1] * v0[1]) + (v0[2] * v0[2] + v0[3] * v0[3]) + (v1[0] * v1[0] + v1[1] * v1[1]) + (v1[2] * v1[2] + v1[3] * v1[3]);
                        bf16* p = cqb + (size_t)row * 256 + bj * 128 + wc * 32 + 4 * fq;
                        st4bf(p, v0); st4bf(p + 16, v1);
                    }
                    s += __shfl_xor(s, 16); s += __shfl_xor(s, 32);
                    if (fq == 0) atomicAdd(ssq_q + row, s);
                } else {
                    {
                        const f32x4 v0 = acc[0][0], v1 = acc[0][1];
                        float s = (v0[0] * v0[0] + v0[1] * v0[1]) + (v0[2] * v0[2] + v0[3] * v0[3]) + (v1[0] * v1[0] + v1[1] * v1[1]) + (v1[2] * v1[2] + v1[3] * v1[3]);
                        bf16* p = ckvb + (size_t)row * 128 + wc * 32 + 4 * fq;
                        st4bf(p, v0); st4bf(p + 16, v1);
                        s += __shfl_xor(s, 16); s += __shfl_xor(s, 32);
                        if (fq == 0) atomicAdd(ssq_kv + row, s);
                    }
                    if (wc == 0) {
                        f32x4 v0 = acc[1][0], v1 = acc[1][1];
                        if (isx) { v0 = rope8(v0, tabC + prow * 16, fq); v1 = rope8(v1, tabC + pcol * 16, fq); }
                        bf16* p = krr + (size_t)row * 32 + 4 * fq;
                        st4bf(p, v0); st4bf(p + 16, v1);
                    }
                }
            }
        }
    }
};

struct EpiUQ {
    static constexpr bool PERM = false, AFTER_DRAIN = false;
    bf16* qm; const float* ssq_q; const float* tabC;
    DI void operator()(const f32x4 (&acc)[2][2][4][2], const pg8::Unit& u, int wr, int wc, int fr, int fq) const {
        const int pn = u.pn; const bool isx = u.pm < 128;
        float rsq[2][4];
#pragma unroll
        for (int ai = 0; ai < 2; ++ai)
#pragma unroll
            for (int m = 0; m < 4; ++m) { int row = u.pm * 256 + ai * 128 + wr * 64 + m * 16 + fr; asm volatile("" : "+v"(row)); rsq[ai][m] = ((const GAS float*)ssq_q)[row]; }
#pragma unroll
        for (int ai = 0; ai < 2; ++ai)
#pragma unroll
            for (int m = 0; m < 4; ++m) {
                int row = u.pm * 256 + ai * 128 + wr * 64 + m * 16 + fr; asm volatile("" : "+v"(row));
                const int tok = row & 4095, prow = tok >> 6, pcol = tok & 63;
                const float rs = rsqrtf(rsq[ai][m] * (1.0f / 256.0f) + EPSN) * C2C;
#pragma unroll
                for (int bj = 0; bj < 2; ++bj)
#pragma unroll
                    for (int n = 0; n < 2; ++n) {
                        const int col0 = pn * 256 + bj * 128 + wc * 32 + n * 16;
                        if (col0 < 384) {
                            f32x4 v = acc[ai][bj][m][n] * rs;
                            const int g6 = (col0 >> 4) % 6;
                            if (isx && g6 >= 4) v = rope8(v, tabC + (g6 == 4 ? prow : pcol) * 16, fq);
                            st4bf(qm + (size_t)row * 384 + col0 + 4 * fq, v);
                        }
                    }
            }
    }
};

struct EpiUKV {
    static constexpr bool PERM = false, AFTER_DRAIN = false;
    bf16* kvm; const float* ssq_kv;
    DI void operator()(const f32x4 (&acc)[2][2][4][2], const pg8::Unit& u, int wr, int wc, int fr, int fq) const {
        float rsq[2][4];
#pragma unroll
        for (int ai = 0; ai < 2; ++ai)
#pragma unroll
            for (int m = 0; m < 4; ++m) { int row = u.pm * 256 + ai * 128 + wr * 64 + m * 16 + fr; asm volatile("" : "+v"(row)); rsq[ai][m] = ((const GAS float*)ssq_kv)[row]; }
#pragma unroll
        for (int ai = 0; ai < 2; ++ai)
#pragma unroll
            for (int m = 0; m < 4; ++m) {
                int row = u.pm * 256 + ai * 128 + wr * 64 + m * 16 + fr; asm volatile("" : "+v"(row));
                const float rs = rsqrtf(rsq[ai][m] * (1.0f / 128.0f) + EPSN);
#pragma unroll
                for (int bj = 0; bj < 2; ++bj)
#pragma unroll
                    for (int n = 0; n < 2; ++n) {
                        const int col0 = u.pn * 256 + bj * 128 + wc * 32 + n * 16;
                        st4bf(kvm + (size_t)row * 512 + col0 + 4 * fq, acc[ai][bj][m][n] * rs);
                    }
            }
    }
};

struct EpiRelu2 {
    static constexpr bool PERM = true, AFTER_DRAIN = false;
    bf16* H; const float *ssqx, *bias;
    DI void operator()(const f32x4 (&acc)[2][2][4][2], const pg8::Unit& u, int wr, int wc, int fr, int fq) const {
        const int col0 = u.pn * 256 + wc * 32 + 8 * fq; const int mi = (u.pm < 128) ? (u.pm >> 4) : 8;
        f32x4 bv[2][2];
#pragma unroll
        for (int bj = 0; bj < 2; ++bj)
#pragma unroll
            for (int n = 0; n < 2; ++n) bv[bj][n] = *(const GAS f32x4*)(bias + mi * 4096 + col0 + bj * 128 + 4 * n);
        float rsx[2][4];
#pragma unroll
        for (int ai = 0; ai < 2; ++ai)
#pragma unroll
            for (int m = 0; m < 4; ++m) { int row = u.pm * 256 + ai * 128 + wr * 64 + m * 16 + fr; asm volatile("" : "+v"(row)); rsx[ai][m] = ((const GAS float*)ssqx)[row]; }
#pragma unroll
        for (int ai = 0; ai < 2; ++ai)
#pragma unroll
            for (int m = 0; m < 4; ++m) {
                int row = u.pm * 256 + ai * 128 + wr * 64 + m * 16 + fr; asm volatile("" : "+v"(row));
                const float rs = rsqrtf(rsx[ai][m] * (1.0f / 1024.0f) + EPSN);
                bf16* rowp = H + (size_t)row * DFF + col0;
#pragma unroll
                for (int bj = 0; bj < 2; ++bj) {
                    f32x4 v0 = acc[ai][bj][m][0] * rs + bv[bj][0], v1 = acc[ai][bj][m][1] * rs + bv[bj][1];
#pragma unroll
                    for (int j = 0; j < 4; ++j) { const float a = fmaxf(v0[j], 0.f), b = fmaxf(v1[j], 0.f); v0[j] = a * a; v1[j] = b * b; }
                    u32x4 w; w.x = cvtpk(v0[0], v0[1]); w.y = cvtpk(v0[2], v0[3]); w.z = cvtpk(v1[0], v1[1]); w.w = cvtpk(v1[2], v1[3]);
                    *(GAS u32x4*)(rowp + bj * 128) = w;
                }
            }
    }
};

struct EpiResid {
    static constexpr bool PERM = false, AFTER_DRAIN = false;
    const float *srcx, *srcc; float *dstx, *dstc; const float* gate; bf16* xg; float* ssq_out; const float *gn, *scn; int donorm;
    DI void operator()(const f32x4 (&acc)[2][2][4][2], const pg8::Unit& u, int wr, int wc, int fr, int fq) const {
        const bool isx = u.pm < 128; const int mi = isx ? (u.pm >> 4) : 8;
        const int col0 = u.pn * 256 + wc * 32 + 4 * fq;
        f32x4 gv[2][2], gp[2][2];
#pragma unroll
        for (int bj = 0; bj < 2; ++bj)
#pragma unroll
            for (int n = 0; n < 2; ++n) { const int c = col0 + bj * 128 + n * 16; gv[bj][n] = *(const GAS f32x4*)(gate + mi * 6144 + c);
                gp[bj][n] = donorm ? *(const GAS f32x4*)(gn + c) * (*(const GAS f32x4*)(scn + mi * 6144 + c) + 1.0f) : (f32x4){0.f, 0.f, 0.f, 0.f}; }
#pragma unroll
        for (int ai = 0; ai < 2; ++ai)
#pragma unroll
        for (int mh = 0; mh < 2; ++mh) {
            f32x4 xs[4][2][2];
#pragma unroll
            for (int m = 2 * mh; m < 2 * mh + 2; ++m) {
                int row = u.pm * 256 + ai * 128 + wr * 64 + m * 16 + fr; asm volatile("" : "+v"(row));
                const float* s = isx ? srcx + (size_t)row * DM : srcc + (size_t)(row - MX) * DM;
#pragma unroll
                for (int bj = 0; bj < 2; ++bj)
#pragma unroll
                    for (int n = 0; n < 2; ++n) xs[m][bj][n] = *(const GAS f32x4*)(s + col0 + bj * 128 + n * 16);
            }
#pragma unroll
            for (int m = 2 * mh; m < 2 * mh + 2; ++m) {
                int row = u.pm * 256 + ai * 128 + wr * 64 + m * 16 + fr; asm volatile("" : "+v"(row));
                float* d = isx ? dstx + (size_t)row * DM : dstc + (size_t)(row - MX) * DM;
                float ss = 0.f;
#pragma unroll
                for (int bj = 0; bj < 2; ++bj)
#pragma unroll
                    for (int n = 0; n < 2; ++n) { const int off = col0 + bj * 128 + n * 16;
                        const f32x4 xn = xs[m][bj][n] + gv[bj][n] * acc[ai][bj][m][n];
                        *(GAS f32x4*)(d + off) = xn;
                        if (donorm) { ss += (xn[0] * xn[0] + xn[1] * xn[1]) + (xn[2] * xn[2] + xn[3] * xn[3]); st4bf(xg + (size_t)row * DM + off, xn * gp[bj][n]); } }
                if (donorm) { ss += __shfl_xor(ss, 16); ss += __shfl_xor(ss, 32); if (fq == 0) atomicAdd(ssq_out + row, ss); }
            }
        }
    }
};

struct SplitOrder {
    int G, c, NS, ksub_bytes;
    DI void init(int G_, int c_, int NS_, int Ksub) { G = G_; c = c_; NS = NS_; ksub_bytes = Ksub * 2; }
    DI bool next(int i, pg8::Unit& u) const { const int idx = i * G + c; if (idx >= 32 * NS) return false; const int ks = idx % NS, tile = idx / NS; u.pn = tile & 3; u.pm = 128 + (tile >> 2); u.kb = ks * ksub_bytes; return true; }
    DI void a_ready(const pg8::Unit&) const {}
    DI void done(const pg8::Unit&) const {}
};
struct EpiPartial {
    static constexpr bool PERM = false, AFTER_DRAIN = false;
    float* part; int ksub_bytes;
    DI void operator()(const f32x4 (&acc)[2][2][4][2], const pg8::Unit& u, int wr, int wc, int fr, int fq) const {
        const int ks = u.kb / ksub_bytes; const int col0 = u.pn * 256 + wc * 32 + 4 * fq;
        float* base = part + (size_t)ks * MC * DM;
#pragma unroll
        for (int ai = 0; ai < 2; ++ai)
#pragma unroll
            for (int m = 0; m < 4; ++m) {
                int row = (u.pm - 128) * 256 + ai * 128 + wr * 64 + m * 16 + fr;
                asm volatile("" : "+v"(row) :: "memory");
                float* rowp = base + (size_t)row * DM + col0;
#pragma unroll
                for (int bj = 0; bj < 2; ++bj)
#pragma unroll
                    for (int n = 0; n < 2; ++n) *(GAS f32x4*)(rowp + bj * 128 + n * 16) = acc[ai][bj][m][n];
            }
    }
};
DI void ctx_finish(const float* part, int NS, const float* src, float* dst, const float* gate8, bf16* xg, float* ssq_out, const float* gn, const float* scn8, const int tid) {
    const int lane = tid & 63, gw = blockIdx.x * 8 + (tid >> 6), NGW = gridDim.x * 8;
    for (int row = gw; row < MC; row += NGW) {
        float s = 0.f;
#pragma unroll
        for (int j = 0; j < 4; ++j) {
            const int col = 256 * j + 4 * lane;
            f32x4 a = {0.f, 0.f, 0.f, 0.f};
            for (int ks = 0; ks < NS; ++ks) a += *(const GAS f32x4*)(part + ((size_t)ks * MC + row) * DM + col);
            const f32x4 xn = *(const GAS f32x4*)(src + (size_t)row * DM + col) + *(const GAS f32x4*)(gate8 + col) * a;
            *(GAS f32x4*)(dst + (size_t)row * DM + col) = xn;
            s += (xn[0] * xn[0] + xn[1] * xn[1]) + (xn[2] * xn[2] + xn[3] * xn[3]);
            st4bf(xg + (size_t)(MX + row) * DM + col, xn * (*(const GAS f32x4*)(gn + col) * (*(const GAS f32x4*)(scn8 + col) + 1.0f)));
        }
        s = wave_sum(s);
        if (lane == 0) ssq_out[MX + row] = s;
    }
}

DI void transpose_item(const float* W, int K, int N, bf16* WT, const float* kscale, LAS float* scr, int item, int lane) {
    const int nblk = N / 32, kb = item / nblk, nb = item % nblk, k0 = 64 * kb, n0 = 32 * nb;
#pragma unroll 16
    for (int i = 0; i < 32; ++i) { const int kk = 2 * i + (lane >> 5); float w = W[(size_t)(k0 + kk) * N + n0 + (lane & 31)]; if (kscale) w *= kscale[k0 + kk]; scr[kk * 33 + (lane & 31)] = w; }
    LDS_WAIT();
    const int c = lane & 7;
#pragma unroll
    for (int j = 0; j < 4; ++j) { const int n = (lane >> 3) + 8 * j; const LAS float* s = scr + (8 * c) * 33 + n;
        u32x4 o; o.x = cvtpk(s[0 * 33], s[1 * 33]); o.y = cvtpk(s[2 * 33], s[3 * 33]); o.z = cvtpk(s[4 * 33], s[5 * 33]); o.w = cvtpk(s[6 * 33], s[7 * 33]);
        *(u32x4*)(WT + (size_t)(n0 + n) * K + k0 + 8 * c) = o; }
    LDS_WAIT();
}

DI void gemv9_item(const float* W, int ldw, int nvalid, int n0, const LAS float* sl, LAS float* red, const float* addb, float* out, int ldo, const int tid) {
    const int col = tid & 31, kg = tid >> 5, n = n0 + col;
    float acc[9];
#pragma unroll
    for (int mi = 0; mi < 9; ++mi) acc[mi] = 0.f;
    if (n < nvalid) {
        const float* w = W + (size_t)(kg * 64) * ldw + n;
#pragma unroll 16
        for (int k = 0; k < 64; ++k) { const float wv = w[(size_t)k * ldw];
#pragma unroll
            for (int mi = 0; mi < 9; ++mi) acc[mi] += sl[mi * 1024 + kg * 64 + k] * wv; }
    }
#pragma unroll
    for (int mi = 0; mi < 9; ++mi) red[(kg * 9 + mi) * 32 + col] = acc[mi];
    __syncthreads();
    if (tid < 288) { const int mi = tid >> 5, cq = tid & 31; float sacc = (addb && n0 + cq < nvalid) ? addb[n0 + cq] : 0.f;
#pragma unroll
        for (int g = 0; g < 16; ++g) sacc += red[(g * 9 + mi) * 32 + cq];
        out[(size_t)mi * ldo + n0 + cq] = sacc; }
    __syncthreads();
}

struct Args { const float* in[19]; float* out; unsigned char* ws; int ph_lo, ph_hi; };

DI void prologue(const Args& a, LAS unsigned char* lds, const int tid) {
    const int lane = tid & 63, wave = __builtin_amdgcn_readfirstlane(tid >> 6);
    int G = gridDim.x; asm volatile("" : "+s"(G));
    const int bx = blockIdx.x;
    unsigned char* ws = a.ws;
    {
        LAS float* sl = (LAS float*)lds;
        LAS float* red = (LAS float*)(lds + 36864);
        const float* c = a.in[1]; const float* cc = a.in[3]; const float* w_ada = a.in[4]; const float* b_ada = a.in[5];
        float* mods = (float*)(ws + WS_MODS);
        for (int idx = tid; idx < 9 * 1024; idx += NTHR) { const int mi = idx >> 10, k = idx & 1023; const float v = mi < 8 ? c[mi * 1024 + k] : cc[k]; sl[idx] = v / (1.0f + expf(-v)); }
        __syncthreads();
        for (int item = bx; item < DEPTH * 192; item += G) {
            const int l = item / 192, n0 = (item % 192) * 32;
            gemv9_item(w_ada + (size_t)l * 1024 * 6144, 6144, 6144, n0, sl, red, b_ada + l * 6144, mods + (size_t)l * 9 * 6144, 6144, tid);
        }
    }
    {
        const int gid = bx * NTHR + tid, NG = G * NTHR;
        float* tabA = (float*)(ws + WS_TAB); float* tabC = tabA + 2048;
        if (gid < 1024) { const int pos = gid >> 4, i = gid & 15; const float fr = exp2f(-(float)i * (1.0f / 16.0f) * 13.287712379549449f); const float rev = ((float)pos * fr) * 0.15915494309189535f;
            tabA[pos * 32 + i] = __builtin_amdgcn_cosf(rev); tabA[pos * 32 + 16 + i] = __builtin_amdgcn_sinf(rev); }
        else if (gid < 1536) { const int g = gid - 1024, pos = g >> 3, i = g & 7; const float fr = exp2f(-(float)i * (1.0f / 8.0f) * 13.287712379549449f); const float rev = ((float)pos * fr) * 0.15915494309189535f;
            tabC[pos * 16 + i] = __builtin_amdgcn_cosf(rev); tabC[pos * 16 + 8 + i] = __builtin_amdgcn_sinf(rev); }
        float* ssq = (float*)(ws + WS_SSQ);
        for (int i = gid; i < DEPTH * 2 * MT; i += NG) ssq[i] = 0.f;
        float* ssqx = (float*)(ws + WS_SSQX);
        for (int i = gid; i < DEPTH * 2 * MT; i += NG) ssqx[i] = 0.f;
        const u32x4 z = {0u, 0u, 0u, 0u};
        for (int i = gid; i < DEPTH * 12288; i += NG) { const int l = i / 12288, r = i % 12288; ((u32x4*)(ws + WS_W + l * WL_STRIDE + WL_IN + (size_t)INW * 1024 * 2))[r] = z; }
        for (int i = gid; i < DEPTH * 4096; i += NG) { const int l = i / 4096, r = i % 4096; ((u32x4*)(ws + WS_W + l * WL_STRIDE + WL_UQ + (size_t)384 * 256 * 2))[r] = z; }
    }
    {
        LAS float* scr = (LAS float*)(lds + wave * 16384);
        const int gw = bx * 8 + wave, NGW = G * 8;
        constexpr int I_IN = 16 * 61, I_OUT = 16 * 32, I_W1 = 16 * 128, I_W2 = 64 * 32, I_UQ = 4 * 12, I_UKV = 2 * 16, I_L = I_IN + I_OUT + I_W1 + I_W2 + I_UQ + I_UKV;
        for (int it = gw; it < DEPTH * I_L; it += NGW) {
            const int l = it / I_L; int r = it % I_L; unsigned char* wb = ws + WS_W + l * WL_STRIDE;
            if (r < I_IN) { transpose_item(a.in[8] + (size_t)l * 1024 * INW, 1024, INW, (bf16*)(wb + WL_IN), nullptr, scr, r, lane); continue; } r -= I_IN;
            if (r < I_OUT) { transpose_item(a.in[15] + (size_t)l * 1024 * 1024, 1024, 1024, (bf16*)(wb + WL_OUT), nullptr, scr, r, lane); continue; } r -= I_OUT;
            if (r < I_W1) { transpose_item(a.in[16] + (size_t)l * 1024 * 4096, 1024, 4096, (bf16*)(wb + WL_W1), nullptr, scr, r, lane); continue; } r -= I_W1;
            if (r < I_W2) { transpose_item(a.in[17] + (size_t)l * 4096 * 1024, 4096, 1024, (bf16*)(wb + WL_W2), nullptr, scr, r, lane); continue; } r -= I_W2;
            if (r < I_UQ) { transpose_item(a.in[12] + (size_t)l * 256 * 384, 256, 384, (bf16*)(wb + WL_UQ), a.in[11] + l * 256, scr, r, lane); continue; } r -= I_UQ;
            transpose_item(a.in[14] + (size_t)l * 128 * 512, 128, 512, (bf16*)(wb + WL_UKV), a.in[13] + l * 128, scr, r, lane);
        }
    }
}

DI void phase1(const Args& a, LAS unsigned char* lds, const int tid) {
    unsigned char* ws = a.ws;
    int G = gridDim.x; asm volatile("" : "+s"(G));
    const int bx = blockIdx.x;
    const float* mods = (const float*)(ws + WS_MODS);
    {
        LAS float* sl = (LAS float*)lds; LAS float* red = (LAS float*)(lds + 36864);
        float* bias1 = (float*)(ws + WS_BIAS1); float* bias4 = (float*)(ws + WS_BIAS4);
        for (int item = bx; item < DEPTH * 192; item += G) {
            const int l = item / 192, r = item % 192, which = r < 64 ? 0 : 1, tile = which ? r - 64 : r;
            const float* mv = mods + (size_t)l * 9 * 6144 + (which ? 3 : 0) * 1024;
            for (int idx = tid; idx < 9 * 1024; idx += NTHR) sl[idx] = mv[(size_t)(idx >> 10) * 6144 + (idx & 1023)];
            __syncthreads();
            if (!which) gemv9_item(a.in[8] + (size_t)l * 1024 * INW, INW, INW, tile * 32, sl, red, nullptr, bias1 + (size_t)l * 9 * 2048, 2048, tid);
            else gemv9_item(a.in[16] + (size_t)l * 1024 * DFF, DFF, DFF, tile * 32, sl, red, nullptr, bias4 + (size_t)l * 9 * 4096, 4096, tid);
        }
    }
    {
        const int lane = tid & 63, gw = bx * 8 + (tid >> 6), NGW = G * 8;
        bf16* Hn = (bf16*)(ws + WS_HN); float* ssqx = (float*)(ws + WS_SSQX); const float* g = a.in[6];
        f32x4 gg[4];
#pragma unroll
        for (int j = 0; j < 4; ++j) gg[j] = *(const GAS f32x4*)(g + 256 * j + 4 * lane);
        for (int row0 = gw; row0 < MT; row0 += 4 * NGW) {
            f32x4 v[4][4];
#pragma unroll
            for (int q = 0; q < 4; ++q) { const int row = row0 + q * NGW;
                if (row < MT) { const float* src = row < MX ? a.in[0] + (size_t)row * DM : a.in[2] + (size_t)(row - MX) * DM;
                    const GAS f32x4* xr = (const GAS f32x4*)src + lane;
#pragma unroll
                    for (int j = 0; j < 4; ++j) v[q][j] = xr[64 * j]; } }
#pragma unroll
            for (int q = 0; q < 4; ++q) { const int row = row0 + q * NGW;
                if (row < MT) { const int mi = row < MX ? (row >> 12) : 8; float s = 0.f;
#pragma unroll
                    for (int j = 0; j < 4; ++j) s += (v[q][j][0] * v[q][j][0] + v[q][j][1] * v[q][j][1]) + (v[q][j][2] * v[q][j][2] + v[q][j][3] * v[q][j][3]);
                    s = wave_sum(s);
                    if (lane == 0) ssqx[row] = s;
                    const float* mrow = mods + (size_t)mi * 6144 + 1024;
#pragma unroll
                    for (int j = 0; j < 4; ++j) { const int col = 256 * j + 4 * lane;
                        const f32x4 sc = *(const GAS f32x4*)(mrow + col);
                        st4bf(Hn + (size_t)row * DM + col, v[q][j] * (gg[j] * (sc + 1.0f))); } } }
        }
    }
}
DI void final_norm_phase(float* x, const float* g, const int tid) {
    const int lane = tid & 63, gw = blockIdx.x * 8 + (tid >> 6), NGW = gridDim.x * 8;
    f32x4 gg[4];
#pragma unroll
    for (int j = 0; j < 4; ++j) gg[j] = *(const GAS f32x4*)(g + 256 * j + 4 * lane);
    for (int row0 = gw; row0 < MX; row0 += 4 * NGW) {
        f32x4 v[4][4];
#pragma unroll
        for (int q = 0; q < 4; ++q) { const int row = row0 + q * NGW;
            if (row < MX) { const GAS f32x4* xr = (const GAS f32x4*)(x + (size_t)row * DM) + lane;
#pragma unroll
                for (int j = 0; j < 4; ++j) v[q][j] = xr[64 * j]; } }
#pragma unroll
        for (int q = 0; q < 4; ++q) { const int row = row0 + q * NGW;
            if (row < MX) { float s = 0.f;
#pragma unroll
                for (int j = 0; j < 4; ++j) s += (v[q][j][0] * v[q][j][0] + v[q][j][1] * v[q][j][1]) + (v[q][j][2] * v[q][j][2] + v[q][j][3] * v[q][j][3]);
                const float r = rsqrtf(wave_sum(s) * (1.0f / DM) + EPSN);
                GAS f32x4* xw = (GAS f32x4*)(x + (size_t)row * DM) + lane;
#pragma unroll
                for (int j = 0; j < 4; ++j) xw[64 * j] = v[q][j] * r * gg[j]; } }
    }
}

struct AttnP { const bf16 *proj, *qm, *kvm, *krr; bf16* mix; const float* sink; const float* rpb; };
constexpr int A_VS = 144, A_KB = 64 * 208, A_VB = 64 * A_VS, L_K = 0, L_V = 2 * A_KB, L_B = L_V + 2 * A_VB;

template <int TYPE> DI int key_row(int t, int j, int b, int nblk, int kr0, int kc0) {
    if (t < 4) return MX + b * 256 + t * 64 + j;
    const int tt = t - 4;
    if (TYPE == 0) return b * 4096 + (nblk - 1) * 128 + tt * 64 + j;
    if (TYPE == 1) { const int tr = tt / 3, tc = tt - 3 * tr; return b * 4096 + (kr0 + 4 * tr + (j >> 4)) * 64 + kc0 + 16 * tc + (j & 15); }
    if (TYPE == 3) { const int tr = tt >> 1, tc = tt & 1; return b * 4096 + (kr0 + 4 * tr + (j >> 4)) * 64 + kc0 + 16 * tc + (j & 15); }
    return b * 4096 + tt * 64 + j;
}

constexpr float ATHR = 6.0f;
template <int TYPE> struct AttnCtx { int t_qi, t_h, kr0, kc0, qr, qc, wr_, wc_; };

#define AT_SB() __builtin_amdgcn_sched_barrier(0)
template <int TYPE, int NKS, int KSTR> DI void at_mfma_block(f32x16& p0, f32x16& p1, f32x16& o0, f32x16& o1, const bf16x8 (&qf)[NKS], const bf16x8 (&pf)[4], float m_,
                                                             const LAS unsigned char* kb0, const LAS unsigned char* vb, bool do_s, bool do_pv) {
    constexpr int NST = NKS + 4, PD = (TYPE == 3) ? 1 : 2;
    bf16x8 fr[NST][2];
    const int first = do_s ? 0 : NKS, last = do_pv ? NST : NKS;
#define AT_LD(i_) do { if ((i_) >= first && (i_) < last) { \
        if ((i_) < NKS) { fr[i_][0] = *(const LAS bf16x8*)(kb0 + (i_) * 32); fr[i_][1] = *(const LAS bf16x8*)(kb0 + 32 * KSTR + (i_) * 32); } \
        else { const int s_ = (i_) - NKS; \
            const s16x4 l0_ = __builtin_bit_cast(s16x4, __builtin_amdgcn_ds_read_tr16_b64_v4i16((LAS s16x4*)(vb + (16 * s_) * A_VS))); \
            const s16x4 h0_ = __builtin_bit_cast(s16x4, __builtin_amdgcn_ds_read_tr16_b64_v4i16((LAS s16x4*)(vb + (16 * s_ + 8) * A_VS))); \
            const s16x4 l1_ = __builtin_bit_cast(s16x4, __builtin_amdgcn_ds_read_tr16_b64_v4i16((LAS s16x4*)(vb + (16 * s_) * A_VS + 64))); \
            const s16x4 h1_ = __builtin_bit_cast(s16x4, __builtin_amdgcn_ds_read_tr16_b64_v4i16((LAS s16x4*)(vb + (16 * s_ + 8) * A_VS + 64))); \
            fr[i_][0] = __builtin_shufflevector(l0_, h0_, 0, 1, 2, 3, 4, 5, 6, 7); fr[i_][1] = __builtin_shufflevector(l1_, h1_, 0, 1, 2, 3, 4, 5, 6, 7); } } } while (0)
    if (do_s) {
        const float nm = -m_;
#pragma unroll
        for (int i = 0; i < 16; ++i) { p0[i] = nm; p1[i] = nm; }
    }
#pragma unroll
    for (int i = 0; i < NST; ++i) {
        if (i == 0) { AT_LD(0); if (PD > 1) AT_LD(1); }
        if (i + PD < NST) AT_LD(i + PD);
        AT_SB();
        if (i >= first && i < last) {
            if (i < NKS) { p0 = __builtin_amdgcn_mfma_f32_32x32x16_bf16(fr[i][0], qf[i < NKS ? i : 0], p0, 0, 0, 0); p1 = __builtin_amdgcn_mfma_f32_32x32x16_bf16(fr[i][1], qf[i < NKS ? i : 0], p1, 0, 0, 0); }
            else { o0 = __builtin_amdgcn_mfma_f32_32x32x16_bf16(fr[i][0], pf[i >= NKS ? i - NKS : 0], o0, 0, 0, 0); o1 = __builtin_amdgcn_mfma_f32_32x32x16_bf16(fr[i][1], pf[i >= NKS ? i - NKS : 0], o1, 0, 0, 0); }
        }
        AT_SB();
    }
#undef AT_LD
}

template <int TYPE> DI void at_valu_block(f32x16& p0, f32x16& p1, f32x16& o0, f32x16& o1, bf16x8 (&pf)[4], float& m_, float& l_, int t, bool first,
                                          int qi, int h, int kr0, int kc0, int qr, int qc, int wr_, int wc_, const LAS float* lbias) {
    if (t >= 4) {
        if (TYPE == 0) {
            const int d0 = 64 * (t - 4) - qi + 4 * h;
#pragma unroll
            for (int i = 0; i < 16; ++i) { const int e = d0 + (i & 3) + 8 * (i >> 2);
                if ((unsigned)e > 256u) p0[i] = -1e30f;
                if ((unsigned)(e + 32) > 256u) p1[i] = -1e30f; }
        } else if (TYPE == 1 || TYPE == 3) {
            const int tt = t - 4, tr = (TYPE == 3) ? (tt >> 1) : tt / 3, tc = (TYPE == 3) ? (tt & 1) : tt - 3 * tr;
            const int krb = kr0 + 4 * tr, kcb = kc0 + 16 * tc + 4 * h;
#pragma unroll
            for (int i = 0; i < 16; ++i) {
                const int kc = kcb + (i & 3) + 8 * ((i >> 2) & 1);
                const bool cv = (unsigned)(kc - wc_) < 16u;
                const int ci = kc - qc + 15;
                { const int kr = krb + (i >> 3); const bool v = cv && ((unsigned)(kr - wr_) < 8u); const int idx = v ? (kr - qr + 7) * 31 + ci : 0; const float bv = lbias[idx]; p0[i] = v ? p0[i] + bv : -1e30f; }
                { const int kr = krb + 2 + (i >> 3); const bool v = cv && ((unsigned)(kr - wr_) < 8u); const int idx = v ? (kr - qr + 7) * 31 + ci : 0; const float bv = lbias[idx]; p1[i] = v ? p1[i] + bv : -1e30f; }
            }
        }
    }
    asm volatile("s_nop 15\n\ts_nop 7" : "+v"(p0), "+v"(p1));
    float mxa = max3f(p0[0], p0[1], p1[0]), mxb = max3f(p0[2], p0[3], p1[1]); mxa = max3f(mxa, p1[2], p1[3]);
#pragma unroll
    for (int i = 4; i < 16; i += 4) { mxa = max3f(mxa, p0[i], p0[i + 1]); mxb = max3f(mxb, p0[i + 2], p0[i + 3]); mxa = max3f(mxa, p1[i], p1[i + 1]); mxb = max3f(mxb, p1[i + 2], p1[i + 3]); }
    float mx = max3f(mxa, mxb, mxb);
    mx = max3f(mx, __shfl_xor(mx, 32), mx);
    if (first || __any(mx > ATHR)) {
        const float dl = (TYPE != 0 && first) ? mx : fmaxf(mx, 0.f);
        const float alpha = fexp2(-dl);
        m_ += dl; l_ *= alpha;
#pragma unroll
        for (int i = 0; i < 16; ++i) { p0[i] -= dl; p1[i] -= dl; o0[i] *= alpha; o1[i] *= alpha; }
    }
    float ls = 0.f;
#pragma unroll
    for (int i = 0; i < 16; ++i) { p0[i] = fexp2(p0[i]); p1[i] = fexp2(p1[i]); ls += p0[i] + p1[i]; }
    l_ += ls;
#pragma unroll
    for (int s = 0; s < 4; ++s) {
        u32x4 pw;
        if (s < 2) { pw.x = cvtpk(p0[8 * s + 0], p0[8 * s + 1]); pw.y = cvtpk(p0[8 * s + 2], p0[8 * s + 3]); pw.z = cvtpk(p0[8 * s + 4], p0[8 * s + 5]); pw.w = cvtpk(p0[8 * s + 6], p0[8 * s + 7]); }
        else { const int s2 = s - 2; pw.x = cvtpk(p1[8 * s2 + 0], p1[8 * s2 + 1]); pw.y = cvtpk(p1[8 * s2 + 2], p1[8 * s2 + 3]); pw.z = cvtpk(p1[8 * s2 + 4], p1[8 * s2 + 5]); pw.w = cvtpk(p1[8 * s2 + 6], p1[8 * s2 + 7]); }
        pf[s] = __builtin_bit_cast(bf16x8, pw);
    }
}

template <int TYPE> DI void attn_unit(const AttnP& P, int uid, bool isctx, LAS unsigned char* lds, const int tid) {
    constexpr int DQK = TYPE == 2 ? 96 : 64, NKS = DQK / 16, KSTR = DQK * 2 + 16;
    const int lane = tid & 63, w = __builtin_amdgcn_readfirstlane(tid >> 6), r = lane & 31, h = lane >> 5;
    int b, hd, kvh = 0, qrow, nblk = 0, kr0 = 0, kc0 = 0, qr = 0, qc = 0, tb0 = 4, tb1 = 4;
    if (TYPE == 0) {
        int gp;
        if (!isctx) { b = uid >> 7; kvh = (uid >> 6) & 1; nblk = (uid >> 1) & 31; gp = uid & 1; qrow = b * 4096 + nblk * 128 + (w & 3) * 32 + r; tb0 = nblk == 0 ? 6 : 4; tb1 = nblk == 31 ? 8 : 10; }
        else { b = uid >> 3; kvh = (uid >> 2) & 1; gp = (uid >> 1) & 1; nblk = uid & 1; qrow = MX + b * 256 + nblk * 128 + (w & 3) * 32 + r; }
        hd = kvh * 4 + gp * 2 + (w >> 2);
    } else if (TYPE == 1 || TYPE == 3) {
        if (!isctx) { b = uid >> 6; hd = (uid >> 4) & 3; const int ib = (uid >> 1) & 7, cp = uid & 1;
            qr = 8 * ib + 2 * (w & 3) + (r >> 4); qc = 16 * (2 * cp + (w >> 2)) + (r & 15); qrow = b * 4096 + qr * 64 + qc;
            kr0 = min(max(8 * ib - 4, 0), 48);
            if (TYPE == 3) { kc0 = min(max(16 * (2 * cp + (w >> 2)) - 8, 0), 32); tb1 = 12; }
            else { kc0 = 16 * cp; tb1 = 16; } }
        else { b = uid >> 2; hd = uid & 3; qrow = MX + b * 256 + w * 32 + r; }
    } else {
        if (!isctx) { b = uid >> 6; hd = (uid >> 4) & 3; qrow = b * 4096 + (uid & 15) * 256 + w * 32 + r; tb1 = 68; }
        else { b = uid >> 2; hd = uid & 3; qrow = MX + b * 256 + w * 32 + r; }
    }
    const int NTA = 4 + (tb1 - tb0);
    const bf16* qp; int ocol;
    if (TYPE == 0) { qp = P.proj + (size_t)qrow * PJS + hd * 64; ocol = hd * 64; }
    else if (TYPE == 1 || TYPE == 3) { qp = P.proj + (size_t)qrow * PJS + 768 + hd * 64; ocol = 512 + hd * 64; }
    else { qp = P.qm + (size_t)qrow * 384 + hd * 96; ocol = 768 + hd * 64; }
    bf16x8 qf[NKS];
#pragma unroll
    for (int ks = 0; ks < NKS; ++ks) qf[ks] = *(const GAS bf16x8*)(qp + 16 * ks + 8 * h);

    float m_ = 0.f, l_ = 0.f;
    if (TYPE == 0) { m_ = P.sink[hd] * LOG2E; l_ = (h == 0) ? 1.f : 0.f; }
    f32x16 o0, o1, p0, p1;
#pragma unroll
    for (int i = 0; i < 16; ++i) { o0[i] = 0.f; o1[i] = 0.f; p0[i] = 0.f; p1[i] = 0.f; }
    bf16x8 pf[4];
#pragma unroll
    for (int s = 0; s < 4; ++s) pf[s] = (bf16x8){0, 0, 0, 0, 0, 0, 0, 0};

    u32x4 kreg, vreg, rreg = {0u, 0u, 0u, 0u}, kreg2, vreg2;
    constexpr int A_HALF = 2 * A_KB + 2 * A_VB;
    const int HB = (TYPE == 3) ? (w >> 2) * A_HALF : 0;
    const int sj = (TYPE == 3) ? ((tid & 255) >> 3) : (tid >> 3), sc = tid & 7;
#define AT_TILE(it_) ((it_) < 4 ? (it_) : (it_) - 4 + tb0)
#define AT_LOADK(t) do { const int kr_ = key_row<TYPE>((t), sj, b, nblk, kr0, kc0); \
        if (TYPE == 2) { kreg = *(const GAS u32x4*)(P.kvm + (size_t)kr_ * 512 + hd * 128 + sc * 8); \
            if (tid < 256) { const int kr2_ = key_row<TYPE>((t), tid >> 2, b, nblk, kr0, kc0); rreg = *(const GAS u32x4*)(P.krr + (size_t)kr2_ * 32 + (tid & 3) * 8); } } \
        else { kreg = *(const GAS u32x4*)(P.proj + (size_t)kr_ * PJS + (TYPE == 0 ? 512 + kvh * 64 : 1024 + hd * 64) + sc * 8); \
            if (TYPE == 3) { const int kr2_ = key_row<TYPE>((t), sj + 32, b, nblk, kr0, kc0); kreg2 = *(const GAS u32x4*)(P.proj + (size_t)kr2_ * PJS + 1024 + hd * 64 + sc * 8); } } } while (0)
#define AT_LOADV(t) do { const int kr_ = key_row<TYPE>((t), sj, b, nblk, kr0, kc0); \
        if (TYPE == 2) vreg = *(const GAS u32x4*)(P.kvm + (size_t)kr_ * 512 + hd * 128 + 64 + sc * 8); \
        else { vreg = *(const GAS u32x4*)(P.proj + (size_t)kr_ * PJS + (TYPE == 0 ? 640 + kvh * 64 : 1280 + hd * 64) + sc * 8); \
            if (TYPE == 3) { const int kr2_ = key_row<TYPE>((t), sj + 32, b, nblk, kr0, kc0); vreg2 = *(const GAS u32x4*)(P.proj + (size_t)kr2_ * PJS + 1280 + hd * 64 + sc * 8); } } } while (0)
#define AT_STOREK(bi) do { *(LAS u32x4*)(lds + HB + L_K + (bi) * A_KB + sj * KSTR + sc * 16) = kreg; \
        if (TYPE == 3) *(LAS u32x4*)(lds + HB + L_K + (bi) * A_KB + (sj + 32) * KSTR + sc * 16) = kreg2; \
        if (TYPE == 2) { if (tid < 256) *(LAS u32x4*)(lds + L_K + (bi) * A_KB + (tid >> 2) * KSTR + 128 + (tid & 3) * 16) = rreg; } } while (0)
#define AT_STOREV(bi) do { *(LAS u32x4*)(lds + HB + L_V + (bi) * A_VB + sj * A_VS + sc * 16) = vreg; \
        if (TYPE == 3) *(LAS u32x4*)(lds + HB + L_V + (bi) * A_VB + (sj + 32) * A_VS + sc * 16) = vreg2; } while (0)
    AT_LOADK(0);
    __syncthreads();
    LAS float* lbias = (LAS float*)(lds + (TYPE == 3 ? 2 * A_HALF : L_B));
    if ((TYPE == 1 || TYPE == 3) && !isctx) { if (tid < 465) lbias[tid] = ((const GAS float*)P.rpb)[hd * 465 + tid] * LOG2E; }
    AT_STOREK(0);
    AT_LOADK(AT_TILE(1)); AT_LOADV(0);
    __syncthreads();
    const int q4 = (lane & 15) >> 2, p4 = lane & 3, blk = (lane >> 4) & 1;
    const int voff = HB + L_V + (4 * h + q4) * A_VS + (16 * blk + 4 * p4) * 2;
    const int koff = HB + L_K + r * KSTR + 16 * h;
    const int wr_ = min(max(qr - 4, 0), 56), wc_ = min(max(qc - 8, 0), 48);
    const int qi = (w & 3) * 32 + r;
    const bool grp1 = (w >> 2) != 0;

#define AT_STAGE(it) do { if ((it) + 1 < NTA) AT_STOREK(((it) + 1) & 1); AT_STOREV((it) & 1); \
        if ((it) + 2 < NTA) AT_LOADK(AT_TILE((it) + 2)); if ((it) + 1 < NTA) AT_LOADV(AT_TILE((it) + 1)); __syncthreads(); } while (0)
    if (!grp1) {
        for (int it = 0; it < NTA; ++it) {
            const int t = AT_TILE(it);
            const LAS unsigned char* kb0 = lds + (it & 1) * A_KB + koff;
            const LAS unsigned char* vb = lds + ((it + 1) & 1) * A_VB + voff;
            at_mfma_block<TYPE, NKS, KSTR>(p0, p1, o0, o1, qf, pf, m_, kb0, vb, true, it > 0);
            at_valu_block<TYPE>(p0, p1, o0, o1, pf, m_, l_, t, it == 0, qi, h, kr0, kc0, qr, qc, wr_, wc_, lbias);
            AT_STAGE(it);
        }
        const LAS unsigned char* vb = lds + ((NTA - 1) & 1) * A_VB + voff;
        at_mfma_block<TYPE, NKS, KSTR>(p0, p1, o0, o1, qf, pf, m_, vb, vb, false, true);
    } else {
        for (int it = 0; it < NTA; ++it) {
            const int tp = AT_TILE(it - 1);
            const LAS unsigned char* kb0 = lds + (it & 1) * A_KB + koff;
            const LAS unsigned char* vb = lds + ((it + 1) & 1) * A_VB + voff;
            if (it > 0) at_valu_block<TYPE>(p0, p1, o0, o1, pf, m_, l_, tp, it == 1, qi, h, kr0, kc0, qr, qc, wr_, wc_, lbias);
            at_mfma_block<TYPE, NKS, KSTR>(p0, p1, o0, o1, qf, pf, m_, kb0, vb, true, it > 0);
            AT_STAGE(it);
        }
        const LAS unsigned char* vb = lds + ((NTA - 1) & 1) * A_VB + voff;
        at_valu_block<TYPE>(p0, p1, o0, o1, pf, m_, l_, AT_TILE(NTA - 1), false, qi, h, kr0, kc0, qr, qc, wr_, wc_, lbias);
        at_mfma_block<TYPE, NKS, KSTR>(p0, p1, o0, o1, qf, pf, m_, vb, vb, false, true);
    }
#undef AT_STAGE
#undef AT_LOADK
#undef AT_LOADV
#undef AT_STOREK
#undef AT_STOREV
#undef AT_TILE
    const float lt = l_ + __shfl_xor(l_, 32), inv = 1.0f / lt;
    bf16* op = P.mix + (size_t)qrow * DM + ocol + 4 * h;
#pragma unroll
    for (int g = 0; g < 4; ++g) {
        const f32x4 v0 = {o0[4 * g] * inv, o0[4 * g + 1] * inv, o0[4 * g + 2] * inv, o0[4 * g + 3] * inv};
        const f32x4 v1 = {o1[4 * g] * inv, o1[4 * g + 1] * inv, o1[4 * g + 2] * inv, o1[4 * g + 3] * inv};
        st4bf(op + 8 * g, v0); st4bf(op + 32 + 8 * g, v1);
    }
}

DI void attn_phase(const AttnP& P, bool last, LAS unsigned char* lds, const int tid_in) {
    const int G = gridDim.x, bx = blockIdx.x;
    const int vcu = (G % 8 == 0) ? (bx % 8) * (G / 8) + bx / 8 : bx;
    const int NU = 2048 + (last ? 0 : 128);
    for (int u = vcu; u < NU; u += G) {
        int tid = tid_in; asm volatile("" : "+v"(tid));
        if (u < 512) attn_unit<2>(P, u, false, lds, tid);
        else if (u < 1024) attn_unit<3>(P, u - 512, false, lds, tid);
        else if (u < 2048) attn_unit<0>(P, u - 1024, false, lds, tid);
        else if (u < 2080) attn_unit<2>(P, u - 2048, true, lds, tid);
        else if (u < 2112) attn_unit<1>(P, u - 2080, true, lds, tid);
        else attn_unit<0>(P, u - 2112, true, lds, tid);
    }
}

#define XB_TMO      128
#define XB_XCNT(j)  (256  + 64 * (j))
#define XB_XSUB(j)  (1280 + 64 * (j))
#define XB_XGEN(j)  (2304 + 64 * (j))
#define XB_TOP      3328
#define XB_TOPGEN   3392
#define XCD_BAR_WORDS 3456
#define XB_SPIN_CAP (1u << 18)

__device__ __forceinline__ unsigned xb_ld(unsigned* p)              { return __hip_atomic_load(p, __ATOMIC_RELAXED, __HIP_MEMORY_SCOPE_AGENT); }
__device__ __forceinline__ unsigned xb_add(unsigned* p, unsigned v) { return __hip_atomic_fetch_add(p, v, __ATOMIC_RELAXED, __HIP_MEMORY_SCOPE_AGENT); }
__device__ __forceinline__ unsigned xb_xcc_id() { return (unsigned)__builtin_amdgcn_s_getreg((3 << 11) | 20) & 0xFu; }
#define XB_SPIN(cond, bar) do { unsigned _sp = 0; while (cond) { __builtin_amdgcn_s_sleep(1); \
    if ((++_sp & 255u) == 0u) { if (xb_ld(&(bar)[XB_TMO])) break; if (_sp > XB_SPIN_CAP) { atomicAdd(&(bar)[XB_TMO], 1u); break; } } } } while (0)

struct XcdBarrier {
    unsigned* bar; unsigned x;
    volatile LAS unsigned* st;
};

__device__ __forceinline__ XcdBarrier xcd_barrier_post(unsigned* bar, volatile LAS unsigned* st) {
    XcdBarrier b; b.bar = bar; b.x = xb_xcc_id(); b.st = st;
    if (threadIdx.x == 0) (void)xb_add(&bar[XB_XCNT(b.x)], 1u);
    return b;
}
__device__ __forceinline__ void xcd_barrier_complete(unsigned* bar, unsigned x, unsigned& nloc, unsigned& nx) {
    const unsigned G = gridDim.x * gridDim.y * gridDim.z;
    unsigned sum, cnt, mine, sp = 0u;
    for (;;) {
        sum = 0u; cnt = 0u; mine = 0u;
#pragma unroll
        for (unsigned j = 0; j < 16; ++j) { const unsigned c = xb_ld(&bar[XB_XCNT(j)]); sum += c; cnt += (c > 0u) ? 1u : 0u; mine = (j == x) ? c : mine; }
        if (sum == G) break;
        __builtin_amdgcn_s_sleep(1);
        if ((++sp & 255u) == 0u) { if (xb_ld(&bar[XB_TMO])) break; if (sp > XB_SPIN_CAP) { atomicAdd(&bar[XB_TMO], 1u); break; } }
    }
    nloc = mine > 0u ? mine : 1u; nx = cnt > 0u ? cnt : 1u;
}

__device__ __forceinline__ void xcd_barrier(const XcdBarrier& b) {
    asm volatile("s_waitcnt vmcnt(0)" ::: "memory");
    __syncthreads();
    if (threadIdx.x == 0) {
        unsigned* bar = b.bar;
        __builtin_amdgcn_s_waitcnt(0);
        unsigned nloc = b.st[0], nx = b.st[1];
        if (nloc == 0u) { xcd_barrier_complete(bar, b.x, nloc, nx); b.st[0] = nloc; b.st[1] = nx; }
        const unsigned old = xb_add(&bar[XB_XSUB(b.x)], 1u);
        const unsigned gen = old / nloc;
        if (old + 1u == (gen + 1u) * nloc) {
            __builtin_amdgcn_fence(__ATOMIC_RELEASE, "agent");
            asm volatile("s_waitcnt vmcnt(0)" ::: "memory");
            const unsigned og = xb_add(&bar[XB_TOP], 1u);
            const unsigned tg = og / nx;
            if (og + 1u == (tg + 1u) * nx) xb_add(&bar[XB_TOPGEN], 1u);
            else XB_SPIN(xb_ld(&bar[XB_TOPGEN]) == tg, bar);
            __builtin_amdgcn_fence(__ATOMIC_ACQUIRE, "agent");
            xb_add(&bar[XB_XGEN(b.x)], 1u);
            asm volatile("s_waitcnt vmcnt(0)" ::: "memory");
        } else {
            XB_SPIN(xb_ld(&bar[XB_XGEN(b.x)]) == gen, bar);
            __builtin_amdgcn_fence(__ATOMIC_ACQUIRE, "agent");
            asm volatile("s_waitcnt vmcnt(0)" ::: "memory");
        }
    }
    __syncthreads();
}

constexpr int NPH = 3 + 6 * DEPTH;
__global__ void __launch_bounds__(NTHR) mk_fwd(Args a) {
    extern __shared__ __attribute__((aligned(16))) unsigned char lds_raw[];
    LAS unsigned char* lds = (LAS unsigned char*)lds_raw;
    const int G = gridDim.x, bx = blockIdx.x;
    const int ph_lo = a.ph_lo, ph_hi = a.ph_hi;
    volatile LAS unsigned* bst = (volatile LAS unsigned*)(lds + 131072);
    if (threadIdx.x < 2) bst[threadIdx.x] = 0u;
    __syncthreads();
    XcdBarrier xbar; xbar.bar = (unsigned*)(a.ws + WS_BAR); xbar.x = 0; xbar.st = bst;
    if (!MK_PER_PHASE) xbar = xcd_barrier_post((unsigned*)(a.ws + WS_BAR), bst);

    for (int ph = ph_lo; ph < ph_hi;) {
        int tid = threadIdx.x; asm volatile("" : "+v"(tid));
        unsigned char* ws = a.ws; asm volatile("" : "+s"(ws));
        float* mods = (float*)(ws + WS_MODS);
        const float* tabA = (const float*)(ws + WS_TAB); const float* tabC = tabA + 2048;
        float* Xc = (float*)(ws + WS_XC);
        bf16* Hn = (bf16*)(ws + WS_HN); bf16* H1 = (bf16*)(ws + WS_H1);
        bf16* proj = (bf16*)(ws + WS_PROJ); bf16* cqb = (bf16*)(ws + WS_CQ); bf16* ckvb = (bf16*)(ws + WS_CKV);
        bf16* qm = (bf16*)(ws + WS_QM); bf16* kvm = (bf16*)(ws + WS_KVM); bf16* krr = (bf16*)(ws + WS_KRR); bf16* mix = (bf16*)(ws + WS_MIX);

        if (ph == 0) prologue(a, lds, tid);
        else if (ph == 1) phase1(a, lds, tid);
        else if (ph == NPH - 1) final_norm_phase(a.out, a.in[18], tid);
        else {
            const int l = (ph - 2) / 6, s = (ph - 2) - 6 * l; const bool last = (l == DEPTH - 1);
            unsigned char* wb = ws + WS_W + (size_t)l * WL_STRIDE;
            const float* mods_l = mods + (size_t)l * 9 * 6144;
            float* ssq_q = (float*)(ws + WS_SSQ) + (size_t)l * 2 * MT; float* ssq_kv = ssq_q + MT;
            float* ssqx1 = (float*)(ws + WS_SSQX) + (size_t)l * 2 * MT; float* ssqx2 = ssqx1 + MT;
            const float* xsrc = (l == 0) ? a.in[0] : a.out;
            const float* csrc = (l == 0) ? a.in[2] : Xc;
            float* part = (float*)(ws + WS_PART);
            if (s == 0) {
                if (l > 0) {
                    const float* mods_p = mods + (size_t)(l - 1) * 9 * 6144;
                    ctx_finish(part, 8, Xc, Xc, mods_p + 5 * 1024 + 8 * 6144, Hn, ssqx1, a.in[6] + l * DM, mods_l + 1 * 1024 + 8 * 6144, tid);
                    xcd_barrier(xbar);
                }
                pg8::Gemm g{Hn, (const bf16*)(wb + WL_IN), MT, 2048, DM, DM}; pg8::StaticOrder S; S.init(MT, 2048, G, bx);
                EpiInProj E{proj, cqb, ckvb, krr, ssq_q, ssq_kv, tabA, tabC, ssqx1, (const float*)(ws + WS_BIAS1) + (size_t)l * 9 * 2048};
                pg8::gemm_phase<EpiInProj, pg8::StaticOrder, true, true>(lds, g, S, E, tid);
            } else if (s == 1) {
                { int Kq = 256; asm volatile("" : "+s"(Kq)); pg8::Gemm g{cqb, (const bf16*)(wb + WL_UQ), MT, 512, Kq, Kq}; pg8::StaticOrder S; S.init(MT, 512, G, bx);
                  EpiUQ E{qm, ssq_q, tabC}; pg8::gemm_phase<EpiUQ, pg8::StaticOrder, true, true>(lds, g, S, E, tid); }
                { int Kk = 128; asm volatile("" : "+s"(Kk)); pg8::Gemm g{ckvb, (const bf16*)(wb + WL_UKV), MT, 512, Kk, Kk}; pg8::StaticOrder S; S.init(MT, 512, G, (bx + G / 2) % G);
                  EpiUKV E{kvm, ssq_kv}; pg8::gemm_phase<EpiUKV, pg8::StaticOrder, true, true>(lds, g, S, E, tid); }
            } else if (s == 2) {
                AttnP P{proj, qm, kvm, krr, mix, a.in[9] + l * 8, a.in[10] + l * 4 * 465};
                attn_phase(P, last, lds, tid);
            } else if (s == 3 || s == 5) {
                const bool outp = (s == 3);
                const int Kfull = outp ? DM : DFF;
                {
                    pg8::Gemm g{outp ? mix : H1, (const bf16*)(wb + (outp ? WL_OUT : WL_W2)), MX, DM, Kfull, Kfull}; pg8::StaticOrder S; S.init(MX, DM, G, bx);
                    const int ln = outp ? l : l + 1;
                    const float* mods_n = mods + (size_t)(ln < DEPTH ? ln : 0) * 9 * 6144;
                    EpiResid E{(outp ? xsrc : a.out), (outp ? csrc : Xc), a.out, Xc, mods_l + (outp ? 2 : 5) * 1024, Hn,
                               outp ? ssqx2 : ssqx1 + (size_t)2 * MT, (outp ? a.in[7] : a.in[6]) + (ln < DEPTH ? ln : 0) * DM, mods_n + (outp ? 4 : 1) * 1024, (outp || !last) ? 1 : 0};
                    pg8::gemm_phase<EpiResid, pg8::StaticOrder, true, true>(lds, g, S, E, tid);
                }
                if (!last) {
                    const int NSs = outp ? 4 : 8;
                    int Ks = Kfull / NSs; asm volatile("" : "+s"(Ks));
                    pg8::Gemm g{outp ? mix : H1, (const bf16*)(wb + (outp ? WL_OUT : WL_W2)), MT, DM, Ks, Kfull}; SplitOrder S; S.init(G, (bx + G / 2) % G, NSs, Ks);
                    EpiPartial E{part, Ks * 2};
                    pg8::gemm_phase<EpiPartial, SplitOrder, true, true>(lds, g, S, E, tid);
                }
            } else {
                const int Mr = last ? MX : MT;
                if (!last) {
                    ctx_finish(part, 4, csrc, Xc, mods_l + 2 * 1024 + 8 * 6144, Hn, ssqx2, a.in[7] + l * DM, mods_l + 4 * 1024 + 8 * 6144, tid);
                    xcd_barrier(xbar);
                }
                pg8::Gemm g{Hn, (const bf16*)(wb + WL_W1), Mr, DFF, DM, DM}; pg8::StaticOrder S; S.init(Mr, DFF, G, bx);
                EpiRelu2 E{H1, ssqx2, (const float*)(ws + WS_BIAS4) + (size_t)l * 9 * 4096}; pg8::gemm_phase<EpiRelu2, pg8::StaticOrder, true, true>(lds, g, S, E, tid);
            }
        }
        ++ph;
        if (ph < ph_hi) { if (ph == 1) cg::this_grid().sync(); else xcd_barrier(xbar); }
    }
}

extern "C" void kernel_launch(void* const* d_in, const int* in_sizes, int n_in, void* d_out, int out_size, void* d_ws, size_t ws_size, hipStream_t stream) {
    static int grid = 0;
    if (grid == 0) {
        if (n_in != 19 || ws_size < WS_END) { fprintf(stderr, "kernel_launch: unexpected inputs (n_in %d, ws %zu)\n", n_in, ws_size); grid = -1; return; }
        int dev = 0, cus = 0, per_cu = 0;
        hipGetDevice(&dev); hipDeviceGetAttribute(&cus, hipDeviceAttributeMultiprocessorCount, dev);
        hipFuncSetAttribute((const void*)mk_fwd, hipFuncAttributeMaxDynamicSharedMemorySize, LDS_BYTES);
        hipOccupancyMaxActiveBlocksPerMultiprocessor(&per_cu, (const void*)mk_fwd, NTHR, LDS_BYTES);
        if (per_cu < 1) { fprintf(stderr, "kernel_launch: occupancy query says %d\n", per_cu); per_cu = 1; }
        (void)hipGetLastError();
        grid = cus * 1;
    }
    if (grid < 0) return;
    Args a{};
    for (int i = 0; i < 19; ++i) a.in[i] = (const float*)d_in[i];
    a.out = (float*)d_out; a.ws = (unsigned char*)d_ws;
#if MK_PER_PHASE
    for (int ph = 0; ph < NPH; ++ph) { a.ph_lo = ph; a.ph_hi = ph + 1; hipLaunchKernelGGL(mk_fwd, dim3(grid), dim3(NTHR), LDS_BYTES, stream, a); }
#else
    a.ph_lo = 0; a.ph_hi = NPH;
    (void)hipMemsetAsync((unsigned char*)d_ws + WS_BAR, 0, 16384, stream);
    void* args[] = {&a};
    hipError_t e = hipLaunchCooperativeKernel((const void*)mk_fwd, dim3(grid), dim3(NTHR), args, LDS_BYTES, stream);
    if (e != hipSuccess) fprintf(stderr, "cooperative launch failed: %s (grid %d)\n", hipGetErrorString(e), grid);
#endif
}
```

```cpp
#include <hip/hip_runtime.h>
#include <hip/hip_cooperative_groups.h>
#include <cstdio>
#include <cstdint>
namespace cg = cooperative_groups;
namespace pg8 {
#define PG8_LAS __attribute__((address_space(3)))
typedef unsigned short bf16_t;
typedef short bf16x8 __attribute__((ext_vector_type(8)));
typedef float f32x4 __attribute__((ext_vector_type(4)));
typedef unsigned u32x4 __attribute__((ext_vector_type(4)));
constexpr int BM = 256, BK = 64, HALF = 128, HTB = HALF * BK * 2  , STAGE_BYTES = 8 * HTB, NXCD = 8, WGM = 8;

__host__ __device__ __forceinline__ int lds_byte(int r, int c) { const int st = (r >> 4) * 2 + (c >> 5), rr = r & 15, cc = c & 31, ob = rr * 64 + cc * 2; return st * 1024 + (ob ^ (((ob >> 9) & 1) << 5)); }
__host__ __device__ __forceinline__ void stage_rc(int b, int& R, int& C) { const int st = b / 1024, sb = b % 1024, swz = sb ^ (((sb >> 9) & 1) << 5); R = (st >> 1) * 16 + swz / 64; C = (st & 1) * 32 + (swz % 64) / 2; }
__host__ __device__ __forceinline__ int perm32(int rho) { const int n = rho >> 4, i = rho & 15; return 8 * (i >> 2) + 4 * n + (i & 3); }

struct Unit { int pm, pn, kb; };
struct Gemm { const bf16_t* A; const bf16_t* Bt; int M, N, K, ld; };

struct StaticOrder {
    int nM, nN, nwg, G, c;
    __host__ __device__ void init(int M, int N, int G_, int c_) { nM = M / BM; nN = N / BM; nwg = nM * nN; G = G_; c = c_; }
    __host__ __device__ bool next(int i, Unit& u) const {
        const long L = (long)i * G + c; if (L >= nwg) return false;
        int wgid = (int)L; { const int q = nwg / NXCD, r = nwg % NXCD, xcd = wgid % NXCD, off = wgid / NXCD; wgid = (xcd < r ? xcd * (q + 1) : r * (q + 1) + (xcd - r) * q) + off; }
        const int nig = WGM * nN, gid = wgid / nig, fm = gid * WGM, gsz = (nM - fm) < WGM ? (nM - fm) : WGM;
        u.pm = fm + ((wgid % nig) % gsz); u.pn = (wgid % nig) / gsz; u.kb = 0; return true;
    }
    __device__ __forceinline__ void a_ready(const Unit&) const {}
    __device__ __forceinline__ void done(const Unit&) const {}
};

__device__ __forceinline__ unsigned cvt_pk_bf16(float lo, float hi) { unsigned r; asm volatile("v_cvt_pk_bf16_f32 %0, %1, %2" : "=v"(r) : "v"(lo), "v"(hi)); return r; }
template <class Epi, class Sched, bool ALIGN_EPI = false, bool SP2 = false>
__device__ __forceinline__ void gemm_phase(PG8_LAS unsigned char* lds, const Gemm g, const Sched& S, const Epi& E, const int tid) {
    const int wid = __builtin_amdgcn_readfirstlane(tid >> 6), lane = tid & 63, wr = wid >> 2, wc = wid & 3, fr = lane & 15, fq = lane >> 4;
    const int K = g.ld, nt = g.K / BK;
    unsigned voffA[2], voffB[2];
#pragma unroll
    for (int i = 0; i < 2; ++i) { int R, C; stage_rc(tid * 16 + i * 8192, R, C); const int Rb = Epi::PERM ? ((R & ~31) + perm32(R & 31)) : R;
        voffA[i] = (unsigned)(R * K + C) * 2u; voffB[i] = (unsigned)(Rb * K + C) * 2u; }
    const size_t kstep = (size_t)(BK * 2);
    const size_t hstep = (size_t)HALF * K * 2;
    const size_t tstep = 2 * hstep;
    const unsigned ldsw = (unsigned)wid * 1024u;
    const int aoff = lds_byte(wr * 64 + fr, fq * 8), boff = lds_byte(wc * 32 + fr, fq * 8);
#define PG8_SA(b, h) (((b) * 2 + (h)) * HTB)
#define PG8_SB(b, h) ((4 + (b) * 2 + (h)) * HTB)
#define PG8_STAGE(bufoff, gbase, voff) do { _Pragma("unroll") for (int _i = 0; _i < 2; ++_i) \
        __builtin_amdgcn_global_load_lds((const unsigned*)((const char*)(gbase) + (voff)[_i]), (PG8_LAS unsigned*)(lds + (bufoff) + ldsw + _i * 8192), 16, 0, 0); } while (0)
#define PG8_LDA(dst, b, h) do { _Pragma("unroll") for (int m = 0; m < 4; ++m) _Pragma("unroll") for (int k = 0; k < 2; ++k) dst[m][k] = *(const PG8_LAS bf16x8*)(lds + PG8_SA(b, h) + aoff + m * 2048 + k * 1024); } while (0)
#define PG8_LDB(dst, b, h) do { _Pragma("unroll") for (int n = 0; n < 2; ++n) _Pragma("unroll") for (int k = 0; k < 2; ++k) dst[n][k] = *(const PG8_LAS bf16x8*)(lds + PG8_SB(b, h) + boff + n * 2048 + k * 1024); } while (0)
#define PG8_MMA(ai, bj, At, Bt) do { __builtin_amdgcn_s_setprio(1); _Pragma("unroll") for (int m = 0; m < 4; ++m) _Pragma("unroll") for (int n = 0; n < 2; ++n) _Pragma("unroll") for (int k = 0; k < 2; ++k) \
        acc[ai][bj][m][n] = __builtin_amdgcn_mfma_f32_16x16x32_bf16(Bt[n][k], At[m][k], acc[ai][bj][m][n], 0, 0, 0); __builtin_amdgcn_s_setprio(0); } while (0)
#define PG8_WAIT_V(n) asm volatile("s_waitcnt vmcnt(" #n ")" ::: "memory")
#define PG8_WAIT_L(n) asm volatile("s_waitcnt lgkmcnt(" #n ")" ::: "memory")
#define PG8_BAR __builtin_amdgcn_s_barrier()
#define PG8_SCHED __builtin_amdgcn_sched_barrier(0)
    Unit cur, nxt; int ui = 0;
    if (!S.next(0, cur)) return;
    f32x4 acc[2][2][4][2];
#pragma unroll
    for (int a = 0; a < 2; ++a)
#pragma unroll
        for (int b = 0; b < 2; ++b)
#pragma unroll
            for (int m = 0; m < 4; ++m)
#pragma unroll
                for (int n = 0; n < 2; ++n) acc[a][b][m][n] = (f32x4){0.f, 0.f, 0.f, 0.f};
    bf16x8 At[4][2], B0[2][2], B1[2][2];
    const char* cA = (const char*)g.A + (size_t)cur.pm * tstep + cur.kb; const char* cB = (const char*)g.Bt + (size_t)cur.pn * tstep + cur.kb;
    S.a_ready(cur);
    if constexpr (SP2) {
        PG8_STAGE(PG8_SB(0, 0), cB, voffB); PG8_STAGE(PG8_SB(0, 1), cB + hstep, voffB); PG8_STAGE(PG8_SA(0, 0), cA, voffA); PG8_STAGE(PG8_SA(0, 1), cA + hstep, voffA);
        if (wr == 1) PG8_BAR;
        PG8_WAIT_V(2); PG8_BAR;
        PG8_STAGE(PG8_SB(1, 0), cB + kstep, voffB); PG8_STAGE(PG8_SA(1, 0), cA + kstep, voffA); PG8_STAGE(PG8_SB(1, 1), cB + hstep + kstep, voffB);
        PG8_WAIT_V(6); PG8_BAR;
    } else {
        PG8_STAGE(PG8_SB(0, 0), cB, voffB); PG8_STAGE(PG8_SA(0, 0), cA, voffA); PG8_STAGE(PG8_SB(0, 1), cB + hstep, voffB); PG8_STAGE(PG8_SA(0, 1), cA + hstep, voffA);
        if (wr == 1) PG8_BAR;
        PG8_WAIT_V(4); PG8_BAR;
        PG8_STAGE(PG8_SB(1, 0), cB + kstep, voffB); PG8_STAGE(PG8_SA(1, 0), cA + kstep, voffA); PG8_STAGE(PG8_SB(1, 1), cB + hstep + kstep, voffB);
        PG8_WAIT_V(6); PG8_BAR;
    }
    for (;;) {
        const bool has_next = S.next(ui + 1, nxt);
        const char* nA = has_next ? (const char*)g.A + (size_t)nxt.pm * tstep + nxt.kb : cA; const char* nB = has_next ? (const char*)g.Bt + (size_t)nxt.pn * tstep + nxt.kb : cB;
        for (int t = 0; t < nt; t += 2) {
            const bool last = (t == nt - 2);
            const char* a1 = cA + (size_t)(t + 1) * kstep;
            const char* a2 = last ? nA : cA + (size_t)(t + 2) * kstep; const char* b2 = last ? nB : cB + (size_t)(t + 2) * kstep;
            const char* a3 = a2 + kstep; const char* b3 = b2 + kstep;
            if (last && has_next) S.a_ready(nxt);
            if constexpr (SP2) {
            PG8_LDB(B0, 0, 0); PG8_LDB(B1, 0, 1); PG8_SCHED; PG8_LDA(At, 0, 0); PG8_STAGE(PG8_SA(1, 1), a1 + hstep, voffA);
            PG8_WAIT_V(8); PG8_WAIT_L(0); PG8_BAR; PG8_MMA(0, 0, At, B0); PG8_MMA(0, 1, At, B1); PG8_BAR; PG8_SCHED;
            PG8_LDA(At, 0, 1); PG8_STAGE(PG8_SB(0, 0), b2, voffB); PG8_STAGE(PG8_SB(0, 1), b2 + hstep, voffB); PG8_STAGE(PG8_SA(0, 0), a2, voffA);
            PG8_WAIT_V(8); PG8_WAIT_L(0); PG8_BAR; PG8_MMA(1, 0, At, B0); PG8_MMA(1, 1, At, B1); PG8_BAR; PG8_SCHED;
            PG8_LDB(B0, 1, 0); PG8_LDB(B1, 1, 1); PG8_SCHED; PG8_LDA(At, 1, 0); PG8_STAGE(PG8_SA(0, 1), a2 + hstep, voffA);
            PG8_WAIT_V(8); PG8_WAIT_L(0); PG8_BAR; PG8_MMA(0, 0, At, B0); PG8_MMA(0, 1, At, B1); PG8_BAR; PG8_SCHED;
            PG8_LDA(At, 1, 1); PG8_STAGE(PG8_SB(1, 0), b3, voffB); PG8_STAGE(PG8_SB(1, 1), b3 + hstep, voffB); PG8_STAGE(PG8_SA(1, 0), a3, voffA);
            PG8_WAIT_V(8); PG8_WAIT_L(0); PG8_BAR; PG8_MMA(1, 0, At, B0); PG8_MMA(1, 1, At, B1); PG8_BAR; PG8_SCHED;
            } else {
            PG8_LDB(B0, 0, 0); PG8_SCHED; PG8_LDA(At, 0, 0); PG8_STAGE(PG8_SA(1, 1), a1 + hstep, voffA);
            PG8_WAIT_L(8); PG8_BAR; PG8_WAIT_L(0); PG8_MMA(0, 0, At, B0); PG8_BAR; PG8_SCHED;
            PG8_LDB(B1, 0, 1); PG8_STAGE(PG8_SB(0, 0), b2, voffB);
            PG8_BAR; PG8_WAIT_L(0); PG8_MMA(0, 1, At, B1); PG8_BAR;
            PG8_LDA(At, 0, 1); PG8_STAGE(PG8_SA(0, 0), a2, voffA);
            PG8_BAR; PG8_WAIT_L(0); PG8_MMA(1, 0, At, B0); PG8_BAR; PG8_SCHED;
            PG8_STAGE(PG8_SB(0, 1), b2 + hstep, voffB);
            PG8_WAIT_V(6); PG8_BAR; PG8_MMA(1, 1, At, B1); PG8_BAR;
            PG8_LDB(B0, 1, 0); PG8_SCHED; PG8_LDA(At, 1, 0); PG8_STAGE(PG8_SA(0, 1), a2 + hstep, voffA);
            PG8_WAIT_L(8); PG8_BAR; PG8_WAIT_L(0); PG8_MMA(0, 0, At, B0); PG8_BAR; PG8_SCHED;
            PG8_LDB(B1, 1, 1); PG8_STAGE(PG8_SB(1, 0), b3, voffB);
            PG8_BAR; PG8_WAIT_L(0); PG8_MMA(0, 1, At, B1); PG8_BAR;
            PG8_LDA(At, 1, 1); PG8_STAGE(PG8_SA(1, 0), a3, voffA);
            PG8_BAR; PG8_WAIT_L(0); PG8_MMA(1, 0, At, B0); PG8_BAR; PG8_SCHED;
            PG8_STAGE(PG8_SB(1, 1), b3 + hstep, voffB);
            PG8_WAIT_V(6); PG8_BAR; PG8_MMA(1, 1, At, B1); PG8_BAR;
            }
        }
        if constexpr (ALIGN_EPI) { if (wr == 0) PG8_BAR; }
        if constexpr (!Epi::AFTER_DRAIN) { E(acc, cur, wr, wc, fr, fq); S.done(cur); }
        if (!has_next) break;
#pragma unroll
        for (int a = 0; a < 2; ++a)
#pragma unroll
            for (int b = 0; b < 2; ++b)
#pragma unroll
                for (int m = 0; m < 4; ++m)
#pragma unroll
                    for (int n = 0; n < 2; ++n) acc[a][b][m][n] = (f32x4){0.f, 0.f, 0.f, 0.f};
        cur = nxt; cA = nA; cB = nB; ++ui;
        if constexpr (ALIGN_EPI) { if (wr == 1) PG8_BAR; }
    }
    PG8_WAIT_V(0);
    if constexpr (!ALIGN_EPI) { if (wr == 0) PG8_BAR; }
    PG8_BAR;
    if constexpr (Epi::AFTER_DRAIN) { E.fused(acc, cur, wr, wc, fr, fq, lds, wid, lane); S.done(cur); }
#undef PG8_SA
#undef PG8_SB
#undef PG8_STAGE
#undef PG8_LDA
#undef PG8_LDB
#undef PG8_MMA
#undef PG8_WAIT_V
#undef PG8_WAIT_L
#undef PG8_BAR
#undef PG8_SCHED
}
}

#define LAS __attribute__((address_space(3)))
#define DI __device__ __forceinline__
#define GAS __attribute__((address_space(1)))
typedef unsigned short bf16;
typedef float f32x4 __attribute__((ext_vector_type(4)));
typedef float f32x16 __attribute__((ext_vector_type(16)));
typedef short bf16x8 __attribute__((ext_vector_type(8)));
typedef short s16x4 __attribute__((ext_vector_type(4)));
typedef unsigned u32x2 __attribute__((ext_vector_type(2)));
typedef unsigned u32x4 __attribute__((ext_vector_type(4)));
typedef float f32x2_t __attribute__((ext_vector_type(2)));
typedef __bf16 bf16x2_t __attribute__((ext_vector_type(2)));

#ifndef MK_MASK
#define MK_MASK 0x1ff
#endif
#define PH_EN(k) (((MK_MASK) >> (k)) & 1)
#ifndef MK_PER_PHASE
#define MK_PER_PHASE 0
#endif

constexpr int DM = 1024, NBATCH = 8, SEQ = 4096, DEPTH = 4, CTXL = 256, DFF = 4096;
constexpr int MX = NBATCH * SEQ, MC = NBATCH * CTXL, MT = MX + MC;
constexpr int INW = 1952, PJS = 1536;
constexpr float LOG2E = 1.4426950408889634f;
constexpr float C2A = 0.125f * LOG2E;
constexpr float C2C = 0.10206207261596575f * LOG2E;
constexpr float EPSN = 1e-6f;
constexpr int NTHR = 512;

constexpr size_t MiB = (size_t)1 << 20;
constexpr size_t WS_TAB = 0;
constexpr size_t WS_BAR = 65536;
constexpr size_t WS_MODS = 1 * MiB;
constexpr size_t WS_SSQ = 2 * MiB;
constexpr size_t WS_XC = 4 * MiB;
constexpr size_t WS_W = 12 * MiB;
constexpr size_t WL_IN = 0, WL_OUT = 4 * MiB, WL_W1 = 6 * MiB, WL_W2 = 14 * MiB, WL_UQ = 22 * MiB, WL_UKV = 22 * MiB + 256 * 1024, WL_STRIDE = 22 * MiB + 512 * 1024;
constexpr size_t WS_HN = 102 * MiB;
constexpr size_t WS_H1 = 170 * MiB;
constexpr size_t WS_PROJ = 170 * MiB;
constexpr size_t WS_CQ = 272 * MiB;
constexpr size_t WS_CKV = 289 * MiB;
constexpr size_t WS_QM = 298 * MiB;
constexpr size_t WS_KVM = 324 * MiB;
constexpr size_t WS_KRR = 358 * MiB;
constexpr size_t WS_MIX = 362 * MiB;
constexpr size_t WS_SSQX = 442 * MiB;
constexpr size_t WS_BIAS1 = 444 * MiB;
constexpr size_t WS_BIAS4 = 445 * MiB;
constexpr size_t WS_PART = 446 * MiB;
constexpr size_t WS_END = 510 * MiB;
constexpr int LDS_BYTES = 131072 + 256;

DI unsigned cvtpk(float lo, float hi) { f32x2_t v = {lo, hi}; bf16x2_t b = __builtin_convertvector(v, bf16x2_t); return __builtin_bit_cast(unsigned, b); }
DI void st4bf(bf16* p, f32x4 v) { u32x2 w; w.x = cvtpk(v[0], v[1]); w.y = cvtpk(v[2], v[3]); *(GAS u32x2*)p = w; }
DI float wave_sum(float v) {
#pragma unroll
    for (int o = 1; o < 64; o <<= 1) v += __shfl_xor(v, o);
    return v;
}
DI float fexp2(float x) { return __builtin_amdgcn_exp2f(x); }
DI float max3f(float a, float b, float c) { float r; asm("v_max3_f32 %0, %1, %2, %3" : "=v"(r) : "v"(a), "v"(b), "v"(c)); return r; }
#define LDS_WAIT() asm volatile("s_waitcnt lgkmcnt(0)" ::: "memory")

DI f32x4 rope8(f32x4 v, const float* tab  , int fq) {
    const int i0 = 4 * (fq & 1);
    const f32x4 cs = *(const f32x4*)(tab + i0), sn = *(const f32x4*)(tab + 8 + i0);
    f32x4 o;
#pragma unroll
    for (int j = 0; j < 4; ++j) { const float pr = __shfl_xor(v[j], 32); o[j] = (fq < 2) ? v[j] * cs[j] - pr * sn[j] : pr * sn[j] + v[j] * cs[j]; }
    return o;
}

struct EpiInProj {
    static constexpr bool PERM = false, AFTER_DRAIN = false;
    bf16 *proj, *cqb, *ckvb, *krr; float *ssq_q, *ssq_kv; const float *tabA, *tabC; const float *ssqx, *bias;
    DI void operator()(const f32x4 (&acc0)[2][2][4][2], const pg8::Unit& u, int wr, int wc, int fr, int fq) const {
        const int pn = u.pn; const bool isx = u.pm < 128; const int mi = isx ? (u.pm >> 4) : 8;
        f32x4 bv[2][2];
#pragma unroll
        for (int bj = 0; bj < 2; ++bj)
#pragma unroll
            for (int n = 0; n < 2; ++n) bv[bj][n] = *(const GAS f32x4*)(bias + mi * 2048 + pn * 256 + bj * 128 + wc * 32 + n * 16 + 4 * fq);
        float rsx[2][4];
#pragma unroll
        for (int ai = 0; ai < 2; ++ai)
#pragma unroll
            for (int m = 0; m < 4; ++m) { int row = u.pm * 256 + ai * 128 + wr * 64 + m * 16 + fr; asm volatile("" : "+v"(row)); rsx[ai][m] = ((const GAS float*)ssqx)[row]; }
#pragma unroll
        for (int ai = 0; ai < 2; ++ai)
#pragma unroll
            for (int m = 0; m < 4; ++m) rsx[ai][m] = rsqrtf(rsx[ai][m] * (1.0f / 1024.0f) + EPSN);
        const bool anyrope = isx && pn <= 2;
#pragma unroll
        for (int ai = 0; ai < 2; ++ai)
#pragma unroll
        for (int mh = 0; mh < 2; ++mh) {
            f32x4 cs[4], sn[4];
#pragma unroll
            for (int m = 2 * mh; m < 2 * mh + 2; ++m) { cs[m] = (f32x4){1.f, 1.f, 1.f, 1.f}; sn[m] = (f32x4){0.f, 0.f, 0.f, 0.f}; }
            if (anyrope) {
#pragma unroll
                for (int m = 2 * mh; m < 2 * mh + 2; ++m) { int row = u.pm * 256 + ai * 128 + wr * 64 + m * 16 + fr; asm volatile("" : "+v"(row)); const int tok = row & 4095; const int pos = (wc & 1) ? (tok & 63) : (tok >> 6);
                    cs[m] = *(const GAS f32x4*)(tabA + pos * 32 + 4 * fq); sn[m] = *(const GAS f32x4*)(tabA + pos * 32 + 16 + 4 * fq); }
            }
#pragma unroll
            for (int m = 2 * mh; m < 2 * mh + 2; ++m) {
                int row = u.pm * 256 + ai * 128 + wr * 64 + m * 16 + fr; asm volatile("" : "+v"(row));
                const int tok = row & 4095, prow = tok >> 6, pcol = tok & 63;
                f32x4 acc[2][2];
#pragma unroll
                for (int bj = 0; bj < 2; ++bj)
#pragma unroll
                    for (int n = 0; n < 2; ++n) acc[bj][n] = acc0[ai][bj][m][n] * rsx[ai][m] + bv[bj][n];
                if (pn < 6) {
#pragma unroll
                    for (int bj = 0; bj < 2; ++bj) {
                        f32x4 v0 = acc[bj][0], v1 = acc[bj][1];
                        if (anyrope && (pn < 2 || bj == 0)) { const f32x4 a = v0 * cs[m] - v1 * sn[m], b = v0 * sn[m] + v1 * cs[m]; v0 = a; v1 = b; }
                        if (pn < 2 || pn == 3) { v0 *= C2A; v1 *= C2A; }
                        bf16* p = proj + (size_t)row * PJS + pn * 256 + bj * 128 + wc * 32 + 4 * fq;
                        st4bf(p, v0); st4bf(p + 16, v1);
                    }
                } else if (pn == 6) {
                    float s = 0.f;
#pragma unroll
                    for (int bj = 0; bj < 2; ++bj) {
                        const f32x4 v0 = acc[bj][0], v1 = acc[bj][1];
                        s += (v0[0] * v0[0] + v0[1] * v0[1]) + (v0[2] * v0[2] + v0[3] * v0[3]) + (v1[0] * v1[0] + v1[1] * v1[1]) + (v1[2] * v1[2] + v1[3] * v1[3]);
                        bf16* p = cqb + (size_t)row * 256 + bj * 128 + wc * 32 + 4 * fq;
                        st4bf(p, v0); st4bf(p + 16, v1);
                    }
                    s += __shfl_xor(s, 16); s += __shfl_xor(s, 32);
                    if (fq == 0) atomicAdd(ssq_q + row, s);
                } else {
                    {
                        const f32x4 v0 = acc[0][0], v1 = acc[0][1];
                        float s = (v0[0] * v0[0] + v0[1] * v0[1]) + (v0[2] * v0[2] + v0[3] * v0[3]) + (v1[0] * v1[0] + v1[1] * v1[1]) + (v1[2] * v1[2] + v1[3] * v1[3]);
                        bf16* p = ckvb + (size_t)row * 128 + wc * 32 + 4 * fq;
                        st4bf(p, v0); st4bf(p + 16, v1);
                        s += __shfl_xor(s, 16); s += __shfl_xor(s, 32);
                        if (fq == 0) atomicAdd(ssq_kv + row, s);
                    }
                    if (wc == 0) {
                        f32x4 v0 = acc[1][0], v1 = acc[1][1];
                        if (isx) { v0 = rope8(v0, tabC + prow * 16, fq); v1 = rope8(v1, tabC + pcol * 16, fq); }
                        bf16* p = krr + (size_t)row * 32 + 4 * fq;
                        st4bf(p, v0); st4bf(p + 16, v1);
                    }
                }
            }
        }
    }
};

struct EpiUQ {
    static constexpr bool PERM = false, AFTER_DRAIN = false;
    bf16* qm; const float* ssq_q; const float* tabC;
    DI void operator()(const f32x4 (&acc)[2][2][4][2], const pg8::Unit& u, int wr, int wc, int fr, int fq) const {
        const int pn = u.pn; const bool isx = u.pm < 128;
        float rsq[2][4];
#pragma unroll
        for (int ai = 0; ai < 2; ++ai)
#pragma unroll
            for (int m = 0; m < 4; ++m) { int row = u.pm * 256 + ai * 128 + wr * 64 + m * 16 + fr; asm volatile("" : "+v"(row)); rsq[ai][m] = ((const GAS float*)ssq_q)[row]; }
#pragma unroll
        for (int ai = 0; ai < 2; ++ai)
#pragma unroll
            for (int m = 0; m < 4; ++m) {
                int row = u.pm * 256 + ai * 128 + wr * 64 + m * 16 + fr; asm volatile("" : "+v"(row));
                const int tok = row & 4095, prow = tok >> 6, pcol = tok & 63;
                const float rs = rsqrtf(rsq[ai][m] * (1.0f / 256.0f) + EPSN) * C2C;
#pragma unroll
                for (int bj = 0; bj < 2; ++bj)
#pragma unroll
                    for (int n = 0; n < 2; ++n) {
                        const int col0 = pn * 256 + bj * 128 + wc * 32 + n * 16;
                        if (col0 < 384) {
                            f32x4 v = acc[ai][bj][m][n] * rs;
                            const int g6 = (col0 >> 4) % 6;
                            if (isx && g6 >= 4) v = rope8(v, tabC + (g6 == 4 ? prow : pcol) * 16, fq);
                            st4bf(qm + (size_t)row * 384 + col0 + 4 * fq, v);
                        }
                    }
            }
    }
};

struct EpiUKV {
    static constexpr bool PERM = false, AFTER_DRAIN = false;
    bf16* kvm; const float* ssq_kv;
    DI void operator()(const f32x4 (&acc)[2][2][4][2], const pg8::Unit& u, int wr, int wc, int fr, int fq) const {
        float rsq[2][4];
#pragma unroll
        for (int ai = 0; ai < 2; ++ai)
#pragma unroll
            for (int m = 0; m < 4; ++m) { int row = u.pm * 256 + ai * 128 + wr * 64 + m * 16 + fr; asm volatile("" : "+v"(row)); rsq[ai][m] = ((const GAS float*)ssq_kv)[row]; }
#pragma unroll
        for (int ai = 0; ai < 2; ++ai)
#pragma unroll
            for (int m = 0; m < 4; ++m) {
                int row = u.pm * 256 + ai * 128 + wr * 64 + m * 16 + fr; asm volatile("" : "+v"(row));
                const float rs = rsqrtf(rsq[ai][m] * (1.0f / 128.0f) + EPSN);
#pragma unroll
                for (int bj = 0; bj < 2; ++bj)
#pragma unroll
                    for (int n = 0; n < 2; ++n) {
                        const int col0 = u.pn * 256 + bj * 128 + wc * 32 + n * 16;
                        st4bf(kvm + (size_t)row * 512 + col0 + 4 * fq, acc[ai][bj][m][n] * rs);
                    }
            }
    }
};

struct EpiRelu2 {
    static constexpr bool PERM = true, AFTER_DRAIN = false;
    bf16* H; const float *ssqx, *bias;
    DI void operator()(const f32x4 (&acc)[2][2][4][2], const pg8::Unit& u, int wr, int wc, int fr, int fq) const {
        const int col0 = u.pn * 256 + wc * 32 + 8 * fq; const int mi = (u.pm < 128) ? (u.pm >> 4) : 8;
        f32x4 bv[2][2];
#pragma unroll
        for (int bj = 0; bj < 2; ++bj)
#pragma unroll
            for (int n = 0; n < 2; ++n) bv[bj][n] = *(const GAS f32x4*)(bias + mi * 4096 + col0 + bj * 128 + 4 * n);
        float rsx[2][4];
#pragma unroll
        for (int ai = 0; ai < 2; ++ai)
#pragma unroll
            for (int m = 0; m < 4; ++m) { int row = u.pm * 256 + ai * 128 + wr * 64 + m * 16 + fr; asm volatile("" : "+v"(row)); rsx[ai][m] = ((const GAS float*)ssqx)[row]; }
#pragma unroll
        for (int ai = 0; ai < 2; ++ai)
#pragma unroll
            for (int m = 0; m < 4; ++m) {
                int row = u.pm * 256 + ai * 128 + wr * 64 + m * 16 + fr; asm volatile("" : "+v"(row));
                const float rs = rsqrtf(rsx[ai][m] * (1.0f / 1024.0f) + EPSN);
                bf16* rowp = H + (size_t)row * DFF + col0;
#pragma unroll
                for (int bj = 0; bj < 2; ++bj) {
                    f32x4 v0 = acc[ai][bj][m][0] * rs + bv[bj][0], v1 = acc[ai][bj][m][1] * rs + bv[bj][1];
#pragma unroll
                    for (int j = 0; j < 4; ++j) { const float a = fmaxf(v0[j], 0.f), b = fmaxf(v1[j], 0.f); v0[j] = a * a; v1[j] = b * b; }
                    u32x4 w; w.x = cvtpk(v0[0], v0[1]); w.y = cvtpk(v0[2], v0[3]); w.z = cvtpk(v1[0], v1[1]); w.w = cvtpk(v1[2], v1[3]);
                    *(GAS u32x4*)(rowp + bj * 128) = w;
                }
            }
    }
};

struct EpiResid {
    static constexpr bool PERM = false, AFTER_DRAIN = false;
    const float *srcx, *srcc; float *dstx, *dstc; const float* gate; bf16* xg; float* ssq_out; const float *gn, *scn; int donorm;
    DI void operator()(const f32x4 (&acc)[2][2][4][2], const pg8::Unit& u, int wr, int wc, int fr, int fq) const {
        const bool isx = u.pm < 128; const int mi = isx ? (u.pm >> 4) : 8;
        const int col0 = u.pn * 256 + wc * 32 + 4 * fq;
        f32x4 gv[2][2], gp[2][2];
#pragma unroll
        for (int bj = 0; bj < 2; ++bj)
#pragma unroll
            for (int n = 0; n < 2; ++n) { const int c = col0 + bj * 128 + n * 16; gv[bj][n] = *(const GAS f32x4*)(gate + mi * 6144 + c);
                gp[bj][n] = donorm ? *(const GAS f32x4*)(gn + c) * (*(const GAS f32x4*)(scn + mi * 6144 + c) + 1.0f) : (f32x4){0.f, 0.f, 0.f, 0.f}; }
#pragma unroll
        for (int ai = 0; ai < 2; ++ai)
#pragma unroll
        for (int mh = 0; mh < 2; ++mh) {
            f32x4 xs[4][2][2];
#pragma unroll
            for (int m = 2 * mh; m < 2 * mh + 2; ++m) {
                int row = u.pm * 256 + ai * 128 + wr * 64 + m * 16 + fr; asm volatile("" : "+v"(row));
                const float* s = isx ? srcx + (size_t)row * DM : srcc + (size_t)(row - MX) * DM;
#pragma unroll
                for (int bj = 0; bj < 2; ++bj)
#pragma unroll
                    for (int n = 0; n < 2; ++n) xs[m][bj][n] = *(const GAS f32x4*)(s + col0 + bj * 128 + n * 16);
            }
#pragma unroll
            for (int m = 2 * mh; m < 2 * mh + 2; ++m) {
                int row = u.pm * 256 + ai * 128 + wr * 64 + m * 16 + fr; asm volatile("" : "+v"(row));
                float* d = isx ? dstx + (size_t)row * DM : dstc + (size_t)(row - MX) * DM;
                float ss = 0.f;
#pragma unroll
                for (int bj = 0; bj < 2; ++bj)
#pragma unroll
                    for (int n = 0; n < 2; ++n) { const int off = col0 + bj * 128 + n * 16;
                        const f32x4 xn = xs[m][bj][n] + gv[bj][n] * acc[ai][bj][m][n];
                        *(GAS f32x4*)(d + off) = xn;
                        if (donorm) { ss += (xn[0] * xn[0] + xn[1] * xn[1]) + (xn[2] * xn[2] + xn[3] * xn[3]); st4bf(xg + (size_t)row * DM + off, xn * gp[bj][n]); } }
                if (donorm) { ss += __shfl_xor(ss, 16); ss += __shfl_xor(ss, 32); if (fq == 0) atomicAdd(ssq_out + row, ss); }
            }
        }
    }
};

struct SplitOrder {
    int G, c, NS, ksub_bytes;
    DI void init(int G_, int c_, int NS_, int Ksub) { G = G_; c = c_; NS = NS_; ksub_bytes = Ksub * 2; }
    DI bool next(int i, pg8::Unit& u) const { const int idx = i * G + c; if (idx >= 32 * NS) return false; const int ks = idx % NS, tile = idx / NS; u.pn = tile & 3; u.pm = 128 + (tile >> 2); u.kb = ks * ksub_bytes; return true; }
    DI void a_ready(const pg8::Unit&) const {}
    DI void done(const pg8::Unit&) const {}
};
struct EpiPartial {
    static constexpr bool PERM = false, AFTER_DRAIN = false;
    float* part; int ksub_bytes;
    DI void operator()(const f32x4 (&acc)[2][2][4][2], const pg8::Unit& u, int wr, int wc, int fr, int fq) const {
        const int ks = u.kb / ksub_bytes; const int col0 = u.pn * 256 + wc * 32 + 4 * fq;
        float* base = part + (size_t)ks * MC * DM;
#pragma unroll
        for (int ai = 0; ai < 2; ++ai)
#pragma unroll
            for (int m = 0; m < 4; ++m) {
                int row = (u.pm - 128) * 256 + ai * 128 + wr * 64 + m * 16 + fr;
                asm volatile("" : "+v"(row) :: "memory");
                float* rowp = base + (size_t)row * DM + col0;
#pragma unroll
                for (int bj = 0; bj < 2; ++bj)
#pragma unroll
                    for (int n = 0; n < 2; ++n) *(GAS f32x4*)(rowp + bj * 128 + n * 16) = acc[ai][bj][m][n];
            }
    }
};
DI void ctx_finish(const float* part, int NS, const float* src, float* dst, const float* gate8, bf16* xg, float* ssq_out, const float* gn, const float* scn8, const int tid) {
    const int lane = tid & 63, gw = blockIdx.x * 8 + (tid >> 6), NGW = gridDim.x * 8;
    for (int row = gw; row < MC; row += NGW) {
        float s = 0.f;
#pragma unroll
        for (int j = 0; j < 4; ++j) {
            const int col = 256 * j + 4 * lane;
            f32x4 a = {0.f, 0.f, 0.f, 0.f};
            for (int ks = 0; ks < NS; ++ks) a += *(const GAS f32x4*)(part + ((size_t)ks * MC + row) * DM + col);
            const f32x4 xn = *(const GAS f32x4*)(src + (size_t)row * DM + col) + *(const GAS f32x4*)(gate8 + col) * a;
            *(GAS f32x4*)(dst + (size_t)row * DM + col) = xn;
            s += (xn[0] * xn[0] + xn[1] * xn[1]) + (xn[2] * xn[2] + xn[3] * xn[3]);
            st4bf(xg + (size_t)(MX + row) * DM + col, xn * (*(const GAS f32x4*)(gn + col) * (*(const GAS f32x4*)(scn8 + col) + 1.0f)));
        }
        s = wave_sum(s);
        if (lane == 0) ssq_out[MX + row] = s;
    }
}

DI void transpose_item(const float* W, int K, int N, bf16* WT, const float* kscale, LAS float* scr, int item, int lane) {
    const int nblk = N / 32, kb = item / nblk, nb = item % nblk, k0 = 64 * kb, n0 = 32 * nb;
#pragma unroll 16
    for (int i = 0; i < 32; ++i) { const int kk = 2 * i + (lane >> 5); float w = W[(size_t)(k0 + kk) * N + n0 + (lane & 31)]; if (kscale) w *= kscale[k0 + kk]; scr[kk * 33 + (lane & 31)] = w; }
    LDS_WAIT();
    const int c = lane & 7;
#pragma unroll
    for (int j = 0; j < 4; ++j) { const int n = (lane >> 3) + 8 * j; const LAS float* s = scr + (8 * c) * 33 + n;
        u32x4 o; o.x = cvtpk(s[0 * 33], s[1 * 33]); o.y = cvtpk(s[2 * 33], s[3 * 33]); o.z = cvtpk(s[4 * 33], s[5 * 33]); o.w = cvtpk(s[6 * 33], s[7 * 33]);
        *(u32x4*)(WT + (size_t)(n0 + n) * K + k0 + 8 * c) = o; }
    LDS_WAIT();
}

DI void gemv9_item(const float* W, int ldw, int nvalid, int n0, const LAS float* sl, LAS float* red, const float* addb, float* out, int ldo, const int tid) {
    const int col = tid & 31, kg = tid >> 5, n = n0 + col;
    float acc[9];
#pragma unroll
    for (int mi = 0; mi < 9; ++mi) acc[mi] = 0.f;
    if (n < nvalid) {
        const float* w = W + (size_t)(kg * 64) * ldw + n;
#pragma unroll 16
        for (int k = 0; k < 64; ++k) { const float wv = w[(size_t)k * ldw];
#pragma unroll
            for (int mi = 0; mi < 9; ++mi) acc[mi] += sl[mi * 1024 + kg * 64 + k] * wv; }
    }
#pragma unroll
    for (int mi = 0; mi < 9; ++mi) red[(kg * 9 + mi) * 32 + col] = acc[mi];
    __syncthreads();
    if (tid < 288) { const int mi = tid >> 5, cq = tid & 31; float sacc = (addb && n0 + cq < nvalid) ? addb[n0 + cq] : 0.f;
#pragma unroll
        for (int g = 0; g < 16; ++g) sacc += red[(g * 9 + mi) * 32 + cq];
        out[(size_t)mi * ldo + n0 + cq] = sacc; }
    __syncthreads();
}

struct Args { const float* in[19]; float* out; unsigned char* ws; int ph_lo, ph_hi; };

DI void prologue(const Args& a, LAS unsigned char* lds, const int tid) {
    const int lane = tid & 63, wave = __builtin_amdgcn_readfirstlane(tid >> 6);
    int G = gridDim.x; asm volatile("" : "+s"(G));
    const int bx = blockIdx.x;
    unsigned char* ws = a.ws;
    {
        LAS float* sl = (LAS float*)lds;
        LAS float* red = (LAS float*)(lds + 36864);
        const float* c = a.in[1]; const float* cc = a.in[3]; const float* w_ada = a.in[4]; const float* b_ada = a.in[5];
        float* mods = (float*)(ws + WS_MODS);
        for (int idx = tid; idx < 9 * 1024; idx += NTHR) { const int mi = idx >> 10, k = idx & 1023; const float v = mi < 8 ? c[mi * 1024 + k] : cc[k]; sl[idx] = v / (1.0f + expf(-v)); }
        __syncthreads();
        for (int item = bx; item < DEPTH * 192; item += G) {
            const int l = item / 192, n0 = (item % 192) * 32;
            gemv9_item(w_ada + (size_t)l * 1024 * 6144, 6144, 6144, n0, sl, red, b_ada + l * 6144, mods + (size_t)l * 9 * 6144, 6144, tid);
        }
    }
    {
        const int gid = bx * NTHR + tid, NG = G * NTHR;
        float* tabA = (float*)(ws + WS_TAB); float* tabC = tabA + 2048;
        if (gid < 1024) { const int pos = gid >> 4, i = gid & 15; const float fr = exp2f(-(float)i * (1.0f / 16.0f) * 13.287712379549449f); const float rev = ((float)pos * fr) * 0.15915494309189535f;
            tabA[pos * 32 + i] = __builtin_amdgcn_cosf(rev); tabA[pos * 32 + 16 + i] = __builtin_amdgcn_sinf(rev); }
        else if (gid < 1536) { const int g = gid - 1024, pos = g >> 3, i = g & 7; const float fr = exp2f(-(float)i * (1.0f / 8.0f) * 13.287712379549449f); const float rev = ((float)pos * fr) * 0.15915494309189535f;
            tabC[pos * 16 + i] = __builtin_amdgcn_cosf(rev); tabC[pos * 16 + 8 + i] = __builtin_amdgcn_sinf(rev); }
        float* ssq = (float*)(ws + WS_SSQ);
        for (int i = gid; i < DEPTH * 2 * MT; i += NG) ssq[i] = 0.f;
        float* ssqx = (float*)(ws + WS_SSQX);
        for (int i = gid; i < DEPTH * 2 * MT; i += NG) ssqx[i] = 0.f;
        const u32x4 z = {0u, 0u, 0u, 0u};
        for (int i = gid; i < DEPTH * 12288; i += NG) { const int l = i / 12288, r = i % 12288; ((u32x4*)(ws + WS_W + l * WL_STRIDE + WL_IN + (size_t)INW * 1024 * 2))[r] = z; }
        for (int i = gid; i < DEPTH * 4096; i += NG) { const int l = i / 4096, r = i % 4096; ((u32x4*)(ws + WS_W + l * WL_STRIDE + WL_UQ + (size_t)384 * 256 * 2))[r] = z; }
    }
    {
        LAS float* scr = (LAS float*)(lds + wave * 16384);
        const int gw = bx * 8 + wave, NGW = G * 8;
        constexpr int I_IN = 16 * 61, I_OUT = 16 * 32, I_W1 = 16 * 128, I_W2 = 64 * 32, I_UQ = 4 * 12, I_UKV = 2 * 16, I_L = I_IN + I_OUT + I_W1 + I_W2 + I_UQ + I_UKV;
        for (int it = gw; it < DEPTH * I_L; it += NGW) {
            const int l = it / I_L; int r = it % I_L; unsigned char* wb = ws + WS_W + l * WL_STRIDE;
            if (r < I_IN) { transpose_item(a.in[8] + (size_t)l * 1024 * INW, 1024, INW, (bf16*)(wb + WL_IN), nullptr, scr, r, lane); continue; } r -= I_IN;
            if (r < I_OUT) { transpose_item(a.in[15] + (size_t)l * 1024 * 1024, 1024, 1024, (bf16*)(wb + WL_OUT), nullptr, scr, r, lane); continue; } r -= I_OUT;
            if (r < I_W1) { transpose_item(a.in[16] + (size_t)l * 1024 * 4096, 1024, 4096, (bf16*)(wb + WL_W1), nullptr, scr, r, lane); continue; } r -= I_W1;
            if (r < I_W2) { transpose_item(a.in[17] + (size_t)l * 4096 * 1024, 4096, 1024, (bf16*)(wb + WL_W2), nullptr, scr, r, lane); continue; } r -= I_W2;
            if (r < I_UQ) { transpose_item(a.in[12] + (size_t)l * 256 * 384, 256, 384, (bf16*)(wb + WL_UQ), a.in[11] + l * 256, scr, r, lane); continue; } r -= I_UQ;
            transpose_item(a.in[14] + (size_t)l * 128 * 512, 128, 512, (bf16*)(wb + WL_UKV), a.in[13] + l * 128, scr, r, lane);
        }
    }
}

DI void phase1(const Args& a, LAS unsigned char* lds, const int tid) {
    unsigned char* ws = a.ws;
    int G = gridDim.x; asm volatile("" : "+s"(G));
    const int bx = blockIdx.x;
    const float* mods = (const float*)(ws + WS_MODS);
    {
        LAS float* sl = (LAS float*)lds; LAS float* red = (LAS float*)(lds + 36864);
        float* bias1 = (float*)(ws + WS_BIAS1); float* bias4 = (float*)(ws + WS_BIAS4);
        for (int item = bx; item < DEPTH * 192; item += G) {
            const int l = item / 192, r = item % 192, which = r < 64 ? 0 : 1, tile = which ? r - 64 : r;
            const float* mv = mods + (size_t)l * 9 * 6144 + (which ? 3 : 0) * 1024;
            for (int idx = tid; idx < 9 * 1024; idx += NTHR) sl[idx] = mv[(size_t)(idx >> 10) * 6144 + (idx & 1023)];
            __syncthreads();
            if (!which) gemv9_item(a.in[8] + (size_t)l * 1024 * INW, INW, INW, tile * 32, sl, red, nullptr, bias1 + (size_t)l * 9 * 2048, 2048, tid);
            else gemv9_item(a.in[16] + (size_t)l * 1024 * DFF, DFF, DFF, tile * 32, sl, red, nullptr, bias4 + (size_t)l * 9 * 4096, 4096, tid);
        }
    }
    {
        const int lane = tid & 63, gw = bx * 8 + (tid >> 6), NGW = G * 8;
        bf16* Hn = (bf16*)(ws + WS_HN); float* ssqx = (float*)(ws + WS_SSQX); const float* g = a.in[6];
        f32x4 gg[4];
#pragma unroll
        for (int j = 0; j < 4; ++j) gg[j] = *(const GAS f32x4*)(g + 256 * j + 4 * lane);
        for (int row0 = gw; row0 < MT; row0 += 4 * NGW) {
            f32x4 v[4][4];
#pragma unroll
            for (int q = 0; q < 4; ++q) { const int row = row0 + q * NGW;
                if (row < MT) { const float* src = row < MX ? a.in[0] + (size_t)row * DM : a.in[2] + (size_t)(row - MX) * DM;
                    const GAS f32x4* xr = (const GAS f32x4*)src + lane;
#pragma unroll
                    for (int j = 0; j < 4; ++j) v[q][j] = xr[64 * j]; } }
#pragma unroll
            for (int q = 0; q < 4; ++q) { const int row = row0 + q * NGW;
                if (row < MT) { const int mi = row < MX ? (row >> 12) : 8; float s = 0.f;
#pragma unroll
                    for (int j = 0; j < 4; ++j) s += (v[q][j][0] * v[q][j][0] + v[q][j][1] * v[q][j][1]) + (v[q][j][2] * v[q][j][2] + v[q][j][3] * v[q][j][3]);
                    s = wave_sum(s);
                    if (lane == 0) ssqx[row] = s;
                    const float* mrow = mods + (size_t)mi * 6144 + 1024;
#pragma unroll
                    for (int j = 0; j < 4; ++j) { const int col = 256 * j + 4 * lane;
                        const f32x4 sc = *(const GAS f32x4*)(mrow + col);
                        st4bf(Hn + (size_t)row * DM + col, v[q][j] * (gg[j] * (sc + 1.0f))); } } }
        }
    }
}
DI void final_norm_phase(float* x, const float* g, const int tid) {
    const int lane = tid & 63, gw = blockIdx.x * 8 + (tid >> 6), NGW = gridDim.x * 8;
    f32x4 gg[4];
#pragma unroll
    for (int j = 0; j < 4; ++j) gg[j] = *(const GAS f32x4*)(g + 256 * j + 4 * lane);
    for (int row0 = gw; row0 < MX; row0 += 4 * NGW) {
        f32x4 v[4][4];
#pragma unroll
        for (int q = 0; q < 4; ++q) { const int row = row0 + q * NGW;
            if (row < MX) { const GAS f32x4* xr = (const GAS f32x4*)(x + (size_t)row * DM) + lane;
#pragma unroll
                for (int j = 0; j < 4; ++j) v[q][j] = xr[64 * j]; } }
#pragma unroll
        for (int q = 0; q < 4; ++q) { const int row = row0 + q * NGW;
            if (row < MX) { float s = 0.f;
#pragma unroll
                for (int j = 0; j < 4; ++j) s += (v[q][j][0] * v[q][j][0] + v[q][j][1] * v[q][j][1]) + (v[q][j][2] * v[q][j][2] + v[q][j][3] * v[q][j][3]);
                const float r = rsqrtf(wave_sum(s) * (1.0f / DM) + EPSN);
                GAS f32x4* xw = (GAS f32x4*)(x + (size_t)row * DM) + lane;
#pragma unroll
                for (int j = 0; j < 4; ++j) xw[64 * j] = v[q][j] * r * gg[j]; } }
    }
}

struct AttnP { const bf16 *proj, *qm, *kvm, *krr; bf16* mix; const float* sink; const float* rpb; };
constexpr int A_VS = 144, A_KB = 64 * 208, A_VB = 64 * A_VS, L_K = 0, L_V = 2 * A_KB, L_B = L_V + 2 * A_VB;

template <int TYPE> DI int key_row(int t, int j, int b, int nblk, int kr0, int kc0) {
    if (t < 4) return MX + b * 256 + t * 64 + j;
    const int tt = t - 4;
    if (TYPE == 0) return b * 4096 + (nblk - 1) * 128 + tt * 64 + j;
    if (TYPE == 1) { const int tr = tt / 3, tc = tt - 3 * tr; return b * 4096 + (kr0 + 4 * tr + (j >> 4)) * 64 + kc0 + 16 * tc + (j & 15); }
    if (TYPE == 3) { const int tr = tt >> 1, tc = tt & 1; return b * 4096 + (kr0 + 4 * tr + (j >> 4)) * 64 + kc0 + 16 * tc + (j & 15); }
    return b * 4096 + tt * 64 + j;
}

constexpr float ATHR = 6.0f;
#define AT_LDS_BARRIER() asm volatile("s_waitcnt lgkmcnt(0)\n\ts_barrier" ::: "memory")
template <int TYPE> struct AttnCtx { int t_qi, t_h, kr0, kc0, qr, qc, wr_, wc_; };

#define AT_SB() __builtin_amdgcn_sched_barrier(0)
template <int TYPE, int NKS, int KSTR> DI void at_mfma_block(f32x16& p0, f32x16& p1, f32x16& o0, f32x16& o1, const bf16x8 (&qf)[NKS], const bf16x8 (&pf)[4], float m_,
                                                             const LAS unsigned char* kb0, const LAS unsigned char* vb, bool do_s, bool do_pv) {
    constexpr int NST = NKS + 4, PD = (TYPE == 3) ? 1 : 2;
    bf16x8 fr[NST][2];
    const int first = do_s ? 0 : NKS, last = do_pv ? NST : NKS;
#define AT_LD(i_) do { if ((i_) >= first && (i_) < last) { \
        if ((i_) < NKS) { fr[i_][0] = *(const LAS bf16x8*)(kb0 + (i_) * 32); fr[i_][1] = *(const LAS bf16x8*)(kb0 + 32 * KSTR + (i_) * 32); } \
        else { const int s_ = (i_) - NKS; \
            const s16x4 l0_ = __builtin_bit_cast(s16x4, __builtin_amdgcn_ds_read_tr16_b64_v4i16((LAS s16x4*)(vb + (16 * s_) * A_VS))); \
            const s16x4 h0_ = __builtin_bit_cast(s16x4, __builtin_amdgcn_ds_read_tr16_b64_v4i16((LAS s16x4*)(vb + (16 * s_ + 8) * A_VS))); \
            const s16x4 l1_ = __builtin_bit_cast(s16x4, __builtin_amdgcn_ds_read_tr16_b64_v4i16((LAS s16x4*)(vb + (16 * s_) * A_VS + 64))); \
            const s16x4 h1_ = __builtin_bit_cast(s16x4, __builtin_amdgcn_ds_read_tr16_b64_v4i16((LAS s16x4*)(vb + (16 * s_ + 8) * A_VS + 64))); \
            fr[i_][0] = __builtin_shufflevector(l0_, h0_, 0, 1, 2, 3, 4, 5, 6, 7); fr[i_][1] = __builtin_shufflevector(l1_, h1_, 0, 1, 2, 3, 4, 5, 6, 7); } } } while (0)
    if (do_s) {
        const float nm = -m_;
#pragma unroll
        for (int i = 0; i < 16; ++i) { p0[i] = nm; p1[i] = nm; }
    }
#pragma unroll
    for (int i = 0; i < NST; ++i) {
        if (i == 0) { AT_LD(0); if (PD > 1) AT_LD(1); }
        if (i + PD < NST) AT_LD(i + PD);
        AT_SB();
        if (i >= first && i < last) {
            if (i < NKS) { p0 = __builtin_amdgcn_mfma_f32_32x32x16_bf16(fr[i][0], qf[i < NKS ? i : 0], p0, 0, 0, 0); p1 = __builtin_amdgcn_mfma_f32_32x32x16_bf16(fr[i][1], qf[i < NKS ? i : 0], p1, 0, 0, 0); }
            else { o0 = __builtin_amdgcn_mfma_f32_32x32x16_bf16(fr[i][0], pf[i >= NKS ? i - NKS : 0], o0, 0, 0, 0); o1 = __builtin_amdgcn_mfma_f32_32x32x16_bf16(fr[i][1], pf[i >= NKS ? i - NKS : 0], o1, 0, 0, 0); }
        }
        AT_SB();
    }
#undef AT_LD
}

template <int TYPE, bool GUARD> DI void at_valu_block(f32x16& p0, f32x16& p1, f32x16& o0, f32x16& o1, bf16x8 (&pf)[4], float& m_, float& l_, int t, bool first,
                                          int qi, int h, int kr0, int kc0, int qr, int qc, int wr_, int wc_, const LAS float* lbias) {
    if (t >= 4) {
        if (TYPE == 0) {
            const int d0 = 64 * (t - 4) - qi + 4 * h;
#pragma unroll
            for (int i = 0; i < 16; ++i) { const int e = d0 + (i & 3) + 8 * (i >> 2);
                if ((unsigned)e > 256u) p0[i] = -1e30f;
                if ((unsigned)(e + 32) > 256u) p1[i] = -1e30f; }
        } else if (TYPE == 1 || TYPE == 3) {
            const int tt = t - 4, tr = (TYPE == 3) ? (tt >> 1) : tt / 3, tc = (TYPE == 3) ? (tt & 1) : tt - 3 * tr;
            const int krb = kr0 + 4 * tr, kcb = kc0 + 16 * tc + 4 * h;
#pragma unroll
            for (int i = 0; i < 16; ++i) {
                const int kc = kcb + (i & 3) + 8 * ((i >> 2) & 1);
                const bool cv = (unsigned)(kc - wc_) < 16u;
                const int ci = kc - qc + 15;
                { const int kr = krb + (i >> 3); const bool v = cv && ((unsigned)(kr - wr_) < 8u); const int idx = v ? (kr - qr + 7) * 31 + ci : 0; const float bv = lbias[idx]; p0[i] = v ? p0[i] + bv : -1e30f; }
                { const int kr = krb + 2 + (i >> 3); const bool v = cv && ((unsigned)(kr - wr_) < 8u); const int idx = v ? (kr - qr + 7) * 31 + ci : 0; const float bv = lbias[idx]; p1[i] = v ? p1[i] + bv : -1e30f; }
            }
        }
    }
    if (GUARD) asm volatile("s_nop 15\n\ts_nop 7" : "+v"(p0), "+v"(p1));
    float mxa = max3f(p0[0], p0[1], p1[0]), mxb = max3f(p0[2], p0[3], p1[1]); mxa = max3f(mxa, p1[2], p1[3]);
#pragma unroll
    for (int i = 4; i < 16; i += 4) { mxa = max3f(mxa, p0[i], p0[i + 1]); mxb = max3f(mxb, p0[i + 2], p0[i + 3]); mxa = max3f(mxa, p1[i], p1[i + 1]); mxb = max3f(mxb, p1[i + 2], p1[i + 3]); }
    float mx = max3f(mxa, mxb, mxb);
    mx = max3f(mx, __shfl_xor(mx, 32), mx);
    if (first || __any(mx > ATHR)) {
        const float dl = (TYPE != 0 && first) ? mx : fmaxf(mx, 0.f);
        const float alpha = fexp2(-dl);
        m_ += dl; l_ *= alpha;
#pragma unroll
        for (int i = 0; i < 16; ++i) { p0[i] -= dl; p1[i] -= dl; o0[i] *= alpha; o1[i] *= alpha; }
    }
    float ls = 0.f;
#pragma unroll
    for (int i = 0; i < 16; ++i) { p0[i] = fexp2(p0[i]); p1[i] = fexp2(p1[i]); ls += p0[i] + p1[i]; }
    l_ += ls;
#pragma unroll
    for (int s = 0; s < 4; ++s) {
        u32x4 pw;
        if (s < 2) { pw.x = cvtpk(p0[8 * s + 0], p0[8 * s + 1]); pw.y = cvtpk(p0[8 * s + 2], p0[8 * s + 3]); pw.z = cvtpk(p0[8 * s + 4], p0[8 * s + 5]); pw.w = cvtpk(p0[8 * s + 6], p0[8 * s + 7]); }
        else { const int s2 = s - 2; pw.x = cvtpk(p1[8 * s2 + 0], p1[8 * s2 + 1]); pw.y = cvtpk(p1[8 * s2 + 2], p1[8 * s2 + 3]); pw.z = cvtpk(p1[8 * s2 + 4], p1[8 * s2 + 5]); pw.w = cvtpk(p1[8 * s2 + 6], p1[8 * s2 + 7]); }
        pf[s] = __builtin_bit_cast(bf16x8, pw);
    }
}

template <int TYPE> DI void attn_unit(const AttnP& P, int uid, bool isctx, LAS unsigned char* lds, const int tid) {
    constexpr int DQK = TYPE == 2 ? 96 : 64, NKS = DQK / 16, KSTR = DQK * 2 + 16;
    const int lane = tid & 63, w = __builtin_amdgcn_readfirstlane(tid >> 6), r = lane & 31, h = lane >> 5;
    int b, hd, kvh = 0, qrow, nblk = 0, kr0 = 0, kc0 = 0, qr = 0, qc = 0, tb0 = 4, tb1 = 4;
    if (TYPE == 0) {
        int gp;
        if (!isctx) { b = uid >> 7; kvh = (uid >> 6) & 1; nblk = (uid >> 1) & 31; gp = uid & 1; qrow = b * 4096 + nblk * 128 + (w & 3) * 32 + r; tb0 = nblk == 0 ? 6 : 4; tb1 = nblk == 31 ? 8 : 10; }
        else { b = uid >> 3; kvh = (uid >> 2) & 1; gp = (uid >> 1) & 1; nblk = uid & 1; qrow = MX + b * 256 + nblk * 128 + (w & 3) * 32 + r; }
        hd = kvh * 4 + gp * 2 + (w >> 2);
    } else if (TYPE == 1 || TYPE == 3) {
        if (!isctx) { b = uid >> 6; hd = (uid >> 4) & 3; const int ib = (uid >> 1) & 7, cp = uid & 1;
            qr = 8 * ib + 2 * (w & 3) + (r >> 4); qc = 16 * (2 * cp + (w >> 2)) + (r & 15); qrow = b * 4096 + qr * 64 + qc;
            kr0 = min(max(8 * ib - 4, 0), 48);
            if (TYPE == 3) { kc0 = min(max(16 * (2 * cp + (w >> 2)) - 8, 0), 32); tb1 = 12; }
            else { kc0 = 16 * cp; tb1 = 16; } }
        else { b = uid >> 2; hd = uid & 3; qrow = MX + b * 256 + w * 32 + r; }
    } else {
        if (!isctx) { b = uid >> 6; hd = (uid >> 4) & 3; qrow = b * 4096 + (uid & 15) * 256 + w * 32 + r; tb1 = 68; }
        else { b = uid >> 2; hd = uid & 3; qrow = MX + b * 256 + w * 32 + r; }
    }
    const int NTA = 4 + (tb1 - tb0);
    const bf16* qp; int ocol;
    if (TYPE == 0) { qp = P.proj + (size_t)qrow * PJS + hd * 64; ocol = hd * 64; }
    else if (TYPE == 1 || TYPE == 3) { qp = P.proj + (size_t)qrow * PJS + 768 + hd * 64; ocol = 512 + hd * 64; }
    else { qp = P.qm + (size_t)qrow * 384 + hd * 96; ocol = 768 + hd * 64; }
    bf16x8 qf[NKS];
#pragma unroll
    for (int ks = 0; ks < NKS; ++ks) qf[ks] = *(const GAS bf16x8*)(qp + 16 * ks + 8 * h);

    float m_ = 0.f, l_ = 0.f;
    if (TYPE == 0) { m_ = P.sink[hd] * LOG2E; l_ = (h == 0) ? 1.f : 0.f; }
    f32x16 o0, o1, p0, p1;
#pragma unroll
    for (int i = 0; i < 16; ++i) { o0[i] = 0.f; o1[i] = 0.f; p0[i] = 0.f; p1[i] = 0.f; }
    bf16x8 pf[4];
#pragma unroll
    for (int s = 0; s < 4; ++s) pf[s] = (bf16x8){0, 0, 0, 0, 0, 0, 0, 0};

    u32x4 kreg, vreg, rreg = {0u, 0u, 0u, 0u}, kreg2, vreg2;
    constexpr int A_HALF = 2 * A_KB + 2 * A_VB;
    const int HB = (TYPE == 3) ? (w >> 2) * A_HALF : 0;
    const int sj = (TYPE == 3) ? ((tid & 255) >> 3) : (tid >> 3), sc = tid & 7;
#define AT_TILE(it_) ((it_) < 4 ? (it_) : (it_) - 4 + tb0)
#define AT_LOADK(t) do { const int kr_ = key_row<TYPE>((t), sj, b, nblk, kr0, kc0); \
        if (TYPE == 2) { kreg = *(const GAS u32x4*)(P.kvm + (size_t)kr_ * 512 + hd * 128 + sc * 8); \
            if (tid < 256) { const int kr2_ = key_row<TYPE>((t), tid >> 2, b, nblk, kr0, kc0); rreg = *(const GAS u32x4*)(P.krr + (size_t)kr2_ * 32 + (tid & 3) * 8); } } \
        else { kreg = *(const GAS u32x4*)(P.proj + (size_t)kr_ * PJS + (TYPE == 0 ? 512 + kvh * 64 : 1024 + hd * 64) + sc * 8); \
            if (TYPE == 3) { const int kr2_ = key_row<TYPE>((t), sj + 32, b, nblk, kr0, kc0); kreg2 = *(const GAS u32x4*)(P.proj + (size_t)kr2_ * PJS + 1024 + hd * 64 + sc * 8); } } } while (0)
#define AT_LOADV(t) do { const int kr_ = key_row<TYPE>((t), sj, b, nblk, kr0, kc0); \
        if (TYPE == 2) vreg = *(const GAS u32x4*)(P.kvm + (size_t)kr_ * 512 + hd * 128 + 64 + sc * 8); \
        else { vreg = *(const GAS u32x4*)(P.proj + (size_t)kr_ * PJS + (TYPE == 0 ? 640 + kvh * 64 : 1280 + hd * 64) + sc * 8); \
            if (TYPE == 3) { const int kr2_ = key_row<TYPE>((t), sj + 32, b, nblk, kr0, kc0); vreg2 = *(const GAS u32x4*)(P.proj + (size_t)kr2_ * PJS + 1280 + hd * 64 + sc * 8); } } } while (0)
#define AT_STOREK(bi) do { *(LAS u32x4*)(lds + HB + L_K + (bi) * A_KB + sj * KSTR + sc * 16) = kreg; \
        if (TYPE == 3) *(LAS u32x4*)(lds + HB + L_K + (bi) * A_KB + (sj + 32) * KSTR + sc * 16) = kreg2; \
        if (TYPE == 2) { if (tid < 256) *(LAS u32x4*)(lds + L_K + (bi) * A_KB + (tid >> 2) * KSTR + 128 + (tid & 3) * 16) = rreg; } } while (0)
#define AT_STOREV(bi) do { *(LAS u32x4*)(lds + HB + L_V + (bi) * A_VB + sj * A_VS + sc * 16) = vreg; \
        if (TYPE == 3) *(LAS u32x4*)(lds + HB + L_V + (bi) * A_VB + (sj + 32) * A_VS + sc * 16) = vreg2; } while (0)
    AT_LOADK(0);
    __syncthreads();
    LAS float* lbias = (LAS float*)(lds + (TYPE == 3 ? 2 * A_HALF : L_B));
    if ((TYPE == 1 || TYPE == 3) && !isctx) { if (tid < 465) lbias[tid] = ((const GAS float*)P.rpb)[hd * 465 + tid] * LOG2E; }
    AT_STOREK(0);
    AT_LOADK(AT_TILE(1)); AT_LOADV(0);
    AT_LDS_BARRIER();
    const int q4 = (lane & 15) >> 2, p4 = lane & 3, blk = (lane >> 4) & 1;
    const int voff = HB + L_V + (4 * h + q4) * A_VS + (16 * blk + 4 * p4) * 2;
    const int koff = HB + L_K + r * KSTR + 16 * h;
    const int wr_ = min(max(qr - 4, 0), 56), wc_ = min(max(qc - 8, 0), 48);
    const int qi = (w & 3) * 32 + r;
    const bool grp1 = (w >> 2) != 0;

#define AT_STAGE(it) do { if ((it) + 1 < NTA) AT_STOREK(((it) + 1) & 1); AT_STOREV((it) & 1); \
        if ((it) + 2 < NTA) AT_LOADK(AT_TILE((it) + 2)); if ((it) + 1 < NTA) AT_LOADV(AT_TILE((it) + 1)); AT_LDS_BARRIER(); } while (0)
    if (!grp1) {
        for (int it = 0; it < NTA; ++it) {
            const int t = AT_TILE(it);
            const LAS unsigned char* kb0 = lds + (it & 1) * A_KB + koff;
            const LAS unsigned char* vb = lds + ((it + 1) & 1) * A_VB + voff;
            at_mfma_block<TYPE, NKS, KSTR>(p0, p1, o0, o1, qf, pf, m_, kb0, vb, true, it > 0);
            at_valu_block<TYPE, true>(p0, p1, o0, o1, pf, m_, l_, t, it == 0, qi, h, kr0, kc0, qr, qc, wr_, wc_, lbias);
            AT_STAGE(it);
        }
        const LAS unsigned char* vb = lds + ((NTA - 1) & 1) * A_VB + voff;
        at_mfma_block<TYPE, NKS, KSTR>(p0, p1, o0, o1, qf, pf, m_, vb, vb, false, true);
    } else {
        for (int it = 0; it < NTA; ++it) {
            const int tp = AT_TILE(it - 1);
            const LAS unsigned char* kb0 = lds + (it & 1) * A_KB + koff;
            const LAS unsigned char* vb = lds + ((it + 1) & 1) * A_VB + voff;
            if (it > 0) at_valu_block<TYPE, false>(p0, p1, o0, o1, pf, m_, l_, tp, it == 1, qi, h, kr0, kc0, qr, qc, wr_, wc_, lbias);
            at_mfma_block<TYPE, NKS, KSTR>(p0, p1, o0, o1, qf, pf, m_, kb0, vb, true, it > 0);
            AT_STAGE(it);
        }
        const LAS unsigned char* vb = lds + ((NTA - 1) & 1) * A_VB + voff;
        at_valu_block<TYPE, false>(p0, p1, o0, o1, pf, m_, l_, AT_TILE(NTA - 1), false, qi, h, kr0, kc0, qr, qc, wr_, wc_, lbias);
        at_mfma_block<TYPE, NKS, KSTR>(p0, p1, o0, o1, qf, pf, m_, vb, vb, false, true);
    }
#undef AT_STAGE
#undef AT_LOADK
#undef AT_LOADV
#undef AT_STOREK
#undef AT_STOREV
#undef AT_TILE
    const float lt = l_ + __shfl_xor(l_, 32), inv = 1.0f / lt;
    bf16* op = P.mix + (size_t)qrow * DM + ocol + 4 * h;
#pragma unroll
    for (int g = 0; g < 4; ++g) {
        const f32x4 v0 = {o0[4 * g] * inv, o0[4 * g + 1] * inv, o0[4 * g + 2] * inv, o0[4 * g + 3] * inv};
        const f32x4 v1 = {o1[4 * g] * inv, o1[4 * g + 1] * inv, o1[4 * g + 2] * inv, o1[4 * g + 3] * inv};
        st4bf(op + 8 * g, v0); st4bf(op + 32 + 8 * g, v1);
    }
}

DI void attn_phase(const AttnP& P, bool last, LAS unsigned char* lds, const int tid_in) {
    const int G = gridDim.x, bx = blockIdx.x;
    const int vcu = (G % 8 == 0) ? (bx % 8) * (G / 8) + bx / 8 : bx;
    const int NU = 2048 + (last ? 0 : 128);
    for (int u = vcu; u < NU; u += G) {
        int tid = tid_in; asm volatile("" : "+v"(tid));
        if (u < 512) attn_unit<2>(P, u, false, lds, tid);
        else if (u < 1024) attn_unit<3>(P, u - 512, false, lds, tid);
        else if (u < 2048) attn_unit<0>(P, u - 1024, false, lds, tid);
        else if (u < 2080) attn_unit<2>(P, u - 2048, true, lds, tid);
        else if (u < 2112) attn_unit<1>(P, u - 2080, true, lds, tid);
        else attn_unit<0>(P, u - 2112, true, lds, tid);
    }
}

#define XB_TMO      128
#define XB_XCNT(j)  (256  + 64 * (j))
#define XB_XSUB(j)  (1280 + 64 * (j))
#define XB_XGEN(j)  (2304 + 64 * (j))
#define XB_TOP      3328
#define XB_TOPGEN   3392
#define XCD_BAR_WORDS 3456
#define XB_SPIN_CAP (1u << 18)

__device__ __forceinline__ unsigned xb_ld(unsigned* p)              { return __hip_atomic_load(p, __ATOMIC_RELAXED, __HIP_MEMORY_SCOPE_AGENT); }
__device__ __forceinline__ unsigned xb_add(unsigned* p, unsigned v) { return __hip_atomic_fetch_add(p, v, __ATOMIC_RELAXED, __HIP_MEMORY_SCOPE_AGENT); }
__device__ __forceinline__ unsigned xb_xcc_id() { return (unsigned)__builtin_amdgcn_s_getreg((3 << 11) | 20) & 0xFu; }
#define XB_SPIN(cond, bar) do { unsigned _sp = 0; while (cond) { __builtin_amdgcn_s_sleep(1); \
    if ((++_sp & 255u) == 0u) { if (xb_ld(&(bar)[XB_TMO])) break; if (_sp > XB_SPIN_CAP) { atomicAdd(&(bar)[XB_TMO], 1u); break; } } } } while (0)

struct XcdBarrier {
    unsigned* bar; unsigned x;
    volatile LAS unsigned* st;
};

__device__ __forceinline__ XcdBarrier xcd_barrier_post(unsigned* bar, volatile LAS unsigned* st) {
    XcdBarrier b; b.bar = bar; b.x = xb_xcc_id(); b.st = st;
    if (threadIdx.x == 0) (void)xb_add(&bar[XB_XCNT(b.x)], 1u);
    return b;
}
__device__ __forceinline__ void xcd_barrier_complete(unsigned* bar, unsigned x, unsigned& nloc, unsigned& nx) {
    const unsigned G = gridDim.x * gridDim.y * gridDim.z;
    unsigned sum, cnt, mine, sp = 0u;
    for (;;) {
        sum = 0u; cnt = 0u; mine = 0u;
#pragma unroll
        for (unsigned j = 0; j < 16; ++j) { const unsigned c = xb_ld(&bar[XB_XCNT(j)]); sum += c; cnt += (c > 0u) ? 1u : 0u; mine = (j == x) ? c : mine; }
        if (sum == G) break;
        __builtin_amdgcn_s_sleep(1);
        if ((++sp & 255u) == 0u) { if (xb_ld(&bar[XB_TMO])) break; if (sp > XB_SPIN_CAP) { atomicAdd(&bar[XB_TMO], 1u); break; } }
    }
    nloc = mine > 0u ? mine : 1u; nx = cnt > 0u ? cnt : 1u;
}

__device__ __forceinline__ void xcd_barrier(const XcdBarrier& b) {
    asm volatile("s_waitcnt vmcnt(0)" ::: "memory");
    __syncthreads();
    if (threadIdx.x == 0) {
        unsigned* bar = b.bar;
        __builtin_amdgcn_s_waitcnt(0);
        unsigned nloc = b.st[0], nx = b.st[1];
        if (nloc == 0u) { xcd_barrier_complete(bar, b.x, nloc, nx); b.st[0] = nloc; b.st[1] = nx; }
        const unsigned old = xb_add(&bar[XB_XSUB(b.x)], 1u);
        const unsigned gen = old / nloc;
        if (old + 1u == (gen + 1u) * nloc) {
            __builtin_amdgcn_fence(__ATOMIC_RELEASE, "agent");
            asm volatile("s_waitcnt vmcnt(0)" ::: "memory");
            const unsigned og = xb_add(&bar[XB_TOP], 1u);
            const unsigned tg = og / nx;
            if (og + 1u == (tg + 1u) * nx) xb_add(&bar[XB_TOPGEN], 1u);
            else XB_SPIN(xb_ld(&bar[XB_TOPGEN]) == tg, bar);
            __builtin_amdgcn_fence(__ATOMIC_ACQUIRE, "agent");
            xb_add(&bar[XB_XGEN(b.x)], 1u);
            asm volatile("s_waitcnt vmcnt(0)" ::: "memory");
        } else {
            XB_SPIN(xb_ld(&bar[XB_XGEN(b.x)]) == gen, bar);
            __builtin_amdgcn_fence(__ATOMIC_ACQUIRE, "agent");
            asm volatile("s_waitcnt vmcnt(0)" ::: "memory");
        }
    }
    __syncthreads();
}

constexpr int NPH = 3 + 6 * DEPTH;
__global__ void __launch_bounds__(NTHR) mk_fwd(Args a) {
    extern __shared__ __attribute__((aligned(16))) unsigned char lds_raw[];
    LAS unsigned char* lds = (LAS unsigned char*)lds_raw;
    const int G = gridDim.x, bx = blockIdx.x;
    const int ph_lo = a.ph_lo, ph_hi = a.ph_hi;
    volatile LAS unsigned* bst = (volatile LAS unsigned*)(lds + 131072);
    if (threadIdx.x < 2) bst[threadIdx.x] = 0u;
    __syncthreads();
    XcdBarrier xbar; xbar.bar = (unsigned*)(a.ws + WS_BAR); xbar.x = 0; xbar.st = bst;
    if (!MK_PER_PHASE) xbar = xcd_barrier_post((unsigned*)(a.ws + WS_BAR), bst);

    for (int ph = ph_lo; ph < ph_hi;) {
        int tid = threadIdx.x; asm volatile("" : "+v"(tid));
        unsigned char* ws = a.ws; asm volatile("" : "+s"(ws));
        float* mods = (float*)(ws + WS_MODS);
        const float* tabA = (const float*)(ws + WS_TAB); const float* tabC = tabA + 2048;
        float* Xc = (float*)(ws + WS_XC);
        bf16* Hn = (bf16*)(ws + WS_HN); bf16* H1 = (bf16*)(ws + WS_H1);
        bf16* proj = (bf16*)(ws + WS_PROJ); bf16* cqb = (bf16*)(ws + WS_CQ); bf16* ckvb = (bf16*)(ws + WS_CKV);
        bf16* qm = (bf16*)(ws + WS_QM); bf16* kvm = (bf16*)(ws + WS_KVM); bf16* krr = (bf16*)(ws + WS_KRR); bf16* mix = (bf16*)(ws + WS_MIX);

        if (ph == 0) prologue(a, lds, tid);
        else if (ph == 1) phase1(a, lds, tid);
        else if (ph == NPH - 1) final_norm_phase(a.out, a.in[18], tid);
        else {
            const int l = (ph - 2) / 6, s = (ph - 2) - 6 * l; const bool last = (l == DEPTH - 1);
            unsigned char* wb = ws + WS_W + (size_t)l * WL_STRIDE;
            const float* mods_l = mods + (size_t)l * 9 * 6144;
            float* ssq_q = (float*)(ws + WS_SSQ) + (size_t)l * 2 * MT; float* ssq_kv = ssq_q + MT;
            float* ssqx1 = (float*)(ws + WS_SSQX) + (size_t)l * 2 * MT; float* ssqx2 = ssqx1 + MT;
            const float* xsrc = (l == 0) ? a.in[0] : a.out;
            const float* csrc = (l == 0) ? a.in[2] : Xc;
            float* part = (float*)(ws + WS_PART);
            if (s == 0) {
                if (l > 0) {
                    const float* mods_p = mods + (size_t)(l - 1) * 9 * 6144;
                    ctx_finish(part, 8, Xc, Xc, mods_p + 5 * 1024 + 8 * 6144, Hn, ssqx1, a.in[6] + l * DM, mods_l + 1 * 1024 + 8 * 6144, tid);
                    xcd_barrier(xbar);
                }
                pg8::Gemm g{Hn, (const bf16*)(wb + WL_IN), MT, 2048, DM, DM}; pg8::StaticOrder S; S.init(MT, 2048, G, bx);
                EpiInProj E{proj, cqb, ckvb, krr, ssq_q, ssq_kv, tabA, tabC, ssqx1, (const float*)(ws + WS_BIAS1) + (size_t)l * 9 * 2048};
                pg8::gemm_phase<EpiInProj, pg8::StaticOrder, true, true>(lds, g, S, E, tid);
            } else if (s == 1) {
                { int Kq = 256; asm volatile("" : "+s"(Kq)); pg8::Gemm g{cqb, (const bf16*)(wb + WL_UQ), MT, 512, Kq, Kq}; pg8::StaticOrder S; S.init(MT, 512, G, bx);
                  EpiUQ E{qm, ssq_q, tabC}; pg8::gemm_phase<EpiUQ, pg8::StaticOrder, true, true>(lds, g, S, E, tid); }
                { int Kk = 128; asm volatile("" : "+s"(Kk)); pg8::Gemm g{ckvb, (const bf16*)(wb + WL_UKV), MT, 512, Kk, Kk}; pg8::StaticOrder S; S.init(MT, 512, G, (bx + G / 2) % G);
                  EpiUKV E{kvm, ssq_kv}; pg8::gemm_phase<EpiUKV, pg8::StaticOrder, true, true>(lds, g, S, E, tid); }
            } else if (s == 2) {
                AttnP P{proj, qm, kvm, krr, mix, a.in[9] + l * 8, a.in[10] + l * 4 * 465};
                attn_phase(P, last, lds, tid);
            } else if (s == 3 || s == 5) {
                const bool outp = (s == 3);
                const int Kfull = outp ? DM : DFF;
                {
                    pg8::Gemm g{outp ? mix : H1, (const bf16*)(wb + (outp ? WL_OUT : WL_W2)), MX, DM, Kfull, Kfull}; pg8::StaticOrder S; S.init(MX, DM, G, bx);
                    const int ln = outp ? l : l + 1;
                    const float* mods_n = mods + (size_t)(ln < DEPTH ? ln : 0) * 9 * 6144;
                    EpiResid E{(outp ? xsrc : a.out), (outp ? csrc : Xc), a.out, Xc, mods_l + (outp ? 2 : 5) * 1024, Hn,
                               outp ? ssqx2 : ssqx1 + (size_t)2 * MT, (outp ? a.in[7] : a.in[6]) + (ln < DEPTH ? ln : 0) * DM, mods_n + (outp ? 4 : 1) * 1024, (outp || !last) ? 1 : 0};
                    pg8::gemm_phase<EpiResid, pg8::StaticOrder, true, true>(lds, g, S, E, tid);
                }
                if (!last) {
                    const int NSs = outp ? 4 : 8;
                    int Ks = Kfull / NSs; asm volatile("" : "+s"(Ks));
                    pg8::Gemm g{outp ? mix : H1, (const bf16*)(wb + (outp ? WL_OUT : WL_W2)), MT, DM, Ks, Kfull}; SplitOrder S; S.init(G, (bx + G / 2) % G, NSs, Ks);
                    EpiPartial E{part, Ks * 2};
                    pg8::gemm_phase<EpiPartial, SplitOrder, true, true>(lds, g, S, E, tid);
                }
            } else {
                const int Mr = last ? MX : MT;
                if (!last) {
                    ctx_finish(part, 4, csrc, Xc, mods_l + 2 * 1024 + 8 * 6144, Hn, ssqx2, a.in[7] + l * DM, mods_l + 4 * 1024 + 8 * 6144, tid);
                    xcd_barrier(xbar);
                }
                pg8::Gemm g{Hn, (const bf16*)(wb + WL_W1), Mr, DFF, DM, DM}; pg8::StaticOrder S; S.init(Mr, DFF, G, bx);
                EpiRelu2 E{H1, ssqx2, (const float*)(ws + WS_BIAS4) + (size_t)l * 9 * 4096}; pg8::gemm_phase<EpiRelu2, pg8::StaticOrder, true, true>(lds, g, S, E, tid);
            }
        }
        ++ph;
        if (ph < ph_hi) { if (ph == 1) cg::this_grid().sync(); else xcd_barrier(xbar); }
    }
}

extern "C" void kernel_launch(void* const* d_in, const int* in_sizes, int n_in, void* d_out, int out_size, void* d_ws, size_t ws_size, hipStream_t stream) {
    static int grid = 0;
    if (grid == 0) {
        if (n_in != 19 || ws_size < WS_END) { fprintf(stderr, "kernel_launch: unexpected inputs (n_in %d, ws %zu)\n", n_in, ws_size); grid = -1; return; }
        int dev = 0, cus = 0, per_cu = 0;
        hipGetDevice(&dev); hipDeviceGetAttribute(&cus, hipDeviceAttributeMultiprocessorCount, dev);
        hipFuncSetAttribute((const void*)mk_fwd, hipFuncAttributeMaxDynamicSharedMemorySize, LDS_BYTES);
        hipOccupancyMaxActiveBlocksPerMultiprocessor(&per_cu, (const void*)mk_fwd, NTHR, LDS_BYTES);
        if (per_cu < 1) { fprintf(stderr, "kernel_launch: occupancy query says %d\n", per_cu); per_cu = 1; }
        (void)hipGetLastError();
        grid = cus * 1;
    }
    if (grid < 0) return;
    Args a{};
    for (int i = 0; i < 19; ++i) a.in[i] = (const float*)d_in[i];
    a.out = (float*)d_out; a.ws = (unsigned char*)d_ws;
#if MK_PER_PHASE
    for (int ph = 0; ph < NPH; ++ph) { a.ph_lo = ph; a.ph_hi = ph + 1; hipLaunchKernelGGL(mk_fwd, dim3(grid), dim3(NTHR), LDS_BYTES, stream, a); }
#else
    a.ph_lo = 0; a.ph_hi = NPH;
    (void)hipMemsetAsync((unsigned char*)d_ws + WS_BAR, 0, 16384, stream);
    void* args[] = {&a};
    hipError_t e = hipLaunchCooperativeKernel((const void*)mk_fwd, dim3(grid), dim3(NTHR), args, LDS_BYTES, stream);
    if (e != hipSuccess) fprintf(stderr, "cooperative launch failed: %s (grid %d)\n", hipGetErrorString(e), grid);
#endif
}
```

```cpp
#include <hip/hip_runtime.h>
#include <hip/hip_cooperative_groups.h>
#include <cstdio>
#include <cstdint>
namespace cg = cooperative_groups;
namespace pg8 {
#define PG8_LAS __attribute__((address_space(3)))
typedef unsigned short bf16_t;
typedef short bf16x8 __attribute__((ext_vector_type(8)));
typedef float f32x4 __attribute__((ext_vector_type(4)));
typedef unsigned u32x4 __attribute__((ext_vector_type(4)));
constexpr int BM = 256, BK = 64, HALF = 128, HTB = HALF * BK * 2  , STAGE_BYTES = 8 * HTB, NXCD = 8, WGM = 8;

__host__ __device__ __forceinline__ int lds_byte(int r, int c) { const int st = (r >> 4) * 2 + (c >> 5), rr = r & 15, cc = c & 31, ob = rr * 64 + cc * 2; return st * 1024 + (ob ^ (((ob >> 9) & 1) << 5)); }
__host__ __device__ __forceinline__ void stage_rc(int b, int& R, int& C) { const int st = b / 1024, sb = b % 1024, swz = sb ^ (((sb >> 9) & 1) << 5); R = (st >> 1) * 16 + swz / 64; C = (st & 1) * 32 + (swz % 64) / 2; }
__host__ __device__ __forceinline__ int perm32(int rho) { const int n = rho >> 4, i = rho & 15; return 8 * (i >> 2) + 4 * n + (i & 3); }

struct Unit { int pm, pn, kb; };
struct Gemm { const bf16_t* A; const bf16_t* Bt; int M, N, K, ld; };

struct StaticOrder {
    int nM, nN, nwg, G, c;
    __host__ __device__ void init(int M, int N, int G_, int c_) { nM = M / BM; nN = N / BM; nwg = nM * nN; G = G_; c = c_; }
    __host__ __device__ bool next(int i, Unit& u) const {
        const long L = (long)i * G + c; if (L >= nwg) return false;
        int wgid = (int)L; { const int q = nwg / NXCD, r = nwg % NXCD, xcd = wgid % NXCD, off = wgid / NXCD; wgid = (xcd < r ? xcd * (q + 1) : r * (q + 1) + (xcd - r) * q) + off; }
        const int nig = WGM * nN, gid = wgid / nig, fm = gid * WGM, gsz = (nM - fm) < WGM ? (nM - fm) : WGM;
        u.pm = fm + ((wgid % nig) % gsz); u.pn = (wgid % nig) / gsz; u.kb = 0; return true;
    }
    __device__ __forceinline__ void a_ready(const Unit&) const {}
    __device__ __forceinline__ void done(const Unit&) const {}
};

__device__ __forceinline__ unsigned cvt_pk_bf16(float lo, float hi) { unsigned r; asm volatile("v_cvt_pk_bf16_f32 %0, %1, %2" : "=v"(r) : "v"(lo), "v"(hi)); return r; }
template <class Epi, class Sched, bool ALIGN_EPI = false, bool SP2 = false>
__device__ __forceinline__ void gemm_phase(PG8_LAS unsigned char* lds, const Gemm g, const Sched& S, const Epi& E, const int tid) {
    const int wid = __builtin_amdgcn_readfirstlane(tid >> 6), lane = tid & 63, wr = wid >> 2, wc = wid & 3, fr = lane & 15, fq = lane >> 4;
    const int K = g.ld, nt = g.K / BK;
    unsigned voffA[2], voffB[2];
#pragma unroll
    for (int i = 0; i < 2; ++i) { int R, C; stage_rc(tid * 16 + i * 8192, R, C); const int Rb = Epi::PERM ? ((R & ~31) + perm32(R & 31)) : R;
        voffA[i] = (unsigned)(R * K + C) * 2u; voffB[i] = (unsigned)(Rb * K + C) * 2u; }
    const size_t kstep = (size_t)(BK * 2);
    const size_t hstep = (size_t)HALF * K * 2;
    const size_t tstep = 2 * hstep;
    const unsigned ldsw = (unsigned)wid * 1024u;
    const int aoff = lds_byte(wr * 64 + fr, fq * 8), boff = lds_byte(wc * 32 + fr, fq * 8);
#define PG8_SA(b, h) (((b) * 2 + (h)) * HTB)
#define PG8_SB(b, h) ((4 + (b) * 2 + (h)) * HTB)
#define PG8_STAGE(bufoff, gbase, voff) do { _Pragma("unroll") for (int _i = 0; _i < 2; ++_i) \
        __builtin_amdgcn_global_load_lds((const unsigned*)((const char*)(gbase) + (voff)[_i]), (PG8_LAS unsigned*)(lds + (bufoff) + ldsw + _i * 8192), 16, 0, 0); } while (0)
#define PG8_LDA(dst, b, h) do { _Pragma("unroll") for (int m = 0; m < 4; ++m) _Pragma("unroll") for (int k = 0; k < 2; ++k) dst[m][k] = *(const PG8_LAS bf16x8*)(lds + PG8_SA(b, h) + aoff + m * 2048 + k * 1024); } while (0)
#define PG8_LDB(dst, b, h) do { _Pragma("unroll") for (int n = 0; n < 2; ++n) _Pragma("unroll") for (int k = 0; k < 2; ++k) dst[n][k] = *(const PG8_LAS bf16x8*)(lds + PG8_SB(b, h) + boff + n * 2048 + k * 1024); } while (0)
#define PG8_MMA(ai, bj, At, Bt) do { __builtin_amdgcn_s_setprio(1); _Pragma("unroll") for (int m = 0; m < 4; ++m) _Pragma("unroll") for (int n = 0; n < 2; ++n) _Pragma("unroll") for (int k = 0; k < 2; ++k) \
        acc[ai][bj][m][n] = __builtin_amdgcn_mfma_f32_16x16x32_bf16(Bt[n][k], At[m][k], acc[ai][bj][m][n], 0, 0, 0); __builtin_amdgcn_s_setprio(0); } while (0)
#define PG8_WAIT_V(n) asm volatile("s_waitcnt vmcnt(" #n ")" ::: "memory")
#define PG8_WAIT_L(n) asm volatile("s_waitcnt lgkmcnt(" #n ")" ::: "memory")
#define PG8_BAR __builtin_amdgcn_s_barrier()
#define PG8_SCHED __builtin_amdgcn_sched_barrier(0)
    Unit cur, nxt; int ui = 0;
    if (!S.next(0, cur)) return;
    f32x4 acc[2][2][4][2];
#pragma unroll
    for (int a = 0; a < 2; ++a)
#pragma unroll
        for (int b = 0; b < 2; ++b)
#pragma unroll
            for (int m = 0; m < 4; ++m)
#pragma unroll
                for (int n = 0; n < 2; ++n) acc[a][b][m][n] = (f32x4){0.f, 0.f, 0.f, 0.f};
    bf16x8 At[4][2], B0[2][2], B1[2][2];
    const char* cA = (const char*)g.A + (size_t)cur.pm * tstep + cur.kb; const char* cB = (const char*)g.Bt + (size_t)cur.pn * tstep + cur.kb;
    S.a_ready(cur);
    if constexpr (SP2) {
        PG8_STAGE(PG8_SB(0, 0), cB, voffB); PG8_STAGE(PG8_SB(0, 1), cB + hstep, voffB); PG8_STAGE(PG8_SA(0, 0), cA, voffA); PG8_STAGE(PG8_SA(0, 1), cA + hstep, voffA);
        if (wr == 1) PG8_BAR;
        PG8_WAIT_V(2); PG8_BAR;
        PG8_STAGE(PG8_SB(1, 0), cB + kstep, voffB); PG8_STAGE(PG8_SA(1, 0), cA + kstep, voffA); PG8_STAGE(PG8_SB(1, 1), cB + hstep + kstep, voffB);
        PG8_WAIT_V(6); PG8_BAR;
    } else {
        PG8_STAGE(PG8_SB(0, 0), cB, voffB); PG8_STAGE(PG8_SA(0, 0), cA, voffA); PG8_STAGE(PG8_SB(0, 1), cB + hstep, voffB); PG8_STAGE(PG8_SA(0, 1), cA + hstep, voffA);
        if (wr == 1) PG8_BAR;
        PG8_WAIT_V(4); PG8_BAR;
        PG8_STAGE(PG8_SB(1, 0), cB + kstep, voffB); PG8_STAGE(PG8_SA(1, 0), cA + kstep, voffA); PG8_STAGE(PG8_SB(1, 1), cB + hstep + kstep, voffB);
        PG8_WAIT_V(6); PG8_BAR;
    }
    for (;;) {
        const bool has_next = S.next(ui + 1, nxt);
        const char* nA = has_next ? (const char*)g.A + (size_t)nxt.pm * tstep + nxt.kb : cA; const char* nB = has_next ? (const char*)g.Bt + (size_t)nxt.pn * tstep + nxt.kb : cB;
        for (int t = 0; t < nt; t += 2) {
            const bool last = (t == nt - 2);
            const char* a1 = cA + (size_t)(t + 1) * kstep;
            const char* a2 = last ? nA : cA + (size_t)(t + 2) * kstep; const char* b2 = last ? nB : cB + (size_t)(t + 2) * kstep;
            const char* a3 = a2 + kstep; const char* b3 = b2 + kstep;
            if (last && has_next) S.a_ready(nxt);
            if constexpr (SP2) {
            PG8_LDB(B0, 0, 0); PG8_LDB(B1, 0, 1); PG8_SCHED; PG8_LDA(At, 0, 0); PG8_STAGE(PG8_SA(1, 1), a1 + hstep, voffA);
            PG8_WAIT_V(8); PG8_WAIT_L(0); PG8_BAR; PG8_MMA(0, 0, At, B0); PG8_MMA(0, 1, At, B1); PG8_BAR; PG8_SCHED;
            PG8_LDA(At, 0, 1); PG8_STAGE(PG8_SB(0, 0), b2, voffB); PG8_STAGE(PG8_SB(0, 1), b2 + hstep, voffB); PG8_STAGE(PG8_SA(0, 0), a2, voffA);
            PG8_WAIT_V(8); PG8_WAIT_L(0); PG8_BAR; PG8_MMA(1, 0, At, B0); PG8_MMA(1, 1, At, B1); PG8_BAR; PG8_SCHED;
            PG8_LDB(B0, 1, 0); PG8_LDB(B1, 1, 1); PG8_SCHED; PG8_LDA(At, 1, 0); PG8_STAGE(PG8_SA(0, 1), a2 + hstep, voffA);
            PG8_WAIT_V(8); PG8_WAIT_L(0); PG8_BAR; PG8_MMA(0, 0, At, B0); PG8_MMA(0, 1, At, B1); PG8_BAR; PG8_SCHED;
            PG8_LDA(At, 1, 1); PG8_STAGE(PG8_SB(1, 0), b3, voffB); PG8_STAGE(PG8_SB(1, 1), b3 + hstep, voffB); PG8_STAGE(PG8_SA(1, 0), a3, voffA);
            PG8_WAIT_V(8); PG8_WAIT_L(0); PG8_BAR; PG8_MMA(1, 0, At, B0); PG8_MMA(1, 1, At, B1); PG8_BAR; PG8_SCHED;
            } else {
            PG8_LDB(B0, 0, 0); PG8_SCHED; PG8_LDA(At, 0, 0); PG8_STAGE(PG8_SA(1, 1), a1 + hstep, voffA);
            PG8_WAIT_L(8); PG8_BAR; PG8_WAIT_L(0); PG8_MMA(0, 0, At, B0); PG8_BAR; PG8_SCHED;
            PG8_LDB(B1, 0, 1); PG8_STAGE(PG8_SB(0, 0), b2, voffB);
            PG8_BAR; PG8_WAIT_L(0); PG8_MMA(0, 1, At, B1); PG8_BAR;
            PG8_LDA(At, 0, 1); PG8_STAGE(PG8_SA(0, 0), a2, voffA);
            PG8_BAR; PG8_WAIT_L(0); PG8_MMA(1, 0, At, B0); PG8_BAR; PG8_SCHED;
            PG8_STAGE(PG8_SB(0, 1), b2 + hstep, voffB);
            PG8_WAIT_V(6); PG8_BAR; PG8_MMA(1, 1, At, B1); PG8_BAR;
            PG8_LDB(B0, 1, 0); PG8_SCHED; PG8_LDA(At, 1, 0); PG8_STAGE(PG8_SA(0, 1), a2 + hstep, voffA);
            PG8_WAIT_L(8); PG8_BAR; PG8_WAIT_L(0); PG8_MMA(0, 0, At, B0); PG8_BAR; PG8_SCHED;
            PG8_LDB(B1, 1, 1); PG8_STAGE(PG8_SB(1, 0), b3, voffB);
            PG8_BAR; PG8_WAIT_L(0); PG8_MMA(0, 1, At, B1); PG8_BAR;
            PG8_LDA(At, 1, 1); PG8_STAGE(PG8_SA(1, 0), a3, voffA);
            PG8_BAR; PG8_WAIT_L(0); PG8_MMA(1, 0, At, B0); PG8_BAR; PG8_SCHED;
            PG8_STAGE(PG8_SB(1, 1), b3 + hstep, voffB);
            PG8_WAIT_V(6); PG8_BAR; PG8_MMA(1, 1, At, B1); PG8_BAR;
            }
        }
        if constexpr (ALIGN_EPI) { if (wr == 0) PG8_BAR; }
        if constexpr (!Epi::AFTER_DRAIN) { E(acc, cur, wr, wc, fr, fq); S.done(cur); }
        if (!has_next) break;
#pragma unroll
        for (int a = 0; a < 2; ++a)
#pragma unroll
            for (int b = 0; b < 2; ++b)
#pragma unroll
                for (int m = 0; m < 4; ++m)
#pragma unroll
                    for (int n = 0; n < 2; ++n) acc[a][b][m][n] = (f32x4){0.f, 0.f, 0.f, 0.f};
        cur = nxt; cA = nA; cB = nB; ++ui;
        if constexpr (ALIGN_EPI) { if (wr == 1) PG8_BAR; }
    }
    PG8_WAIT_V(0);
    if constexpr (!ALIGN_EPI) { if (wr == 0) PG8_BAR; }
    PG8_BAR;
    if constexpr (Epi::AFTER_DRAIN) { E.fused(acc, cur, wr, wc, fr, fq, lds, wid, lane); S.done(cur); }
#undef PG8_SA
#undef PG8_SB
#undef PG8_STAGE
#undef PG8_LDA
#undef PG8_LDB
#undef PG8_MMA
#undef PG8_WAIT_V
#undef PG8_WAIT_L
#undef PG8_BAR
#undef PG8_SCHED
}
}

#define LAS __attribute__((address_space(3)))
#define DI __device__ __forceinline__
#define GAS __attribute__((address_space(1)))
typedef unsigned short bf16;
typedef float f32x4 __attribute__((ext_vector_type(4)));
typedef float f32x16 __attribute__((ext_vector_type(16)));
typedef short bf16x8 __attribute__((ext_vector_type(8)));
typedef short s16x4 __attribute__((ext_vector_type(4)));
typedef unsigned u32x2 __attribute__((ext_vector_type(2)));
typedef unsigned u32x4 __attribute__((ext_vector_type(4)));
typedef float f32x2_t __attribute__((ext_vector_type(2)));
typedef __bf16 bf16x2_t __attribute__((ext_vector_type(2)));

#ifndef MK_MASK
#define MK_MASK 0x1ff
#endif
#define PH_EN(k) (((MK_MASK) >> (k)) & 1)
#ifndef MK_PER_PHASE
#define MK_PER_PHASE 0
#endif

constexpr int DM = 1024, NBATCH = 8, SEQ = 4096, DEPTH = 4, CTXL = 256, DFF = 4096;
constexpr int MX = NBATCH * SEQ, MC = NBATCH * CTXL, MT = MX + MC;
constexpr int INW = 1952, PJS = 1536;
constexpr float LOG2E = 1.4426950408889634f;
constexpr float C2A = 0.125f * LOG2E;
constexpr float C2C = 0.10206207261596575f * LOG2E;
constexpr float EPSN = 1e-6f;
constexpr int NTHR = 512;

constexpr size_t MiB = (size_t)1 << 20;
constexpr size_t WS_TAB = 0;
constexpr size_t WS_BAR = 65536;
constexpr size_t WS_MODS = 1 * MiB;
constexpr size_t WS_SSQ = 2 * MiB;
constexpr size_t WS_XC = 4 * MiB;
constexpr size_t WS_W = 12 * MiB;
constexpr size_t WL_IN = 0, WL_OUT = 4 * MiB, WL_W1 = 6 * MiB, WL_W2 = 14 * MiB, WL_UQ = 22 * MiB, WL_UKV = 22 * MiB + 256 * 1024, WL_STRIDE = 22 * MiB + 512 * 1024;
constexpr size_t WS_HN = 102 * MiB;
constexpr size_t WS_H1 = 170 * MiB;
constexpr size_t WS_PROJ = 170 * MiB;
constexpr size_t WS_CQ = 272 * MiB;
constexpr size_t WS_CKV = 289 * MiB;
constexpr size_t WS_QM = 298 * MiB;
constexpr size_t WS_KVM = 324 * MiB;
constexpr size_t WS_KRR = 358 * MiB;
constexpr size_t WS_MIX = 362 * MiB;
constexpr size_t WS_SSQX = 442 * MiB;
constexpr size_t WS_BIAS1 = 444 * MiB;
constexpr size_t WS_BIAS4 = 445 * MiB;
constexpr size_t WS_PART = 446 * MiB;
constexpr size_t WS_END = 510 * MiB;
constexpr int LDS_BYTES = 131072 + 256;

DI unsigned cvtpk(float lo, float hi) { f32x2_t v = {lo, hi}; bf16x2_t b = __builtin_convertvector(v, bf16x2_t); return __builtin_bit_cast(unsigned, b); }
DI void st4bf(bf16* p, f32x4 v) { u32x2 w; w.x = cvtpk(v[0], v[1]); w.y = cvtpk(v[2], v[3]); *(GAS u32x2*)p = w; }
DI float wave_sum(float v) {
#pragma unroll
    for (int o = 1; o < 64; o <<= 1) v += __shfl_xor(v, o);
    return v;
}
DI float fexp2(float x) { return __builtin_amdgcn_exp2f(x); }
DI float max3f(float a, float b, float c) { float r; asm("v_max3_f32 %0, %1, %2, %3" : "=v"(r) : "v"(a), "v"(b), "v"(c)); return r; }
#define LDS_WAIT() asm volatile("s_waitcnt lgkmcnt(0)" ::: "memory")

DI f32x4 rope8(f32x4 v, const float* tab  , int fq) {
    const int i0 = 4 * (fq & 1);
    const f32x4 cs = *(const f32x4*)(tab + i0), sn = *(const f32x4*)(tab + 8 + i0);
    f32x4 o;
#pragma unroll
    for (int j = 0; j < 4; ++j) { const float pr = __shfl_xor(v[j], 32); o[j] = (fq < 2) ? v[j] * cs[j] - pr * sn[j] : pr * sn[j] + v[j] * cs[j]; }
    return o;
}

struct EpiInProj {
    static constexpr bool PERM = false, AFTER_DRAIN = false;
    bf16 *proj, *cqb, *ckvb, *krr; float *ssq_q, *ssq_kv; const float *tabA, *tabC; const float *ssqx, *bias;
    DI void operator()(const f32x4 (&acc0)[2][2][4][2], const pg8::Unit& u, int wr, int wc, int fr, int fq) const {
        const int pn = u.pn; const bool isx = u.pm < 128; const int mi = isx ? (u.pm >> 4) : 8;
        f32x4 bv[2][2];
#pragma unroll
        for (int bj = 0; bj < 2; ++bj)
#pragma unroll
            for (int n = 0; n < 2; ++n) bv[bj][n] = *(const GAS f32x4*)(bias + mi * 2048 + pn * 256 + bj * 128 + wc * 32 + n * 16 + 4 * fq);
        float rsx[2][4];
#pragma unroll
        for (int ai = 0; ai < 2; ++ai)
#pragma unroll
            for (int m = 0; m < 4; ++m) { int row = u.pm * 256 + ai * 128 + wr * 64 + m * 16 + fr; asm volatile("" : "+v"(row)); rsx[ai][m] = ((const GAS float*)ssqx)[row]; }
#pragma unroll
        for (int ai = 0; ai < 2; ++ai)
#pragma unroll
            for (int m = 0; m < 4; ++m) rsx[ai][m] = rsqrtf(rsx[ai][m] * (1.0f / 1024.0f) + EPSN);
        const bool anyrope = isx && pn <= 2;
#pragma unroll
        for (int ai = 0; ai < 2; ++ai)
#pragma unroll
        for (int mh = 0; mh < 2; ++mh) {
            f32x4 cs[4], sn[4];
#pragma unroll
            for (int m = 2 * mh; m < 2 * mh + 2; ++m) { cs[m] = (f32x4){1.f, 1.f, 1.f, 1.f}; sn[m] = (f32x4){0.f, 0.f, 0.f, 0.f}; }
            if (anyrope) {
#pragma unroll
                for (int m = 2 * mh; m < 2 * mh + 2; ++m) { int row = u.pm * 256 + ai * 128 + wr * 64 + m * 16 + fr; asm volatile("" : "+v"(row)); const int tok = row & 4095; const int pos = (wc & 1) ? (tok & 63) : (tok >> 6);
                    cs[m] = *(const GAS f32x4*)(tabA + pos * 32 + 4 * fq); sn[m] = *(const GAS f32x4*)(tabA + pos * 32 + 16 + 4 * fq); }
            }
#pragma unroll
            for (int m = 2 * mh; m < 2 * mh + 2; ++m) {
                int row = u.pm * 256 + ai * 128 + wr * 64 + m * 16 + fr; asm volatile("" : "+v"(row));
                const int tok = row & 4095, prow = tok >> 6, pcol = tok & 63;
                f32x4 acc[2][2];
#pragma unroll
                for (int bj = 0; bj < 2; ++bj)
#pragma unroll
                    for (int n = 0; n < 2; ++n) acc[bj][n] = acc0[ai][bj][m][n] * rsx[ai][m] + bv[bj][n];
                if (pn < 6) {
#pragma unroll
                    for (int bj = 0; bj < 2; ++bj) {
                        f32x4 v0 = acc[bj][0], v1 = acc[bj][1];
                        if (anyrope && (pn < 2 || bj == 0)) { const f32x4 a = v0 * cs[m] - v1 * sn[m], b = v0 * sn[m] + v1 * cs[m]; v0 = a; v1 = b; }
                        if (pn < 2 || pn == 3) { v0 *= C2A; v1 *= C2A; }
                        bf16* p = proj + (size_t)row * PJS + pn * 256 + bj * 128 + wc * 32 + 4 * fq;
                        st4bf(p, v0); st4bf(p + 16, v1);
                    }
                } else if (pn == 6) {
                    float s = 0.f;
#pragma unroll
                    for (int bj = 0; bj < 2; ++bj) {
                        const f32x4 v0 = acc[bj][0], v1 = acc[bj][1];
                        s += (v0[0] * v0[0] + v0[1] * v0[1]) + (v0[2] * v0[2] + v0[3] * v0[3]) + (v1[0] * v1[0] + v1[1] * v1[1]) + (v1[2] * v1[2] + v1[3] * v1[3]);
                        bf16* p = cqb + (size_t)row * 256 + bj * 128 + wc * 32 + 4 * fq;
                        st4bf(p, v0); st4bf(p + 16, v1);
                    }
                    s += __shfl_xor(s, 16); s += __shfl_xor(s, 32);
                    if (fq == 0) atomicAdd(ssq_q + row, s);
                } else {
                    {
                        const f32x4 v0 = acc[0][0], v1 = acc[0][1];
                        float s = (v0[0] * v0[0] + v0[1] * v0[1]) + (v0[2] * v0[2] + v0[3] * v0[3]) + (v1[0] * v1[0] + v1[1] * v1[1]) + (v1[2] * v1[2] + v1[3] * v1[3]);
                        bf16* p = ckvb + (size_t)row * 128 + wc * 32 + 4 * fq;
                        st4bf(p, v0); st4bf(p + 16, v1);
                        s += __shfl_xor(s, 16); s += __shfl_xor(s, 32);
                        if (fq == 0) atomicAdd(ssq_kv + row, s);
                    }
                    if (wc == 0) {
                        f32x4 v0 = acc[1][0], v1 = acc[1][1];
                        if (isx) { v0 = rope8(v0, tabC + prow * 16, fq); v1 = rope8(v1, tabC + pcol * 16, fq); }
                        bf16* p = krr + (size_t)row * 32 + 4 * fq;
                        st4bf(p, v0); st4bf(p + 16, v1);
                    }
                }
            }
        }
    }
};

struct EpiUQ {
    static constexpr bool PERM = false, AFTER_DRAIN = false;
    bf16* qm; const float* ssq_q; const float* tabC;
    DI void operator()(const f32x4 (&acc)[2][2][4][2], const pg8::Unit& u, int wr, int wc, int fr, int fq) const {
        const int pn = u.pn; const bool isx = u.pm < 128;
        float rsq[2][4];
#pragma unroll
        for (int ai = 0; ai < 2; ++ai)
#pragma unroll
            for (int m = 0; m < 4; ++m) { int row = u.pm * 256 + ai * 128 + wr * 64 + m * 16 + fr; asm volatile("" : "+v"(row)); rsq[ai][m] = ((const GAS float*)ssq_q)[row]; }
#pragma unroll
        for (int ai = 0; ai < 2; ++ai)
#pragma unroll
            for (int m = 0; m < 4; ++m) {
                int row = u.pm * 256 + ai * 128 + wr * 64 + m * 16 + fr; asm volatile("" : "+v"(row));
                const int tok = row & 4095, prow = tok >> 6, pcol = tok & 63;
                const float rs = rsqrtf(rsq[ai][m] * (1.0f / 256.0f) + EPSN) * C2C;
#pragma unroll
                for (int bj = 0; bj < 2; ++bj)
#pragma unroll
                    for (int n = 0; n < 2; ++n) {
                        const int col0 = pn * 256 + bj * 128 + wc * 32 + n * 16;
                        if (col0 < 384) {
                            f32x4 v = acc[ai][bj][m][n] * rs;
                            const int g6 = (col0 >> 4) % 6;
                            if (isx && g6 >= 4) v = rope8(v, tabC + (g6 == 4 ? prow : pcol) * 16, fq);
                            st4bf(qm + (size_t)row * 384 + col0 + 4 * fq, v);
                        }
                    }
            }
    }
};

struct EpiUKV {
    static constexpr bool PERM = false, AFTER_DRAIN = false;
    bf16* kvm; const float* ssq_kv;
    DI void operator()(const f32x4 (&acc)[2][2][4][2], const pg8::Unit& u, int wr, int wc, int fr, int fq) const {
        float rsq[2][4];
#pragma unroll
        for (int ai = 0; ai < 2; ++ai)
#pragma unroll
            for (int m = 0; m < 4; ++m) { int row = u.pm * 256 + ai * 128 + wr * 64 + m * 16 + fr; asm volatile("" : "+v"(row)); rsq[ai][m] = ((const GAS float*)ssq_kv)[row]; }
#pragma unroll
        for (int ai = 0; ai < 2; ++ai)
#pragma unroll
            for (int m = 0; m < 4; ++m) {
                int row = u.pm * 256 + ai * 128 + wr * 64 + m * 16 + fr; asm volatile("" : "+v"(row));
                const float rs = rsqrtf(rsq[ai][m] * (1.0f / 128.0f) + EPSN);
#pragma unroll
                for (int bj = 0; bj < 2; ++bj)
#pragma unroll
                    for (int n = 0; n < 2; ++n) {
                        const int col0 = u.pn * 256 + bj * 128 + wc * 32 + n * 16;
                        st4bf(kvm + (size_t)row * 512 + col0 + 4 * fq, acc[ai][bj][m][n] * rs);
                    }
            }
    }
};

struct EpiRelu2 {
    static constexpr bool PERM = true, AFTER_DRAIN = false;
    bf16* H; const float *ssqx, *bias;
    DI void operator()(const f32x4 (&acc)[2][2][4][2], const pg8::Unit& u, int wr, int wc, int fr, int fq) const {
        const int col0 = u.pn * 256 + wc * 32 + 8 * fq; const int mi = (u.pm < 128) ? (u.pm >> 4) : 8;
        f32x4 bv[2][2];
#pragma unroll
        for (int bj = 0; bj < 2; ++bj)
#pragma unroll
            for (int n = 0; n < 2; ++n) bv[bj][n] = *(const GAS f32x4*)(bias + mi * 4096 + col0 + bj * 128 + 4 * n);
        float rsx[2][4];
#pragma unroll
        for (int ai = 0; ai < 2; ++ai)
#pragma unroll
            for (int m = 0; m < 4; ++m) { int row = u.pm * 256 + ai * 128 + wr * 64 + m * 16 + fr; asm volatile("" : "+v"(row)); rsx[ai][m] = ((const GAS float*)ssqx)[row]; }
#pragma unroll
        for (int ai = 0; ai < 2; ++ai)
#pragma unroll
            for (int m = 0; m < 4; ++m) {
                int row = u.pm * 256 + ai * 128 + wr * 64 + m * 16 + fr; asm volatile("" : "+v"(row));
                const float rs = rsqrtf(rsx[ai][m] * (1.0f / 1024.0f) + EPSN);
                bf16* rowp = H + (size_t)row * DFF + col0;
#pragma unroll
                for (int bj = 0; bj < 2; ++bj) {
                    f32x4 v0 = acc[ai][bj][m][0] * rs + bv[bj][0], v1 = acc[ai][bj][m][1] * rs + bv[bj][1];
#pragma unroll
                    for (int j = 0; j < 4; ++j) { const float a = fmaxf(v0[j], 0.f), b = fmaxf(v1[j], 0.f); v0[j] = a * a; v1[j] = b * b; }
                    u32x4 w; w.x = cvtpk(v0[0], v0[1]); w.y = cvtpk(v0[2], v0[3]); w.z = cvtpk(v1[0], v1[1]); w.w = cvtpk(v1[2], v1[3]);
                    *(GAS u32x4*)(rowp + bj * 128) = w;
                }
            }
    }
};

struct EpiResid {
    static constexpr bool PERM = false, AFTER_DRAIN = false;
    const float *srcx, *srcc; float *dstx, *dstc; const float* gate; bf16* xg; float* ssq_out; const float *gn, *scn; int donorm;
    DI void operator()(const f32x4 (&acc)[2][2][4][2], const pg8::Unit& u, int wr, int wc, int fr, int fq) const {
        const bool isx = u.pm < 128; const int mi = isx ? (u.pm >> 4) : 8;
        const int col0 = u.pn * 256 + wc * 32 + 4 * fq;
        f32x4 gv[2][2], gp[2][2];
#pragma unroll
        for (int bj = 0; bj < 2; ++bj)
#pragma unroll
            for (int n = 0; n < 2; ++n) { const int c = col0 + bj * 128 + n * 16; gv[bj][n] = *(const GAS f32x4*)(gate + mi * 6144 + c);
                gp[bj][n] = donorm ? *(const GAS f32x4*)(gn + c) * (*(const GAS f32x4*)(scn + mi * 6144 + c) + 1.0f) : (f32x4){0.f, 0.f, 0.f, 0.f}; }
#pragma unroll
        for (int ai = 0; ai < 2; ++ai)
#pragma unroll
        for (int mh = 0; mh < 2; ++mh) {
            f32x4 xs[4][2][2];
#pragma unroll
            for (int m = 2 * mh; m < 2 * mh + 2; ++m) {
                int row = u.pm * 256 + ai * 128 + wr * 64 + m * 16 + fr; asm volatile("" : "+v"(row));
                const float* s = isx ? srcx + (size_t)row * DM : srcc + (size_t)(row - MX) * DM;
#pragma unroll
                for (int bj = 0; bj < 2; ++bj)
#pragma unroll
                    for (int n = 0; n < 2; ++n) xs[m][bj][n] = *(const GAS f32x4*)(s + col0 + bj * 128 + n * 16);
            }
#pragma unroll
            for (int m = 2 * mh; m < 2 * mh + 2; ++m) {
                int row = u.pm * 256 + ai * 128 + wr * 64 + m * 16 + fr; asm volatile("" : "+v"(row));
                float* d = isx ? dstx + (size_t)row * DM : dstc + (size_t)(row - MX) * DM;
                float ss = 0.f;
#pragma unroll
                for (int bj = 0; bj < 2; ++bj)
#pragma unroll
                    for (int n = 0; n < 2; ++n) { const int off = col0 + bj * 128 + n * 16;
                        const f32x4 xn = xs[m][bj][n] + gv[bj][n] * acc[ai][bj][m][n];
                        *(GAS f32x4*)(d + off) = xn;
                        if (donorm) { ss += (xn[0] * xn[0] + xn[1] * xn[1]) + (xn[2] * xn[2] + xn[3] * xn[3]); st4bf(xg + (size_t)row * DM + off, xn * gp[bj][n]); } }
                if (donorm) { ss += __shfl_xor(ss, 16); ss += __shfl_xor(ss, 32); if (fq == 0) atomicAdd(ssq_out + row, ss); }
            }
        }
    }
};

struct SplitOrder {
    int G, c, NS, ksub_bytes;
    DI void init(int G_, int c_, int NS_, int Ksub) { G = G_; c = c_; NS = NS_; ksub_bytes = Ksub * 2; }
    DI bool next(int i, pg8::Unit& u) const { const int idx = i * G + c; if (idx >= 32 * NS) return false; const int ks = idx % NS, tile = idx / NS; u.pn = tile & 3; u.pm = 128 + (tile >> 2); u.kb = ks * ksub_bytes; return true; }
    DI void a_ready(const pg8::Unit&) const {}
    DI void done(const pg8::Unit&) const {}
};
struct EpiPartial {
    static constexpr bool PERM = false, AFTER_DRAIN = false;
    float* part; int ksub_bytes;
    DI void operator()(const f32x4 (&acc)[2][2][4][2], const pg8::Unit& u, int wr, int wc, int fr, int fq) const {
        const int ks = u.kb / ksub_bytes; const int col0 = u.pn * 256 + wc * 32 + 4 * fq;
        float* base = part + (size_t)ks * MC * DM;
#pragma unroll
        for (int ai = 0; ai < 2; ++ai)
#pragma unroll
            for (int m = 0; m < 4; ++m) {
                int row = (u.pm - 128) * 256 + ai * 128 + wr * 64 + m * 16 + fr;
                asm volatile("" : "+v"(row) :: "memory");
                float* rowp = base + (size_t)row * DM + col0;
#pragma unroll
                for (int bj = 0; bj < 2; ++bj)
#pragma unroll
                    for (int n = 0; n < 2; ++n) *(GAS f32x4*)(rowp + bj * 128 + n * 16) = acc[ai][bj][m][n];
            }
    }
};
DI void ctx_finish(const float* part, int NS, const float* src, float* dst, const float* gate8, bf16* xg, float* ssq_out, const float* gn, const float* scn8, const int tid) {
    const int lane = tid & 63, gw = blockIdx.x * 8 + (tid >> 6), NGW = gridDim.x * 8;
    for (int row = gw; row < MC; row += NGW) {
        float s = 0.f;
#pragma unroll
        for (int j = 0; j < 4; ++j) {
            const int col = 256 * j + 4 * lane;
            f32x4 a = {0.f, 0.f, 0.f, 0.f};
            for (int ks = 0; ks < NS; ++ks) a += *(const GAS f32x4*)(part + ((size_t)ks * MC + row) * DM + col);
            const f32x4 xn = *(const GAS f32x4*)(src + (size_t)row * DM + col) + *(const GAS f32x4*)(gate8 + col) * a;
            *(GAS f32x4*)(dst + (size_t)row * DM + col) = xn;
            s += (xn[0] * xn[0] + xn[1] * xn[1]) + (xn[2] * xn[2] + xn[3] * xn[3]);
            st4bf(xg + (size_t)(MX + row) * DM + col, xn * (*(const GAS f32x4*)(gn + col) * (*(const GAS f32x4*)(scn8 + col) + 1.0f)));
        }
        s = wave_sum(s);
        if (lane == 0) ssq_out[MX + row] = s;
    }
}

DI void transpose_item(const float* W, int K, int N, bf16* WT, const float* kscale, LAS float* scr, int item, int lane) {
    const int nblk = N / 32, kb = item / nblk, nb = item % nblk, k0 = 64 * kb, n0 = 32 * nb;
#pragma unroll 16
    for (int i = 0; i < 32; ++i) { const int kk = 2 * i + (lane >> 5); float w = W[(size_t)(k0 + kk) * N + n0 + (lane & 31)]; if (kscale) w *= kscale[k0 + kk]; scr[kk * 33 + (lane & 31)] = w; }
    LDS_WAIT();
    const int c = lane & 7;
#pragma unroll
    for (int j = 0; j < 4; ++j) { const int n = (lane >> 3) + 8 * j; const LAS float* s = scr + (8 * c) * 33 + n;
        u32x4 o; o.x = cvtpk(s[0 * 33], s[1 * 33]); o.y = cvtpk(s[2 * 33], s[3 * 33]); o.z = cvtpk(s[4 * 33], s[5 * 33]); o.w = cvtpk(s[6 * 33], s[7 * 33]);
        *(u32x4*)(WT + (size_t)(n0 + n) * K + k0 + 8 * c) = o; }
    LDS_WAIT();
}

DI void gemv9_item(const float* W, int ldw, int nvalid, int n0, const LAS float* sl, LAS float* red, const float* addb, float* out, int ldo, const int tid) {
    const int col = tid & 31, kg = tid >> 5, n = n0 + col;
    float acc[9];
#pragma unroll
    for (int mi = 0; mi < 9; ++mi) acc[mi] = 0.f;
    if (n < nvalid) {
        const float* w = W + (size_t)(kg * 64) * ldw + n;
#pragma unroll 16
        for (int k = 0; k < 64; ++k) { const float wv = w[(size_t)k * ldw];
#pragma unroll
            for (int mi = 0; mi < 9; ++mi) acc[mi] += sl[mi * 1024 + kg * 64 + k] * wv; }
    }
#pragma unroll
    for (int mi = 0; mi < 9; ++mi) red[(kg * 9 + mi) * 32 + col] = acc[mi];
    __syncthreads();
    if (tid < 288) { const int mi = tid >> 5, cq = tid & 31; float sacc = (addb && n0 + cq < nvalid) ? addb[n0 + cq] : 0.f;
#pragma unroll
        for (int g = 0; g < 16; ++g) sacc += red[(g * 9 + mi) * 32 + cq];
        out[(size_t)mi * ldo + n0 + cq] = sacc; }
    __syncthreads();
}

struct Args { const float* in[19]; float* out; unsigned char* ws; int ph_lo, ph_hi; };

DI void prologue(const Args& a, LAS unsigned char* lds, const int tid) {
    const int lane = tid & 63, wave = __builtin_amdgcn_readfirstlane(tid >> 6);
    int G = gridDim.x; asm volatile("" : "+s"(G));
    const int bx = blockIdx.x;
    unsigned char* ws = a.ws;
    {
        LAS float* sl = (LAS float*)lds;
        LAS float* red = (LAS float*)(lds + 36864);
        const float* c = a.in[1]; const float* cc = a.in[3]; const float* w_ada = a.in[4]; const float* b_ada = a.in[5];
        float* mods = (float*)(ws + WS_MODS);
        for (int idx = tid; idx < 9 * 1024; idx += NTHR) { const int mi = idx >> 10, k = idx & 1023; const float v = mi < 8 ? c[mi * 1024 + k] : cc[k]; sl[idx] = v / (1.0f + expf(-v)); }
        __syncthreads();
        for (int item = bx; item < DEPTH * 192; item += G) {
            const int l = item / 192, n0 = (item % 192) * 32;
            gemv9_item(w_ada + (size_t)l * 1024 * 6144, 6144, 6144, n0, sl, red, b_ada + l * 6144, mods + (size_t)l * 9 * 6144, 6144, tid);
        }
    }
    {
        const int gid = bx * NTHR + tid, NG = G * NTHR;
        float* tabA = (float*)(ws + WS_TAB); float* tabC = tabA + 2048;
        if (gid < 1024) { const int pos = gid >> 4, i = gid & 15; const float fr = exp2f(-(float)i * (1.0f / 16.0f) * 13.287712379549449f); const float rev = ((float)pos * fr) * 0.15915494309189535f;
            tabA[pos * 32 + i] = __builtin_amdgcn_cosf(rev); tabA[pos * 32 + 16 + i] = __builtin_amdgcn_sinf(rev); }
        else if (gid < 1536) { const int g = gid - 1024, pos = g >> 3, i = g & 7; const float fr = exp2f(-(float)i * (1.0f / 8.0f) * 13.287712379549449f); const float rev = ((float)pos * fr) * 0.15915494309189535f;
            tabC[pos * 16 + i] = __builtin_amdgcn_cosf(rev); tabC[pos * 16 + 8 + i] = __builtin_amdgcn_sinf(rev); }
        float* ssq = (float*)(ws + WS_SSQ);
        for (int i = gid; i < DEPTH * 2 * MT; i += NG) ssq[i] = 0.f;
        float* ssqx = (float*)(ws + WS_SSQX);
        for (int i = gid; i < DEPTH * 2 * MT; i += NG) ssqx[i] = 0.f;
        const u32x4 z = {0u, 0u, 0u, 0u};
        for (int i = gid; i < DEPTH * 12288; i += NG) { const int l = i / 12288, r = i % 12288; ((u32x4*)(ws + WS_W + l * WL_STRIDE + WL_IN + (size_t)INW * 1024 * 2))[r] = z; }
        for (int i = gid; i < DEPTH * 4096; i += NG) { const int l = i / 4096, r = i % 4096; ((u32x4*)(ws + WS_W + l * WL_STRIDE + WL_UQ + (size_t)384 * 256 * 2))[r] = z; }
    }
    {
        LAS float* scr = (LAS float*)(lds + wave * 16384);
        const int gw = bx * 8 + wave, NGW = G * 8;
        constexpr int I_IN = 16 * 61, I_OUT = 16 * 32, I_W1 = 16 * 128, I_W2 = 64 * 32, I_UQ = 4 * 12, I_UKV = 2 * 16, I_L = I_IN + I_OUT + I_W1 + I_W2 + I_UQ + I_UKV;
        for (int it = gw; it < DEPTH * I_L; it += NGW) {
            const int l = it / I_L; int r = it % I_L; unsigned char* wb = ws + WS_W + l * WL_STRIDE;
            if (r < I_IN) { transpose_item(a.in[8] + (size_t)l * 1024 * INW, 1024, INW, (bf16*)(wb + WL_IN), nullptr, scr, r, lane); continue; } r -= I_IN;
            if (r < I_OUT) { transpose_item(a.in[15] + (size_t)l * 1024 * 1024, 1024, 1024, (bf16*)(wb + WL_OUT), nullptr, scr, r, lane); continue; } r -= I_OUT;
            if (r < I_W1) { transpose_item(a.in[16] + (size_t)l * 1024 * 4096, 1024, 4096, (bf16*)(wb + WL_W1), nullptr, scr, r, lane); continue; } r -= I_W1;
            if (r < I_W2) { transpose_item(a.in[17] + (size_t)l * 4096 * 1024, 4096, 1024, (bf16*)(wb + WL_W2), nullptr, scr, r, lane); continue; } r -= I_W2;
            if (r < I_UQ) { transpose_item(a.in[12] + (size_t)l * 256 * 384, 256, 384, (bf16*)(wb + WL_UQ), a.in[11] + l * 256, scr, r, lane); continue; } r -= I_UQ;
            transpose_item(a.in[14] + (size_t)l * 128 * 512, 128, 512, (bf16*)(wb + WL_UKV), a.in[13] + l * 128, scr, r, lane);
        }
    }
}

DI void phase1(const Args& a, LAS unsigned char* lds, const int tid) {
    unsigned char* ws = a.ws;
    int G = gridDim.x; asm volatile("" : "+s"(G));
    const int bx = blockIdx.x;
    const float* mods = (const float*)(ws + WS_MODS);
    {
        LAS float* sl = (LAS float*)lds; LAS float* red = (LAS float*)(lds + 36864);
        float* bias1 = (float*)(ws + WS_BIAS1); float* bias4 = (float*)(ws + WS_BIAS4);
        for (int item = bx; item < DEPTH * 192; item += G) {
            const int l = item / 192, r = item % 192, which = r < 64 ? 0 : 1, tile = which ? r - 64 : r;
            const float* mv = mods + (size_t)l * 9 * 6144 + (which ? 3 : 0) * 1024;
            for (int idx = tid; idx < 9 * 1024; idx += NTHR) sl[idx] = mv[(size_t)(idx >> 10) * 6144 + (idx & 1023)];
            __syncthreads();
            if (!which) gemv9_item(a.in[8] + (size_t)l * 1024 * INW, INW, INW, tile * 32, sl, red, nullptr, bias1 + (size_t)l * 9 * 2048, 2048, tid);
            else gemv9_item(a.in[16] + (size_t)l * 1024 * DFF, DFF, DFF, tile * 32, sl, red, nullptr, bias4 + (size_t)l * 9 * 4096, 4096, tid);
        }
    }
    {
        const int lane = tid & 63, gw = bx * 8 + (tid >> 6), NGW = G * 8;
        bf16* Hn = (bf16*)(ws + WS_HN); float* ssqx = (float*)(ws + WS_SSQX); const float* g = a.in[6];
        f32x4 gg[4];
#pragma unroll
        for (int j = 0; j < 4; ++j) gg[j] = *(const GAS f32x4*)(g + 256 * j + 4 * lane);
        for (int row0 = gw; row0 < MT; row0 += 4 * NGW) {
            f32x4 v[4][4];
#pragma unroll
            for (int q = 0; q < 4; ++q) { const int row = row0 + q * NGW;
                if (row < MT) { const float* src = row < MX ? a.in[0] + (size_t)row * DM : a.in[2] + (size_t)(row - MX) * DM;
                    const GAS f32x4* xr = (const GAS f32x4*)src + lane;
#pragma unroll
                    for (int j = 0; j < 4; ++j) v[q][j] = xr[64 * j]; } }
#pragma unroll
            for (int q = 0; q < 4; ++q) { const int row = row0 + q * NGW;
                if (row < MT) { const int mi = row < MX ? (row >> 12) : 8; float s = 0.f;
#pragma unroll
                    for (int j = 0; j < 4; ++j) s += (v[q][j][0] * v[q][j][0] + v[q][j][1] * v[q][j][1]) + (v[q][j][2] * v[q][j][2] + v[q][j][3] * v[q][j][3]);
                    s = wave_sum(s);
                    if (lane == 0) ssqx[row] = s;
                    const float* mrow = mods + (size_t)mi * 6144 + 1024;
#pragma unroll
                    for (int j = 0; j < 4; ++j) { const int col = 256 * j + 4 * lane;
                        const f32x4 sc = *(const GAS f32x4*)(mrow + col);
                        st4bf(Hn + (size_t)row * DM + col, v[q][j] * (gg[j] * (sc + 1.0f))); } } }
        }
    }
}
DI void final_norm_phase(float* x, const float* g, const int tid) {
    const int lane = tid & 63, gw = blockIdx.x * 8 + (tid >> 6), NGW = gridDim.x * 8;
    f32x4 gg[4];
#pragma unroll
    for (int j = 0; j < 4; ++j) gg[j] = *(const GAS f32x4*)(g + 256 * j + 4 * lane);
    for (int row0 = gw; row0 < MX; row0 += 4 * NGW) {
        f32x4 v[4][4];
#pragma unroll
        for (int q = 0; q < 4; ++q) { const int row = row0 + q * NGW;
            if (row < MX) { const GAS f32x4* xr = (const GAS f32x4*)(x + (size_t)row * DM) + lane;
#pragma unroll
                for (int j = 0; j < 4; ++j) v[q][j] = xr[64 * j]; } }
#pragma unroll
        for (int q = 0; q < 4; ++q) { const int row = row0 + q * NGW;
            if (row < MX) { float s = 0.f;
#pragma unroll
                for (int j = 0; j < 4; ++j) s += (v[q][j][0] * v[q][j][0] + v[q][j][1] * v[q][j][1]) + (v[q][j][2] * v[q][j][2] + v[q][j][3] * v[q][j][3]);
                const float r = rsqrtf(wave_sum(s) * (1.0f / DM) + EPSN);
                GAS f32x4* xw = (GAS f32x4*)(x + (size_t)row * DM) + lane;
#pragma unroll
                for (int j = 0; j < 4; ++j) xw[64 * j] = v[q][j] * r * gg[j]; } }
    }
}

struct AttnP { const bf16 *proj, *qm, *kvm, *krr; bf16* mix; const float* sink; const float* rpb; };
constexpr int A_VS = 144, A_KB = 64 * 208, A_VB = 64 * A_VS, L_K = 0, L_V = 2 * A_KB, L_B = L_V + 2 * A_VB;

template <int TYPE> DI int key_row(int t, int j, int b, int nblk, int kr0, int kc0) {
    if (t < 4) return MX + b * 256 + t * 64 + j;
    const int tt = t - 4;
    if (TYPE == 0) return b * 4096 + (nblk - 1) * 128 + tt * 64 + j;
    if (TYPE == 1) { const int tr = tt / 3, tc = tt - 3 * tr; return b * 4096 + (kr0 + 4 * tr + (j >> 4)) * 64 + kc0 + 16 * tc + (j & 15); }
    if (TYPE == 3) { const int tr = tt >> 1, tc = tt & 1; return b * 4096 + (kr0 + 4 * tr + (j >> 4)) * 64 + kc0 + 16 * tc + (j & 15); }
    return b * 4096 + tt * 64 + j;
}

constexpr float ATHR = 6.0f;
#define AT_LDS_BARRIER() asm volatile("s_waitcnt lgkmcnt(0)\n\ts_barrier" ::: "memory")
template <int TYPE> struct AttnCtx { int t_qi, t_h, kr0, kc0, qr, qc, wr_, wc_; };

#define AT_SB() __builtin_amdgcn_sched_barrier(0)
template <int TYPE, int NKS, int KSTR> DI void at_mfma_block(f32x16& p0, f32x16& p1, f32x16& o0, f32x16& o1, const bf16x8 (&qf)[NKS], const bf16x8 (&pf)[4], float m_,
                                                             const LAS unsigned char* kb0, const LAS unsigned char* vb, bool do_s, bool do_pv) {
    constexpr int NST = NKS + 4, PD = (TYPE == 3) ? 1 : 2;
    bf16x8 fr[NST][2];
    const int first = do_s ? 0 : NKS, last = do_pv ? NST : NKS;
#define AT_LD(i_) do { if ((i_) >= first && (i_) < last) { \
        if ((i_) < NKS) { fr[i_][0] = *(const LAS bf16x8*)(kb0 + (i_) * 32); fr[i_][1] = *(const LAS bf16x8*)(kb0 + 32 * KSTR + (i_) * 32); } \
        else { const int s_ = (i_) - NKS; \
            const s16x4 l0_ = __builtin_bit_cast(s16x4, __builtin_amdgcn_ds_read_tr16_b64_v4i16((LAS s16x4*)(vb + (16 * s_) * A_VS))); \
            const s16x4 h0_ = __builtin_bit_cast(s16x4, __builtin_amdgcn_ds_read_tr16_b64_v4i16((LAS s16x4*)(vb + (16 * s_ + 8) * A_VS))); \
            const s16x4 l1_ = __builtin_bit_cast(s16x4, __builtin_amdgcn_ds_read_tr16_b64_v4i16((LAS s16x4*)(vb + (16 * s_) * A_VS + 64))); \
            const s16x4 h1_ = __builtin_bit_cast(s16x4, __builtin_amdgcn_ds_read_tr16_b64_v4i16((LAS s16x4*)(vb + (16 * s_ + 8) * A_VS + 64))); \
            fr[i_][0] = __builtin_shufflevector(l0_, h0_, 0, 1, 2, 3, 4, 5, 6, 7); fr[i_][1] = __builtin_shufflevector(l1_, h1_, 0, 1, 2, 3, 4, 5, 6, 7); } } } while (0)
    if (do_s) {
        const float nm = -m_;
#pragma unroll
        for (int i = 0; i < 16; ++i) { p0[i] = nm; p1[i] = nm; }
    }
#pragma unroll
    for (int i = 0; i < NST; ++i) {
        if (i == 0) { AT_LD(0); if (PD > 1) AT_LD(1); }
        if (i + PD < NST) AT_LD(i + PD);
        AT_SB();
        if (i >= first && i < last) {
            if (i < NKS) { p0 = __builtin_amdgcn_mfma_f32_32x32x16_bf16(fr[i][0], qf[i < NKS ? i : 0], p0, 0, 0, 0); p1 = __builtin_amdgcn_mfma_f32_32x32x16_bf16(fr[i][1], qf[i < NKS ? i : 0], p1, 0, 0, 0); }
            else { o0 = __builtin_amdgcn_mfma_f32_32x32x16_bf16(fr[i][0], pf[i >= NKS ? i - NKS : 0], o0, 0, 0, 0); o1 = __builtin_amdgcn_mfma_f32_32x32x16_bf16(fr[i][1], pf[i >= NKS ? i - NKS : 0], o1, 0, 0, 0); }
        }
        AT_SB();
    }
#undef AT_LD
}

template <int TYPE, bool GUARD> DI void at_valu_block(f32x16& p0, f32x16& p1, f32x16& o0, f32x16& o1, bf16x8 (&pf)[4], float& m_, float& l_, int t, bool first,
                                          int qi, int h, int kr0, int kc0, int qr, int qc, int wr_, int wc_, const LAS float* lbias) {
    if (t >= 4) {
        if (TYPE == 0) {
            const int d0 = 64 * (t - 4) - qi + 4 * h;
#pragma unroll
            for (int i = 0; i < 16; ++i) { const int e = d0 + (i & 3) + 8 * (i >> 2);
                if ((unsigned)e > 256u) p0[i] = -1e30f;
                if ((unsigned)(e + 32) > 256u) p1[i] = -1e30f; }
        } else if (TYPE == 1 || TYPE == 3) {
            const int tt = t - 4, tr = (TYPE == 3) ? (tt >> 1) : tt / 3, tc = (TYPE == 3) ? (tt & 1) : tt - 3 * tr;
            const int krb = kr0 + 4 * tr, kcb = kc0 + 16 * tc + 4 * h;
#pragma unroll
            for (int i = 0; i < 16; ++i) {
                const int kc = kcb + (i & 3) + 8 * ((i >> 2) & 1);
                const bool cv = (unsigned)(kc - wc_) < 16u;
                const int ci = kc - qc + 15;
                { const int kr = krb + (i >> 3); const bool v = cv && ((unsigned)(kr - wr_) < 8u); const int idx = v ? (kr - qr + 7) * 31 + ci : 0; const float bv = lbias[idx]; p0[i] = v ? p0[i] + bv : -1e30f; }
                { const int kr = krb + 2 + (i >> 3); const bool v = cv && ((unsigned)(kr - wr_) < 8u); const int idx = v ? (kr - qr + 7) * 31 + ci : 0; const float bv = lbias[idx]; p1[i] = v ? p1[i] + bv : -1e30f; }
            }
        }
    }
    if (GUARD && first) asm volatile("s_nop 15\n\ts_nop 7" : "+v"(p0), "+v"(p1));
    float mxa = max3f(p0[0], p0[1], p1[0]), mxb = max3f(p0[2], p0[3], p1[1]); mxa = max3f(mxa, p1[2], p1[3]);
#pragma unroll
    for (int i = 4; i < 16; i += 4) { mxa = max3f(mxa, p0[i], p0[i + 1]); mxb = max3f(mxb, p0[i + 2], p0[i + 3]); mxa = max3f(mxa, p1[i], p1[i + 1]); mxb = max3f(mxb, p1[i + 2], p1[i + 3]); }
    float mx = max3f(mxa, mxb, mxb);
    { const auto rr = __builtin_amdgcn_permlane32_swap(__float_as_uint(mx), __float_as_uint(mx), false, false); mx = max3f(__uint_as_float(rr[0]), __uint_as_float(rr[1]), mx); }
    if (first || __any(mx > ATHR)) {
        const float dl = (TYPE != 0 && first) ? mx : fmaxf(mx, 0.f);
        const float alpha = fexp2(-dl);
        m_ += dl; l_ *= alpha;
#pragma unroll
        for (int i = 0; i < 16; ++i) { p0[i] -= dl; p1[i] -= dl; o0[i] *= alpha; o1[i] *= alpha; }
    }
    float ls = 0.f;
#pragma unroll
    for (int i = 0; i < 16; ++i) { p0[i] = fexp2(p0[i]); p1[i] = fexp2(p1[i]); ls += p0[i] + p1[i]; }
    l_ += ls;
#pragma unroll
    for (int s = 0; s < 4; ++s) {
        u32x4 pw;
        if (s < 2) { pw.x = cvtpk(p0[8 * s + 0], p0[8 * s + 1]); pw.y = cvtpk(p0[8 * s + 2], p0[8 * s + 3]); pw.z = cvtpk(p0[8 * s + 4], p0[8 * s + 5]); pw.w = cvtpk(p0[8 * s + 6], p0[8 * s + 7]); }
        else { const int s2 = s - 2; pw.x = cvtpk(p1[8 * s2 + 0], p1[8 * s2 + 1]); pw.y = cvtpk(p1[8 * s2 + 2], p1[8 * s2 + 3]); pw.z = cvtpk(p1[8 * s2 + 4], p1[8 * s2 + 5]); pw.w = cvtpk(p1[8 * s2 + 6], p1[8 * s2 + 7]); }
        pf[s] = __builtin_bit_cast(bf16x8, pw);
    }
}

template <int TYPE> DI void attn_unit(const AttnP& P, int uid, bool isctx, LAS unsigned char* lds, const int tid) {
    constexpr int DQK = TYPE == 2 ? 96 : 64, NKS = DQK / 16, KSTR = DQK * 2 + 16;
    const int lane = tid & 63, w = __builtin_amdgcn_readfirstlane(tid >> 6), r = lane & 31, h = lane >> 5;
    int b, hd, kvh = 0, qrow, nblk = 0, kr0 = 0, kc0 = 0, qr = 0, qc = 0, tb0 = 4, tb1 = 4;
    if (TYPE == 0) {
        int gp;
        if (!isctx) { b = uid >> 7; kvh = (uid >> 6) & 1; nblk = (uid >> 1) & 31; gp = uid & 1; qrow = b * 4096 + nblk * 128 + (w & 3) * 32 + r; tb0 = nblk == 0 ? 6 : 4; tb1 = nblk == 31 ? 8 : 10; }
        else { b = uid >> 3; kvh = (uid >> 2) & 1; gp = (uid >> 1) & 1; nblk = uid & 1; qrow = MX + b * 256 + nblk * 128 + (w & 3) * 32 + r; }
        hd = kvh * 4 + gp * 2 + (w >> 2);
    } else if (TYPE == 1 || TYPE == 3) {
        if (!isctx) { b = uid >> 6; hd = (uid >> 4) & 3; const int ib = (uid >> 1) & 7, cp = uid & 1;
            qr = 8 * ib + 2 * (w & 3) + (r >> 4); qc = 16 * (2 * cp + (w >> 2)) + (r & 15); qrow = b * 4096 + qr * 64 + qc;
            kr0 = min(max(8 * ib - 4, 0), 48);
            if (TYPE == 3) { kc0 = min(max(16 * (2 * cp + (w >> 2)) - 8, 0), 32); tb1 = 12; }
            else { kc0 = 16 * cp; tb1 = 16; } }
        else { b = uid >> 2; hd = uid & 3; qrow = MX + b * 256 + w * 32 + r; }
    } else {
        if (!isctx) { b = uid >> 6; hd = (uid >> 4) & 3; qrow = b * 4096 + (uid & 15) * 256 + w * 32 + r; tb1 = 68; }
        else { b = uid >> 2; hd = uid & 3; qrow = MX + b * 256 + w * 32 + r; }
    }
    const int NTA = 4 + (tb1 - tb0);
    const bf16* qp; int ocol;
    if (TYPE == 0) { qp = P.proj + (size_t)qrow * PJS + hd * 64; ocol = hd * 64; }
    else if (TYPE == 1 || TYPE == 3) { qp = P.proj + (size_t)qrow * PJS + 768 + hd * 64; ocol = 512 + hd * 64; }
    else { qp = P.qm + (size_t)qrow * 384 + hd * 96; ocol = 768 + hd * 64; }
    bf16x8 qf[NKS];
#pragma unroll
    for (int ks = 0; ks < NKS; ++ks) qf[ks] = *(const GAS bf16x8*)(qp + 16 * ks + 8 * h);

    float m_ = 0.f, l_ = 0.f;
    if (TYPE == 0) { m_ = P.sink[hd] * LOG2E; l_ = (h == 0) ? 1.f : 0.f; }
    f32x16 o0, o1, p0, p1;
#pragma unroll
    for (int i = 0; i < 16; ++i) { o0[i] = 0.f; o1[i] = 0.f; p0[i] = 0.f; p1[i] = 0.f; }
    bf16x8 pf[4];
#pragma unroll
    for (int s = 0; s < 4; ++s) pf[s] = (bf16x8){0, 0, 0, 0, 0, 0, 0, 0};

    u32x4 kreg, vreg, rreg = {0u, 0u, 0u, 0u}, kreg2, vreg2;
    constexpr int A_HALF = 2 * A_KB + 2 * A_VB;
    const int HB = (TYPE == 3) ? (w >> 2) * A_HALF : 0;
    const int sj = (TYPE == 3) ? ((tid & 255) >> 3) : (tid >> 3), sc = tid & 7;
#define AT_TILE(it_) ((it_) < 4 ? (it_) : (it_) - 4 + tb0)
#define AT_LOADK(t) do { const int kr_ = key_row<TYPE>((t), sj, b, nblk, kr0, kc0); \
        if (TYPE == 2) { kreg = *(const GAS u32x4*)(P.kvm + (size_t)kr_ * 512 + hd * 128 + sc * 8); \
            if (tid < 256) { const int kr2_ = key_row<TYPE>((t), tid >> 2, b, nblk, kr0, kc0); rreg = *(const GAS u32x4*)(P.krr + (size_t)kr2_ * 32 + (tid & 3) * 8); } } \
        else { kreg = *(const GAS u32x4*)(P.proj + (size_t)kr_ * PJS + (TYPE == 0 ? 512 + kvh * 64 : 1024 + hd * 64) + sc * 8); \
            if (TYPE == 3) { const int kr2_ = key_row<TYPE>((t), sj + 32, b, nblk, kr0, kc0); kreg2 = *(const GAS u32x4*)(P.proj + (size_t)kr2_ * PJS + 1024 + hd * 64 + sc * 8); } } } while (0)
#define AT_LOADV(t) do { const int kr_ = key_row<TYPE>((t), sj, b, nblk, kr0, kc0); \
        if (TYPE == 2) vreg = *(const GAS u32x4*)(P.kvm + (size_t)kr_ * 512 + hd * 128 + 64 + sc * 8); \
        else { vreg = *(const GAS u32x4*)(P.proj + (size_t)kr_ * PJS + (TYPE == 0 ? 640 + kvh * 64 : 1280 + hd * 64) + sc * 8); \
            if (TYPE == 3) { const int kr2_ = key_row<TYPE>((t), sj + 32, b, nblk, kr0, kc0); vreg2 = *(const GAS u32x4*)(P.proj + (size_t)kr2_ * PJS + 1280 + hd * 64 + sc * 8); } } } while (0)
#define AT_STOREK(bi) do { *(LAS u32x4*)(lds + HB + L_K + (bi) * A_KB + sj * KSTR + sc * 16) = kreg; \
        if (TYPE == 3) *(LAS u32x4*)(lds + HB + L_K + (bi) * A_KB + (sj + 32) * KSTR + sc * 16) = kreg2; \
        if (TYPE == 2) { if (tid < 256) *(LAS u32x4*)(lds + L_K + (bi) * A_KB + (tid >> 2) * KSTR + 128 + (tid & 3) * 16) = rreg; } } while (0)
#define AT_STOREV(bi) do { *(LAS u32x4*)(lds + HB + L_V + (bi) * A_VB + sj * A_VS + sc * 16) = vreg; \
        if (TYPE == 3) *(LAS u32x4*)(lds + HB + L_V + (bi) * A_VB + (sj + 32) * A_VS + sc * 16) = vreg2; } while (0)
    AT_LOADK(0);
    __syncthreads();
    LAS float* lbias = (LAS float*)(lds + (TYPE == 3 ? 2 * A_HALF : L_B));
    if ((TYPE == 1 || TYPE == 3) && !isctx) { if (tid < 465) lbias[tid] = ((const GAS float*)P.rpb)[hd * 465 + tid] * LOG2E; }
    AT_STOREK(0);
    AT_LOADK(AT_TILE(1)); AT_LOADV(0);
    AT_LDS_BARRIER();
    const int q4 = (lane & 15) >> 2, p4 = lane & 3, blk = (lane >> 4) & 1;
    const int voff = HB + L_V + (4 * h + q4) * A_VS + (16 * blk + 4 * p4) * 2;
    const int koff = HB + L_K + r * KSTR + 16 * h;
    const int wr_ = min(max(qr - 4, 0), 56), wc_ = min(max(qc - 8, 0), 48);
    const int qi = (w & 3) * 32 + r;
    const bool grp1 = (w >> 2) != 0;

#define AT_STAGE(it) do { if ((it) + 1 < NTA) AT_STOREK(((it) + 1) & 1); AT_STOREV((it) & 1); \
        if ((it) + 2 < NTA) AT_LOADK(AT_TILE((it) + 2)); if ((it) + 1 < NTA) AT_LOADV(AT_TILE((it) + 1)); AT_LDS_BARRIER(); } while (0)
    if (!grp1) {
        for (int it = 0; it < NTA; ++it) {
            const int t = AT_TILE(it);
            const LAS unsigned char* kb0 = lds + (it & 1) * A_KB + koff;
            const LAS unsigned char* vb = lds + ((it + 1) & 1) * A_VB + voff;
            at_mfma_block<TYPE, NKS, KSTR>(p0, p1, o0, o1, qf, pf, m_, kb0, vb, true, it > 0);
            at_valu_block<TYPE, true>(p0, p1, o0, o1, pf, m_, l_, t, it == 0, qi, h, kr0, kc0, qr, qc, wr_, wc_, lbias);
            AT_STAGE(it);
        }
        const LAS unsigned char* vb = lds + ((NTA - 1) & 1) * A_VB + voff;
        at_mfma_block<TYPE, NKS, KSTR>(p0, p1, o0, o1, qf, pf, m_, vb, vb, false, true);
    } else {
        for (int it = 0; it < NTA; ++it) {
            const int tp = AT_TILE(it - 1);
            const LAS unsigned char* kb0 = lds + (it & 1) * A_KB + koff;
            const LAS unsigned char* vb = lds + ((it + 1) & 1) * A_VB + voff;
            if (it > 0) at_valu_block<TYPE, false>(p0, p1, o0, o1, pf, m_, l_, tp, it == 1, qi, h, kr0, kc0, qr, qc, wr_, wc_, lbias);
            at_mfma_block<TYPE, NKS, KSTR>(p0, p1, o0, o1, qf, pf, m_, kb0, vb, true, it > 0);
            AT_STAGE(it);
        }
        const LAS unsigned char* vb = lds + ((NTA - 1) & 1) * A_VB + voff;
        at_valu_block<TYPE, false>(p0, p1, o0, o1, pf, m_, l_, AT_TILE(NTA - 1), false, qi, h, kr0, kc0, qr, qc, wr_, wc_, lbias);
        at_mfma_block<TYPE, NKS, KSTR>(p0, p1, o0, o1, qf, pf, m_, vb, vb, false, true);
    }
#undef AT_STAGE
#undef AT_LOADK
#undef AT_LOADV
#undef AT_STOREK
#undef AT_STOREV
#undef AT_TILE
    const float lt = l_ + __shfl_xor(l_, 32), inv = 1.0f / lt;
    bf16* op = P.mix + (size_t)qrow * DM + ocol + 4 * h;
#pragma unroll
    for (int g = 0; g < 4; ++g) {
        const f32x4 v0 = {o0[4 * g] * inv, o0[4 * g + 1] * inv, o0[4 * g + 2] * inv, o0[4 * g + 3] * inv};
        const f32x4 v1 = {o1[4 * g] * inv, o1[4 * g + 1] * inv, o1[4 * g + 2] * inv, o1[4 * g + 3] * inv};
        st4bf(op + 8 * g, v0); st4bf(op + 32 + 8 * g, v1);
    }
}

DI void attn_phase(const AttnP& P, bool last, LAS unsigned char* lds, const int tid_in) {
    const int G = gridDim.x, bx = blockIdx.x;
    const int vcu = (G % 8 == 0) ? (bx % 8) * (G / 8) + bx / 8 : bx;
    const int NU = 2048 + (last ? 0 : 128);
    for (int u = vcu; u < NU; u += G) {
        int tid = tid_in; asm volatile("" : "+v"(tid));
        if (u < 512) attn_unit<2>(P, u, false, lds, tid);
        else if (u < 1024) attn_unit<3>(P, u - 512, false, lds, tid);
        else if (u < 2048) attn_unit<0>(P, u - 1024, false, lds, tid);
        else if (u < 2080) attn_unit<2>(P, u - 2048, true, lds, tid);
        else if (u < 2112) attn_unit<1>(P, u - 2080, true, lds, tid);
        else attn_unit<0>(P, u - 2112, true, lds, tid);
    }
}

#define XB_TMO      128
#define XB_XCNT(j)  (256  + 64 * (j))
#define XB_XSUB(j)  (1280 + 64 * (j))
#define XB_XGEN(j)  (2304 + 64 * (j))
#define XB_TOP      3328
#define XB_TOPGEN   3392
#define XCD_BAR_WORDS 3456
#define XB_SPIN_CAP (1u << 18)

__device__ __forceinline__ unsigned xb_ld(unsigned* p)              { return __hip_atomic_load(p, __ATOMIC_RELAXED, __HIP_MEMORY_SCOPE_AGENT); }
__device__ __forceinline__ unsigned xb_add(unsigned* p, unsigned v) { return __hip_atomic_fetch_add(p, v, __ATOMIC_RELAXED, __HIP_MEMORY_SCOPE_AGENT); }
__device__ __forceinline__ unsigned xb_xcc_id() { return (unsigned)__builtin_amdgcn_s_getreg((3 << 11) | 20) & 0xFu; }
#define XB_SPIN(cond, bar) do { unsigned _sp = 0; while (cond) { __builtin_amdgcn_s_sleep(1); \
    if ((++_sp & 255u) == 0u) { if (xb_ld(&(bar)[XB_TMO])) break; if (_sp > XB_SPIN_CAP) { atomicAdd(&(bar)[XB_TMO], 1u); break; } } } } while (0)

struct XcdBarrier {
    unsigned* bar; unsigned x;
    volatile LAS unsigned* st;
};

__device__ __forceinline__ XcdBarrier xcd_barrier_post(unsigned* bar, volatile LAS unsigned* st) {
    XcdBarrier b; b.bar = bar; b.x = xb_xcc_id(); b.st = st;
    if (threadIdx.x == 0) (void)xb_add(&bar[XB_XCNT(b.x)], 1u);
    return b;
}
__device__ __forceinline__ void xcd_barrier_complete(unsigned* bar, unsigned x, unsigned& nloc, unsigned& nx) {
    const unsigned G = gridDim.x * gridDim.y * gridDim.z;
    unsigned sum, cnt, mine, sp = 0u;
    for (;;) {
        sum = 0u; cnt = 0u; mine = 0u;
#pragma unroll
        for (unsigned j = 0; j < 16; ++j) { const unsigned c = xb_ld(&bar[XB_XCNT(j)]); sum += c; cnt += (c > 0u) ? 1u : 0u; mine = (j == x) ? c : mine; }
        if (sum == G) break;
        __builtin_amdgcn_s_sleep(1);
        if ((++sp & 255u) == 0u) { if (xb_ld(&bar[XB_TMO])) break; if (sp > XB_SPIN_CAP) { atomicAdd(&bar[XB_TMO], 1u); break; } }
    }
    nloc = mine > 0u ? mine : 1u; nx = cnt > 0u ? cnt : 1u;
}

__device__ __forceinline__ void xcd_barrier(const XcdBarrier& b) {
    asm volatile("s_waitcnt vmcnt(0)" ::: "memory");
    __syncthreads();
    if (threadIdx.x == 0) {
        unsigned* bar = b.bar;
        __builtin_amdgcn_s_waitcnt(0);
        unsigned nloc = b.st[0], nx = b.st[1];
        if (nloc == 0u) { xcd_barrier_complete(bar, b.x, nloc, nx); b.st[0] = nloc; b.st[1] = nx; }
        const unsigned old = xb_add(&bar[XB_XSUB(b.x)], 1u);
        const unsigned gen = old / nloc;
        if (old + 1u == (gen + 1u) * nloc) {
            __builtin_amdgcn_fence(__ATOMIC_RELEASE, "agent");
            asm volatile("s_waitcnt vmcnt(0)" ::: "memory");
            const unsigned og = xb_add(&bar[XB_TOP], 1u);
            const unsigned tg = og / nx;
            if (og + 1u == (tg + 1u) * nx) xb_add(&bar[XB_TOPGEN], 1u);
            else XB_SPIN(xb_ld(&bar[XB_TOPGEN]) == tg, bar);
            __builtin_amdgcn_fence(__ATOMIC_ACQUIRE, "agent");
            xb_add(&bar[XB_XGEN(b.x)], 1u);
            asm volatile("s_waitcnt vmcnt(0)" ::: "memory");
        } else {
            XB_SPIN(xb_ld(&bar[XB_XGEN(b.x)]) == gen, bar);
            __builtin_amdgcn_fence(__ATOMIC_ACQUIRE, "agent");
            asm volatile("s_waitcnt vmcnt(0)" ::: "memory");
        }
    }
    __syncthreads();
}

constexpr int NPH = 3 + 6 * DEPTH;
__global__ void __launch_bounds__(NTHR) mk_fwd(Args a) {
    extern __shared__ __attribute__((aligned(16))) unsigned char lds_raw[];
    LAS unsigned char* lds = (LAS unsigned char*)lds_raw;
    const int G = gridDim.x, bx = blockIdx.x;
    const int ph_lo = a.ph_lo, ph_hi = a.ph_hi;
    volatile LAS unsigned* bst = (volatile LAS unsigned*)(lds + 131072);
    if (threadIdx.x < 2) bst[threadIdx.x] = 0u;
    __syncthreads();
    XcdBarrier xbar; xbar.bar = (unsigned*)(a.ws + WS_BAR); xbar.x = 0; xbar.st = bst;
    if (!MK_PER_PHASE) xbar = xcd_barrier_post((unsigned*)(a.ws + WS_BAR), bst);

    for (int ph = ph_lo; ph < ph_hi;) {
        int tid = threadIdx.x; asm volatile("" : "+v"(tid));
        unsigned char* ws = a.ws; asm volatile("" : "+s"(ws));
        float* mods = (float*)(ws + WS_MODS);
        const float* tabA = (const float*)(ws + WS_TAB); const float* tabC = tabA + 2048;
        float* Xc = (float*)(ws + WS_XC);
        bf16* Hn = (bf16*)(ws + WS_HN); bf16* H1 = (bf16*)(ws + WS_H1);
        bf16* proj = (bf16*)(ws + WS_PROJ); bf16* cqb = (bf16*)(ws + WS_CQ); bf16* ckvb = (bf16*)(ws + WS_CKV);
        bf16* qm = (bf16*)(ws + WS_QM); bf16* kvm = (bf16*)(ws + WS_KVM); bf16* krr = (bf16*)(ws + WS_KRR); bf16* mix = (bf16*)(ws + WS_MIX);

        if (ph == 0) prologue(a, lds, tid);
        else if (ph == 1) phase1(a, lds, tid);
        else if (ph == NPH - 1) final_norm_phase(a.out, a.in[18], tid);
        else {
            const int l = (ph - 2) / 6, s = (ph - 2) - 6 * l; const bool last = (l == DEPTH - 1);
            unsigned char* wb = ws + WS_W + (size_t)l * WL_STRIDE;
            const float* mods_l = mods + (size_t)l * 9 * 6144;
            float* ssq_q = (float*)(ws + WS_SSQ) + (size_t)l * 2 * MT; float* ssq_kv = ssq_q + MT;
            float* ssqx1 = (float*)(ws + WS_SSQX) + (size_t)l * 2 * MT; float* ssqx2 = ssqx1 + MT;
            const float* xsrc = (l == 0) ? a.in[0] : a.out;
            const float* csrc = (l == 0) ? a.in[2] : Xc;
            float* part = (float*)(ws + WS_PART);
            if (s == 0) {
                if (l > 0) {
                    const float* mods_p = mods + (size_t)(l - 1) * 9 * 6144;
                    ctx_finish(part, 8, Xc, Xc, mods_p + 5 * 1024 + 8 * 6144, Hn, ssqx1, a.in[6] + l * DM, mods_l + 1 * 1024 + 8 * 6144, tid);
                    xcd_barrier(xbar);
                }
                pg8::Gemm g{Hn, (const bf16*)(wb + WL_IN), MT, 2048, DM, DM}; pg8::StaticOrder S; S.init(MT, 2048, G, bx);
                EpiInProj E{proj, cqb, ckvb, krr, ssq_q, ssq_kv, tabA, tabC, ssqx1, (const float*)(ws + WS_BIAS1) + (size_t)l * 9 * 2048};
                pg8::gemm_phase<EpiInProj, pg8::StaticOrder, true, true>(lds, g, S, E, tid);
            } else if (s == 1) {
                { int Kq = 256; asm volatile("" : "+s"(Kq)); pg8::Gemm g{cqb, (const bf16*)(wb + WL_UQ), MT, 512, Kq, Kq}; pg8::StaticOrder S; S.init(MT, 512, G, bx);
                  EpiUQ E{qm, ssq_q, tabC}; pg8::gemm_phase<EpiUQ, pg8::StaticOrder, true, true>(lds, g, S, E, tid); }
                { int Kk = 128; asm volatile("" : "+s"(Kk)); pg8::Gemm g{ckvb, (const bf16*)(wb + WL_UKV), MT, 512, Kk, Kk}; pg8::StaticOrder S; S.init(MT, 512, G, (bx + G / 2) % G);
                  EpiUKV E{kvm, ssq_kv}; pg8::gemm_phase<EpiUKV, pg8::StaticOrder, true, true>(lds, g, S, E, tid); }
            } else if (s == 2) {
                AttnP P{proj, qm, kvm, krr, mix, a.in[9] + l * 8, a.in[10] + l * 4 * 465};
                attn_phase(P, last, lds, tid);
            } else if (s == 3 || s == 5) {
                const bool outp = (s == 3);
                const int Kfull = outp ? DM : DFF;
                {
                    pg8::Gemm g{outp ? mix : H1, (const bf16*)(wb + (outp ? WL_OUT : WL_W2)), MX, DM, Kfull, Kfull}; pg8::StaticOrder S; S.init(MX, DM, G, bx);
                    const int ln = outp ? l : l + 1;
                    const float* mods_n = mods + (size_t)(ln < DEPTH ? ln : 0) * 9 * 6144;
                    EpiResid E{(outp ? xsrc : a.out), (outp ? csrc : Xc), a.out, Xc, mods_l + (outp ? 2 : 5) * 1024, Hn,
                               outp ? ssqx2 : ssqx1 + (size_t)2 * MT, (outp ? a.in[7] : a.in[6]) + (ln < DEPTH ? ln : 0) * DM, mods_n + (outp ? 4 : 1) * 1024, (outp || !last) ? 1 : 0};
                    pg8::gemm_phase<EpiResid, pg8::StaticOrder, true, true>(lds, g, S, E, tid);
                }
                if (!last) {
                    const int NSs = outp ? 4 : 8;
                    int Ks = Kfull / NSs; asm volatile("" : "+s"(Ks));
                    pg8::Gemm g{outp ? mix : H1, (const bf16*)(wb + (outp ? WL_OUT : WL_W2)), MT, DM, Ks, Kfull}; SplitOrder S; S.init(G, (bx + G / 2) % G, NSs, Ks);
                    EpiPartial E{part, Ks * 2};
                    pg8::gemm_phase<EpiPartial, SplitOrder, true, true>(lds, g, S, E, tid);
                }
            } else {
                const int Mr = last ? MX : MT;
                if (!last) {
                    ctx_finish(part, 4, csrc, Xc, mods_l + 2 * 1024 + 8 * 6144, Hn, ssqx2, a.in[7] + l * DM, mods_l + 4 * 1024 + 8 * 6144, tid);
                    xcd_barrier(xbar);
                }
                pg8::Gemm g{Hn, (const bf16*)(wb + WL_W1), Mr, DFF, DM, DM}; pg8::StaticOrder S; S.init(Mr, DFF, G, bx);
                EpiRelu2 E{H1, ssqx2, (const float*)(ws + WS_BIAS4) + (size_t)l * 9 * 4096}; pg8::gemm_phase<EpiRelu2, pg8::StaticOrder, true, true>(lds, g, S, E, tid);
            }
        }
        ++ph;
        if (ph < ph_hi) { if (ph == 1) cg::this_grid().sync(); else xcd_barrier(xbar); }
    }
}

extern "C" void kernel_launch(void* const* d_in, const int* in_sizes, int n_in, void* d_out, int out_size, void* d_ws, size_t ws_size, hipStream_t stream) {
    static int grid = 0;
    if (grid == 0) {
        if (n_in != 19 || ws_size < WS_END) { fprintf(stderr, "kernel_launch: unexpected inputs (n_in %d, ws %zu)\n", n_in, ws_size); grid = -1; return; }
        int dev = 0, cus = 0, per_cu = 0;
        hipGetDevice(&dev); hipDeviceGetAttribute(&cus, hipDeviceAttributeMultiprocessorCount, dev);
        hipFuncSetAttribute((const void*)mk_fwd, hipFuncAttributeMaxDynamicSharedMemorySize, LDS_BYTES);
        hipOccupancyMaxActiveBlocksPerMultiprocessor(&per_cu, (const void*)mk_fwd, NTHR, LDS_BYTES);
        if (per_cu < 1) { fprintf(stderr, "kernel_launch: occupancy query says %d\n", per_cu); per_cu = 1; }
        (void)hipGetLastError();
        grid = cus * 1;
    }
    if (grid < 0) return;
    Args a{};
    for (int i = 0; i < 19; ++i) a.in[i] = (const float*)d_in[i];
    a.out = (float*)d_out; a.ws = (unsigned char*)d_ws;
#if MK_PER_PHASE
    for (int ph = 0; ph < NPH; ++ph) { a.ph_lo = ph; a.ph_hi = ph + 1; hipLaunchKernelGGL(mk_fwd, dim3(grid), dim3(NTHR), LDS_BYTES, stream, a); }
#else
    a.ph_lo = 0; a.ph_hi = NPH;
    (void)hipMemsetAsync((unsigned char*)d_ws + WS_BAR, 0, 16384, stream);
    void* args[] = {&a};
    hipError_t e = hipLaunchCooperativeKernel((const void*)mk_fwd, dim3(grid), dim3(NTHR), args, LDS_BYTES, stream);
    if (e != hipSuccess) fprintf(stderr, "cooperative launch failed: %s (grid %d)\n", hipGetErrorString(e), grid);
#endif
}
```
